# Optimizing an MI355X kernel written in HIP

```python
import jax, jax.numpy as jnp
from jax import lax
import numpy as np

D_MODEL = 1024
BATCH = 2
SEQ = 8192
DEPTH = 1

D_MIX = D_MODEL
D_ATTN = D_MIX // 2
HEAD_DIM_ATTN = 64
N_HEADS_ATTN = D_ATTN // HEAD_DIM_ATTN
D_MLSTM = D_MIX - D_ATTN
HEAD_DIM_MLSTM = 128
N_HEADS_MLSTM = D_MLSTM // HEAD_DIM_MLSTM
IN_SPLITS = (D_ATTN, 2 * D_ATTN, 3 * D_ATTN, 3 * D_ATTN + D_MLSTM, 3 * D_ATTN + 2 * D_MLSTM,
             3 * D_ATTN + 3 * D_MLSTM, 3 * D_ATTN + 3 * D_MLSTM + N_HEADS_MLSTM)
D_IN = 3 * D_ATTN + 3 * D_MLSTM + 2 * N_HEADS_MLSTM
DILATED_BRANCHES = ((128, 1), (512, 4), (2048, 16))
MAX_WINDOW = 2048
Q_BLOCK = 128
CONV_K = 4
MLSTM_CHUNK = 64
N_EXPERTS = 32
TOP_K = 4
D_FF = D_MODEL
SWIGLU_LIMIT = 7.0
SWIGLU_ALPHA = 1.702
EXPERT_BLOCK = 128
EPS = 1e-6

kernel_name = 'hybrid_dilated_attn_mlstm_moe'


def rmsnorm(x, g):
    xf = x.astype(jnp.float32)
    y = xf * lax.rsqrt(jnp.mean(xf * xf, axis=-1, keepdims=True) + EPS)
    return (y * g.astype(jnp.float32)).astype(x.dtype)


def alibi_slopes(n):
    return jnp.exp2(-8.0 * jnp.arange(1, n + 1, dtype=jnp.float32) / n)


def dilated_sliding_attention(q, k, v, slopes):
    B, H, S, Dh = q.shape
    pad = ((0, 0), (0, 0), (MAX_WINDOW, 0), (0, 0))
    k_pad = jnp.pad(k, pad)
    v_pad = jnp.pad(v, pad)
    n_blocks = S // Q_BLOCK

    def query_block(blk):
        t0 = blk * Q_BLOCK
        qb = lax.dynamic_slice_in_dim(q, t0, Q_BLOCK, axis=2)
        pos = t0 + jnp.arange(Q_BLOCK)
        outs, lses = [], []
        for window, dil in DILATED_BRANCHES:
            dist = dil * jnp.arange(window // dil + 1)
            kpos = pos[:, None] - dist[None, :]
            idx = (kpos + MAX_WINDOW).reshape(-1)
            kg = jnp.take(k_pad, idx, axis=2).reshape(B, H, Q_BLOCK, -1, Dh)
            vg = jnp.take(v_pad, idx, axis=2).reshape(B, H, Q_BLOCK, -1, Dh)
            s = jnp.einsum('bhqd,bhqnd->bhqn', qb, kg).astype(jnp.float32)
            s = s - slopes[:, None, None] * dist.astype(jnp.float32)
            s = jnp.where(kpos >= 0, s, -jnp.inf)
            m = jnp.max(s, axis=-1, keepdims=True)
            p = jnp.exp(s - m)
            denom = jnp.sum(p, axis=-1)
            o = jnp.einsum('bhqn,bhqnd->bhqd', p, vg.astype(jnp.float32)) / denom[..., None]
            outs.append(o)
            lses.append(m[..., 0] + jnp.log(denom))
        w = jax.nn.softmax(jnp.stack(lses), axis=0)
        return jnp.einsum('rbhq,rbhqd->bhqd', w, jnp.stack(outs))

    o = lax.map(query_block, jnp.arange(n_blocks))
    return jnp.moveaxis(o, 0, 2).reshape(B, H, S, Dh).astype(q.dtype)


def mlstm_chunkwise(q, k, v, i_pre, f_pre):
    B, NH, S, DH = q.shape
    L = MLSTM_CHUNK
    nc = S // L

    def chunks(t):
        return jnp.moveaxis(t.astype(jnp.float32).reshape(B, NH, nc, L, *t.shape[3:]), 2, 0)

    log_f = jax.nn.log_sigmoid(f_pre.astype(jnp.float32))
    causal = jnp.tril(jnp.ones((L, L), dtype=bool))

    def step(carry, inp):
        C, n, m = carry
        qc, kc, vc, ic, lfc = inp
        b = jnp.cumsum(lfc, axis=-1)
        log_d = jnp.where(causal, b[..., :, None] - b[..., None, :] + ic[..., None, :], -jnp.inf)
        log_inter = b + m[..., None]
        m_t = jnp.maximum(log_inter, jnp.max(log_d, axis=-1))
        d = jnp.exp(log_d - m_t[..., None])
        inter = jnp.exp(log_inter - m_t)
        s = jnp.einsum('bhtd,bhsd->bhts', qc, kc) * d
        num = jnp.einsum('bhts,bhse->bhte', s, vc) + inter[..., None] * jnp.einsum('bhtd,bhde->bhte', qc, C)
        den = jnp.sum(s, axis=-1) + inter * jnp.einsum('bhtd,bhd->bht', qc, n)
        h = num / jnp.maximum(jnp.abs(den), jnp.exp(-m_t))[..., None]
        b_last = b[..., -1]
        log_w = b_last[..., None] - b + ic
        m_new = jnp.maximum(b_last + m, jnp.max(log_w, axis=-1))
        w = jnp.exp(log_w - m_new[..., None])
        decay = jnp.exp(b_last + m - m_new)
        C_new = decay[..., None, None] * C + jnp.einsum('bhs,bhsd,bhse->bhde', w, kc, vc)
        n_new = decay[..., None] * n + jnp.einsum('bhs,bhsd->bhd', w, kc)
        return (C_new, n_new, m_new), h

    init = (jnp.zeros((B, NH, DH, DH), jnp.float32), jnp.zeros((B, NH, DH), jnp.float32),
            jnp.zeros((B, NH), jnp.float32))
    _, hs = lax.scan(step, init, (chunks(q), chunks(k), chunks(v), chunks(i_pre), chunks(log_f)))
    return jnp.moveaxis(hs, 0, 2).reshape(B, NH, S, DH)


def moe_ffn(h, w_router, b_router, w_gate_up, b_gate_up, w_down, b_down):
    B, S, D = h.shape
    T = B * S
    A = T * TOP_K
    xf = h.reshape(T, D)
    logits = jnp.dot(xf, w_router).astype(jnp.float32) + b_router.astype(jnp.float32)
    top_v, top_e = lax.top_k(logits, TOP_K)
    gates = jax.nn.softmax(top_v, axis=-1)
    flat_e = top_e.reshape(A)
    order = jnp.argsort(flat_e).astype(jnp.int32)
    sizes = jnp.bincount(flat_e, length=N_EXPERTS)
    starts = jnp.cumsum(sizes) - sizes
    psizes = (sizes + EXPERT_BLOCK - 1) // EXPERT_BLOCK * EXPERT_BLOCK
    pends = jnp.cumsum(psizes)
    pstarts = pends - psizes
    e_sorted = flat_e[order]
    dest = pstarts[e_sorted] + (jnp.arange(A) - starts[e_sorted])
    n_blocks = -(-A // EXPERT_BLOCK) + N_EXPERTS
    n_slots = n_blocks * EXPERT_BLOCK
    slot_assign = jnp.full((n_slots,), A, jnp.int32).at[dest].set(order)
    slot_token = slot_assign // TOP_K
    slot_gate = jnp.concatenate([gates.reshape(A), jnp.zeros((1,), jnp.float32)])[slot_assign]
    block_expert = jnp.minimum(jnp.searchsorted(pends, jnp.arange(n_blocks) * EXPERT_BLOCK, side='right'),
                               N_EXPERTS - 1)
    x_ext = jnp.concatenate([xf, jnp.zeros((1, D), xf.dtype)], axis=0)

    def expert_block(args):
        tok, e = args
        xb = x_ext[tok]
        gu = jnp.dot(xb, w_gate_up[e]) + b_gate_up[e]
        gate = jnp.minimum(gu[:, :D_FF], SWIGLU_LIMIT)
        up = jnp.clip(gu[:, D_FF:], -SWIGLU_LIMIT, SWIGLU_LIMIT)
        act = gate * jax.nn.sigmoid(SWIGLU_ALPHA * gate) * (up + 1.0)
        return jnp.dot(act, w_down[e]) + b_down[e]

    ys = lax.map(expert_block, (slot_token.reshape(n_blocks, EXPERT_BLOCK), block_expert))
    ys = ys.reshape(n_slots, D) * slot_gate[:, None].astype(ys.dtype)
    out = jax.ops.segment_sum(ys, slot_token, num_segments=T + 1)[:T]
    return out.reshape(B, S, D)


def setup_inputs(seed: int = 0) -> dict:
    key = jax.random.key(seed)
    ks = jax.random.split(key, 20)

    def nrm(k, shape, scale):
        return scale * jax.random.normal(k, shape, jnp.float32)

    L = DEPTH
    return {
        'x': nrm(ks[0], (BATCH, SEQ, D_MODEL), 1.0),
        'norm1_g': 1.0 + nrm(ks[1], (L, D_MODEL), 0.1),
        'w_in': nrm(ks[2], (L, D_MODEL, D_IN), D_MODEL ** -0.5),
        'q_norm_g': 1.0 + nrm(ks[3], (L, HEAD_DIM_ATTN), 0.1),
        'k_norm_g': 1.0 + nrm(ks[4], (L, HEAD_DIM_ATTN), 0.1),
        'conv_w': nrm(ks[5], (L, CONV_K, D_MLSTM), CONV_K ** -0.5),
        'conv_b': nrm(ks[6], (L, D_MLSTM), 0.02),
        'w_mq': nrm(ks[7], (L, N_HEADS_MLSTM, HEAD_DIM_MLSTM, HEAD_DIM_MLSTM), HEAD_DIM_MLSTM ** -0.5),
        'w_mk': nrm(ks[8], (L, N_HEADS_MLSTM, HEAD_DIM_MLSTM, HEAD_DIM_MLSTM), HEAD_DIM_MLSTM ** -0.5),
        'b_igate': nrm(ks[9], (L, N_HEADS_MLSTM), 0.1),
        'b_fgate': jnp.linspace(3.0, 6.0, N_HEADS_MLSTM)[None, :] + nrm(ks[10], (L, N_HEADS_MLSTM), 0.1),
        'mh_norm_g': 1.0 + nrm(ks[11], (L, N_HEADS_MLSTM, HEAD_DIM_MLSTM), 0.1),
        'w_out': nrm(ks[12], (L, D_MIX, D_MODEL), D_MIX ** -0.5),
        'norm2_g': 1.0 + nrm(ks[13], (L, D_MODEL), 0.1),
        'w_router': nrm(ks[14], (L, D_MODEL, N_EXPERTS), D_MODEL ** -0.5),
        'b_router': nrm(ks[15], (L, N_EXPERTS), 0.01),
        'w_gate_up': nrm(ks[16], (L, N_EXPERTS, D_MODEL, 2 * D_FF), D_MODEL ** -0.5),
        'b_gate_up': nrm(ks[17], (L, N_EXPERTS, 2 * D_FF), 0.02),
        'w_down': nrm(ks[18], (L, N_EXPERTS, D_FF, D_MODEL), D_FF ** -0.5),
        'b_down': nrm(ks[19], (L, N_EXPERTS, D_MODEL), 0.02),
    }


def reference(x, norm1_g, w_in, q_norm_g, k_norm_g, conv_w, conv_b, w_mq, w_mk, b_igate, b_fgate,
              mh_norm_g, w_out, norm2_g, w_router, b_router, w_gate_up, b_gate_up, w_down, b_down):
    B, S, _ = x.shape
    slopes = alibi_slopes(N_HEADS_ATTN)

    def heads(t, nh, dh):
        return t.reshape(B, S, nh, dh).transpose(0, 2, 1, 3)

    for l in range(DEPTH):
        h = rmsnorm(x, norm1_g[l])
        z = jnp.einsum('bsd,de->bse', h, w_in[l])
        q_a, k_a, v_a, x_m, v_m, o_m, i_pre, f_pre = jnp.split(z, IN_SPLITS, axis=-1)

        qa = rmsnorm(heads(q_a, N_HEADS_ATTN, HEAD_DIM_ATTN), q_norm_g[l]) * (HEAD_DIM_ATTN ** -0.5)
        ka = rmsnorm(heads(k_a, N_HEADS_ATTN, HEAD_DIM_ATTN), k_norm_g[l])
        va = heads(v_a, N_HEADS_ATTN, HEAD_DIM_ATTN)
        attn = dilated_sliding_attention(qa, ka, va, slopes)
        attn = attn.transpose(0, 2, 1, 3).reshape(B, S, D_ATTN).astype(x.dtype)

        xp = jnp.pad(x_m, ((0, 0), (CONV_K - 1, 0), (0, 0)))
        xc = conv_b[l] + xp[:, 0:S, :] * conv_w[l, 0]
        for j in range(1, CONV_K):
            xc = xc + xp[:, j:j + S, :] * conv_w[l, j]
        xc = jax.nn.silu(xc).reshape(B, S, N_HEADS_MLSTM, HEAD_DIM_MLSTM)
        qm = jnp.einsum('bshd,hde->bhse', xc, w_mq[l])
        km = jnp.einsum('bshd,hde->bhse', xc, w_mk[l]) * (HEAD_DIM_MLSTM ** -0.5)
        vm = heads(v_m, N_HEADS_MLSTM, HEAD_DIM_MLSTM)
        ig = (i_pre + b_igate[l]).transpose(0, 2, 1)
        fg = (f_pre + b_fgate[l]).transpose(0, 2, 1)
        hm = mlstm_chunkwise(qm, km, vm, ig, fg)
        hm = rmsnorm(hm, mh_norm_g[l][:, None, :])
        hm = hm.transpose(0, 2, 1, 3).reshape(B, S, D_MLSTM).astype(x.dtype)
        mlstm_out = jax.nn.sigmoid(o_m) * hm

        mixed = jnp.concatenate([attn, mlstm_out], axis=-1)
        x = x + jnp.einsum('bse,ed->bsd', mixed, w_out[l])

        x = x + moe_ffn(rmsnorm(x, norm2_g[l]), w_router[l], b_router[l], w_gate_up[l], b_gate_up[l],
                        w_down[l], b_down[l])
    return x
```

```cpp
#include <hip/hip_runtime.h>
#include <cstdio>
#include <cstdint>

namespace {
constexpr int BATCH = 2, SEQ = 8192, T = BATCH * SEQ, DM = 1024, DIN = 3080;
constexpr int NHA = 8, HDA = 64, NHM = 4, HDM = 128;
constexpr int NE = 32, TOPK = 4, DFF = 1024;
constexpr int CH = 256, NCH = SEQ / CH;
constexpr float EPS = 1e-6f;
constexpr int ZQ = 0, ZK = 512, ZV = 1024, ZXM = 1536, ZVM = 2048, ZOM = 2560, ZI = 3072, ZF = 3076;

__device__ __forceinline__ float wave_sum(float v) {
#pragma unroll
    for (int o = 1; o < 64; o <<= 1) v += __shfl_xor(v, o);
    return v;
}
__device__ __forceinline__ float sigmoidf_(float x) { return 1.0f / (1.0f + expf(-x)); }

__global__ void __launch_bounds__(256) k_rmsnorm(const float* __restrict__ x, const float* __restrict__ g, float* __restrict__ out, int rows) {
    const int row = (blockIdx.x * 256 + threadIdx.x) >> 6, lane = threadIdx.x & 63;
    if (row >= rows) return;
    const float4* xr = (const float4*)(x + (size_t)row * DM);
    const float4* gr = (const float4*)g;
    float4 v[4]; float s = 0.f;
#pragma unroll
    for (int j = 0; j < 4; ++j) { v[j] = xr[lane + 64 * j]; s += v[j].x * v[j].x + v[j].y * v[j].y + v[j].z * v[j].z + v[j].w * v[j].w; }
    s = wave_sum(s);
    const float r = 1.0f / sqrtf(s * (1.0f / DM) + EPS);
    float4* o = (float4*)(out + (size_t)row * DM);
#pragma unroll
    for (int j = 0; j < 4; ++j) { const float4 gg = gr[lane + 64 * j]; float4 w; w.x = v[j].x * r * gg.x; w.y = v[j].y * r * gg.y; w.z = v[j].z * r * gg.z; w.w = v[j].w * r * gg.w; o[lane + 64 * j] = w; }
}

template <bool DUAL, class ARow>
__device__ __forceinline__ void gemm_core(ARow arow, int mvalid, const float* __restrict__ W, int ldw, int n0, int N, int dual_off, int K,
                                          float (&acc)[4][4], float (&acc2)[4][4], float (*As)[68], float (*Ws)[64], float (*Ws2)[64]) {
    const int tid = threadIdx.x, ty = tid >> 4, tx = tid & 15;
    const int ar = tid >> 2, ak = (tid & 3) * 4;
    const int wk = tid >> 4, wn = (tid & 15) * 4;
    const float* ap = (ar < mvalid) ? arow(ar) : nullptr;
#pragma unroll
    for (int i = 0; i < 4; ++i)
#pragma unroll
        for (int j = 0; j < 4; ++j) { acc[i][j] = 0.f; acc2[i][j] = 0.f; }
    for (int k0 = 0; k0 < K; k0 += 16) {
        float4 av = ap ? *(const float4*)(ap + k0 + ak) : make_float4(0.f, 0.f, 0.f, 0.f);
        float4 wv = (n0 + wn < N) ? *(const float4*)(W + (size_t)(k0 + wk) * ldw + n0 + wn) : make_float4(0.f, 0.f, 0.f, 0.f);
        float4 wv2 = make_float4(0.f, 0.f, 0.f, 0.f);
        if (DUAL) wv2 = *(const float4*)(W + (size_t)(k0 + wk) * ldw + n0 + dual_off + wn);
        __syncthreads();
        As[ak + 0][ar] = av.x; As[ak + 1][ar] = av.y; As[ak + 2][ar] = av.z; As[ak + 3][ar] = av.w;
        *(float4*)&Ws[wk][wn] = wv;
        if (DUAL) *(float4*)&Ws2[wk][wn] = wv2;
        __syncthreads();
#pragma unroll
        for (int k = 0; k < 16; ++k) {
            const float4 a = *(const float4*)&As[k][ty * 4];
            const float4 b = *(const float4*)&Ws[k][tx * 4];
            const float aa[4] = {a.x, a.y, a.z, a.w}, bb[4] = {b.x, b.y, b.z, b.w};
#pragma unroll
            for (int i = 0; i < 4; ++i)
#pragma unroll
                for (int j = 0; j < 4; ++j) acc[i][j] += aa[i] * bb[j];
            if (DUAL) {
                const float4 b2 = *(const float4*)&Ws2[k][tx * 4];
                const float cc[4] = {b2.x, b2.y, b2.z, b2.w};
#pragma unroll
                for (int i = 0; i < 4; ++i)
#pragma unroll
                    for (int j = 0; j < 4; ++j) acc2[i][j] += aa[i] * cc[j];
            }
        }
    }
}

__global__ void __launch_bounds__(256) k_gemm(const float* __restrict__ A, int lda, const float* __restrict__ W, int ldw, float* __restrict__ C, int ldc,
                                              int M, int N, int K, float scale, const float* __restrict__ resid, long wz, int az, int cz) {
    __shared__ float As[16][68]; __shared__ float Ws[16][64];
    const int z = blockIdx.z; A += (size_t)z * az; W += (size_t)z * wz; C += (size_t)z * cz;
    const int n0 = blockIdx.x * 64, m0 = blockIdx.y * 64;
    float acc[4][4], acc2[4][4];
    gemm_core<false>([&](int r) { return A + (size_t)(m0 + r) * lda; }, M - m0, W, ldw, n0, N, 0, K, acc, acc2, As, Ws, Ws);
    const int ty = threadIdx.x >> 4, tx = threadIdx.x & 15;
#pragma unroll
    for (int i = 0; i < 4; ++i) { const int r = m0 + ty * 4 + i; if (r >= M) continue;
#pragma unroll
        for (int j = 0; j < 4; ++j) { const int c = n0 + tx * 4 + j; if (c >= N) continue;
            float v = acc[i][j] * scale; if (resid) v += resid[(size_t)r * ldc + c]; C[(size_t)r * ldc + c] = v; } }
}

__global__ void __launch_bounds__(256) k_qknorm(float* __restrict__ Z, const float* __restrict__ gq, const float* __restrict__ gk) {
    const int tok = (blockIdx.x * 256 + threadIdx.x) >> 6, lane = threadIdx.x & 63;
    if (tok >= T) return;
    float* zr = Z + (size_t)tok * DIN;
#pragma unroll
    for (int part = 0; part < 2; ++part) {
        float* p = zr + (part ? ZK : ZQ) + lane * 8;
        const float* g = (part ? gk : gq) + (lane & 7) * 8;
        float4 a = *(float4*)p, b = *(float4*)(p + 4);
        float s = a.x * a.x + a.y * a.y + a.z * a.z + a.w * a.w + b.x * b.x + b.y * b.y + b.z * b.z + b.w * b.w;
        s += __shfl_xor(s, 1); s += __shfl_xor(s, 2); s += __shfl_xor(s, 4);
        float r = 1.0f / sqrtf(s * (1.0f / HDA) + EPS); if (!part) r *= 0.125f;
        a.x *= r * g[0]; a.y *= r * g[1]; a.z *= r * g[2]; a.w *= r * g[3]; b.x *= r * g[4]; b.y *= r * g[5]; b.z *= r * g[6]; b.w *= r * g[7];
        *(float4*)p = a; *(float4*)(p + 4) = b;
    }
}

__global__ void __launch_bounds__(256) k_attn(const float* __restrict__ Z, float* __restrict__ MIX) {
    const int tok = blockIdx.x * 256 + threadIdx.x, h = blockIdx.y;
    const int tl = tok % SEQ;
    float q[64], o[64];
    const float* qp = Z + (size_t)tok * DIN + ZQ + h * 64;
#pragma unroll
    for (int i = 0; i < 64; i += 4) { const float4 v = *(const float4*)(qp + i); q[i] = v.x; q[i + 1] = v.y; q[i + 2] = v.z; q[i + 3] = v.w; }
#pragma unroll
    for (int i = 0; i < 64; ++i) o[i] = 0.f;
    float m = -INFINITY, l = 0.f;
    const float slope = exp2f(-(float)(h + 1));
    for (int br = 0; br < 3; ++br) {
        const int dil = br == 0 ? 1 : (br == 1 ? 4 : 16);
        for (int j = 0; j <= 128; ++j) {
            const int d = dil * j;
            if (d > tl) break;
            const float* kp = Z + (size_t)(tok - d) * DIN + ZK + h * 64;
            const float* vp = Z + (size_t)(tok - d) * DIN + ZV + h * 64;
            float s = 0.f;
#pragma unroll
            for (int i = 0; i < 64; i += 4) { const float4 v = *(const float4*)(kp + i); s += q[i] * v.x + q[i + 1] * v.y + q[i + 2] * v.z + q[i + 3] * v.w; }
            s -= slope * (float)d;
            const float mn = fmaxf(m, s);
            const float c = expf(m - mn), p = expf(s - mn);
            l = l * c + p;
#pragma unroll
            for (int i = 0; i < 64; i += 4) { const float4 v = *(const float4*)(vp + i);
                o[i] = o[i] * c + p * v.x; o[i + 1] = o[i + 1] * c + p * v.y; o[i + 2] = o[i + 2] * c + p * v.z; o[i + 3] = o[i + 3] * c + p * v.w; }
            m = mn;
        }
    }
    const float inv = 1.0f / l;
    float* op = MIX + (size_t)tok * DM + h * 64;
#pragma unroll
    for (int i = 0; i < 64; i += 4) *(float4*)(op + i) = make_float4(o[i] * inv, o[i + 1] * inv, o[i + 2] * inv, o[i + 3] * inv);
}

__global__ void __launch_bounds__(256) k_conv(const float* __restrict__ Z, const float* __restrict__ cw, const float* __restrict__ cb, float* __restrict__ XC) {
    const int idx = blockIdx.x * 256 + threadIdx.x;
    const int tok = idx >> 9, ch = idx & 511, tl = tok % SEQ;
    float a = cb[ch];
#pragma unroll
    for (int j = 0; j < 4; ++j) { const int dt = 3 - j; if (tl - dt >= 0) a += cw[j * 512 + ch] * Z[(size_t)(tok - dt) * DIN + ZXM + ch]; }
    XC[idx] = a * sigmoidf_(a);
}

__global__ void __launch_bounds__(512) k_ml1(const float* __restrict__ Z, const float* __restrict__ KM, const float* __restrict__ bi, const float* __restrict__ bf,
                                             float* __restrict__ BC, float* __restrict__ IG, float* __restrict__ BT, float* __restrict__ U, float* __restrict__ NV) {
    __shared__ float bc[256], wv[256], Ks[32][128], Vs[32][128];
    const int unit = blockIdx.x, bh = unit / NCH, c = unit % NCH, b = bh / NHM, h = bh % NHM, tid = threadIdx.x;
    const int t0 = b * SEQ + c * CH;
    float ig = 0.f;
    if (tid < 256) {
        const float f = Z[(size_t)(t0 + tid) * DIN + ZF + h] + bf[h];
        bc[tid] = fminf(f, 0.f) - log1pf(expf(-fabsf(f)));
        ig = Z[(size_t)(t0 + tid) * DIN + ZI + h] + bi[h];
    }
    __syncthreads();
    if (tid == 0) { float s = 0.f; for (int i = 0; i < 256; ++i) { s += bc[i]; bc[i] = s; } }
    __syncthreads();
    if (tid < 256) { BC[(size_t)(t0 + tid) * 4 + h] = bc[tid]; IG[(size_t)(t0 + tid) * 4 + h] = ig; wv[tid] = expf(bc[255] - bc[tid] + ig); }
    if (tid == 0) BT[unit] = bc[255];
    const int d = tid >> 2, e0 = (tid & 3) * 32;
    float acc[32]; float nv = 0.f;
#pragma unroll
    for (int i = 0; i < 32; ++i) acc[i] = 0.f;
    for (int s0 = 0; s0 < CH; s0 += 32) {
        __syncthreads();
#pragma unroll
        for (int i = 0; i < 8; ++i) { const int id = tid + 512 * i, r = id >> 7, cc = id & 127;
            Ks[r][cc] = KM[(size_t)(t0 + s0 + r) * 512 + h * 128 + cc];
            Vs[r][cc] = Z[(size_t)(t0 + s0 + r) * DIN + ZVM + h * 128 + cc]; }
        __syncthreads();
        for (int r = 0; r < 32; ++r) { const float kw = Ks[r][d] * wv[s0 + r]; nv += kw;
#pragma unroll
            for (int i = 0; i < 32; ++i) acc[i] += kw * Vs[r][e0 + i]; }
    }
    float* up = U + (size_t)unit * 16384 + d * 128 + e0;
#pragma unroll
    for (int i = 0; i < 32; ++i) up[i] = acc[i];
    if ((tid & 3) == 0) NV[unit * 128 + d] = nv;
}

__global__ void __launch_bounds__(512) k_ml3(const float* __restrict__ Z, const float* __restrict__ QM, const float* __restrict__ KM, const float* __restrict__ BC, const float* __restrict__ IG,
                                             const float* __restrict__ BT, const float* __restrict__ U, const float* __restrict__ NV, const float* __restrict__ gn, float* __restrict__ MIX) {
    extern __shared__ float sm[];
    float* Cs = sm;
    float* nvs = Cs + 16384;
    float* Qs = nvs + 128;
    float* Ks = Qs + 4096;
    float* Vs = Ks + 4096;
    float* Ps = Vs + 4096;
    float* bq = Ps + 32 * 33;
    float* bk = bq + 32;
    float* ik = bk + 32;
    const int unit = blockIdx.x, bh = unit / NCH, c = unit % NCH, b = bh / NHM, h = bh % NHM, tid = threadIdx.x;
    const int t0 = b * SEQ + c * CH;
    {
        float cc[32]; float n = 0.f;
#pragma unroll
        for (int i = 0; i < 32; ++i) cc[i] = 0.f;
        for (int j = 0; j < c; ++j) {
            const float dec = expf(BT[bh * NCH + j]);
            const float* up = U + (size_t)(bh * NCH + j) * 16384;
#pragma unroll
            for (int i = 0; i < 32; ++i) cc[i] = dec * cc[i] + up[tid + 512 * i];
            if (tid < 128) n = dec * n + NV[(bh * NCH + j) * 128 + tid];
        }
#pragma unroll
        for (int i = 0; i < 32; ++i) Cs[tid + 512 * i] = cc[i];
        if (tid < 128) nvs[tid] = n;
    }
    const int r = tid >> 4, e0 = (tid & 15) * 8;
    for (int qb = 0; qb < 8; ++qb) {
        __syncthreads();
#pragma unroll
        for (int i = 0; i < 8; ++i) { const int id = tid + 512 * i, rr = id >> 7, cc = id & 127; Qs[rr * 128 + cc] = QM[(size_t)(t0 + qb * 32 + rr) * 512 + h * 128 + cc]; }
        if (tid < 32) bq[tid] = BC[(size_t)(t0 + qb * 32 + tid) * 4 + h];
        __syncthreads();
        float num[8]; float den = 0.f;
#pragma unroll
        for (int i = 0; i < 8; ++i) num[i] = 0.f;
        for (int d = 0; d < 128; ++d) { const float qv = Qs[r * 128 + d]; den += qv * nvs[d];
#pragma unroll
            for (int i = 0; i < 8; ++i) num[i] += qv * Cs[d * 128 + e0 + i]; }
        const float eb = expf(bq[r]);
        den *= eb;
#pragma unroll
        for (int i = 0; i < 8; ++i) num[i] *= eb;
        for (int kb = 0; kb <= qb; ++kb) {
            __syncthreads();
#pragma unroll
            for (int i = 0; i < 8; ++i) { const int id = tid + 512 * i, rr = id >> 7, cc = id & 127;
                Ks[rr * 128 + cc] = KM[(size_t)(t0 + kb * 32 + rr) * 512 + h * 128 + cc];
                Vs[rr * 128 + cc] = Z[(size_t)(t0 + kb * 32 + rr) * DIN + ZVM + h * 128 + cc]; }
            if (tid < 32) { bk[tid] = BC[(size_t)(t0 + kb * 32 + tid) * 4 + h]; ik[tid] = IG[(size_t)(t0 + kb * 32 + tid) * 4 + h]; }
            __syncthreads();
#pragma unroll
            for (int u = 0; u < 2; ++u) { const int id = tid * 2 + u, pr = id >> 5, pc = id & 31;
                float s = 0.f;
                for (int d = 0; d < 128; ++d) s += Qs[pr * 128 + d] * Ks[pc * 128 + d];
                const int tq = qb * 32 + pr, ts = kb * 32 + pc;
                Ps[pr * 33 + pc] = (ts <= tq) ? s * expf(bq[pr] - bk[pc] + ik[pc]) : 0.f; }
            __syncthreads();
            for (int pc = 0; pc < 32; ++pc) { const float p = Ps[r * 33 + pc]; den += p;
#pragma unroll
                for (int i = 0; i < 8; ++i) num[i] += p * Vs[pc * 128 + e0 + i]; }
        }
        const float dd = 1.0f / fmaxf(fabsf(den), 1.0f);
        float ss = 0.f;
#pragma unroll
        for (int i = 0; i < 8; ++i) { num[i] *= dd; ss += num[i] * num[i]; }
        ss += __shfl_xor(ss, 1); ss += __shfl_xor(ss, 2); ss += __shfl_xor(ss, 4); ss += __shfl_xor(ss, 8);
        const float rstd = 1.0f / sqrtf(ss * (1.0f / HDM) + EPS);
        const int tok = t0 + qb * 32 + r;
#pragma unroll
        for (int i = 0; i < 8; ++i) { const float og = Z[(size_t)tok * DIN + ZOM + h * 128 + e0 + i];
            MIX[(size_t)tok * DM + 512 + h * 128 + e0 + i] = sigmoidf_(og) * num[i] * rstd * gn[h * 128 + e0 + i]; }
    }
}

__global__ void __launch_bounds__(256) k_router(const float* __restrict__ X1, const float* __restrict__ g2, const float* __restrict__ wr, const float* __restrict__ br,
                                                float* __restrict__ H2, int* __restrict__ cnt, int* __restrict__ ltok, float* __restrict__ lgate) {
    const int tok = (blockIdx.x * 256 + threadIdx.x) >> 6, lane = threadIdx.x & 63;
    if (tok >= T) return;
    const float4* xr = (const float4*)(X1 + (size_t)tok * DM);
    float4 v[4]; float s = 0.f;
#pragma unroll
    for (int j = 0; j < 4; ++j) { v[j] = xr[lane + 64 * j]; s += v[j].x * v[j].x + v[j].y * v[j].y + v[j].z * v[j].z + v[j].w * v[j].w; }
    s = wave_sum(s);
    const float r = 1.0f / sqrtf(s * (1.0f / DM) + EPS);
    float4* o = (float4*)(H2 + (size_t)tok * DM);
#pragma unroll
    for (int j = 0; j < 4; ++j) { const float4 gg = ((const float4*)g2)[lane + 64 * j]; v[j].x *= r * gg.x; v[j].y *= r * gg.y; v[j].z *= r * gg.z; v[j].w *= r * gg.w; o[lane + 64 * j] = v[j]; }
    float mylogit = -INFINITY;
    for (int e = 0; e < NE; ++e) {
        float p = 0.f;
#pragma unroll
        for (int j = 0; j < 4; ++j) { const int k = 4 * (lane + 64 * j);
            p += v[j].x * wr[(k + 0) * NE + e] + v[j].y * wr[(k + 1) * NE + e] + v[j].z * wr[(k + 2) * NE + e] + v[j].w * wr[(k + 3) * NE + e]; }
        p = wave_sum(p) + br[e];
        if (lane == e) mylogit = p;
    }
    float tv[4]; int te[4];
#pragma unroll
    for (int k = 0; k < 4; ++k) {
        float bv = mylogit; int bi = lane;
#pragma unroll
        for (int off = 1; off < 64; off <<= 1) { const float ov = __shfl_xor(bv, off); const int oi = __shfl_xor(bi, off);
            if (ov > bv || (ov == bv && oi < bi)) { bv = ov; bi = oi; } }
        tv[k] = bv; te[k] = bi;
        if (lane == bi) mylogit = -INFINITY;
    }
    const float e1 = expf(tv[1] - tv[0]), e2 = expf(tv[2] - tv[0]), e3 = expf(tv[3] - tv[0]);
    const float inv = 1.0f / (1.0f + e1 + e2 + e3);
    if (lane < 4) {
        const int ee = lane == 0 ? te[0] : (lane == 1 ? te[1] : (lane == 2 ? te[2] : te[3]));
        const float gg = (lane == 0 ? 1.0f : (lane == 1 ? e1 : (lane == 2 ? e2 : e3))) * inv;
        const int p = atomicAdd(&cnt[ee], 1);
        ltok[ee * T + p] = tok; lgate[ee * T + p] = gg;
    }
}

__global__ void __launch_bounds__(256) k_moe1(const float* __restrict__ H2, const float* __restrict__ Wgu, const float* __restrict__ bgu, const int* __restrict__ cnt, const int* __restrict__ ltok, float* __restrict__ ACT) {
    __shared__ float As[16][68]; __shared__ float Ws[16][64]; __shared__ float Ws2[16][64];
    const int e = blockIdx.z, n = cnt[e], m0 = blockIdx.y * 64;
    if (m0 >= n) return;
    int off = 0; for (int i = 0; i < e; ++i) off += cnt[i];
    const int n0 = blockIdx.x * 64;
    const int* lt = ltok + e * T + m0;
    const float* W = Wgu + (size_t)e * DM * 2 * DFF;
    float acc[4][4], acc2[4][4];
    gemm_core<true>([&](int r) { return H2 + (size_t)lt[r] * DM; }, n - m0, W, 2 * DFF, n0, 2 * DFF, DFF, DM, acc, acc2, As, Ws, Ws2);
    const int ty = threadIdx.x >> 4, tx = threadIdx.x & 15;
#pragma unroll
    for (int i = 0; i < 4; ++i) { const int r = m0 + ty * 4 + i; if (r >= n) continue;
#pragma unroll
        for (int j = 0; j < 4; ++j) { const int c = n0 + tx * 4 + j;
            float g = acc[i][j] + bgu[e * 2 * DFF + c], u = acc2[i][j] + bgu[e * 2 * DFF + DFF + c];
            g = fminf(g, 7.0f); u = fminf(fmaxf(u, -7.0f), 7.0f);
            ACT[(size_t)(off + r) * DFF + c] = g * sigmoidf_(1.702f * g) * (u + 1.0f); } }
}
__global__ void __launch_bounds__(256) k_moe2(const float* __restrict__ ACT, const float* __restrict__ Wd, const float* __restrict__ bd, const int* __restrict__ cnt, const int* __restrict__ ltok, const float* __restrict__ lgate, float* __restrict__ OUT) {
    __shared__ float As[16][68]; __shared__ float Ws[16][64];
    const int e = blockIdx.z, n = cnt[e], m0 = blockIdx.y * 64;
    if (m0 >= n) return;
    int off = 0; for (int i = 0; i < e; ++i) off += cnt[i];
    const int n0 = blockIdx.x * 64;
    const float* W = Wd + (size_t)e * DFF * DM;
    float acc[4][4], acc2[4][4];
    gemm_core<false>([&](int r) { return ACT + (size_t)(off + m0 + r) * DFF; }, n - m0, W, DM, n0, DM, 0, DFF, acc, acc2, As, Ws, Ws);
    const int ty = threadIdx.x >> 4, tx = threadIdx.x & 15;
#pragma unroll
    for (int i = 0; i < 4; ++i) { const int r = m0 + ty * 4 + i; if (r >= n) continue;
        const int tok = ltok[e * T + r]; const float gt = lgate[e * T + r];
#pragma unroll
        for (int j = 0; j < 4; ++j) { const int c = n0 + tx * 4 + j; atomicAdd(&OUT[(size_t)tok * DM + c], gt * (acc[i][j] + bd[e * DM + c])); } }
}
}

extern "C" void kernel_launch(void* const* d_in, const int* in_sizes, int n_in, void* d_out, int out_size, void* d_ws, size_t ws_size, hipStream_t stream) {
    const float* x = (const float*)d_in[0];
    const float* norm1_g = (const float*)d_in[1];
    const float* w_in = (const float*)d_in[2];
    const float* q_norm_g = (const float*)d_in[3];
    const float* k_norm_g = (const float*)d_in[4];
    const float* conv_w = (const float*)d_in[5];
    const float* conv_b = (const float*)d_in[6];
    const float* w_mq = (const float*)d_in[7];
    const float* w_mk = (const float*)d_in[8];
    const float* b_igate = (const float*)d_in[9];
    const float* b_fgate = (const float*)d_in[10];
    const float* mh_norm_g = (const float*)d_in[11];
    const float* w_out = (const float*)d_in[12];
    const float* norm2_g = (const float*)d_in[13];
    const float* w_router = (const float*)d_in[14];
    const float* b_router = (const float*)d_in[15];
    const float* w_gate_up = (const float*)d_in[16];
    const float* b_gate_up = (const float*)d_in[17];
    const float* w_down = (const float*)d_in[18];
    const float* b_down = (const float*)d_in[19];
    float* out = (float*)d_out;
    char* ws = (char*)d_ws;
    size_t o = 0;
    auto take = [&](size_t bytes) { char* p = ws + o; o += (bytes + 255) & ~(size_t)255; return p; };
    int* cnt = (int*)take(4096);
    float* XN = (float*)take((size_t)T * DM * 4);
    float* Z = (float*)take((size_t)T * DIN * 4);
    float* XC = (float*)take((size_t)T * 512 * 4);
    float* QM = (float*)take((size_t)T * 512 * 4);
    float* KM = (float*)take((size_t)T * 512 * 4);
    float* BC = (float*)take((size_t)T * 4 * 4);
    float* IG = (float*)take((size_t)T * 4 * 4);
    float* BT = (float*)take(256 * 4);
    float* U = (float*)take((size_t)256 * 16384 * 4);
    float* NV = (float*)take(256 * 128 * 4);
    float* MIX = (float*)take((size_t)T * DM * 4);
    int* ltok = (int*)take((size_t)NE * T * 4);
    float* lgate = (float*)take((size_t)NE * T * 4);
    float* ACT = (float*)take((size_t)T * TOPK * DFF * 4);
    if (o > ws_size) { fprintf(stderr, "kernel_launch: workspace too small: need %zu have %zu\n", o, ws_size); return; }
    float* H2 = XN;

    hipMemsetAsync(cnt, 0, 4096, stream);
    k_rmsnorm<<<T / 4, 256, 0, stream>>>(x, norm1_g, XN, T);
    k_gemm<<<dim3((DIN + 63) / 64, T / 64, 1), 256, 0, stream>>>(XN, DM, w_in, DIN, Z, DIN, T, DIN, DM, 1.0f, nullptr, 0, 0, 0);
    k_qknorm<<<T / 4, 256, 0, stream>>>(Z, q_norm_g, k_norm_g);
    k_attn<<<dim3(T / 256, NHA), 256, 0, stream>>>(Z, MIX);
    k_conv<<<T * 512 / 256, 256, 0, stream>>>(Z, conv_w, conv_b, XC);
    k_gemm<<<dim3(2, T / 64, NHM), 256, 0, stream>>>(XC, 512, w_mq, 128, QM, 512, T, 128, 128, 1.0f, nullptr, 128 * 128, 128, 128);
    k_gemm<<<dim3(2, T / 64, NHM), 256, 0, stream>>>(XC, 512, w_mk, 128, KM, 512, T, 128, 128, 0.08838834764831845f, nullptr, 128 * 128, 128, 128);
    k_ml1<<<256, 512, 0, stream>>>(Z, KM, b_igate, b_fgate, BC, IG, BT, U, NV);
    constexpr int ML3_LDS = (16384 + 128 + 3 * 4096 + 32 * 33 + 96) * 4;
    static bool attr_done = false;
    if (!attr_done) { hipFuncSetAttribute((const void*)k_ml3, hipFuncAttributeMaxDynamicSharedMemorySize, ML3_LDS); attr_done = true; }
    k_ml3<<<256, 512, ML3_LDS, stream>>>(Z, QM, KM, BC, IG, BT, U, NV, mh_norm_g, MIX);
    k_gemm<<<dim3(DM / 64, T / 64, 1), 256, 0, stream>>>(MIX, DM, w_out, DM, out, DM, T, DM, DM, 1.0f, x, 0, 0, 0);
    k_router<<<T / 4, 256, 0, stream>>>(out, norm2_g, w_router, b_router, H2, cnt, ltok, lgate);
    k_moe1<<<dim3(DFF / 64, T / 64, NE), 256, 0, stream>>>(H2, w_gate_up, b_gate_up, cnt, ltok, ACT);
    k_moe2<<<dim3(DM / 64, T / 64, NE), 256, 0, stream>>>(ACT, w_down, b_down, cnt, ltok, lgate, out);
}
```

```cpp
#include <hip/hip_runtime.h>
#include <hip/hip_cooperative_groups.h>
#include <cstdio>
#include <cstdint>
namespace cg = cooperative_groups;

#define LAS __attribute__((address_space(3)))
typedef unsigned short bf16_t;
typedef short bf16x8 __attribute__((ext_vector_type(8)));
typedef short s16x4 __attribute__((ext_vector_type(4)));
typedef float f32x4 __attribute__((ext_vector_type(4)));
typedef unsigned u32x4 __attribute__((ext_vector_type(4)));
typedef unsigned u32x2 __attribute__((ext_vector_type(2)));

namespace {
constexpr int BATCH = 2, SEQ = 8192, T = BATCH * SEQ, DM = 1024, DIN = 3080, NZ = 3072;
constexpr int NHA = 8, NHM = 4, HDM = 128;
constexpr int NE = 32, DFF = 1024;
constexpr int CH = 256, NCH = SEQ / CH;
constexpr float EPS = 1e-6f;
constexpr float LOG2E = 1.4426950408889634f;
constexpr int ZQ = 0, ZK = 512, ZV = 1024, ZXM = 1536, ZVM = 2048, ZOM = 2560;
constexpr int NWAVES = 8, NTHR = 512;
constexpr int MAXTR = 288;
constexpr size_t MiB = 1u << 20;
constexpr size_t WS_CTL = 0;
constexpr size_t WS_WIN = 1 * MiB;
constexpr size_t WS_WOUT = 7 * MiB;
constexpr size_t WS_WQK = 9 * MiB;
constexpr size_t WS_WGU = 16 * MiB;
constexpr size_t WS_WD = 144 * MiB;
constexpr size_t WS_XN = 208 * MiB;
constexpr size_t WS_Z = 240 * MiB;
constexpr size_t WS_GATE = 336 * MiB;
constexpr size_t WS_XC = 337 * MiB;
constexpr size_t WS_QK = 353 * MiB;
constexpr size_t WS_BC = 385 * MiB;
constexpr size_t WS_IG = 385 * MiB + 512 * 1024;
constexpr size_t WS_BT = 386 * MiB;
constexpr size_t WS_NV = 386 * MiB + 4096;
constexpr size_t WS_U = 387 * MiB;
constexpr size_t WS_MIX = 403 * MiB;
constexpr size_t WS_LTOK = 435 * MiB;
constexpr size_t WS_LGATE = 437 * MiB;
constexpr size_t WS_TKE = 439 * MiB;
constexpr size_t WS_ACT = 440 * MiB;
constexpr size_t WS_Y = 584 * MiB;
constexpr size_t WS_END = 728 * MiB;
constexpr int LDS_STAGE = 0;
constexpr int LDS_TAB = 131072;
constexpr int LDS_BYTES = 131072 + 1024;

__device__ __forceinline__ unsigned f2bf(float f) { unsigned u = __builtin_bit_cast(unsigned, f); return (u + 0x7fffu + ((u >> 16) & 1u)) >> 16; }
__device__ __forceinline__ unsigned pk2(float lo, float hi) { return f2bf(lo) | (f2bf(hi) << 16); }
__device__ __forceinline__ float bf2f(unsigned b) { return __builtin_bit_cast(float, b << 16); }
__device__ __forceinline__ float bflo(unsigned w) { return __builtin_bit_cast(float, w << 16); }
__device__ __forceinline__ float bfhi(unsigned w) { return __builtin_bit_cast(float, w & 0xffff0000u); }
__device__ __forceinline__ float wave_sum(float v) {
#pragma unroll
    for (int o = 1; o < 64; o <<= 1) v += __shfl_xor(v, o);
    return v;
}
__device__ __forceinline__ float sigmoidf_(float x) { return 1.0f / (1.0f + __expf(-x)); }
}

namespace pg8 {
constexpr int BM = 256, BK = 64, HALF = 128, HTB = HALF * BK * 2, STAGE_BYTES = 8 * HTB, NXCD = 8, WGM = 8;
__host__ __device__ __forceinline__ int lds_byte(int r, int c) { const int st = (r >> 4) * 2 + (c >> 5), rr = r & 15, cc = c & 31, ob = rr * 64 + cc * 2; return st * 1024 + (ob ^ (((ob >> 9) & 1) << 5)); }
__host__ __device__ __forceinline__ void stage_rc(int b, int& R, int& C) { const int st = b / 1024, sb = b % 1024, swz = sb ^ (((sb >> 9) & 1) << 5); R = (st >> 1) * 16 + swz / 64; C = (st & 1) * 32 + (swz % 64) / 2; }
__host__ __device__ __forceinline__ int perm32(int rho) { const int n = rho >> 4, i = rho & 15; return 8 * (i >> 2) + 4 * n + (i & 3); }

__device__ __forceinline__ bool tile_order(int i, int G, int c, int nM, int nN, int& pm, int& pn) {
    const int nwg = nM * nN; const long L = (long)i * G + c; if (L >= nwg) return false;
    int wgid = (int)L; { const int q = nwg / NXCD, r = nwg % NXCD, xcd = wgid % NXCD, off = wgid / NXCD; wgid = (xcd < r ? xcd * (q + 1) : r * (q + 1) + (xcd - r) * q) + off; }
    const int nig = WGM * nN, gid = wgid / nig, fm = gid * WGM, gsz = (nM - fm) < WGM ? (nM - fm) : WGM;
    pm = fm + ((wgid % nig) % gsz); pn = (wgid % nig) / gsz; return true;
}

struct Unit { int pm, pn, e, mt; };

struct DenseSched {
    int nM, nN, G, c, K; const char* Bt;
    static constexpr bool DRAIN = false;
    __device__ __forceinline__ bool next(int i, Unit& u) const { u.e = 0; u.mt = 0; return tile_order(i, G, c, nM, nN, u.pm, u.pn); }
    __device__ __forceinline__ void a_off(const Unit& u, const int (&R)[2], const int (&C)[2], unsigned (&off)[2][2]) const {
#pragma unroll
        for (int h = 0; h < 2; ++h)
#pragma unroll
            for (int i = 0; i < 2; ++i) off[h][i] = (unsigned)(((u.pm * BM + h * HALF + R[i]) * K + C[i]) * 2);
    }
    __device__ __forceinline__ const char* b_ptr(const Unit& u) const { return Bt + (size_t)u.pn * BM * K * 2; }
};
template <bool GATHER> struct MoeSched {
    const LAS int* trs; const LAS int* cnts; int nN, G, c, K; const char* Bt; size_t bstride; const int* ltok;
    static constexpr bool DRAIN = GATHER;
    __device__ __forceinline__ bool next(int i, Unit& u) const {
        const int nM = __builtin_amdgcn_readfirstlane(trs[NE]);
        if (!tile_order(i, G, c, nM, nN, u.pm, u.pn)) return false;
        int e = 0;
        for (int j = 1; j < NE; ++j) e += (__builtin_amdgcn_readfirstlane(trs[j]) <= u.pm) ? 1 : 0;
        u.e = e; u.mt = u.pm - __builtin_amdgcn_readfirstlane(trs[e]); return true;
    }
    __device__ __forceinline__ void a_off(const Unit& u, const int (&R)[2], const int (&C)[2], unsigned (&off)[2][2]) const {
        const int n = __builtin_amdgcn_readfirstlane(cnts[u.e]);
#pragma unroll
        for (int h = 0; h < 2; ++h)
#pragma unroll
            for (int i = 0; i < 2; ++i) {
                int row;
                if (GATHER) { const int p = u.mt * BM + h * HALF + R[i]; row = (p < n) ? ltok[u.e * T + p] : 0; }
                else row = u.pm * BM + h * HALF + R[i];
                off[h][i] = (unsigned)((row * K + C[i]) * 2);
            }
    }
    __device__ __forceinline__ const char* b_ptr(const Unit& u) const { return Bt + (size_t)u.e * bstride + (size_t)u.pn * BM * K * 2; }
};

struct EpiBf16 {
    static constexpr bool PERM = true;
    bf16_t* O; int ldc;
    __device__ __forceinline__ void operator()(const f32x4 (&acc)[2][2][4][2], const Unit& u, int wr, int wc, int fr, int fq) const {
        const int row0 = u.pm * BM + wr * 64 + fr, col0 = u.pn * BM + wc * 32 + 8 * fq;
#pragma unroll
        for (int ai = 0; ai < 2; ++ai)
#pragma unroll
            for (int m = 0; m < 4; ++m) { bf16_t* rowp = O + (size_t)(row0 + ai * HALF + m * 16) * ldc + col0;
#pragma unroll
                for (int bj = 0; bj < 2; ++bj) { const f32x4 v0 = acc[ai][bj][m][0], v1 = acc[ai][bj][m][1];
                    u32x4 w; w.x = pk2(v0[0], v0[1]); w.y = pk2(v0[2], v0[3]); w.z = pk2(v1[0], v1[1]); w.w = pk2(v1[2], v1[3]);
                    *(u32x4*)(rowp + bj * HALF) = w; } }
    }
};
struct EpiResF32 {
    static constexpr bool PERM = false;
    float* C; const float* Rs; int ldc;
    __device__ __forceinline__ void operator()(const f32x4 (&acc)[2][2][4][2], const Unit& u, int wr, int wc, int fr, int fq) const {
        const int row0 = u.pm * BM + wr * 64 + fr, col0 = u.pn * BM + wc * 32 + 4 * fq;
#pragma unroll
        for (int ai = 0; ai < 2; ++ai)
#pragma unroll
            for (int m = 0; m < 4; ++m) { const size_t ro = (size_t)(row0 + ai * HALF + m * 16) * ldc + col0;
#pragma unroll
                for (int bj = 0; bj < 2; ++bj)
#pragma unroll
                    for (int n = 0; n < 2; ++n) { const f32x4 r = *(const f32x4*)(Rs + ro + bj * HALF + n * 16); *(f32x4*)(C + ro + bj * HALF + n * 16) = acc[ai][bj][m][n] + r; } }
    }
};
struct EpiSwiglu {
    static constexpr bool PERM = true;
    bf16_t* O; const float* bgu;
    __device__ __forceinline__ void operator()(const f32x4 (&acc)[2][2][4][2], const Unit& u, int wr, int wc, int fr, int fq) const {
        const int row0 = u.pm * BM + wr * 64 + fr, f0 = u.pn * HALF + wc * 32 + 8 * fq;
        const float* bg = bgu + (size_t)u.e * 2 * DFF + f0;
        f32x4 bgv[2], buv[2];
#pragma unroll
        for (int n = 0; n < 2; ++n) { bgv[n] = *(const f32x4*)(bg + 4 * n); buv[n] = *(const f32x4*)(bg + DFF + 4 * n); }
#pragma unroll
        for (int ai = 0; ai < 2; ++ai)
#pragma unroll
            for (int m = 0; m < 4; ++m) { bf16_t* rowp = O + (size_t)(row0 + ai * HALF + m * 16) * DFF + f0;
                float r[8];
#pragma unroll
                for (int n = 0; n < 2; ++n) { const f32x4 gv = acc[ai][0][m][n] + bgv[n], uv = acc[ai][1][m][n] + buv[n];
#pragma unroll
                    for (int j = 0; j < 4; ++j) { const float gg = fminf(gv[j], 7.0f), uu = fminf(fmaxf(uv[j], -7.0f), 7.0f);
                        r[4 * n + j] = gg * (uu + 1.0f) / (1.0f + __expf(-1.702f * gg)); } }
                u32x4 w; w.x = pk2(r[0], r[1]); w.y = pk2(r[2], r[3]); w.z = pk2(r[4], r[5]); w.w = pk2(r[6], r[7]);
                *(u32x4*)rowp = w; }
    }
};
struct EpiDown {
    static constexpr bool PERM = true;
    bf16_t* O; const float* bd; const float* lgate; const LAS int* cnts;
    __device__ __forceinline__ void operator()(const f32x4 (&acc)[2][2][4][2], const Unit& u, int wr, int wc, int fr, int fq) const {
        const int row0 = u.pm * BM + wr * 64 + fr, col0 = u.pn * BM + wc * 32 + 8 * fq;
        const int n_e = cnts[u.e];
        f32x4 bv[2][2];
#pragma unroll
        for (int bj = 0; bj < 2; ++bj)
#pragma unroll
            for (int n = 0; n < 2; ++n) bv[bj][n] = *(const f32x4*)(bd + (size_t)u.e * DM + col0 + bj * HALF + 4 * n);
#pragma unroll
        for (int ai = 0; ai < 2; ++ai)
#pragma unroll
            for (int m = 0; m < 4; ++m) { const int rt = wr * 64 + fr + ai * HALF + m * 16, p = u.mt * BM + rt;
                const float gt = (p < n_e) ? lgate[(size_t)u.e * T + p] : 0.f;
                bf16_t* rowp = O + (size_t)(row0 + ai * HALF + m * 16) * DM + col0;
#pragma unroll
                for (int bj = 0; bj < 2; ++bj) { const f32x4 v0 = (acc[ai][bj][m][0] + bv[bj][0]) * gt, v1 = (acc[ai][bj][m][1] + bv[bj][1]) * gt;
                    u32x4 w; w.x = pk2(v0[0], v0[1]); w.y = pk2(v0[2], v0[3]); w.z = pk2(v1[0], v1[1]); w.w = pk2(v1[2], v1[3]);
                    *(u32x4*)(rowp + bj * HALF) = w; } }
    }
};

template <class Epi, class Sched>
__device__ __forceinline__ void gemm_phase(LAS unsigned char* lds, const char* A0, const int K, const Sched& S, const Epi& E) {
    const int tid = threadIdx.x, wid = __builtin_amdgcn_readfirstlane(tid >> 6), lane = tid & 63, wr = wid >> 2, wc = wid & 3, fr = lane & 15, fq = lane >> 4;
    const int nt = K / BK;
    int Rr[2], Cc[2]; unsigned voffB[2];
#pragma unroll
    for (int i = 0; i < 2; ++i) { stage_rc(tid * 16 + i * 8192, Rr[i], Cc[i]); const int Rb = Epi::PERM ? ((Rr[i] & ~31) + perm32(Rr[i] & 31)) : Rr[i]; voffB[i] = (unsigned)(Rb * K + Cc[i]) * 2u; }
    const size_t kstep = (size_t)(BK * 2);
    const size_t hstep = (size_t)HALF * K * 2;
    const unsigned ldsw = (unsigned)wid * 1024u;
    const int aoff = lds_byte(wr * 64 + fr, fq * 8), boff = lds_byte(wc * 32 + fr, fq * 8);
#define PG8_SA(b, h) (((b) * 2 + (h)) * HTB)
#define PG8_SB(b, h) ((4 + (b) * 2 + (h)) * HTB)
#define PG8_STAGE_B(bufoff, gbase) do { _Pragma("unroll") for (int _i = 0; _i < 2; ++_i) \
        __builtin_amdgcn_global_load_lds((const unsigned*)((const char*)(gbase) + voffB[_i]), (LAS unsigned*)(lds + (bufoff) + ldsw + _i * 8192), 16, 0, 0); } while (0)
#define PG8_STAGE_A(bufoff, gbase, o0, o1) do { \
        __builtin_amdgcn_global_load_lds((const unsigned*)((const char*)(gbase) + (o0)), (LAS unsigned*)(lds + (bufoff) + ldsw), 16, 0, 0); \
        __builtin_amdgcn_global_load_lds((const unsigned*)((const char*)(gbase) + (o1)), (LAS unsigned*)(lds + (bufoff) + ldsw + 8192), 16, 0, 0); } while (0)
#define PG8_LDA(dst, b, h) do { _Pragma("unroll") for (int m = 0; m < 4; ++m) _Pragma("unroll") for (int k = 0; k < 2; ++k) dst[m][k] = *(const LAS bf16x8*)(lds + PG8_SA(b, h) + aoff + m * 2048 + k * 1024); } while (0)
#define PG8_LDB(dst, b, h) do { _Pragma("unroll") for (int n = 0; n < 2; ++n) _Pragma("unroll") for (int k = 0; k < 2; ++k) dst[n][k] = *(const LAS bf16x8*)(lds + PG8_SB(b, h) + boff + n * 2048 + k * 1024); } while (0)
#define PG8_MMA(ai, bj, At, Bt) do { __builtin_amdgcn_s_setprio(1); _Pragma("unroll") for (int m = 0; m < 4; ++m) _Pragma("unroll") for (int n = 0; n < 2; ++n) _Pragma("unroll") for (int k = 0; k < 2; ++k) \
        acc[ai][bj][m][n] = __builtin_amdgcn_mfma_f32_16x16x32_bf16(Bt[n][k], At[m][k], acc[ai][bj][m][n], 0, 0, 0); __builtin_amdgcn_s_setprio(0); } while (0)
#define PG8_WAIT_V(n) asm volatile("s_waitcnt vmcnt(" #n ")" ::: "memory")
#define PG8_WAIT_L(n) asm volatile("s_waitcnt lgkmcnt(" #n ")" ::: "memory")
#define PG8_BAR __builtin_amdgcn_s_barrier()
#define PG8_SCHED __builtin_amdgcn_sched_barrier(0)
    Unit cur, nxt; int ui = 0;
    if (!S.next(0, cur)) return;
    f32x4 acc[2][2][4][2];
#pragma unroll
    for (int a = 0; a < 2; ++a)
#pragma unroll
        for (int b = 0; b < 2; ++b)
#pragma unroll
            for (int m = 0; m < 4; ++m)
#pragma unroll
                for (int n = 0; n < 2; ++n) acc[a][b][m][n] = (f32x4){0.f, 0.f, 0.f, 0.f};
    bf16x8 At[4][2], B0[2][2], B1[2][2];
    unsigned offC[2][2], offN[2][2];
    S.a_off(cur, Rr, Cc, offC);
    const char* cB = S.b_ptr(cur);
    if (Sched::DRAIN) PG8_WAIT_V(0);
    PG8_STAGE_B(PG8_SB(0, 0), cB); PG8_STAGE_B(PG8_SB(0, 1), cB + hstep); PG8_STAGE_A(PG8_SA(0, 0), A0, offC[0][0], offC[0][1]); PG8_STAGE_A(PG8_SA(0, 1), A0, offC[1][0], offC[1][1]);
    if (wr == 1) PG8_BAR;
    PG8_WAIT_V(2); PG8_BAR;
    PG8_STAGE_B(PG8_SB(1, 0), cB + kstep); PG8_STAGE_A(PG8_SA(1, 0), A0 + kstep, offC[0][0], offC[0][1]); PG8_STAGE_B(PG8_SB(1, 1), cB + hstep + kstep);
    PG8_WAIT_V(6); PG8_BAR;
    for (;;) {
        const bool has_next = S.next(ui + 1, nxt);
        const char* nB = cB;
        if (has_next) { S.a_off(nxt, Rr, Cc, offN); nB = S.b_ptr(nxt); }
        else {
#pragma unroll
            for (int h = 0; h < 2; ++h)
#pragma unroll
                for (int i = 0; i < 2; ++i) offN[h][i] = offC[h][i];
        }
        if (Sched::DRAIN) PG8_WAIT_V(0);
        for (int t = 0; t < nt; t += 2) {
            const bool last = (t == nt - 2);
            const char* a1 = A0 + (size_t)(t + 1) * kstep;
            const char* a2 = last ? A0 : A0 + (size_t)(t + 2) * kstep; const char* b2 = last ? nB : cB + (size_t)(t + 2) * kstep;
            const char* a3 = a2 + kstep; const char* b3 = b2 + kstep;
            const unsigned o00 = last ? offN[0][0] : offC[0][0], o01 = last ? offN[0][1] : offC[0][1], o10 = last ? offN[1][0] : offC[1][0], o11 = last ? offN[1][1] : offC[1][1];
            PG8_LDB(B0, 0, 0); PG8_LDB(B1, 0, 1); PG8_SCHED; PG8_LDA(At, 0, 0); PG8_STAGE_A(PG8_SA(1, 1), a1, offC[1][0], offC[1][1]);
            PG8_WAIT_V(8); PG8_WAIT_L(0); PG8_BAR; PG8_MMA(0, 0, At, B0); PG8_MMA(0, 1, At, B1); PG8_BAR; PG8_SCHED;
            PG8_LDA(At, 0, 1); PG8_STAGE_B(PG8_SB(0, 0), b2); PG8_STAGE_B(PG8_SB(0, 1), b2 + hstep); PG8_STAGE_A(PG8_SA(0, 0), a2, o00, o01);
            PG8_WAIT_V(8); PG8_WAIT_L(0); PG8_BAR; PG8_MMA(1, 0, At, B0); PG8_MMA(1, 1, At, B1); PG8_BAR; PG8_SCHED;
            PG8_LDB(B0, 1, 0); PG8_LDB(B1, 1, 1); PG8_SCHED; PG8_LDA(At, 1, 0); PG8_STAGE_A(PG8_SA(0, 1), a2, o10, o11);
            PG8_WAIT_V(8); PG8_WAIT_L(0); PG8_BAR; PG8_MMA(0, 0, At, B0); PG8_MMA(0, 1, At, B1); PG8_BAR; PG8_SCHED;
            PG8_LDA(At, 1, 1); PG8_STAGE_B(PG8_SB(1, 0), b3); PG8_STAGE_B(PG8_SB(1, 1), b3 + hstep); PG8_STAGE_A(PG8_SA(1, 0), a3, o00, o01);
            PG8_WAIT_V(8); PG8_WAIT_L(0); PG8_BAR; PG8_MMA(1, 0, At, B0); PG8_MMA(1, 1, At, B1); PG8_BAR; PG8_SCHED;
        }
        if (wr == 0) PG8_BAR;
        E(acc, cur, wr, wc, fr, fq);
        if (!has_next) break;
#pragma unroll
        for (int a = 0; a < 2; ++a)
#pragma unroll
            for (int b = 0; b < 2; ++b)
#pragma unroll
                for (int m = 0; m < 4; ++m)
#pragma unroll
                    for (int n = 0; n < 2; ++n) acc[a][b][m][n] = (f32x4){0.f, 0.f, 0.f, 0.f};
        cur = nxt; cB = nB; ++ui;
#pragma unroll
        for (int h = 0; h < 2; ++h)
#pragma unroll
            for (int i = 0; i < 2; ++i) offC[h][i] = offN[h][i];
        if (wr == 1) PG8_BAR;
    }
    PG8_WAIT_V(0);
    PG8_BAR;
#undef PG8_SA
#undef PG8_SB
#undef PG8_STAGE_A
#undef PG8_STAGE_B
#undef PG8_LDA
#undef PG8_LDB
#undef PG8_MMA
#undef PG8_WAIT_V
#undef PG8_WAIT_L
#undef PG8_BAR
#undef PG8_SCHED
}
}

namespace {
struct Params { const float* in[20]; float* out; unsigned char* ws; };

struct Frame {
    LAS unsigned char* lds;
    int tid, lane, wave, G, vcu, gw, ngw;
};

__device__ __forceinline__ void transpose_item(const float* Wt  , int ldw, bf16_t* WTt  , int ldt, float scale, LAS float* scr, int lane) {
#pragma unroll 8
    for (int i = 0; i < 32; ++i) { const int kk = 2 * i + (lane >> 5); scr[kk * 33 + (lane & 31)] = Wt[(size_t)kk * ldw + (lane & 31)]; }
    asm volatile("s_waitcnt lgkmcnt(0)" ::: "memory");
    const int c = lane & 7;
#pragma unroll
    for (int j = 0; j < 4; ++j) { const int n = (lane >> 3) + 8 * j; const LAS float* s = scr + (8 * c) * 33 + n;
        u32x4 o; o.x = pk2(s[0 * 33] * scale, s[1 * 33] * scale); o.y = pk2(s[2 * 33] * scale, s[3 * 33] * scale); o.z = pk2(s[4 * 33] * scale, s[5 * 33] * scale); o.w = pk2(s[6 * 33] * scale, s[7 * 33] * scale);
        *(u32x4*)(WTt + (size_t)n * ldt + 8 * c) = o; }
    asm volatile("s_waitcnt lgkmcnt(0)" ::: "memory");
}

__device__ __forceinline__ void p0_prologue(const Params& P, Frame& F) {
    unsigned char* ws = P.ws;
    const float* w_in = P.in[2];
    LAS float* scr = (LAS float*)(F.lds + F.wave * 8448);
    LAS float* gwl = (LAS float*)(F.lds + 73728);
    for (int i = F.tid; i < 1024 * 8; i += NTHR) gwl[i] = w_in[(size_t)(i >> 3) * DIN + NZ + (i & 7)];
    __syncthreads();
    constexpr int I_IN = 16 * 96, I_OUT = 16 * 32, I_QK = 8 * 2 * 4, I_GU = NE * 16 * 64, I_D = NE * 16 * 32, I_ZERO = 8 * 3;
    constexpr int NITEMS = I_IN + I_OUT + I_QK + I_ZERO + I_GU + I_D;
    bf16_t* WinT = (bf16_t*)(ws + WS_WIN); bf16_t* WoutT = (bf16_t*)(ws + WS_WOUT); bf16_t* WqkT = (bf16_t*)(ws + WS_WQK);
    bf16_t* WguT = (bf16_t*)(ws + WS_WGU); bf16_t* WdT = (bf16_t*)(ws + WS_WD);
    for (int it = F.gw; it < NITEMS; it += F.ngw) {
        int r = it;
        if (r < I_IN) { const int kb = r / 96, nb = r % 96; transpose_item(w_in + (size_t)(64 * kb) * DIN + 32 * nb, DIN, WinT + (size_t)(32 * nb) * DM + 64 * kb, DM, 1.f, scr, F.lane); continue; } r -= I_IN;
        if (r < I_OUT) { const int kb = r / 32, nb = r % 32; transpose_item(P.in[12] + (size_t)(64 * kb) * DM + 32 * nb, DM, WoutT + (size_t)(32 * nb) * DM + 64 * kb, DM, 1.f, scr, F.lane); continue; } r -= I_OUT;
        if (r < I_QK) { const int isk = r >> 5, h = (r >> 3) & 3, kb = (r >> 2) & 1, nb = r & 3;
            const float* src = P.in[isk ? 8 : 7] + (size_t)h * 16384 + (size_t)(64 * kb) * 128 + 32 * nb;
            transpose_item(src, 128, WqkT + (size_t)(isk * 512 + h * 128 + 32 * nb) * 512 + h * 128 + 64 * kb, 512, isk ? 0.08838834764831845f : 1.f, scr, F.lane); continue; } r -= I_QK;
        if (r < I_ZERO) {
            const int rb = r / 3, j = r % 3, cb = j + (j >= (rb & 3) ? 1 : 0);
            for (int q = F.lane; q < 128 * 16; q += 64) { const int rr = q >> 4, cc = q & 15; *(u32x4*)(WqkT + (size_t)(rb * 128 + rr) * 512 + cb * 128 + cc * 8) = (u32x4){0u, 0u, 0u, 0u}; }
            continue; } r -= I_ZERO;
        if (r < I_GU) { const int e = r >> 10, kb = (r >> 6) & 15, nb = r & 63, n0 = 32 * nb, f = n0 & 1023, up = n0 >> 10;
            const int drow = (f >> 7) * 256 + up * 128 + (f & 127);
            transpose_item(P.in[16] + (size_t)e * DM * 2 * DFF + (size_t)(64 * kb) * 2 * DFF + n0, 2 * DFF, WguT + (size_t)e * 2 * DFF * DM + (size_t)drow * DM + 64 * kb, DM, 1.f, scr, F.lane); continue; } r -= I_GU;
        { const int e = r >> 9, kb = (r >> 5) & 15, nb = r & 31;
            transpose_item(P.in[18] + (size_t)e * DFF * DM + (size_t)(64 * kb) * DM + 32 * nb, DM, WdT + (size_t)e * DM * DFF + (size_t)(32 * nb) * DFF + 64 * kb, DFF, 1.f, scr, F.lane); }
    }
    const float* x = P.in[0]; const float* g1 = P.in[1];
    bf16_t* XN = (bf16_t*)(ws + WS_XN); float* GATE = (float*)(ws + WS_GATE);
    for (int row = F.gw; row < T; row += F.ngw) {
        const f32x4* xr = (const f32x4*)(x + (size_t)row * DM);
        f32x4 v[4]; float s = 0.f;
#pragma unroll
        for (int j = 0; j < 4; ++j) { v[j] = xr[F.lane + 64 * j]; s += v[j][0] * v[j][0] + v[j][1] * v[j][1] + v[j][2] * v[j][2] + v[j][3] * v[j][3]; }
        s = wave_sum(s);
        const float rs = 1.0f / sqrtf(s * (1.0f / DM) + EPS);
        float ga[8];
#pragma unroll
        for (int c = 0; c < 8; ++c) ga[c] = 0.f;
#pragma unroll
        for (int j = 0; j < 4; ++j) { const f32x4 gg = ((const f32x4*)g1)[F.lane + 64 * j]; v[j] = v[j] * rs * gg;
            u32x2 w; w.x = pk2(v[j][0], v[j][1]); w.y = pk2(v[j][2], v[j][3]);
            *(u32x2*)(XN + (size_t)row * DM + 4 * (F.lane + 64 * j)) = w;
#pragma unroll
            for (int q = 0; q < 4; ++q) { const int k = 4 * (F.lane + 64 * j) + q; const f32x4 w0 = *(const LAS f32x4*)(gwl + k * 8), w1 = *(const LAS f32x4*)(gwl + k * 8 + 4);
                ga[0] += v[j][q] * w0[0]; ga[1] += v[j][q] * w0[1]; ga[2] += v[j][q] * w0[2]; ga[3] += v[j][q] * w0[3];
                ga[4] += v[j][q] * w1[0]; ga[5] += v[j][q] * w1[1]; ga[6] += v[j][q] * w1[2]; ga[7] += v[j][q] * w1[3]; } }
#pragma unroll
        for (int c = 0; c < 8; ++c) ga[c] = wave_sum(ga[c]);
        if (F.lane == 0) { *(f32x4*)(GATE + (size_t)row * 8) = (f32x4){ga[0], ga[1], ga[2], ga[3]}; *(f32x4*)(GATE + (size_t)row * 8 + 4) = (f32x4){ga[4], ga[5], ga[6], ga[7]}; }
    }
}

__device__ __forceinline__ void p2_tokprep(const Params& P, Frame& F) {
    bf16_t* Z = (bf16_t*)(P.ws + WS_Z); bf16_t* XC = (bf16_t*)(P.ws + WS_XC);
    const float* gq = P.in[3]; const float* gk = P.in[4]; const float* cw = P.in[5]; const float* cb = P.in[6];
    const int lane = F.lane;
    for (int tok = F.gw; tok < T; tok += F.ngw) {
        bf16_t* zr = Z + (size_t)tok * NZ;
#pragma unroll
        for (int part = 0; part < 2; ++part) {
            bf16_t* p = zr + (part ? ZK : ZQ) + lane * 8;
            const float* g = (part ? gk : gq) + (lane & 7) * 8;
            const u32x4 w = *(const u32x4*)p;
            float a[8] = {bflo(w.x), bfhi(w.x), bflo(w.y), bfhi(w.y), bflo(w.z), bfhi(w.z), bflo(w.w), bfhi(w.w)};
            float s = 0.f;
#pragma unroll
            for (int i = 0; i < 8; ++i) s += a[i] * a[i];
            s += __shfl_xor(s, 1); s += __shfl_xor(s, 2); s += __shfl_xor(s, 4);
            float r = 1.0f / sqrtf(s * (1.0f / 64.f) + EPS); if (!part) r *= 0.125f * LOG2E;
#pragma unroll
            for (int i = 0; i < 8; ++i) a[i] *= r * g[i];
            u32x4 o; o.x = pk2(a[0], a[1]); o.y = pk2(a[2], a[3]); o.z = pk2(a[4], a[5]); o.w = pk2(a[6], a[7]);
            *(u32x4*)p = o;
        }
        {
            const int tl = tok % SEQ; const int ch = lane * 8;
            float a[8];
#pragma unroll
            for (int i = 0; i < 8; ++i) a[i] = cb[ch + i];
#pragma unroll
            for (int j = 0; j < 4; ++j) { const int dt = 3 - j; if (tl - dt >= 0) {
                    const u32x4 w = *(const u32x4*)(Z + (size_t)(tok - dt) * NZ + ZXM + ch);
                    const float xv[8] = {bflo(w.x), bfhi(w.x), bflo(w.y), bfhi(w.y), bflo(w.z), bfhi(w.z), bflo(w.w), bfhi(w.w)};
#pragma unroll
                    for (int i = 0; i < 8; ++i) a[i] += cw[j * 512 + ch + i] * xv[i]; } }
#pragma unroll
            for (int i = 0; i < 8; ++i) a[i] = a[i] * sigmoidf_(a[i]);
            u32x4 o; o.x = pk2(a[0], a[1]); o.y = pk2(a[2], a[3]); o.z = pk2(a[4], a[5]); o.w = pk2(a[6], a[7]);
            *(u32x4*)(XC + (size_t)tok * 512 + ch) = o;
        }
    }
}

__device__ __forceinline__ void attn_phase(const Params& P, Frame& F) {
    const bf16_t* Z = (const bf16_t*)(P.ws + WS_Z); bf16_t* MIX = (bf16_t*)(P.ws + WS_MIX);
    const int lane = F.lane, i = lane & 15, g = lane >> 4;
    float gm = fabsf(P.in[4][lane]);
#pragma unroll
    for (int o = 1; o < 64; o <<= 1) gm = fmaxf(gm, __shfl_xor(gm, o));
    const float kmax = 8.0f * gm * 1.01f;
    LAS unsigned char* vb = F.lds + F.wave * 4608;
    const int vwr = (lane >> 3) * 144 + (lane & 7) * 16;
    const int vrd = (4 * g + (i >> 2)) * 144 + (i & 3) * 8;
    for (int tile = F.gw; tile < 8192; tile += F.ngw) {
        const int r = tile & 15, blk = (tile >> 4) & 31, h = (tile >> 9) & 7, b = tile >> 12;
        const int tl0 = blk * 256 + r, T0 = b * SEQ + tl0;
        const bf16_t* qrow = Z + (size_t)(T0 + 16 * i) * NZ + ZQ + h * 64;
        const bf16x8 qf0 = *(const bf16x8*)(qrow + 8 * g), qf1 = *(const bf16x8*)(qrow + 32 + 8 * g);
        float ss = 0.f;
#pragma unroll
        for (int j = 0; j < 8; ++j) { const float a = bf2f((unsigned short)qf0[j]), c = bf2f((unsigned short)qf1[j]); ss += a * a + c * c; }
        ss += __shfl_xor(ss, 16); ss += __shfl_xor(ss, 32);
        const float ref = sqrtf(ss) * kmax;
        const float slope2 = exp2f(-(float)(h + 1)) * LOG2E;
        f32x4 o[4];
#pragma unroll
        for (int dt = 0; dt < 4; ++dt) o[dt] = (f32x4){0.f, 0.f, 0.f, 0.f};
        float lsum = 0.f;
        const bf16_t* Kh = Z + (size_t)b * SEQ * NZ + ZK + h * 64 + 8 * g;
        const bf16_t* Vh = Z + (size_t)b * SEQ * NZ + ZV + h * 64 + 8 * (lane & 7);
        bf16x8 kfn[2][2]; u32x4 vrn[4];
#define ATT_LOAD(bi_) do { const int bi__ = (bi_); const int br_ = bi__ < 12 ? 0 : (bi__ < 18 ? 1 : 2); const int d_ = 1 << (2 * br_); const int nb_ = -128 + 32 * (bi__ - (br_ == 0 ? 0 : (br_ == 1 ? 12 : 18))); \
        _Pragma("unroll") for (int sb = 0; sb < 2; ++sb) { int kp = tl0 + (nb_ + 16 * sb + i) * d_; kp = kp < 0 ? 0 : (kp > SEQ - 1 ? SEQ - 1 : kp); const bf16_t* kr = Kh + (size_t)kp * NZ; kfn[sb][0] = *(const bf16x8*)kr; kfn[sb][1] = *(const bf16x8*)(kr + 32); } \
        _Pragma("unroll") for (int c = 0; c < 4; ++c) { int kp = tl0 + (nb_ + 8 * c + (lane >> 3)) * d_; kp = kp < 0 ? 0 : (kp > SEQ - 1 ? SEQ - 1 : kp); vrn[c] = *(const u32x4*)(Vh + (size_t)kp * NZ); } } while (0)
        ATT_LOAD(0);
        for (int bi = 0; bi < 23; ++bi) {
            bf16x8 kf[2][2]; u32x4 vr[4];
#pragma unroll
            for (int sb = 0; sb < 2; ++sb) { kf[sb][0] = kfn[sb][0]; kf[sb][1] = kfn[sb][1]; }
#pragma unroll
            for (int c = 0; c < 4; ++c) vr[c] = vrn[c];
            if (bi + 1 < 23) ATT_LOAD(bi + 1);
            const int br = bi < 12 ? 0 : (bi < 18 ? 1 : 2), dd = 1 << (2 * br), u = 16 / dd;
            const int nb = -128 + 32 * (bi - (br == 0 ? 0 : (br == 1 ? 12 : 18)));
#pragma unroll
            for (int c = 0; c < 4; ++c) *(LAS u32x4*)(vb + vwr + c * 8 * 144) = vr[c];
            f32x4 s[2];
#pragma unroll
            for (int sb = 0; sb < 2; ++sb) { s[sb] = __builtin_amdgcn_mfma_f32_16x16x32_bf16(kf[sb][0], qf0, (f32x4){0.f, 0.f, 0.f, 0.f}, 0, 0, 0);
                s[sb] = __builtin_amdgcn_mfma_f32_16x16x32_bf16(kf[sb][1], qf1, s[sb], 0, 0, 0); }
            float p[8];
#pragma unroll
            for (int sb = 0; sb < 2; ++sb)
#pragma unroll
                for (int j = 0; j < 4; ++j) { const int n = nb + 16 * sb + 4 * g + j, a = u * i - n;
                    const bool valid = (a >= 0) && (a <= 128) && (tl0 + n * dd >= 0);
                    const float e = s[sb][j] - slope2 * (float)(a * dd) - ref;
                    const float pv = valid ? __builtin_amdgcn_exp2f(e) : 0.f;
                    p[4 * sb + j] = pv; lsum += pv; }
            u32x4 pw; pw.x = pk2(p[0], p[1]); pw.y = pk2(p[2], p[3]); pw.z = pk2(p[4], p[5]); pw.w = pk2(p[6], p[7]);
            const bf16x8 pf = __builtin_bit_cast(bf16x8, pw);
#pragma unroll
            for (int dt = 0; dt < 4; ++dt) {
                const s16x4 v0 = __builtin_amdgcn_ds_read_tr16_b64_v4i16((LAS s16x4*)(vb + vrd + dt * 32));
                const s16x4 v1 = __builtin_amdgcn_ds_read_tr16_b64_v4i16((LAS s16x4*)(vb + vrd + 16 * 144 + dt * 32));
                const bf16x8 vf = (bf16x8){v0[0], v0[1], v0[2], v0[3], v1[0], v1[1], v1[2], v1[3]};
                o[dt] = __builtin_amdgcn_mfma_f32_16x16x32_bf16(vf, pf, o[dt], 0, 0, 0);
            }
        }
#undef ATT_LOAD
        lsum += __shfl_xor(lsum, 16); lsum += __shfl_xor(lsum, 32);
        const float inv = 1.0f / lsum;
        bf16_t* orow = MIX + (size_t)(T0 + 16 * i) * DM + h * 64 + 4 * g;
#pragma unroll
        for (int dt = 0; dt < 4; ++dt) { u32x2 w; w.x = pk2(o[dt][0] * inv, o[dt][1] * inv); w.y = pk2(o[dt][2] * inv, o[dt][3] * inv); *(u32x2*)(orow + 16 * dt) = w; }
    }
}

__device__ __forceinline__ void ml1_phase(const Params& P, Frame& F) {
    const bf16_t* Z = (const bf16_t*)(P.ws + WS_Z); const bf16_t* QK = (const bf16_t*)(P.ws + WS_QK); const float* GATE = (const float*)(P.ws + WS_GATE);
    float* BC = (float*)(P.ws + WS_BC); float* IG = (float*)(P.ws + WS_IG); float* BT = (float*)(P.ws + WS_BT); float* U = (float*)(P.ws + WS_U); float* NV = (float*)(P.ws + WS_NV);
    const float* bi = P.in[9]; const float* bf = P.in[10];
    LAS float* bc = (LAS float*)(F.lds); LAS float* wv = bc + 256; LAS float* Ks = wv + 256; LAS float* Vs = Ks + 32 * 128;
    const int tid = F.tid;
    for (int unit = F.vcu; unit < 256; unit += F.G) {
        const int bh = unit / NCH, c = unit % NCH, b = bh / NHM, h = bh % NHM, t0 = b * SEQ + c * CH;
        float ig = 0.f;
        __syncthreads();
        if (tid < 256) { const float f = GATE[(size_t)(t0 + tid) * 8 + 4 + h] + bf[h];
            bc[tid] = fminf(f, 0.f) - log1pf(__expf(-fabsf(f)));
            ig = GATE[(size_t)(t0 + tid) * 8 + h] + bi[h]; }
        __syncthreads();
        if (tid == 0) { float s = 0.f; for (int q = 0; q < 256; ++q) { s += bc[q]; bc[q] = s; } }
        __syncthreads();
        if (tid < 256) { BC[(size_t)(t0 + tid) * 4 + h] = bc[tid]; IG[(size_t)(t0 + tid) * 4 + h] = ig; wv[tid] = __expf(bc[255] - bc[tid] + ig); }
        if (tid == 0) BT[unit] = bc[255];
        const int d = tid >> 2, e0 = (tid & 3) * 32;
        float acc[32]; float nv = 0.f;
#pragma unroll
        for (int q = 0; q < 32; ++q) acc[q] = 0.f;
        for (int s0 = 0; s0 < CH; s0 += 32) {
            __syncthreads();
            { const int rr = tid >> 4, cc = (tid & 15) * 8;
                const u32x4 kw = *(const u32x4*)(QK + (size_t)(t0 + s0 + rr) * 1024 + 512 + h * 128 + cc);
                const u32x4 vw = *(const u32x4*)(Z + (size_t)(t0 + s0 + rr) * NZ + ZVM + h * 128 + cc);
                LAS float* kd = Ks + rr * 128 + cc; LAS float* vd = Vs + rr * 128 + cc;
                kd[0] = bflo(kw.x); kd[1] = bfhi(kw.x); kd[2] = bflo(kw.y); kd[3] = bfhi(kw.y); kd[4] = bflo(kw.z); kd[5] = bfhi(kw.z); kd[6] = bflo(kw.w); kd[7] = bfhi(kw.w);
                vd[0] = bflo(vw.x); vd[1] = bfhi(vw.x); vd[2] = bflo(vw.y); vd[3] = bfhi(vw.y); vd[4] = bflo(vw.z); vd[5] = bfhi(vw.z); vd[6] = bflo(vw.w); vd[7] = bfhi(vw.w); }
            __syncthreads();
            for (int rr = 0; rr < 32; ++rr) { const float kw = Ks[rr * 128 + d] * wv[s0 + rr]; nv += kw;
#pragma unroll
                for (int q = 0; q < 32; ++q) acc[q] += kw * Vs[rr * 128 + e0 + q]; }
        }
        float* up = U + (size_t)unit * 16384 + d * 128 + e0;
#pragma unroll
        for (int q = 0; q < 32; q += 4) *(f32x4*)(up + q) = (f32x4){acc[q], acc[q + 1], acc[q + 2], acc[q + 3]};
        if ((tid & 3) == 0) NV[unit * 128 + d] = nv;
    }
}

__device__ __forceinline__ void ml3_phase(const Params& P, Frame& F) {
    const bf16_t* Z = (const bf16_t*)(P.ws + WS_Z); const bf16_t* QK = (const bf16_t*)(P.ws + WS_QK);
    const float* BC = (const float*)(P.ws + WS_BC); const float* IG = (const float*)(P.ws + WS_IG); const float* BT = (const float*)(P.ws + WS_BT);
    const float* U = (const float*)(P.ws + WS_U); const float* NV = (const float*)(P.ws + WS_NV); const float* gn = P.in[11];
    bf16_t* MIX = (bf16_t*)(P.ws + WS_MIX);
    LAS float* Cs = (LAS float*)F.lds; LAS float* nvs = Cs + 16384; LAS float* Qs = nvs + 128; LAS float* Ks = Qs + 4096; LAS float* Vs = Ks + 4096;
    LAS float* Ps = Vs + 4096; LAS float* bq = Ps + 32 * 33; LAS float* bk = bq + 32; LAS float* ik = bk + 32;
    const int tid = F.tid;
    for (int unit = F.vcu; unit < 256; unit += F.G) {
        const int bh = unit / NCH, c = unit % NCH, b = bh / NHM, h = bh % NHM, t0 = b * SEQ + c * CH;
        __syncthreads();
        {   float cc[32]; float n = 0.f;
#pragma unroll
            for (int q = 0; q < 32; ++q) cc[q] = 0.f;
            for (int j = 0; j < c; ++j) {
                const float dec = __expf(BT[bh * NCH + j]);
                const float* up = U + (size_t)(bh * NCH + j) * 16384;
#pragma unroll
                for (int q = 0; q < 32; ++q) cc[q] = dec * cc[q] + up[tid + 512 * q];
                if (tid < 128) n = dec * n + NV[(bh * NCH + j) * 128 + tid];
            }
#pragma unroll
            for (int q = 0; q < 32; ++q) Cs[tid + 512 * q] = cc[q];
            if (tid < 128) nvs[tid] = n;
        }
        const int r = tid >> 4, e0 = (tid & 15) * 8;
        const int lr = tid >> 4, lc = (tid & 15) * 8;
        for (int qb = 0; qb < 8; ++qb) {
            __syncthreads();
            { const u32x4 w = *(const u32x4*)(QK + (size_t)(t0 + qb * 32 + lr) * 1024 + h * 128 + lc); LAS float* qd = Qs + lr * 128 + lc;
                qd[0] = bflo(w.x); qd[1] = bfhi(w.x); qd[2] = bflo(w.y); qd[3] = bfhi(w.y); qd[4] = bflo(w.z); qd[5] = bfhi(w.z); qd[6] = bflo(w.w); qd[7] = bfhi(w.w); }
            if (tid < 32) bq[tid] = BC[(size_t)(t0 + qb * 32 + tid) * 4 + h];
            __syncthreads();
            float num[8]; float den = 0.f;
#pragma unroll
            for (int q = 0; q < 8; ++q) num[q] = 0.f;
            for (int d = 0; d < 128; ++d) { const float qv = Qs[r * 128 + d]; den += qv * nvs[d];
#pragma unroll
                for (int q = 0; q < 8; ++q) num[q] += qv * Cs[d * 128 + e0 + q]; }
            const float eb = __expf(bq[r]);
            den *= eb;
#pragma unroll
            for (int q = 0; q < 8; ++q) num[q] *= eb;
            for (int kb = 0; kb <= qb; ++kb) {
                __syncthreads();
                { const u32x4 kw = *(const u32x4*)(QK + (size_t)(t0 + kb * 32 + lr) * 1024 + 512 + h * 128 + lc);
                    const u32x4 vw = *(const u32x4*)(Z + (size_t)(t0 + kb * 32 + lr) * NZ + ZVM + h * 128 + lc);
                    LAS float* kd = Ks + lr * 128 + lc; LAS float* vd = Vs + lr * 128 + lc;
                    kd[0] = bflo(kw.x); kd[1] = bfhi(kw.x); kd[2] = bflo(kw.y); kd[3] = bfhi(kw.y); kd[4] = bflo(kw.z); kd[5] = bfhi(kw.z); kd[6] = bflo(kw.w); kd[7] = bfhi(kw.w);
                    vd[0] = bflo(vw.x); vd[1] = bfhi(vw.x); vd[2] = bflo(vw.y); vd[3] = bfhi(vw.y); vd[4] = bflo(vw.z); vd[5] = bfhi(vw.z); vd[6] = bflo(vw.w); vd[7] = bfhi(vw.w); }
                if (tid < 32) { bk[tid] = BC[(size_t)(t0 + kb * 32 + tid) * 4 + h]; ik[tid] = IG[(size_t)(t0 + kb * 32 + tid) * 4 + h]; }
                __syncthreads();
#pragma unroll
                for (int uu = 0; uu < 2; ++uu) { const int id = tid * 2 + uu, pr = id >> 5, pc = id & 31;
                    float s = 0.f;
                    for (int d = 0; d < 128; ++d) s += Qs[pr * 128 + d] * Ks[pc * 128 + d];
                    const int tq = qb * 32 + pr, ts = kb * 32 + pc;
                    Ps[pr * 33 + pc] = (ts <= tq) ? s * __expf(bq[pr] - bk[pc] + ik[pc]) : 0.f; }
                __syncthreads();
                for (int pc = 0; pc < 32; ++pc) { const float pv = Ps[r * 33 + pc]; den += pv;
#pragma unroll
                    for (int q = 0; q < 8; ++q) num[q] += pv * Vs[pc * 128 + e0 + q]; }
            }
            const float dd = 1.0f / fmaxf(fabsf(den), 1.0f);
            float ss = 0.f;
#pragma unroll
            for (int q = 0; q < 8; ++q) { num[q] *= dd; ss += num[q] * num[q]; }
            ss += __shfl_xor(ss, 1); ss += __shfl_xor(ss, 2); ss += __shfl_xor(ss, 4); ss += __shfl_xor(ss, 8);
            const float rstd = 1.0f / sqrtf(ss * (1.0f / HDM) + EPS);
            const int tok = t0 + qb * 32 + r;
            const u32x4 ow = *(const u32x4*)(Z + (size_t)tok * NZ + ZOM + h * 128 + e0);
            const float og[8] = {bflo(ow.x), bfhi(ow.x), bflo(ow.y), bfhi(ow.y), bflo(ow.z), bfhi(ow.z), bflo(ow.w), bfhi(ow.w)};
            float res[8];
#pragma unroll
            for (int q = 0; q < 8; ++q) res[q] = sigmoidf_(og[q]) * num[q] * rstd * gn[h * 128 + e0 + q];
            u32x4 w; w.x = pk2(res[0], res[1]); w.y = pk2(res[2], res[3]); w.z = pk2(res[4], res[5]); w.w = pk2(res[6], res[7]);
            *(u32x4*)(MIX + (size_t)tok * DM + 512 + h * 128 + e0) = w;
        }
    }
}

__device__ __forceinline__ void router_phase(const Params& P, Frame& F) {
    const float* X1 = P.out; const float* g2 = P.in[13]; const float* wr = P.in[14]; const float* br = P.in[15];
    bf16_t* H2 = (bf16_t*)(P.ws + WS_XN); int* cnt = (int*)(P.ws + WS_CTL); int* ltok = (int*)(P.ws + WS_LTOK); float* lgate = (float*)(P.ws + WS_LGATE); int* tke = (int*)(P.ws + WS_TKE);
    const int lane = F.lane;
    for (int tok = F.gw; tok < T; tok += F.ngw) {
        const f32x4* xr = (const f32x4*)(X1 + (size_t)tok * DM);
        f32x4 v[4]; float s = 0.f;
#pragma unroll
        for (int j = 0; j < 4; ++j) { v[j] = xr[lane + 64 * j]; s += v[j][0] * v[j][0] + v[j][1] * v[j][1] + v[j][2] * v[j][2] + v[j][3] * v[j][3]; }
        s = wave_sum(s);
        const float r = 1.0f / sqrtf(s * (1.0f / DM) + EPS);
#pragma unroll
        for (int j = 0; j < 4; ++j) { const f32x4 gg = ((const f32x4*)g2)[lane + 64 * j]; v[j] = v[j] * r * gg;
            u32x2 w; w.x = pk2(v[j][0], v[j][1]); w.y = pk2(v[j][2], v[j][3]); *(u32x2*)(H2 + (size_t)tok * DM + 4 * (lane + 64 * j)) = w; }
        float mylogit = -INFINITY;
        for (int e4 = 0; e4 < NE; e4 += 4) {
            f32x4 pa = (f32x4){0.f, 0.f, 0.f, 0.f};
#pragma unroll
            for (int j = 0; j < 4; ++j)
#pragma unroll
                for (int q = 0; q < 4; ++q) { const int k = 4 * (lane + 64 * j) + q; pa += *(const f32x4*)(wr + (size_t)k * NE + e4) * v[j][q]; }
#pragma unroll
            for (int q = 0; q < 4; ++q) { const float pq = wave_sum(pa[q]) + br[e4 + q]; if (lane == e4 + q) mylogit = pq; }
        }
        float tv[4]; int te[4];
#pragma unroll
        for (int k = 0; k < 4; ++k) {
            float bv = mylogit; int bi = lane;
#pragma unroll
            for (int off = 1; off < 64; off <<= 1) { const float ov = __shfl_xor(bv, off); const int oi = __shfl_xor(bi, off);
                if (ov > bv || (ov == bv && oi < bi)) { bv = ov; bi = oi; } }
            tv[k] = bv; te[k] = bi;
            if (lane == bi) mylogit = -INFINITY;
        }
        const float e1 = __expf(tv[1] - tv[0]), e2 = __expf(tv[2] - tv[0]), e3 = __expf(tv[3] - tv[0]);
        const float inv = 1.0f / (1.0f + e1 + e2 + e3);
        if (lane < 4) {
            const int ee = lane == 0 ? te[0] : (lane == 1 ? te[1] : (lane == 2 ? te[2] : te[3]));
            const float gg = (lane == 0 ? 1.0f : (lane == 1 ? e1 : (lane == 2 ? e2 : e3))) * inv;
            const int p = atomicAdd(&cnt[ee], 1);
            ltok[ee * T + p] = tok; lgate[ee * T + p] = gg; tke[tok * 4 + lane] = ee | (p << 8);
        }
    }
}

__device__ __forceinline__ void build_tables(const Params& P, Frame& F) {
    LAS int* trs = (LAS int*)(F.lds + LDS_TAB); LAS int* cnts = trs + 64;
    const int* cnt = (const int*)(P.ws + WS_CTL);
    if (F.tid == 0) { int a = 0; for (int e = 0; e < NE; ++e) { const int n = cnt[e]; trs[e] = a; cnts[e] = n; a += (n + 255) >> 8; } trs[NE] = a; }
    __syncthreads();
}

__device__ __forceinline__ void combine_phase(const Params& P, Frame& F) {
    const LAS int* trs = (const LAS int*)(F.lds + LDS_TAB);
    const bf16_t* Y = (const bf16_t*)(P.ws + WS_Y); const int* tke = (const int*)(P.ws + WS_TKE);
    float* out = P.out; const int lane = F.lane;
    for (int tok = F.gw; tok < T; tok += F.ngw) {
        f32x4 a[4];
#pragma unroll
        for (int j = 0; j < 4; ++j) a[j] = *(const f32x4*)(out + (size_t)tok * DM + 4 * (lane + 64 * j));
#pragma unroll
        for (int k = 0; k < 4; ++k) { const int w = tke[tok * 4 + k], e = w & 255, p = w >> 8; const size_t slot = (size_t)trs[e] * 256 + p;
#pragma unroll
            for (int j = 0; j < 4; ++j) { const u32x2 y = *(const u32x2*)(Y + slot * DM + 4 * (lane + 64 * j)); a[j][0] += bflo(y.x); a[j][1] += bfhi(y.x); a[j][2] += bflo(y.y); a[j][3] += bfhi(y.y); } }
#pragma unroll
        for (int j = 0; j < 4; ++j) *(f32x4*)(out + (size_t)tok * DM + 4 * (lane + 64 * j)) = a[j];
    }
}

__global__ void __launch_bounds__(NTHR) fwd_megakernel(Params P) {
    extern __shared__ __attribute__((aligned(16))) unsigned char lds_raw[];
    cg::grid_group grid = cg::this_grid();
    Frame F;
    F.lds = (LAS unsigned char*)lds_raw;
    F.tid = threadIdx.x; F.lane = F.tid & 63; F.wave = __builtin_amdgcn_readfirstlane(F.tid >> 6);
    F.G = gridDim.x; { const int bx = blockIdx.x; F.vcu = (F.G % 8 == 0) ? (bx % 8) * (F.G / 8) + bx / 8 : bx; }
    F.gw = F.vcu * NWAVES + F.wave; F.ngw = F.G * NWAVES;
    unsigned char* ws = P.ws;
    LAS unsigned char* stage = F.lds + LDS_STAGE;

    p0_prologue(P, F);
    grid.sync();
    {
        pg8::DenseSched S{T / 256, NZ / 256, F.G, (int)blockIdx.x, DM, (const char*)(ws + WS_WIN)};
        pg8::EpiBf16 E{(bf16_t*)(ws + WS_Z), NZ};
        pg8::gemm_phase(stage, (const char*)(ws + WS_XN), DM, S, E);
    }
    grid.sync();
    p2_tokprep(P, F);
    grid.sync();
    {
        pg8::DenseSched S{T / 256, 1024 / 256, F.G, (int)blockIdx.x, 512, (const char*)(ws + WS_WQK)};
        pg8::EpiBf16 E{(bf16_t*)(ws + WS_QK), 1024};
        pg8::gemm_phase(stage, (const char*)(ws + WS_XC), 512, S, E);
    }
    attn_phase(P, F);
    grid.sync();
    ml1_phase(P, F);
    grid.sync();
    ml3_phase(P, F);
    grid.sync();
    {
        pg8::DenseSched S{T / 256, DM / 256, F.G, (int)blockIdx.x, DM, (const char*)(ws + WS_WOUT)};
        pg8::EpiResF32 E{P.out, P.in[0], DM};
        pg8::gemm_phase(stage, (const char*)(ws + WS_MIX), DM, S, E);
    }
    grid.sync();
    router_phase(P, F);
    grid.sync();
    build_tables(P, F);
    const LAS int* trs = (const LAS int*)(F.lds + LDS_TAB); const LAS int* cnts = trs + 64;
    {
        pg8::MoeSched<true> S{trs, cnts, 8, F.G, (int)blockIdx.x, DM, (const char*)(ws + WS_WGU), (size_t)2 * DFF * DM * 2, (const int*)(ws + WS_LTOK)};
        pg8::EpiSwiglu E{(bf16_t*)(ws + WS_ACT), P.in[17]};
        pg8::gemm_phase(stage, (const char*)(ws + WS_XN), DM, S, E);
    }
    grid.sync();
    {
        pg8::MoeSched<false> S{trs, cnts, 4, F.G, (int)blockIdx.x, DFF, (const char*)(ws + WS_WD), (size_t)DM * DFF * 2, nullptr};
        pg8::EpiDown E{(bf16_t*)(ws + WS_Y), P.in[19], (const float*)(ws + WS_LGATE), cnts};
        pg8::gemm_phase(stage, (const char*)(ws + WS_ACT), DFF, S, E);
    }
    grid.sync();
    combine_phase(P, F);
}
}

extern "C" void kernel_launch(void* const* d_in, const int* in_sizes, int n_in, void* d_out, int out_size, void* d_ws, size_t ws_size, hipStream_t stream) {
    static int grid = 0;
    if (grid == 0) {
        if (n_in != 20 || out_size != T * DM || ws_size < WS_END) { fprintf(stderr, "kernel_launch: unexpected problem (n_in %d out %d ws %zu)\n", n_in, out_size, ws_size); grid = -1; return; }
        int dev = 0, cus = 0, per_cu = 0;
        (void)hipGetDevice(&dev);
        (void)hipDeviceGetAttribute(&cus, hipDeviceAttributeMultiprocessorCount, dev);
        (void)hipFuncSetAttribute((const void*)fwd_megakernel, hipFuncAttributeMaxDynamicSharedMemorySize, LDS_BYTES);
        (void)hipOccupancyMaxActiveBlocksPerMultiprocessor(&per_cu, (const void*)fwd_megakernel, NTHR, LDS_BYTES);
        if (per_cu < 1) { fprintf(stderr, "kernel_launch: occupancy query says %d blocks per CU\n", per_cu); per_cu = 1; }
        grid = cus;
    }
    if (grid < 0) return;
    (void)hipMemsetAsync((char*)d_ws + WS_CTL, 0, 65536, stream);
    Params p{};
    for (int i = 0; i < 20; ++i) p.in[i] = (const float*)d_in[i];
    p.out = (float*)d_out; p.ws = (unsigned char*)d_ws;
    void* args[] = {&p};
    hipError_t e = hipLaunchCooperativeKernel((const void*)fwd_megakernel, dim3(grid), dim3(NTHR), args, LDS_BYTES, stream);
    if (e != hipSuccess) fprintf(stderr, "cooperative launch failed: %s (grid %d)\n", hipGetErrorString(e), grid);
}
```

```cpp
#include <hip/hip_runtime.h>
#include <cstdio>
#include <cstdint>

#define LAS __attribute__((address_space(3)))
typedef unsigned short bf16_t;
typedef short bf16x8 __attribute__((ext_vector_type(8)));
typedef short s16x4 __attribute__((ext_vector_type(4)));
typedef float f32x4 __attribute__((ext_vector_type(4)));
typedef unsigned u32x4 __attribute__((ext_vector_type(4)));
typedef unsigned u32x2 __attribute__((ext_vector_type(2)));

namespace {
constexpr int BATCH = 2, SEQ = 8192, T = BATCH * SEQ, DM = 1024, DIN = 3080, NZ = 3072;
constexpr int NHA = 8, NHM = 4, HDM = 128;
constexpr int NE = 32, DFF = 1024;
constexpr int CH = 256, NCH = SEQ / CH;
constexpr float EPS = 1e-6f;
constexpr float LOG2E = 1.4426950408889634f;
constexpr int ZQ = 0, ZK = 512, ZV = 1024, ZXM = 1536, ZVM = 2048, ZOM = 2560;
constexpr int NWAVES = 8, NTHR = 512;
constexpr int MAXTR = 288;
constexpr size_t MiB = 1u << 20;
constexpr size_t WS_CTL = 0;
constexpr size_t WS_WIN = 1 * MiB;
constexpr size_t WS_WOUT = 7 * MiB;
constexpr size_t WS_WQK = 9 * MiB;
constexpr size_t WS_WGU = 16 * MiB;
constexpr size_t WS_WD = 144 * MiB;
constexpr size_t WS_XN = 208 * MiB;
constexpr size_t WS_Z = 240 * MiB;
constexpr size_t WS_GATE = 336 * MiB;
constexpr size_t WS_XC = 337 * MiB;
constexpr size_t WS_QK = 353 * MiB;
constexpr size_t WS_BC = 385 * MiB;
constexpr size_t WS_IG = 385 * MiB + 512 * 1024;
constexpr size_t WS_BT = 386 * MiB;
constexpr size_t WS_NV = 386 * MiB + 4096;
constexpr size_t WS_U = 387 * MiB;
constexpr size_t WS_MIX = 403 * MiB;
constexpr size_t WS_LTOK = 435 * MiB;
constexpr size_t WS_LGATE = 437 * MiB;
constexpr size_t WS_TKE = 439 * MiB;
constexpr size_t WS_ACT = 440 * MiB;
constexpr size_t WS_Y = 584 * MiB;
constexpr size_t WS_END = 728 * MiB;
constexpr int LDS_STAGE = 0;
constexpr int LDS_TAB = 131072;
constexpr int LDS_BYTES = 131072 + 1024;

__device__ __forceinline__ unsigned f2bf(float f) { unsigned u = __builtin_bit_cast(unsigned, f); return (u + 0x7fffu + ((u >> 16) & 1u)) >> 16; }
__device__ __forceinline__ unsigned pk2(float lo, float hi) { return f2bf(lo) | (f2bf(hi) << 16); }
__device__ __forceinline__ float bf2f(unsigned b) { return __builtin_bit_cast(float, b << 16); }
__device__ __forceinline__ float bflo(unsigned w) { return __builtin_bit_cast(float, w << 16); }
__device__ __forceinline__ float bfhi(unsigned w) { return __builtin_bit_cast(float, w & 0xffff0000u); }
__device__ __forceinline__ float wave_sum(float v) {
#pragma unroll
    for (int o = 1; o < 64; o <<= 1) v += __shfl_xor(v, o);
    return v;
}
__device__ __forceinline__ float sigmoidf_(float x) { return 1.0f / (1.0f + __expf(-x)); }
}

namespace pg8 {
constexpr int BM = 256, BK = 64, HALF = 128, HTB = HALF * BK * 2, STAGE_BYTES = 8 * HTB, NXCD = 8, WGM = 8;
__host__ __device__ __forceinline__ int lds_byte(int r, int c) { const int st = (r >> 4) * 2 + (c >> 5), rr = r & 15, cc = c & 31, ob = rr * 64 + cc * 2; return st * 1024 + (ob ^ (((ob >> 9) & 1) << 5)); }
__host__ __device__ __forceinline__ void stage_rc(int b, int& R, int& C) { const int st = b / 1024, sb = b % 1024, swz = sb ^ (((sb >> 9) & 1) << 5); R = (st >> 1) * 16 + swz / 64; C = (st & 1) * 32 + (swz % 64) / 2; }
__host__ __device__ __forceinline__ int perm32(int rho) { const int n = rho >> 4, i = rho & 15; return 8 * (i >> 2) + 4 * n + (i & 3); }

__device__ __forceinline__ bool tile_order(int i, int G, int c, int nM, int nN, int& pm, int& pn) {
    const int nwg = nM * nN; const long L = (long)i * G + c; if (L >= nwg) return false;
    int wgid = (int)L; { const int q = nwg / NXCD, r = nwg % NXCD, xcd = wgid % NXCD, off = wgid / NXCD; wgid = (xcd < r ? xcd * (q + 1) : r * (q + 1) + (xcd - r) * q) + off; }
    const int nig = WGM * nN, gid = wgid / nig, fm = gid * WGM, gsz = (nM - fm) < WGM ? (nM - fm) : WGM;
    pm = fm + ((wgid % nig) % gsz); pn = (wgid % nig) / gsz; return true;
}

struct Unit { int pm, pn, e, mt; };

struct DenseSched {
    int nM, nN, G, c, K; const char* Bt;
    static constexpr bool DRAIN = false;
    __device__ __forceinline__ bool next(int i, Unit& u) const { u.e = 0; u.mt = 0; return tile_order(i, G, c, nM, nN, u.pm, u.pn); }
    __device__ __forceinline__ void a_off(const Unit& u, const int (&R)[2], const int (&C)[2], unsigned (&off)[2][2]) const {
#pragma unroll
        for (int h = 0; h < 2; ++h)
#pragma unroll
            for (int i = 0; i < 2; ++i) off[h][i] = (unsigned)(((u.pm * BM + h * HALF + R[i]) * K + C[i]) * 2);
    }
    __device__ __forceinline__ const char* b_ptr(const Unit& u) const { return Bt + (size_t)u.pn * BM * K * 2; }
};
template <bool GATHER> struct MoeSched {
    const LAS int* trs; const LAS int* cnts; int nN, G, c, K; const char* Bt; size_t bstride; const int* ltok;
    static constexpr bool DRAIN = GATHER;
    __device__ __forceinline__ bool next(int i, Unit& u) const {
        const int nM = __builtin_amdgcn_readfirstlane(trs[NE]);
        if (!tile_order(i, G, c, nM, nN, u.pm, u.pn)) return false;
        int e = 0;
        for (int j = 1; j < NE; ++j) e += (__builtin_amdgcn_readfirstlane(trs[j]) <= u.pm) ? 1 : 0;
        u.e = e; u.mt = u.pm - __builtin_amdgcn_readfirstlane(trs[e]); return true;
    }
    __device__ __forceinline__ void a_off(const Unit& u, const int (&R)[2], const int (&C)[2], unsigned (&off)[2][2]) const {
        const int n = __builtin_amdgcn_readfirstlane(cnts[u.e]);
#pragma unroll
        for (int h = 0; h < 2; ++h)
#pragma unroll
            for (int i = 0; i < 2; ++i) {
                int row;
                if (GATHER) { const int p = u.mt * BM + h * HALF + R[i]; row = (p < n) ? ltok[u.e * T + p] : 0; }
                else row = u.pm * BM + h * HALF + R[i];
                off[h][i] = (unsigned)((row * K + C[i]) * 2);
            }
    }
    __device__ __forceinline__ const char* b_ptr(const Unit& u) const { return Bt + (size_t)u.e * bstride + (size_t)u.pn * BM * K * 2; }
};

struct EpiBf16 {
    static constexpr bool PERM = true;
    bf16_t* O; int ldc;
    __device__ __forceinline__ void operator()(const f32x4 (&acc)[2][2][4][2], const Unit& u, int wr, int wc, int fr, int fq) const {
        const int row0 = u.pm * BM + wr * 64 + fr, col0 = u.pn * BM + wc * 32 + 8 * fq;
#pragma unroll
        for (int ai = 0; ai < 2; ++ai)
#pragma unroll
            for (int m = 0; m < 4; ++m) { bf16_t* rowp = O + (size_t)(row0 + ai * HALF + m * 16) * ldc + col0;
#pragma unroll
                for (int bj = 0; bj < 2; ++bj) { const f32x4 v0 = acc[ai][bj][m][0], v1 = acc[ai][bj][m][1];
                    u32x4 w; w.x = pk2(v0[0], v0[1]); w.y = pk2(v0[2], v0[3]); w.z = pk2(v1[0], v1[1]); w.w = pk2(v1[2], v1[3]);
                    *(u32x4*)(rowp + bj * HALF) = w; } }
    }
};
struct EpiResF32 {
    static constexpr bool PERM = false;
    float* C; const float* Rs; int ldc;
    __device__ __forceinline__ void operator()(const f32x4 (&acc)[2][2][4][2], const Unit& u, int wr, int wc, int fr, int fq) const {
        const int row0 = u.pm * BM + wr * 64 + fr, col0 = u.pn * BM + wc * 32 + 4 * fq;
#pragma unroll
        for (int ai = 0; ai < 2; ++ai)
#pragma unroll
            for (int m = 0; m < 4; ++m) { const size_t ro = (size_t)(row0 + ai * HALF + m * 16) * ldc + col0;
#pragma unroll
                for (int bj = 0; bj < 2; ++bj)
#pragma unroll
                    for (int n = 0; n < 2; ++n) { const f32x4 r = *(const f32x4*)(Rs + ro + bj * HALF + n * 16); *(f32x4*)(C + ro + bj * HALF + n * 16) = acc[ai][bj][m][n] + r; } }
    }
};
struct EpiSwiglu {
    static constexpr bool PERM = true;
    bf16_t* O; const float* bgu;
    __device__ __forceinline__ void operator()(const f32x4 (&acc)[2][2][4][2], const Unit& u, int wr, int wc, int fr, int fq) const {
        const int row0 = u.pm * BM + wr * 64 + fr, f0 = u.pn * HALF + wc * 32 + 8 * fq;
        const float* bg = bgu + (size_t)u.e * 2 * DFF + f0;
        f32x4 bgv[2], buv[2];
#pragma unroll
        for (int n = 0; n < 2; ++n) { bgv[n] = *(const f32x4*)(bg + 4 * n); buv[n] = *(const f32x4*)(bg + DFF + 4 * n); }
#pragma unroll
        for (int ai = 0; ai < 2; ++ai)
#pragma unroll
            for (int m = 0; m < 4; ++m) { bf16_t* rowp = O + (size_t)(row0 + ai * HALF + m * 16) * DFF + f0;
                float r[8];
#pragma unroll
                for (int n = 0; n < 2; ++n) { const f32x4 gv = acc[ai][0][m][n] + bgv[n], uv = acc[ai][1][m][n] + buv[n];
#pragma unroll
                    for (int j = 0; j < 4; ++j) { const float gg = fminf(gv[j], 7.0f), uu = fminf(fmaxf(uv[j], -7.0f), 7.0f);
                        r[4 * n + j] = gg * (uu + 1.0f) / (1.0f + __expf(-1.702f * gg)); } }
                u32x4 w; w.x = pk2(r[0], r[1]); w.y = pk2(r[2], r[3]); w.z = pk2(r[4], r[5]); w.w = pk2(r[6], r[7]);
                *(u32x4*)rowp = w; }
    }
};
struct EpiDown {
    static constexpr bool PERM = true;
    bf16_t* O; const float* bd; const float* lgate; const LAS int* cnts;
    __device__ __forceinline__ void operator()(const f32x4 (&acc)[2][2][4][2], const Unit& u, int wr, int wc, int fr, int fq) const {
        const int row0 = u.pm * BM + wr * 64 + fr, col0 = u.pn * BM + wc * 32 + 8 * fq;
        const int n_e = cnts[u.e];
        f32x4 bv[2][2];
#pragma unroll
        for (int bj = 0; bj < 2; ++bj)
#pragma unroll
            for (int n = 0; n < 2; ++n) bv[bj][n] = *(const f32x4*)(bd + (size_t)u.e * DM + col0 + bj * HALF + 4 * n);
#pragma unroll
        for (int ai = 0; ai < 2; ++ai)
#pragma unroll
            for (int m = 0; m < 4; ++m) { const int rt = wr * 64 + fr + ai * HALF + m * 16, p = u.mt * BM + rt;
                const float gt = (p < n_e) ? lgate[(size_t)u.e * T + p] : 0.f;
                bf16_t* rowp = O + (size_t)(row0 + ai * HALF + m * 16) * DM + col0;
#pragma unroll
                for (int bj = 0; bj < 2; ++bj) { const f32x4 v0 = (acc[ai][bj][m][0] + bv[bj][0]) * gt, v1 = (acc[ai][bj][m][1] + bv[bj][1]) * gt;
                    u32x4 w; w.x = pk2(v0[0], v0[1]); w.y = pk2(v0[2], v0[3]); w.z = pk2(v1[0], v1[1]); w.w = pk2(v1[2], v1[3]);
                    *(u32x4*)(rowp + bj * HALF) = w; } }
    }
};

template <class Epi, class Sched>
__device__ __forceinline__ void gemm_phase(LAS unsigned char* lds, const char* A0, const int K, const Sched& S, const Epi& E) {
    const int tid = threadIdx.x, wid = __builtin_amdgcn_readfirstlane(tid >> 6), lane = tid & 63, wr = wid >> 2, wc = wid & 3, fr = lane & 15, fq = lane >> 4;
    const int nt = K / BK;
    int Rr[2], Cc[2]; unsigned voffB[2];
#pragma unroll
    for (int i = 0; i < 2; ++i) { stage_rc(tid * 16 + i * 8192, Rr[i], Cc[i]); const int Rb = Epi::PERM ? ((Rr[i] & ~31) + perm32(Rr[i] & 31)) : Rr[i]; voffB[i] = (unsigned)(Rb * K + Cc[i]) * 2u; }
    const size_t kstep = (size_t)(BK * 2);
    const size_t hstep = (size_t)HALF * K * 2;
    const unsigned ldsw = (unsigned)wid * 1024u;
    const int aoff = lds_byte(wr * 64 + fr, fq * 8), boff = lds_byte(wc * 32 + fr, fq * 8);
#define PG8_SA(b, h) (((b) * 2 + (h)) * HTB)
#define PG8_SB(b, h) ((4 + (b) * 2 + (h)) * HTB)
#define PG8_STAGE_B(bufoff, gbase) do { _Pragma("unroll") for (int _i = 0; _i < 2; ++_i) \
        __builtin_amdgcn_global_load_lds((const unsigned*)((const char*)(gbase) + voffB[_i]), (LAS unsigned*)(lds + (bufoff) + ldsw + _i * 8192), 16, 0, 0); } while (0)
#define PG8_STAGE_A(bufoff, gbase, o0, o1) do { \
        __builtin_amdgcn_global_load_lds((const unsigned*)((const char*)(gbase) + (o0)), (LAS unsigned*)(lds + (bufoff) + ldsw), 16, 0, 0); \
        __builtin_amdgcn_global_load_lds((const unsigned*)((const char*)(gbase) + (o1)), (LAS unsigned*)(lds + (bufoff) + ldsw + 8192), 16, 0, 0); } while (0)
#define PG8_LDA(dst, b, h) do { _Pragma("unroll") for (int m = 0; m < 4; ++m) _Pragma("unroll") for (int k = 0; k < 2; ++k) dst[m][k] = *(const LAS bf16x8*)(lds + PG8_SA(b, h) + aoff + m * 2048 + k * 1024); } while (0)
#define PG8_LDB(dst, b, h) do { _Pragma("unroll") for (int n = 0; n < 2; ++n) _Pragma("unroll") for (int k = 0; k < 2; ++k) dst[n][k] = *(const LAS bf16x8*)(lds + PG8_SB(b, h) + boff + n * 2048 + k * 1024); } while (0)
#define PG8_MMA(ai, bj, At, Bt) do { __builtin_amdgcn_s_setprio(1); _Pragma("unroll") for (int m = 0; m < 4; ++m) _Pragma("unroll") for (int n = 0; n < 2; ++n) _Pragma("unroll") for (int k = 0; k < 2; ++k) \
        acc[ai][bj][m][n] = __builtin_amdgcn_mfma_f32_16x16x32_bf16(Bt[n][k], At[m][k], acc[ai][bj][m][n], 0, 0, 0); __builtin_amdgcn_s_setprio(0); } while (0)
#define PG8_WAIT_V(n) asm volatile("s_waitcnt vmcnt(" #n ")" ::: "memory")
#define PG8_WAIT_L(n) asm volatile("s_waitcnt lgkmcnt(" #n ")" ::: "memory")
#define PG8_BAR __builtin_amdgcn_s_barrier()
#define PG8_SCHED __builtin_amdgcn_sched_barrier(0)
    Unit cur, nxt; int ui = 0;
    if (!S.next(0, cur)) return;
    f32x4 acc[2][2][4][2];
#pragma unroll
    for (int a = 0; a < 2; ++a)
#pragma unroll
        for (int b = 0; b < 2; ++b)
#pragma unroll
            for (int m = 0; m < 4; ++m)
#pragma unroll
                for (int n = 0; n < 2; ++n) acc[a][b][m][n] = (f32x4){0.f, 0.f, 0.f, 0.f};
    bf16x8 At[4][2], B0[2][2], B1[2][2];
    unsigned offC[2][2], offN[2][2];
    S.a_off(cur, Rr, Cc, offC);
    const char* cB = S.b_ptr(cur);
    if (Sched::DRAIN) PG8_WAIT_V(0);
    PG8_STAGE_B(PG8_SB(0, 0), cB); PG8_STAGE_B(PG8_SB(0, 1), cB + hstep); PG8_STAGE_A(PG8_SA(0, 0), A0, offC[0][0], offC[0][1]); PG8_STAGE_A(PG8_SA(0, 1), A0, offC[1][0], offC[1][1]);
    if (wr == 1) PG8_BAR;
    PG8_WAIT_V(2); PG8_BAR;
    PG8_STAGE_B(PG8_SB(1, 0), cB + kstep); PG8_STAGE_A(PG8_SA(1, 0), A0 + kstep, offC[0][0], offC[0][1]); PG8_STAGE_B(PG8_SB(1, 1), cB + hstep + kstep);
    PG8_WAIT_V(6); PG8_BAR;
    for (;;) {
        const bool has_next = S.next(ui + 1, nxt);
        const char* nB = cB;
        if (has_next) { S.a_off(nxt, Rr, Cc, offN); nB = S.b_ptr(nxt); }
        else {
#pragma unroll
            for (int h = 0; h < 2; ++h)
#pragma unroll
                for (int i = 0; i < 2; ++i) offN[h][i] = offC[h][i];
        }
        if (Sched::DRAIN) PG8_WAIT_V(0);
        for (int t = 0; t < nt; t += 2) {
            const bool last = (t == nt - 2);
            const char* a1 = A0 + (size_t)(t + 1) * kstep;
            const char* a2 = last ? A0 : A0 + (size_t)(t + 2) * kstep; const char* b2 = last ? nB : cB + (size_t)(t + 2) * kstep;
            const char* a3 = a2 + kstep; const char* b3 = b2 + kstep;
            const unsigned o00 = last ? offN[0][0] : offC[0][0], o01 = last ? offN[0][1] : offC[0][1], o10 = last ? offN[1][0] : offC[1][0], o11 = last ? offN[1][1] : offC[1][1];
            PG8_LDB(B0, 0, 0); PG8_LDB(B1, 0, 1); PG8_SCHED; PG8_LDA(At, 0, 0); PG8_STAGE_A(PG8_SA(1, 1), a1, offC[1][0], offC[1][1]);
            PG8_WAIT_V(8); PG8_WAIT_L(0); PG8_BAR; PG8_MMA(0, 0, At, B0); PG8_MMA(0, 1, At, B1); PG8_BAR; PG8_SCHED;
            PG8_LDA(At, 0, 1); PG8_STAGE_B(PG8_SB(0, 0), b2); PG8_STAGE_B(PG8_SB(0, 1), b2 + hstep); PG8_STAGE_A(PG8_SA(0, 0), a2, o00, o01);
            PG8_WAIT_V(8); PG8_WAIT_L(0); PG8_BAR; PG8_MMA(1, 0, At, B0); PG8_MMA(1, 1, At, B1); PG8_BAR; PG8_SCHED;
            PG8_LDB(B0, 1, 0); PG8_LDB(B1, 1, 1); PG8_SCHED; PG8_LDA(At, 1, 0); PG8_STAGE_A(PG8_SA(0, 1), a2, o10, o11);
            PG8_WAIT_V(8); PG8_WAIT_L(0); PG8_BAR; PG8_MMA(0, 0, At, B0); PG8_MMA(0, 1, At, B1); PG8_BAR; PG8_SCHED;
            PG8_LDA(At, 1, 1); PG8_STAGE_B(PG8_SB(1, 0), b3); PG8_STAGE_B(PG8_SB(1, 1), b3 + hstep); PG8_STAGE_A(PG8_SA(1, 0), a3, o00, o01);
            PG8_WAIT_V(8); PG8_WAIT_L(0); PG8_BAR; PG8_MMA(1, 0, At, B0); PG8_MMA(1, 1, At, B1); PG8_BAR; PG8_SCHED;
        }
        if (wr == 0) PG8_BAR;
        E(acc, cur, wr, wc, fr, fq);
        if (!has_next) break;
#pragma unroll
        for (int a = 0; a < 2; ++a)
#pragma unroll
            for (int b = 0; b < 2; ++b)
#pragma unroll
                for (int m = 0; m < 4; ++m)
#pragma unroll
                    for (int n = 0; n < 2; ++n) acc[a][b][m][n] = (f32x4){0.f, 0.f, 0.f, 0.f};
        cur = nxt; cB = nB; ++ui;
#pragma unroll
        for (int h = 0; h < 2; ++h)
#pragma unroll
            for (int i = 0; i < 2; ++i) offC[h][i] = offN[h][i];
        if (wr == 1) PG8_BAR;
    }
    PG8_WAIT_V(0);
    PG8_BAR;
#undef PG8_SA
#undef PG8_SB
#undef PG8_STAGE_A
#undef PG8_STAGE_B
#undef PG8_LDA
#undef PG8_LDB
#undef PG8_MMA
#undef PG8_WAIT_V
#undef PG8_WAIT_L
#undef PG8_BAR
#undef PG8_SCHED
}
}

namespace {
struct Params { const float* in[20]; float* out; unsigned char* ws; };

struct Frame {
    LAS unsigned char* lds;
    int tid, lane, wave, G, vcu, gw, ngw;
};

__device__ __forceinline__ void transpose_item(const float* Wt  , int ldw, bf16_t* WTt  , int ldt, float scale, LAS float* scr, int lane) {
#pragma unroll 8
    for (int i = 0; i < 32; ++i) { const int kk = 2 * i + (lane >> 5); scr[kk * 33 + (lane & 31)] = Wt[(size_t)kk * ldw + (lane & 31)]; }
    asm volatile("s_waitcnt lgkmcnt(0)" ::: "memory");
    const int c = lane & 7;
#pragma unroll
    for (int j = 0; j < 4; ++j) { const int n = (lane >> 3) + 8 * j; const LAS float* s = scr + (8 * c) * 33 + n;
        u32x4 o; o.x = pk2(s[0 * 33] * scale, s[1 * 33] * scale); o.y = pk2(s[2 * 33] * scale, s[3 * 33] * scale); o.z = pk2(s[4 * 33] * scale, s[5 * 33] * scale); o.w = pk2(s[6 * 33] * scale, s[7 * 33] * scale);
        *(u32x4*)(WTt + (size_t)n * ldt + 8 * c) = o; }
    asm volatile("s_waitcnt lgkmcnt(0)" ::: "memory");
}

__device__ __forceinline__ void p0_prologue(const Params& P, Frame& F) {
    unsigned char* ws = P.ws;
    const float* w_in = P.in[2];
    LAS float* scr = (LAS float*)(F.lds + F.wave * 8448);
    LAS float* gwl = (LAS float*)(F.lds + 73728);
    for (int i = F.tid; i < 1024 * 8; i += NTHR) gwl[i] = w_in[(size_t)(i >> 3) * DIN + NZ + (i & 7)];
    __syncthreads();
    constexpr int I_IN = 16 * 96, I_OUT = 16 * 32, I_QK = 8 * 2 * 4, I_GU = NE * 16 * 64, I_D = NE * 16 * 32, I_ZERO = 8 * 3;
    constexpr int NITEMS = I_IN + I_OUT + I_QK + I_ZERO + I_GU + I_D;
    bf16_t* WinT = (bf16_t*)(ws + WS_WIN); bf16_t* WoutT = (bf16_t*)(ws + WS_WOUT); bf16_t* WqkT = (bf16_t*)(ws + WS_WQK);
    bf16_t* WguT = (bf16_t*)(ws + WS_WGU); bf16_t* WdT = (bf16_t*)(ws + WS_WD);
    for (int it = F.gw; it < NITEMS; it += F.ngw) {
        int r = it;
        if (r < I_IN) { const int kb = r / 96, nb = r % 96; transpose_item(w_in + (size_t)(64 * kb) * DIN + 32 * nb, DIN, WinT + (size_t)(32 * nb) * DM + 64 * kb, DM, 1.f, scr, F.lane); continue; } r -= I_IN;
        if (r < I_OUT) { const int kb = r / 32, nb = r % 32; transpose_item(P.in[12] + (size_t)(64 * kb) * DM + 32 * nb, DM, WoutT + (size_t)(32 * nb) * DM + 64 * kb, DM, 1.f, scr, F.lane); continue; } r -= I_OUT;
        if (r < I_QK) { const int isk = r >> 5, h = (r >> 3) & 3, kb = (r >> 2) & 1, nb = r & 3;
            const float* src = P.in[isk ? 8 : 7] + (size_t)h * 16384 + (size_t)(64 * kb) * 128 + 32 * nb;
            transpose_item(src, 128, WqkT + (size_t)(isk * 512 + h * 128 + 32 * nb) * 512 + h * 128 + 64 * kb, 512, isk ? 0.08838834764831845f : 1.f, scr, F.lane); continue; } r -= I_QK;
        if (r < I_ZERO) {
            const int rb = r / 3, j = r % 3, cb = j + (j >= (rb & 3) ? 1 : 0);
            for (int q = F.lane; q < 128 * 16; q += 64) { const int rr = q >> 4, cc = q & 15; *(u32x4*)(WqkT + (size_t)(rb * 128 + rr) * 512 + cb * 128 + cc * 8) = (u32x4){0u, 0u, 0u, 0u}; }
            continue; } r -= I_ZERO;
        if (r < I_GU) { const int e = r >> 10, kb = (r >> 6) & 15, nb = r & 63, n0 = 32 * nb, f = n0 & 1023, up = n0 >> 10;
            const int drow = (f >> 7) * 256 + up * 128 + (f & 127);
            transpose_item(P.in[16] + (size_t)e * DM * 2 * DFF + (size_t)(64 * kb) * 2 * DFF + n0, 2 * DFF, WguT + (size_t)e * 2 * DFF * DM + (size_t)drow * DM + 64 * kb, DM, 1.f, scr, F.lane); continue; } r -= I_GU;
        { const int e = r >> 9, kb = (r >> 5) & 15, nb = r & 31;
            transpose_item(P.in[18] + (size_t)e * DFF * DM + (size_t)(64 * kb) * DM + 32 * nb, DM, WdT + (size_t)e * DM * DFF + (size_t)(32 * nb) * DFF + 64 * kb, DFF, 1.f, scr, F.lane); }
    }
    const float* x = P.in[0]; const float* g1 = P.in[1];
    bf16_t* XN = (bf16_t*)(ws + WS_XN); float* GATE = (float*)(ws + WS_GATE);
    for (int row = F.gw; row < T; row += F.ngw) {
        const f32x4* xr = (const f32x4*)(x + (size_t)row * DM);
        f32x4 v[4]; float s = 0.f;
#pragma unroll
        for (int j = 0; j < 4; ++j) { v[j] = xr[F.lane + 64 * j]; s += v[j][0] * v[j][0] + v[j][1] * v[j][1] + v[j][2] * v[j][2] + v[j][3] * v[j][3]; }
        s = wave_sum(s);
        const float rs = 1.0f / sqrtf(s * (1.0f / DM) + EPS);
        float ga[8];
#pragma unroll
        for (int c = 0; c < 8; ++c) ga[c] = 0.f;
#pragma unroll
        for (int j = 0; j < 4; ++j) { const f32x4 gg = ((const f32x4*)g1)[F.lane + 64 * j]; v[j] = v[j] * rs * gg;
            u32x2 w; w.x = pk2(v[j][0], v[j][1]); w.y = pk2(v[j][2], v[j][3]);
            *(u32x2*)(XN + (size_t)row * DM + 4 * (F.lane + 64 * j)) = w;
#pragma unroll
            for (int q = 0; q < 4; ++q) { const int k = 4 * (F.lane + 64 * j) + q; const f32x4 w0 = *(const LAS f32x4*)(gwl + k * 8), w1 = *(const LAS f32x4*)(gwl + k * 8 + 4);
                ga[0] += v[j][q] * w0[0]; ga[1] += v[j][q] * w0[1]; ga[2] += v[j][q] * w0[2]; ga[3] += v[j][q] * w0[3];
                ga[4] += v[j][q] * w1[0]; ga[5] += v[j][q] * w1[1]; ga[6] += v[j][q] * w1[2]; ga[7] += v[j][q] * w1[3]; } }
#pragma unroll
        for (int c = 0; c < 8; ++c) ga[c] = wave_sum(ga[c]);
        if (F.lane == 0) { *(f32x4*)(GATE + (size_t)row * 8) = (f32x4){ga[0], ga[1], ga[2], ga[3]}; *(f32x4*)(GATE + (size_t)row * 8 + 4) = (f32x4){ga[4], ga[5], ga[6], ga[7]}; }
    }
}

__device__ __forceinline__ void p2_tokprep(const Params& P, Frame& F) {
    bf16_t* Z = (bf16_t*)(P.ws + WS_Z); bf16_t* XC = (bf16_t*)(P.ws + WS_XC);
    const float* gq = P.in[3]; const float* gk = P.in[4]; const float* cw = P.in[5]; const float* cb = P.in[6];
    const int lane = F.lane;
    for (int tok = F.gw; tok < T; tok += F.ngw) {
        bf16_t* zr = Z + (size_t)tok * NZ;
#pragma unroll
        for (int part = 0; part < 2; ++part) {
            bf16_t* p = zr + (part ? ZK : ZQ) + lane * 8;
            const float* g = (part ? gk : gq) + (lane & 7) * 8;
            const u32x4 w = *(const u32x4*)p;
            float a[8] = {bflo(w.x), bfhi(w.x), bflo(w.y), bfhi(w.y), bflo(w.z), bfhi(w.z), bflo(w.w), bfhi(w.w)};
            float s = 0.f;
#pragma unroll
            for (int i = 0; i < 8; ++i) s += a[i] * a[i];
            s += __shfl_xor(s, 1); s += __shfl_xor(s, 2); s += __shfl_xor(s, 4);
            float r = 1.0f / sqrtf(s * (1.0f / 64.f) + EPS); if (!part) r *= 0.125f * LOG2E;
#pragma unroll
            for (int i = 0; i < 8; ++i) a[i] *= r * g[i];
            u32x4 o; o.x = pk2(a[0], a[1]); o.y = pk2(a[2], a[3]); o.z = pk2(a[4], a[5]); o.w = pk2(a[6], a[7]);
            *(u32x4*)p = o;
        }
        {
            const int tl = tok % SEQ; const int ch = lane * 8;
            float a[8];
#pragma unroll
            for (int i = 0; i < 8; ++i) a[i] = cb[ch + i];
#pragma unroll
            for (int j = 0; j < 4; ++j) { const int dt = 3 - j; if (tl - dt >= 0) {
                    const u32x4 w = *(const u32x4*)(Z + (size_t)(tok - dt) * NZ + ZXM + ch);
                    const float xv[8] = {bflo(w.x), bfhi(w.x), bflo(w.y), bfhi(w.y), bflo(w.z), bfhi(w.z), bflo(w.w), bfhi(w.w)};
#pragma unroll
                    for (int i = 0; i < 8; ++i) a[i] += cw[j * 512 + ch + i] * xv[i]; } }
#pragma unroll
            for (int i = 0; i < 8; ++i) a[i] = a[i] * sigmoidf_(a[i]);
            u32x4 o; o.x = pk2(a[0], a[1]); o.y = pk2(a[2], a[3]); o.z = pk2(a[4], a[5]); o.w = pk2(a[6], a[7]);
            *(u32x4*)(XC + (size_t)tok * 512 + ch) = o;
        }
    }
}

__device__ __forceinline__ void attn_phase(const Params& P, Frame& F) {
    const bf16_t* Z = (const bf16_t*)(P.ws + WS_Z); bf16_t* MIX = (bf16_t*)(P.ws + WS_MIX);
    const int lane = F.lane, i = lane & 15, g = lane >> 4;
    float gm = fabsf(P.in[4][lane]);
#pragma unroll
    for (int o = 1; o < 64; o <<= 1) gm = fmaxf(gm, __shfl_xor(gm, o));
    const float kmax = 8.0f * gm * 1.01f;
    LAS unsigned char* vb = F.lds + F.wave * 4608;
    const int vwr = (lane >> 3) * 144 + (lane & 7) * 16;
    const int vrd = (4 * g + (i >> 2)) * 144 + (i & 3) * 8;
    for (int tile = F.gw; tile < 8192; tile += F.ngw) {
        const int r = tile & 15, blk = (tile >> 4) & 31, h = (tile >> 9) & 7, b = tile >> 12;
        const int tl0 = blk * 256 + r, T0 = b * SEQ + tl0;
        const bf16_t* qrow = Z + (size_t)(T0 + 16 * i) * NZ + ZQ + h * 64;
        const bf16x8 qf0 = *(const bf16x8*)(qrow + 8 * g), qf1 = *(const bf16x8*)(qrow + 32 + 8 * g);
        float ss = 0.f;
#pragma unroll
        for (int j = 0; j < 8; ++j) { const float a = bf2f((unsigned short)qf0[j]), c = bf2f((unsigned short)qf1[j]); ss += a * a + c * c; }
        ss += __shfl_xor(ss, 16); ss += __shfl_xor(ss, 32);
        const float ref = sqrtf(ss) * kmax;
        const float slope2 = exp2f(-(float)(h + 1)) * LOG2E;
        f32x4 o[4];
#pragma unroll
        for (int dt = 0; dt < 4; ++dt) o[dt] = (f32x4){0.f, 0.f, 0.f, 0.f};
        float lsum = 0.f;
        const bf16_t* Kh = Z + (size_t)b * SEQ * NZ + ZK + h * 64 + 8 * g;
        const bf16_t* Vh = Z + (size_t)b * SEQ * NZ + ZV + h * 64 + 8 * (lane & 7);
        bf16x8 kfn[2][2]; u32x4 vrn[4];
#define ATT_LOAD(bi_) do { const int bi__ = (bi_); const int br_ = bi__ < 12 ? 0 : (bi__ < 18 ? 1 : 2); const int d_ = 1 << (2 * br_); const int nb_ = -128 + 32 * (bi__ - (br_ == 0 ? 0 : (br_ == 1 ? 12 : 18))); \
        _Pragma("unroll") for (int sb = 0; sb < 2; ++sb) { int kp = tl0 + (nb_ + 16 * sb + i) * d_; kp = kp < 0 ? 0 : (kp > SEQ - 1 ? SEQ - 1 : kp); const bf16_t* kr = Kh + (size_t)kp * NZ; kfn[sb][0] = *(const bf16x8*)kr; kfn[sb][1] = *(const bf16x8*)(kr + 32); } \
        _Pragma("unroll") for (int c = 0; c < 4; ++c) { int kp = tl0 + (nb_ + 8 * c + (lane >> 3)) * d_; kp = kp < 0 ? 0 : (kp > SEQ - 1 ? SEQ - 1 : kp); vrn[c] = *(const u32x4*)(Vh + (size_t)kp * NZ); } } while (0)
        ATT_LOAD(0);
        for (int bi = 0; bi < 23; ++bi) {
            bf16x8 kf[2][2]; u32x4 vr[4];
#pragma unroll
            for (int sb = 0; sb < 2; ++sb) { kf[sb][0] = kfn[sb][0]; kf[sb][1] = kfn[sb][1]; }
#pragma unroll
            for (int c = 0; c < 4; ++c) vr[c] = vrn[c];
            if (bi + 1 < 23) ATT_LOAD(bi + 1);
            const int br = bi < 12 ? 0 : (bi < 18 ? 1 : 2), dd = 1 << (2 * br), u = 16 / dd;
            const int nb = -128 + 32 * (bi - (br == 0 ? 0 : (br == 1 ? 12 : 18)));
#pragma unroll
            for (int c = 0; c < 4; ++c) *(LAS u32x4*)(vb + vwr + c * 8 * 144) = vr[c];
            f32x4 s[2];
#pragma unroll
            for (int sb = 0; sb < 2; ++sb) { s[sb] = __builtin_amdgcn_mfma_f32_16x16x32_bf16(kf[sb][0], qf0, (f32x4){0.f, 0.f, 0.f, 0.f}, 0, 0, 0);
                s[sb] = __builtin_amdgcn_mfma_f32_16x16x32_bf16(kf[sb][1], qf1, s[sb], 0, 0, 0); }
            float p[8];
#pragma unroll
            for (int sb = 0; sb < 2; ++sb)
#pragma unroll
                for (int j = 0; j < 4; ++j) { const int n = nb + 16 * sb + 4 * g + j, a = u * i - n;
                    const bool valid = (a >= 0) && (a <= 128) && (tl0 + n * dd >= 0);
                    const float e = s[sb][j] - slope2 * (float)(a * dd) - ref;
                    const float pv = valid ? __builtin_amdgcn_exp2f(e) : 0.f;
                    p[4 * sb + j] = pv; lsum += pv; }
            u32x4 pw; pw.x = pk2(p[0], p[1]); pw.y = pk2(p[2], p[3]); pw.z = pk2(p[4], p[5]); pw.w = pk2(p[6], p[7]);
            const bf16x8 pf = __builtin_bit_cast(bf16x8, pw);
#pragma unroll
            for (int dt = 0; dt < 4; ++dt) {
                const s16x4 v0 = __builtin_amdgcn_ds_read_tr16_b64_v4i16((LAS s16x4*)(vb + vrd + dt * 32));
                const s16x4 v1 = __builtin_amdgcn_ds_read_tr16_b64_v4i16((LAS s16x4*)(vb + vrd + 16 * 144 + dt * 32));
                const bf16x8 vf = (bf16x8){v0[0], v0[1], v0[2], v0[3], v1[0], v1[1], v1[2], v1[3]};
                o[dt] = __builtin_amdgcn_mfma_f32_16x16x32_bf16(vf, pf, o[dt], 0, 0, 0);
            }
        }
#undef ATT_LOAD
        lsum += __shfl_xor(lsum, 16); lsum += __shfl_xor(lsum, 32);
        const float inv = 1.0f / lsum;
        bf16_t* orow = MIX + (size_t)(T0 + 16 * i) * DM + h * 64 + 4 * g;
#pragma unroll
        for (int dt = 0; dt < 4; ++dt) { u32x2 w; w.x = pk2(o[dt][0] * inv, o[dt][1] * inv); w.y = pk2(o[dt][2] * inv, o[dt][3] * inv); *(u32x2*)(orow + 16 * dt) = w; }
    }
}

__device__ __forceinline__ bf16x8 tr2(LAS unsigned char* p0, LAS unsigned char* p1) {
    const s16x4 a = __builtin_amdgcn_ds_read_tr16_b64_v4i16((LAS s16x4*)p0);
    const s16x4 b = __builtin_amdgcn_ds_read_tr16_b64_v4i16((LAS s16x4*)p1);
    return (bf16x8){a[0], a[1], a[2], a[3], b[0], b[1], b[2], b[3]};
}
#define MFMA16(a, b, c) __builtin_amdgcn_mfma_f32_16x16x32_bf16((a), (b), (c), 0, 0, 0)

__device__ __forceinline__ void ml1_phase(const Params& P, Frame& F) {
    const bf16_t* Z = (const bf16_t*)(P.ws + WS_Z); const bf16_t* QK = (const bf16_t*)(P.ws + WS_QK); const float* GATE = (const float*)(P.ws + WS_GATE);
    float* BC = (float*)(P.ws + WS_BC); float* IG = (float*)(P.ws + WS_IG); float* BT = (float*)(P.ws + WS_BT); float* U = (float*)(P.ws + WS_U); float* NV = (float*)(P.ws + WS_NV);
    const float* bi = P.in[9]; const float* bf = P.in[10];
    constexpr int PIT = 272;
    LAS unsigned char* KIM = F.lds; LAS unsigned char* VIM = F.lds + 128 * PIT;
    LAS float* bc = (LAS float*)(F.lds + 2 * 128 * PIT); LAS float* wv = bc + 256;
    const int tid = F.tid, lane = F.lane, i = lane & 15, g = lane >> 4, w = F.wave;
    bf16x8 ones;
#pragma unroll
    for (int j = 0; j < 8; ++j) ones[j] = (i == 0) ? (short)0x3F80 : (short)0;
    for (int unit = F.vcu; unit < 256; unit += F.G) {
        const int bh = unit / NCH, c = unit % NCH, b = bh / NHM, h = bh % NHM, t0 = b * SEQ + c * CH;
        float ig = 0.f;
        __syncthreads();
        if (tid < 256) { const float f = GATE[(size_t)(t0 + tid) * 8 + 4 + h] + bf[h];
            bc[tid] = fminf(f, 0.f) - log1pf(__expf(-fabsf(f)));
            ig = GATE[(size_t)(t0 + tid) * 8 + h] + bi[h]; }
        __syncthreads();
        if (w == 0) {
            const f32x4 a = *(const LAS f32x4*)(bc + 4 * lane);
            const float s1 = a[0], s2 = s1 + a[1], s3 = s2 + a[2], s4 = s3 + a[3];
            float x = s4;
#pragma unroll
            for (int off = 1; off < 64; off <<= 1) { const float v = __shfl_up(x, off); if (lane >= off) x += v; }
            const float ex = x - s4;
            *(LAS f32x4*)(bc + 4 * lane) = (f32x4){ex + s1, ex + s2, ex + s3, ex + s4};
        }
        __syncthreads();
        if (tid < 256) { BC[(size_t)(t0 + tid) * 4 + h] = bc[tid]; IG[(size_t)(t0 + tid) * 4 + h] = ig; wv[tid] = __expf(bc[255] - bc[tid] + ig); }
        if (tid == 0) BT[unit] = bc[255];
        f32x4 acc[9];
#pragma unroll
        for (int q = 0; q < 9; ++q) acc[q] = (f32x4){0.f, 0.f, 0.f, 0.f};
        for (int half = 0; half < 2; ++half) {
            __syncthreads();
#pragma unroll
            for (int q = 0; q < 4; ++q) { const int id = tid + 512 * q, row = id >> 4, c8 = (id & 15) * 8, sidx = half * 128 + row;
                const u32x4 kw = *(const u32x4*)(QK + (size_t)(t0 + sidx) * 1024 + 512 + h * 128 + c8);
                const u32x4 vw = *(const u32x4*)(Z + (size_t)(t0 + sidx) * NZ + ZVM + h * 128 + c8);
                const float ws_ = wv[sidx];
                u32x4 ks; ks.x = pk2(bflo(kw.x) * ws_, bfhi(kw.x) * ws_); ks.y = pk2(bflo(kw.y) * ws_, bfhi(kw.y) * ws_); ks.z = pk2(bflo(kw.z) * ws_, bfhi(kw.z) * ws_); ks.w = pk2(bflo(kw.w) * ws_, bfhi(kw.w) * ws_);
                *(LAS u32x4*)(KIM + row * PIT + c8 * 2) = ks; *(LAS u32x4*)(VIM + row * PIT + c8 * 2) = vw; }
            __syncthreads();
#pragma unroll
            for (int kk = 0; kk < 4; ++kk) {
                const int ro = (32 * kk + 8 * g + (i >> 2)) * PIT + (i & 3) * 8;
                const bf16x8 af = tr2(KIM + ro + 32 * w, KIM + ro + 4 * PIT + 32 * w);
#pragma unroll
                for (int et = 0; et < 8; ++et) { const bf16x8 bfr = tr2(VIM + ro + 32 * et, VIM + ro + 4 * PIT + 32 * et); acc[et] = MFMA16(af, bfr, acc[et]); }
                acc[8] = MFMA16(af, ones, acc[8]);
            }
        }
        float* up = U + (size_t)unit * 16384 + (size_t)(16 * w + 4 * g) * 128 + i;
#pragma unroll
        for (int et = 0; et < 8; ++et)
#pragma unroll
            for (int j = 0; j < 4; ++j) up[j * 128 + 16 * et] = acc[et][j];
        if (i == 0) {
#pragma unroll
            for (int j = 0; j < 4; ++j) NV[unit * 128 + 16 * w + 4 * g + j] = acc[8][j];
        }
    }
}

__device__ __forceinline__ void ml3_phase(const Params& P, Frame& F) {
    const bf16_t* Z = (const bf16_t*)(P.ws + WS_Z); const bf16_t* QK = (const bf16_t*)(P.ws + WS_QK);
    const float* BC = (const float*)(P.ws + WS_BC); const float* IG = (const float*)(P.ws + WS_IG); const float* BT = (const float*)(P.ws + WS_BT);
    const float* U = (const float*)(P.ws + WS_U); const float* NV = (const float*)(P.ws + WS_NV); const float* gn = P.in[11];
    bf16_t* MIX = (bf16_t*)(P.ws + WS_MIX);
    constexpr int CP = 288, VP = 272;
    LAS unsigned char* CIM = F.lds;
    LAS unsigned char* VIM = F.lds + 128 * CP;
    LAS float* cs = (LAS float*)(F.lds + 128 * CP + 256 * VP);
    LAS float* bq = cs + 256;
    const int tid = F.tid, lane = F.lane, i = lane & 15, g = lane >> 4, w = F.wave;
    for (int unit = F.vcu; unit < 256; unit += F.G) {
        const int bh = unit / NCH, c = unit % NCH, b = bh / NHM, h = bh % NHM, t0 = b * SEQ + c * CH;
        __syncthreads();
#pragma unroll
        for (int q = 0; q < 8; ++q) { const int id = tid + 512 * q, row = id >> 4, c8 = (id & 15) * 8;
            *(LAS u32x4*)(VIM + row * VP + c8 * 2) = *(const u32x4*)(Z + (size_t)(t0 + row) * NZ + ZVM + h * 128 + c8); }
        if (tid < 256) { const float bb = BC[(size_t)(t0 + tid) * 4 + h]; bq[tid] = bb; cs[tid] = IG[(size_t)(t0 + tid) * 4 + h] - bb; }
        {   f32x4 cc[4][2]; float n = 0.f;
#pragma unroll
            for (int q = 0; q < 4; ++q) { cc[q][0] = (f32x4){0.f, 0.f, 0.f, 0.f}; cc[q][1] = (f32x4){0.f, 0.f, 0.f, 0.f}; }
            for (int j = 0; j < c; ++j) {
                const float dec = __expf(BT[bh * NCH + j]);
                const float* up = U + (size_t)(bh * NCH + j) * 16384;
#pragma unroll
                for (int q = 0; q < 4; ++q) { const int id = tid + 512 * q; const f32x4 u0 = *(const f32x4*)(up + id * 8), u1 = *(const f32x4*)(up + id * 8 + 4);
                    cc[q][0] = cc[q][0] * dec + u0; cc[q][1] = cc[q][1] * dec + u1; }
                if (tid < 128) n = dec * n + NV[(bh * NCH + j) * 128 + tid];
            }
#pragma unroll
            for (int q = 0; q < 4; ++q) { const int id = tid + 512 * q, d = id >> 4, e8 = (id & 15) * 8;
                u32x4 o; o.x = pk2(cc[q][0][0], cc[q][0][1]); o.y = pk2(cc[q][0][2], cc[q][0][3]); o.z = pk2(cc[q][1][0], cc[q][1][1]); o.w = pk2(cc[q][1][2], cc[q][1][3]);
                *(LAS u32x4*)(CIM + d * CP + e8 * 2) = o; }
            if (tid < 128) { *(LAS u32x4*)(CIM + tid * CP + 256) = (u32x4){f2bf(n), 0u, 0u, 0u}; *(LAS u32x4*)(CIM + tid * CP + 272) = (u32x4){0u, 0u, 0u, 0u}; }
        }
        __syncthreads();
#pragma unroll 1
        for (int a = 0; a < 2; ++a) {
            const int qt = a ? 15 - w : w;
            bf16x8 qf[4];
            { const bf16_t* qp = QK + (size_t)(t0 + 16 * qt + i) * 1024 + h * 128 + 8 * g;
#pragma unroll
                for (int ks = 0; ks < 4; ++ks) qf[ks] = *(const bf16x8*)(qp + 32 * ks); }
            const float bt = bq[16 * qt + i];
            f32x4 acc[8]; float den;
            {
                f32x4 a8 = (f32x4){0.f, 0.f, 0.f, 0.f};
#pragma unroll
                for (int et = 0; et < 8; ++et) acc[et] = (f32x4){0.f, 0.f, 0.f, 0.f};
#pragma unroll
                for (int ks = 0; ks < 4; ++ks) {
                    const int ro = (32 * ks + 8 * g + (i >> 2)) * CP + (i & 3) * 8;
#pragma unroll
                    for (int et = 0; et < 8; ++et) { const bf16x8 cf = tr2(CIM + ro + 32 * et, CIM + ro + 4 * CP + 32 * et); acc[et] = MFMA16(cf, qf[ks], acc[et]); }
                    const bf16x8 cf = tr2(CIM + ro + 256, CIM + ro + 4 * CP + 256);
                    a8 = MFMA16(cf, qf[ks], a8);
                }
                const float eb = __expf(bt);
#pragma unroll
                for (int et = 0; et < 8; ++et) acc[et] = acc[et] * eb;
                den = (g == 0) ? a8[0] * eb : 0.f;
            }
            const int kbhi = qt >> 1;
#pragma unroll 1
            for (int kb = 0; kb <= kbhi; ++kb) {
                float p[8];
#pragma unroll
                for (int sb = 0; sb < 2; ++sb) {
                    const bf16_t* kp = QK + (size_t)(t0 + 32 * kb + 16 * sb + i) * 1024 + 512 + h * 128 + 8 * g;
                    f32x4 sacc = (f32x4){0.f, 0.f, 0.f, 0.f};
#pragma unroll
                    for (int ks = 0; ks < 4; ++ks) { const bf16x8 kf = *(const bf16x8*)(kp + 32 * ks); sacc = MFMA16(kf, qf[ks], sacc); }
                    const f32x4 cv = *(const LAS f32x4*)(cs + 32 * kb + 16 * sb + 4 * g);
#pragma unroll
                    for (int j = 0; j < 4; ++j) { const int srow = 32 * kb + 16 * sb + 4 * g + j, tcol = 16 * qt + i;
                        const float pv = (srow <= tcol) ? sacc[j] * __expf(bt + cv[j]) : 0.f;
                        p[4 * sb + j] = pv; den += pv; } }
                u32x4 pw; pw.x = pk2(p[0], p[1]); pw.y = pk2(p[2], p[3]); pw.z = pk2(p[4], p[5]); pw.w = pk2(p[6], p[7]);
                const bf16x8 pf = __builtin_bit_cast(bf16x8, pw);
                const int ro = (32 * kb + 4 * g + (i >> 2)) * VP + (i & 3) * 8;
#pragma unroll
                for (int et = 0; et < 8; ++et) { const bf16x8 vf = tr2(VIM + ro + 32 * et, VIM + ro + 16 * VP + 32 * et); acc[et] = MFMA16(vf, pf, acc[et]); }
            }
            float dn = den; dn += __shfl_xor(dn, 16); dn += __shfl_xor(dn, 32);
            const float dd = 1.0f / fmaxf(fabsf(dn), 1.0f);
            float ss = 0.f;
#pragma unroll
            for (int et = 0; et < 8; ++et) { acc[et] = acc[et] * dd; ss += acc[et][0] * acc[et][0] + acc[et][1] * acc[et][1] + acc[et][2] * acc[et][2] + acc[et][3] * acc[et][3]; }
            ss += __shfl_xor(ss, 16); ss += __shfl_xor(ss, 32);
            const float rstd = 1.0f / sqrtf(ss * (1.0f / HDM) + EPS);
            const int tok = t0 + 16 * qt + i;
#pragma unroll
            for (int et = 0; et < 8; ++et) { const int e0 = 16 * et + 4 * g;
                const u32x2 ow = *(const u32x2*)(Z + (size_t)tok * NZ + ZOM + h * 128 + e0);
                const f32x4 gv = *(const f32x4*)(gn + h * 128 + e0);
                const float r0 = sigmoidf_(bflo(ow.x)) * acc[et][0] * rstd * gv[0], r1 = sigmoidf_(bfhi(ow.x)) * acc[et][1] * rstd * gv[1];
                const float r2 = sigmoidf_(bflo(ow.y)) * acc[et][2] * rstd * gv[2], r3 = sigmoidf_(bfhi(ow.y)) * acc[et][3] * rstd * gv[3];
                u32x2 o; o.x = pk2(r0, r1); o.y = pk2(r2, r3);
                *(u32x2*)(MIX + (size_t)tok * DM + 512 + h * 128 + e0) = o; }
        }
    }
}

__device__ __forceinline__ void router_phase(const Params& P, Frame& F) {
    const float* X1 = P.out; const float* g2 = P.in[13]; const float* wr = P.in[14]; const float* br = P.in[15];
    bf16_t* H2 = (bf16_t*)(P.ws + WS_XN); int* cnt = (int*)(P.ws + WS_CTL); int* ltok = (int*)(P.ws + WS_LTOK); float* lgate = (float*)(P.ws + WS_LGATE); int* tke = (int*)(P.ws + WS_TKE);
    const int lane = F.lane;
    for (int tok = F.gw; tok < T; tok += F.ngw) {
        const f32x4* xr = (const f32x4*)(X1 + (size_t)tok * DM);
        f32x4 v[4]; float s = 0.f;
#pragma unroll
        for (int j = 0; j < 4; ++j) { v[j] = xr[lane + 64 * j]; s += v[j][0] * v[j][0] + v[j][1] * v[j][1] + v[j][2] * v[j][2] + v[j][3] * v[j][3]; }
        s = wave_sum(s);
        const float r = 1.0f / sqrtf(s * (1.0f / DM) + EPS);
#pragma unroll
        for (int j = 0; j < 4; ++j) { const f32x4 gg = ((const f32x4*)g2)[lane + 64 * j]; v[j] = v[j] * r * gg;
            u32x2 w; w.x = pk2(v[j][0], v[j][1]); w.y = pk2(v[j][2], v[j][3]); *(u32x2*)(H2 + (size_t)tok * DM + 4 * (lane + 64 * j)) = w; }
        float mylogit = -INFINITY;
        for (int e4 = 0; e4 < NE; e4 += 4) {
            f32x4 pa = (f32x4){0.f, 0.f, 0.f, 0.f};
#pragma unroll
            for (int j = 0; j < 4; ++j)
#pragma unroll
                for (int q = 0; q < 4; ++q) { const int k = 4 * (lane + 64 * j) + q; pa += *(const f32x4*)(wr + (size_t)k * NE + e4) * v[j][q]; }
#pragma unroll
            for (int q = 0; q < 4; ++q) { const float pq = wave_sum(pa[q]) + br[e4 + q]; if (lane == e4 + q) mylogit = pq; }
        }
        float tv[4]; int te[4];
#pragma unroll
        for (int k = 0; k < 4; ++k) {
            float bv = mylogit; int bi = lane;
#pragma unroll
            for (int off = 1; off < 64; off <<= 1) { const float ov = __shfl_xor(bv, off); const int oi = __shfl_xor(bi, off);
                if (ov > bv || (ov == bv && oi < bi)) { bv = ov; bi = oi; } }
            tv[k] = bv; te[k] = bi;
            if (lane == bi) mylogit = -INFINITY;
        }
        const float e1 = __expf(tv[1] - tv[0]), e2 = __expf(tv[2] - tv[0]), e3 = __expf(tv[3] - tv[0]);
        const float inv = 1.0f / (1.0f + e1 + e2 + e3);
        if (lane < 4) {
            const int ee = lane == 0 ? te[0] : (lane == 1 ? te[1] : (lane == 2 ? te[2] : te[3]));
            const float gg = (lane == 0 ? 1.0f : (lane == 1 ? e1 : (lane == 2 ? e2 : e3))) * inv;
            const int p = atomicAdd(&cnt[ee], 1);
            ltok[ee * T + p] = tok; lgate[ee * T + p] = gg; tke[tok * 4 + lane] = ee | (p << 8);
        }
    }
}

__device__ __forceinline__ void build_tables(const Params& P, Frame& F) {
    LAS int* trs = (LAS int*)(F.lds + LDS_TAB); LAS int* cnts = trs + 64;
    const int* cnt = (const int*)(P.ws + WS_CTL);
    if (F.tid == 0) { int a = 0; for (int e = 0; e < NE; ++e) { const int n = cnt[e]; trs[e] = a; cnts[e] = n; a += (n + 255) >> 8; } trs[NE] = a; }
    __syncthreads();
}

__device__ __forceinline__ void combine_phase(const Params& P, Frame& F) {
    const LAS int* trs = (const LAS int*)(F.lds + LDS_TAB);
    const bf16_t* Y = (const bf16_t*)(P.ws + WS_Y); const int* tke = (const int*)(P.ws + WS_TKE);
    float* out = P.out; const int lane = F.lane;
    for (int tok = F.gw; tok < T; tok += F.ngw) {
        f32x4 a[4];
#pragma unroll
        for (int j = 0; j < 4; ++j) a[j] = *(const f32x4*)(out + (size_t)tok * DM + 4 * (lane + 64 * j));
#pragma unroll
        for (int k = 0; k < 4; ++k) { const int w = tke[tok * 4 + k], e = w & 255, p = w >> 8; const size_t slot = (size_t)trs[e] * 256 + p;
#pragma unroll
            for (int j = 0; j < 4; ++j) { const u32x2 y = *(const u32x2*)(Y + slot * DM + 4 * (lane + 64 * j)); a[j][0] += bflo(y.x); a[j][1] += bfhi(y.x); a[j][2] += bflo(y.y); a[j][3] += bfhi(y.y); } }
#pragma unroll
        for (int j = 0; j < 4; ++j) *(f32x4*)(out + (size_t)tok * DM + 4 * (lane + 64 * j)) = a[j];
    }
}


#define XB_TMO      128
#define XB_XCNT(j)  (256  + 64 * (j))
#define XB_XSUB(j)  (1280 + 64 * (j))
#define XB_XGEN(j)  (2304 + 64 * (j))
#define XB_TOP      3328
#define XB_TOPGEN   3392
#define XCD_BAR_WORDS 3456
#define XB_SPIN_CAP (1u << 18)
__device__ __forceinline__ unsigned xb_ld(unsigned* p)              { return __hip_atomic_load(p, __ATOMIC_RELAXED, __HIP_MEMORY_SCOPE_AGENT); }
__device__ __forceinline__ unsigned xb_add(unsigned* p, unsigned v) { return __hip_atomic_fetch_add(p, v, __ATOMIC_RELAXED, __HIP_MEMORY_SCOPE_AGENT); }
__device__ __forceinline__ unsigned xb_xcc_id() { return (unsigned)__builtin_amdgcn_s_getreg((3 << 11) | 20) & 0xFu; }
#define XB_SPIN(cond, bar) do { unsigned _sp = 0; while (cond) { __builtin_amdgcn_s_sleep(1); \
    if ((++_sp & 255u) == 0u) { if (xb_ld(&(bar)[XB_TMO])) break; if (_sp > XB_SPIN_CAP) { atomicAdd(&(bar)[XB_TMO], 1u); break; } } } } while (0)
struct XcdBarrier { unsigned* bar; unsigned x; volatile LAS unsigned* st; };
__device__ __forceinline__ XcdBarrier xcd_barrier_post(unsigned* bar, volatile LAS unsigned* st) {
    XcdBarrier b; b.bar = bar; b.x = xb_xcc_id(); b.st = st;
    if (threadIdx.x == 0) (void)xb_add(&bar[XB_XCNT(b.x)], 1u);
    return b;
}
__device__ __forceinline__ void xcd_barrier_complete(unsigned* bar, unsigned x, unsigned& nloc, unsigned& nx) {
    const unsigned G = gridDim.x * gridDim.y * gridDim.z;
    unsigned sum, cnt, mine, sp = 0u;
    for (;;) {
        sum = 0u; cnt = 0u; mine = 0u;
#pragma unroll
        for (unsigned j = 0; j < 16; ++j) { const unsigned c = xb_ld(&bar[XB_XCNT(j)]); sum += c; cnt += (c > 0u) ? 1u : 0u; mine = (j == x) ? c : mine; }
        if (sum == G) break;
        __builtin_amdgcn_s_sleep(1);
        if ((++sp & 255u) == 0u) { if (xb_ld(&bar[XB_TMO])) break; if (sp > XB_SPIN_CAP) { atomicAdd(&bar[XB_TMO], 1u); break; } }
    }
    nloc = mine > 0u ? mine : 1u; nx = cnt > 0u ? cnt : 1u;
}
__device__ __forceinline__ void xcd_barrier(const XcdBarrier& b) {
    asm volatile("s_waitcnt vmcnt(0)" ::: "memory");
    __syncthreads();
    if (threadIdx.x == 0) {
        unsigned* bar = b.bar;
        __builtin_amdgcn_s_waitcnt(0);
        unsigned nloc = b.st[0], nx = b.st[1];
        if (nloc == 0u) { xcd_barrier_complete(bar, b.x, nloc, nx); b.st[0] = nloc; b.st[1] = nx; }
        const unsigned old = xb_add(&bar[XB_XSUB(b.x)], 1u);
        const unsigned gen = old / nloc;
        if (old + 1u == (gen + 1u) * nloc) {
            __builtin_amdgcn_fence(__ATOMIC_RELEASE, "agent");
            asm volatile("s_waitcnt vmcnt(0)" ::: "memory");
            const unsigned og = xb_add(&bar[XB_TOP], 1u);
            const unsigned tg = og / nx;
            if (og + 1u == (tg + 1u) * nx) xb_add(&bar[XB_TOPGEN], 1u);
            else XB_SPIN(xb_ld(&bar[XB_TOPGEN]) == tg, bar);
            __builtin_amdgcn_fence(__ATOMIC_ACQUIRE, "agent");
            xb_add(&bar[XB_XGEN(b.x)], 1u);
            asm volatile("s_waitcnt vmcnt(0)" ::: "memory");
        } else {
            XB_SPIN(xb_ld(&bar[XB_XGEN(b.x)]) == gen, bar);
            __builtin_amdgcn_fence(__ATOMIC_ACQUIRE, "agent");
            asm volatile("s_waitcnt vmcnt(0)" ::: "memory");
        }
    }
    __syncthreads();
}

__global__ void __launch_bounds__(NTHR) fwd_megakernel(Params P) {
    extern __shared__ __attribute__((aligned(16))) unsigned char lds_raw[];
    Frame F;
    F.lds = (LAS unsigned char*)lds_raw;
    F.tid = threadIdx.x; F.lane = F.tid & 63; F.wave = __builtin_amdgcn_readfirstlane(F.tid >> 6);
    F.G = gridDim.x; { const int bx = blockIdx.x; F.vcu = (F.G % 8 == 0) ? (bx % 8) * (F.G / 8) + bx / 8 : bx; }
    F.gw = F.vcu * NWAVES + F.wave; F.ngw = F.G * NWAVES;
    unsigned char* ws = P.ws;
    LAS unsigned char* stage = F.lds + LDS_STAGE;
    volatile LAS unsigned* bst = (volatile LAS unsigned*)(F.lds + LDS_TAB + 512);
    if (F.tid < 2) bst[F.tid] = 0u;
    __syncthreads();
    const XcdBarrier bar = xcd_barrier_post((unsigned*)(ws + WS_CTL) + 1024, bst);
#define GRID_SYNC() xcd_barrier(bar)

    p0_prologue(P, F);
    GRID_SYNC();
    {
        pg8::DenseSched S{T / 256, NZ / 256, F.G, (int)blockIdx.x, DM, (const char*)(ws + WS_WIN)};
        pg8::EpiBf16 E{(bf16_t*)(ws + WS_Z), NZ};
        pg8::gemm_phase(stage, (const char*)(ws + WS_XN), DM, S, E);
    }
    GRID_SYNC();
    p2_tokprep(P, F);
    GRID_SYNC();
    {
        pg8::DenseSched S{T / 256, 1024 / 256, F.G, (int)blockIdx.x, 512, (const char*)(ws + WS_WQK)};
        pg8::EpiBf16 E{(bf16_t*)(ws + WS_QK), 1024};
        pg8::gemm_phase(stage, (const char*)(ws + WS_XC), 512, S, E);
    }
    attn_phase(P, F);
    GRID_SYNC();
    ml1_phase(P, F);
    GRID_SYNC();
    ml3_phase(P, F);
    GRID_SYNC();
    {
        pg8::DenseSched S{T / 256, DM / 256, F.G, (int)blockIdx.x, DM, (const char*)(ws + WS_WOUT)};
        pg8::EpiResF32 E{P.out, P.in[0], DM};
        pg8::gemm_phase(stage, (const char*)(ws + WS_MIX), DM, S, E);
    }
    GRID_SYNC();
    router_phase(P, F);
    GRID_SYNC();
    build_tables(P, F);
    const LAS int* trs = (const LAS int*)(F.lds + LDS_TAB); const LAS int* cnts = trs + 64;
    {
        pg8::MoeSched<true> S{trs, cnts, 8, F.G, (int)blockIdx.x, DM, (const char*)(ws + WS_WGU), (size_t)2 * DFF * DM * 2, (const int*)(ws + WS_LTOK)};
        pg8::EpiSwiglu E{(bf16_t*)(ws + WS_ACT), P.in[17]};
        pg8::gemm_phase(stage, (const char*)(ws + WS_XN), DM, S, E);
    }
    GRID_SYNC();
    {
        pg8::MoeSched<false> S{trs, cnts, 4, F.G, (int)blockIdx.x, DFF, (const char*)(ws + WS_WD), (size_t)DM * DFF * 2, nullptr};
        pg8::EpiDown E{(bf16_t*)(ws + WS_Y), P.in[19], (const float*)(ws + WS_LGATE), cnts};
        pg8::gemm_phase(stage, (const char*)(ws + WS_ACT), DFF, S, E);
    }
    GRID_SYNC();
    combine_phase(P, F);
}
}

extern "C" void kernel_launch(void* const* d_in, const int* in_sizes, int n_in, void* d_out, int out_size, void* d_ws, size_t ws_size, hipStream_t stream) {
    static int grid = 0;
    if (grid == 0) {
        if (n_in != 20 || out_size != T * DM || ws_size < WS_END) { fprintf(stderr, "kernel_launch: unexpected problem (n_in %d out %d ws %zu)\n", n_in, out_size, ws_size); grid = -1; return; }
        int dev = 0, cus = 0, per_cu = 0;
        (void)hipGetDevice(&dev);
        (void)hipDeviceGetAttribute(&cus, hipDeviceAttributeMultiprocessorCount, dev);
        (void)hipFuncSetAttribute((const void*)fwd_megakernel, hipFuncAttributeMaxDynamicSharedMemorySize, LDS_BYTES);
        (void)hipOccupancyMaxActiveBlocksPerMultiprocessor(&per_cu, (const void*)fwd_megakernel, NTHR, LDS_BYTES);
        if (per_cu < 1) { fprintf(stderr, "kernel_launch: occupancy query says %d blocks per CU\n", per_cu); per_cu = 1; }
        grid = cus;
    }
    if (grid < 0) return;
    (void)hipMemsetAsync((char*)d_ws + WS_CTL, 0, 65536, stream);
    Params p{};
    for (int i = 0; i < 20; ++i) p.in[i] = (const float*)d_in[i];
    p.out = (float*)d_out; p.ws = (unsigned char*)d_ws;
    hipLaunchKernelGGL(fwd_megakernel, dim3(grid), dim3(NTHR), LDS_BYTES, stream, p);
    const hipError_t e = hipPeekAtLastError();
    if (e != hipSuccess) fprintf(stderr, "launch failed: %s (grid %d)\n", hipGetErrorString(e), grid);
}
```

```cpp
#include <hip/hip_runtime.h>
#include <cstdio>
#include <cstdint>

#define LAS __attribute__((address_space(3)))
typedef unsigned short bf16_t;
typedef short bf16x8 __attribute__((ext_vector_type(8)));
typedef short s16x4 __attribute__((ext_vector_type(4)));
typedef float f32x4 __attribute__((ext_vector_type(4)));
typedef unsigned u32x4 __attribute__((ext_vector_type(4)));
typedef unsigned u32x2 __attribute__((ext_vector_type(2)));

namespace {
constexpr int BATCH = 2, SEQ = 8192, T = BATCH * SEQ, DM = 1024, DIN = 3080, NZ = 3072;
constexpr int NHA = 8, NHM = 4, HDM = 128;
constexpr int NE = 32, DFF = 1024;
constexpr int CH = 256, NCH = SEQ / CH;
constexpr float EPS = 1e-6f;
constexpr float LOG2E = 1.4426950408889634f;
constexpr int ZQ = 0, ZK = 512, ZV = 1024, ZXM = 1536, ZVM = 2048, ZOM = 2560;
constexpr int NWAVES = 8, NTHR = 512;
constexpr int MAXTR = 288;
constexpr int TPROBE = -1;
constexpr int DUP = 0;
constexpr size_t MiB = 1u << 20;
constexpr size_t WS_CTL = 0;
constexpr size_t WS_WIN = 1 * MiB;
constexpr size_t WS_WOUT = 7 * MiB;
constexpr size_t WS_WQK = 9 * MiB;
constexpr size_t WS_WGU = 16 * MiB;
constexpr size_t WS_WD = 144 * MiB;
constexpr size_t WS_XN = 208 * MiB;
constexpr size_t WS_Z = 240 * MiB;
constexpr size_t WS_GATE = 336 * MiB;
constexpr size_t WS_XC = 337 * MiB;
constexpr size_t WS_QK = 353 * MiB;
constexpr size_t WS_BC = 385 * MiB;
constexpr size_t WS_IG = 385 * MiB + 512 * 1024;
constexpr size_t WS_BT = 386 * MiB;
constexpr size_t WS_NV = 386 * MiB + 4096;
constexpr size_t WS_U = 387 * MiB;
constexpr size_t WS_MIX = 403 * MiB;
constexpr size_t WS_LTOK = 435 * MiB;
constexpr size_t WS_LGATE = 437 * MiB;
constexpr size_t WS_TKE = 439 * MiB;
constexpr size_t WS_WRT = 439 * MiB + 512 * 1024;
constexpr size_t WS_ACT = 440 * MiB;
constexpr size_t WS_Y = 584 * MiB;
constexpr size_t WS_END = 728 * MiB;
constexpr int LDS_STAGE = 0;
constexpr int LDS_TAB = 131072;
constexpr int LDS_BYTES = 131072 + 1024;

__device__ __forceinline__ unsigned f2bf(float f) { unsigned u = __builtin_bit_cast(unsigned, f); return (u + 0x7fffu + ((u >> 16) & 1u)) >> 16; }
__device__ __forceinline__ unsigned pk2(float lo, float hi) { return f2bf(lo) | (f2bf(hi) << 16); }
__device__ __forceinline__ float bf2f(unsigned b) { return __builtin_bit_cast(float, b << 16); }
__device__ __forceinline__ float bflo(unsigned w) { return __builtin_bit_cast(float, w << 16); }
__device__ __forceinline__ float bfhi(unsigned w) { return __builtin_bit_cast(float, w & 0xffff0000u); }
__device__ __forceinline__ float wave_sum(float v) {
#pragma unroll
    for (int o = 1; o < 64; o <<= 1) v += __shfl_xor(v, o);
    return v;
}
__device__ __forceinline__ float sigmoidf_(float x) { return 1.0f / (1.0f + __expf(-x)); }
}

namespace pg8 {
constexpr int BM = 256, BK = 64, HALF = 128, HTB = HALF * BK * 2, STAGE_BYTES = 8 * HTB, NXCD = 8, WGM = 8;
__host__ __device__ __forceinline__ int lds_byte(int r, int c) { const int st = (r >> 4) * 2 + (c >> 5), rr = r & 15, cc = c & 31, ob = rr * 64 + cc * 2; return st * 1024 + (ob ^ (((ob >> 9) & 1) << 5)); }
__host__ __device__ __forceinline__ void stage_rc(int b, int& R, int& C) { const int st = b / 1024, sb = b % 1024, swz = sb ^ (((sb >> 9) & 1) << 5); R = (st >> 1) * 16 + swz / 64; C = (st & 1) * 32 + (swz % 64) / 2; }
__host__ __device__ __forceinline__ int perm32(int rho) { const int n = rho >> 4, i = rho & 15; return 8 * (i >> 2) + 4 * n + (i & 3); }

__device__ __forceinline__ bool tile_order(int i, int G, int c, int nM, int nN, int& pm, int& pn) {
    const int nwg = nM * nN; const long L = (long)i * G + c; if (L >= nwg) return false;
    int wgid = (int)L; { const int q = nwg / NXCD, r = nwg % NXCD, xcd = wgid % NXCD, off = wgid / NXCD; wgid = (xcd < r ? xcd * (q + 1) : r * (q + 1) + (xcd - r) * q) + off; }
    const int nig = WGM * nN, gid = wgid / nig, fm = gid * WGM, gsz = (nM - fm) < WGM ? (nM - fm) : WGM;
    pm = fm + ((wgid % nig) % gsz); pn = (wgid % nig) / gsz; return true;
}

struct Unit { int pm, pn, e, mt; };

struct DenseSched {
    int nM, nN, G, c, K; const char* Bt; int reps;
    static constexpr bool DRAIN = false;
    __device__ __forceinline__ bool next(int i, Unit& u) const { u.e = 0; u.mt = 0; const int per = (nM * nN + G - 1) / G; if (i >= per * reps) return false; if (!tile_order(i % per, G, c, nM, nN, u.pm, u.pn)) return tile_order(0, G, c, nM, nN, u.pm, u.pn); return true; }
    __device__ __forceinline__ void a_off(const Unit& u, const int (&R)[2], const int (&C)[2], unsigned (&off)[2][2]) const {
#pragma unroll
        for (int h = 0; h < 2; ++h)
#pragma unroll
            for (int i = 0; i < 2; ++i) off[h][i] = (unsigned)(((u.pm * BM + h * HALF + R[i]) * K + C[i]) * 2);
    }
    __device__ __forceinline__ const char* b_ptr(const Unit& u) const { return Bt + (size_t)u.pn * BM * K * 2; }
};
template <bool GATHER> struct MoeSched {
    const LAS int* trs; const LAS int* cnts; int nN, G, c, K; const char* Bt; size_t bstride; const int* ltok;
    static constexpr bool DRAIN = GATHER;
    __device__ __forceinline__ bool next(int i, Unit& u) const {
        const int nM = __builtin_amdgcn_readfirstlane(trs[NE]);
        if (!tile_order(i, G, c, nM, nN, u.pm, u.pn)) return false;
        int e = 0;
        for (int j = 1; j < NE; ++j) e += (__builtin_amdgcn_readfirstlane(trs[j]) <= u.pm) ? 1 : 0;
        u.e = e; u.mt = u.pm - __builtin_amdgcn_readfirstlane(trs[e]); return true;
    }
    __device__ __forceinline__ void a_off(const Unit& u, const int (&R)[2], const int (&C)[2], unsigned (&off)[2][2]) const {
        const int n = __builtin_amdgcn_readfirstlane(cnts[u.e]);
#pragma unroll
        for (int h = 0; h < 2; ++h)
#pragma unroll
            for (int i = 0; i < 2; ++i) {
                int row;
                if (GATHER) { const int p = u.mt * BM + h * HALF + R[i]; row = (p < n) ? ltok[u.e * T + p] : 0; }
                else row = u.pm * BM + h * HALF + R[i];
                off[h][i] = (unsigned)((row * K + C[i]) * 2);
            }
    }
    __device__ __forceinline__ const char* b_ptr(const Unit& u) const { return Bt + (size_t)u.e * bstride + (size_t)u.pn * BM * K * 2; }
};

struct EpiBf16 {
    static constexpr bool PERM = true;
    bf16_t* O; int ldc;
    __device__ __forceinline__ void operator()(const f32x4 (&acc)[2][2][4][2], const Unit& u, int wr, int wc, int fr, int fq) const {
        const int row0 = u.pm * BM + wr * 64 + fr, col0 = u.pn * BM + wc * 32 + 8 * fq;
#pragma unroll
        for (int ai = 0; ai < 2; ++ai)
#pragma unroll
            for (int m = 0; m < 4; ++m) { bf16_t* rowp = O + (size_t)(row0 + ai * HALF + m * 16) * ldc + col0;
#pragma unroll
                for (int bj = 0; bj < 2; ++bj) { const f32x4 v0 = acc[ai][bj][m][0], v1 = acc[ai][bj][m][1];
                    u32x4 w; w.x = pk2(v0[0], v0[1]); w.y = pk2(v0[2], v0[3]); w.z = pk2(v1[0], v1[1]); w.w = pk2(v1[2], v1[3]);
                    *(u32x4*)(rowp + bj * HALF) = w; } }
    }
};
struct EpiResF32 {
    static constexpr bool PERM = false;
    float* C; const float* Rs; int ldc;
    __device__ __forceinline__ void operator()(const f32x4 (&acc)[2][2][4][2], const Unit& u, int wr, int wc, int fr, int fq) const {
        const int row0 = u.pm * BM + wr * 64 + fr, col0 = u.pn * BM + wc * 32 + 4 * fq;
#pragma unroll
        for (int ai = 0; ai < 2; ++ai)
#pragma unroll
            for (int m = 0; m < 4; ++m) { const size_t ro = (size_t)(row0 + ai * HALF + m * 16) * ldc + col0;
#pragma unroll
                for (int bj = 0; bj < 2; ++bj)
#pragma unroll
                    for (int n = 0; n < 2; ++n) { const f32x4 r = *(const f32x4*)(Rs + ro + bj * HALF + n * 16); *(f32x4*)(C + ro + bj * HALF + n * 16) = acc[ai][bj][m][n] + r; } }
    }
};
struct EpiSwiglu {
    static constexpr bool PERM = true;
    bf16_t* O; const float* bgu;
    __device__ __forceinline__ void operator()(const f32x4 (&acc)[2][2][4][2], const Unit& u, int wr, int wc, int fr, int fq) const {
        const int row0 = u.pm * BM + wr * 64 + fr, f0 = u.pn * HALF + wc * 32 + 8 * fq;
        const float* bg = bgu + (size_t)u.e * 2 * DFF + f0;
        f32x4 bgv[2], buv[2];
#pragma unroll
        for (int n = 0; n < 2; ++n) { bgv[n] = *(const f32x4*)(bg + 4 * n); buv[n] = *(const f32x4*)(bg + DFF + 4 * n); }
#pragma unroll
        for (int ai = 0; ai < 2; ++ai)
#pragma unroll
            for (int m = 0; m < 4; ++m) { bf16_t* rowp = O + (size_t)(row0 + ai * HALF + m * 16) * DFF + f0;
                float r[8];
#pragma unroll
                for (int n = 0; n < 2; ++n) { const f32x4 gv = acc[ai][0][m][n] + bgv[n], uv = acc[ai][1][m][n] + buv[n];
#pragma unroll
                    for (int j = 0; j < 4; ++j) { const float gg = fminf(gv[j], 7.0f), uu = fminf(fmaxf(uv[j], -7.0f), 7.0f);
                        r[4 * n + j] = gg * (uu + 1.0f) / (1.0f + __expf(-1.702f * gg)); } }
                u32x4 w; w.x = pk2(r[0], r[1]); w.y = pk2(r[2], r[3]); w.z = pk2(r[4], r[5]); w.w = pk2(r[6], r[7]);
                *(u32x4*)rowp = w; }
    }
};
struct EpiDown {
    static constexpr bool PERM = true;
    bf16_t* O; const float* bd; const float* lgate; const LAS int* cnts;
    __device__ __forceinline__ void operator()(const f32x4 (&acc)[2][2][4][2], const Unit& u, int wr, int wc, int fr, int fq) const {
        const int row0 = u.pm * BM + wr * 64 + fr, col0 = u.pn * BM + wc * 32 + 8 * fq;
        const int n_e = cnts[u.e];
        f32x4 bv[2][2];
#pragma unroll
        for (int bj = 0; bj < 2; ++bj)
#pragma unroll
            for (int n = 0; n < 2; ++n) bv[bj][n] = *(const f32x4*)(bd + (size_t)u.e * DM + col0 + bj * HALF + 4 * n);
#pragma unroll
        for (int ai = 0; ai < 2; ++ai)
#pragma unroll
            for (int m = 0; m < 4; ++m) { const int rt = wr * 64 + fr + ai * HALF + m * 16, p = u.mt * BM + rt;
                const float gt = (p < n_e) ? lgate[(size_t)u.e * T + p] : 0.f;
                bf16_t* rowp = O + (size_t)(row0 + ai * HALF + m * 16) * DM + col0;
#pragma unroll
                for (int bj = 0; bj < 2; ++bj) { const f32x4 v0 = (acc[ai][bj][m][0] + bv[bj][0]) * gt, v1 = (acc[ai][bj][m][1] + bv[bj][1]) * gt;
                    u32x4 w; w.x = pk2(v0[0], v0[1]); w.y = pk2(v0[2], v0[3]); w.z = pk2(v1[0], v1[1]); w.w = pk2(v1[2], v1[3]);
                    *(u32x4*)(rowp + bj * HALF) = w; } }
    }
};

template <class Epi, class Sched>
__device__ __forceinline__ void gemm_phase(LAS unsigned char* lds, const char* A0, const int K, const Sched& S, const Epi& E) {
    const int tid = threadIdx.x, wid = __builtin_amdgcn_readfirstlane(tid >> 6), lane = tid & 63, wr = wid >> 2, wc = wid & 3, fr = lane & 15, fq = lane >> 4;
    const int nt = K / BK;
    int Rr[2], Cc[2]; unsigned voffB[2];
#pragma unroll
    for (int i = 0; i < 2; ++i) { stage_rc(tid * 16 + i * 8192, Rr[i], Cc[i]); const int Rb = Epi::PERM ? ((Rr[i] & ~31) + perm32(Rr[i] & 31)) : Rr[i]; voffB[i] = (unsigned)(Rb * K + Cc[i]) * 2u; }
    const size_t kstep = (size_t)(BK * 2);
    const size_t hstep = (size_t)HALF * K * 2;
    const unsigned ldsw = (unsigned)wid * 1024u;
    const int aoff = lds_byte(wr * 64 + fr, fq * 8), boff = lds_byte(wc * 32 + fr, fq * 8);
#define PG8_SA(b, h) (((b) * 2 + (h)) * HTB)
#define PG8_SB(b, h) ((4 + (b) * 2 + (h)) * HTB)
#define PG8_STAGE_B(bufoff, gbase) do { _Pragma("unroll") for (int _i = 0; _i < 2; ++_i) \
        __builtin_amdgcn_global_load_lds((const unsigned*)((const char*)(gbase) + voffB[_i]), (LAS unsigned*)(lds + (bufoff) + ldsw + _i * 8192), 16, 0, 0); } while (0)
#define PG8_STAGE_A(bufoff, gbase, o0, o1) do { \
        __builtin_amdgcn_global_load_lds((const unsigned*)((const char*)(gbase) + (o0)), (LAS unsigned*)(lds + (bufoff) + ldsw), 16, 0, 0); \
        __builtin_amdgcn_global_load_lds((const unsigned*)((const char*)(gbase) + (o1)), (LAS unsigned*)(lds + (bufoff) + ldsw + 8192), 16, 0, 0); } while (0)
#define PG8_LDA(dst, b, h) do { _Pragma("unroll") for (int m = 0; m < 4; ++m) _Pragma("unroll") for (int k = 0; k < 2; ++k) dst[m][k] = *(const LAS bf16x8*)(lds + PG8_SA(b, h) + aoff + m * 2048 + k * 1024); } while (0)
#define PG8_LDB(dst, b, h) do { _Pragma("unroll") for (int n = 0; n < 2; ++n) _Pragma("unroll") for (int k = 0; k < 2; ++k) dst[n][k] = *(const LAS bf16x8*)(lds + PG8_SB(b, h) + boff + n * 2048 + k * 1024); } while (0)
#define PG8_MMA(ai, bj, At, Bt) do { __builtin_amdgcn_s_setprio(1); _Pragma("unroll") for (int m = 0; m < 4; ++m) _Pragma("unroll") for (int n = 0; n < 2; ++n) _Pragma("unroll") for (int k = 0; k < 2; ++k) \
        acc[ai][bj][m][n] = __builtin_amdgcn_mfma_f32_16x16x32_bf16(Bt[n][k], At[m][k], acc[ai][bj][m][n], 0, 0, 0); __builtin_amdgcn_s_setprio(0); } while (0)
#define PG8_WAIT_V(n) asm volatile("s_waitcnt vmcnt(" #n ")" ::: "memory")
#define PG8_WAIT_L(n) asm volatile("s_waitcnt lgkmcnt(" #n ")" ::: "memory")
#define PG8_BAR __builtin_amdgcn_s_barrier()
#define PG8_SCHED __builtin_amdgcn_sched_barrier(0)
    Unit cur, nxt; int ui = 0;
    if (!S.next(0, cur)) return;
    f32x4 acc[2][2][4][2];
#pragma unroll
    for (int a = 0; a < 2; ++a)
#pragma unroll
        for (int b = 0; b < 2; ++b)
#pragma unroll
            for (int m = 0; m < 4; ++m)
#pragma unroll
                for (int n = 0; n < 2; ++n) acc[a][b][m][n] = (f32x4){0.f, 0.f, 0.f, 0.f};
    bf16x8 At[4][2], B0[2][2], B1[2][2];
    unsigned offC[2][2], offN[2][2];
    S.a_off(cur, Rr, Cc, offC);
    const char* cB = S.b_ptr(cur);
    if (Sched::DRAIN) PG8_WAIT_V(0);
    PG8_STAGE_B(PG8_SB(0, 0), cB); PG8_STAGE_B(PG8_SB(0, 1), cB + hstep); PG8_STAGE_A(PG8_SA(0, 0), A0, offC[0][0], offC[0][1]); PG8_STAGE_A(PG8_SA(0, 1), A0, offC[1][0], offC[1][1]);
    if (wr == 1) PG8_BAR;
    PG8_WAIT_V(2); PG8_BAR;
    PG8_STAGE_B(PG8_SB(1, 0), cB + kstep); PG8_STAGE_A(PG8_SA(1, 0), A0 + kstep, offC[0][0], offC[0][1]); PG8_STAGE_B(PG8_SB(1, 1), cB + hstep + kstep);
    PG8_WAIT_V(6); PG8_BAR;
    for (;;) {
        const bool has_next = S.next(ui + 1, nxt);
        const char* nB = cB;
        if (has_next) { S.a_off(nxt, Rr, Cc, offN); nB = S.b_ptr(nxt); }
        else {
#pragma unroll
            for (int h = 0; h < 2; ++h)
#pragma unroll
                for (int i = 0; i < 2; ++i) offN[h][i] = offC[h][i];
        }
        if (Sched::DRAIN) PG8_WAIT_V(0);
        for (int t = 0; t < nt; t += 2) {
            const bool last = (t == nt - 2);
            const char* a1 = A0 + (size_t)(t + 1) * kstep;
            const char* a2 = last ? A0 : A0 + (size_t)(t + 2) * kstep; const char* b2 = last ? nB : cB + (size_t)(t + 2) * kstep;
            const char* a3 = a2 + kstep; const char* b3 = b2 + kstep;
            const unsigned o00 = last ? offN[0][0] : offC[0][0], o01 = last ? offN[0][1] : offC[0][1], o10 = last ? offN[1][0] : offC[1][0], o11 = last ? offN[1][1] : offC[1][1];
            PG8_LDB(B0, 0, 0); PG8_LDB(B1, 0, 1); PG8_SCHED; PG8_LDA(At, 0, 0); PG8_STAGE_A(PG8_SA(1, 1), a1, offC[1][0], offC[1][1]);
            PG8_WAIT_V(8); PG8_WAIT_L(0); PG8_BAR; PG8_MMA(0, 0, At, B0); PG8_MMA(0, 1, At, B1); PG8_BAR; PG8_SCHED;
            PG8_LDA(At, 0, 1); PG8_STAGE_B(PG8_SB(0, 0), b2); PG8_STAGE_B(PG8_SB(0, 1), b2 + hstep); PG8_STAGE_A(PG8_SA(0, 0), a2, o00, o01);
            PG8_WAIT_V(8); PG8_WAIT_L(0); PG8_BAR; PG8_MMA(1, 0, At, B0); PG8_MMA(1, 1, At, B1); PG8_BAR; PG8_SCHED;
            PG8_LDB(B0, 1, 0); PG8_LDB(B1, 1, 1); PG8_SCHED; PG8_LDA(At, 1, 0); PG8_STAGE_A(PG8_SA(0, 1), a2, o10, o11);
            PG8_WAIT_V(8); PG8_WAIT_L(0); PG8_BAR; PG8_MMA(0, 0, At, B0); PG8_MMA(0, 1, At, B1); PG8_BAR; PG8_SCHED;
            PG8_LDA(At, 1, 1); PG8_STAGE_B(PG8_SB(1, 0), b3); PG8_STAGE_B(PG8_SB(1, 1), b3 + hstep); PG8_STAGE_A(PG8_SA(1, 0), a3, o00, o01);
            PG8_WAIT_V(8); PG8_WAIT_L(0); PG8_BAR; PG8_MMA(1, 0, At, B0); PG8_MMA(1, 1, At, B1); PG8_BAR; PG8_SCHED;
        }
        if (wr == 0) PG8_BAR;
        E(acc, cur, wr, wc, fr, fq);
        if (!has_next) break;
#pragma unroll
        for (int a = 0; a < 2; ++a)
#pragma unroll
            for (int b = 0; b < 2; ++b)
#pragma unroll
                for (int m = 0; m < 4; ++m)
#pragma unroll
                    for (int n = 0; n < 2; ++n) acc[a][b][m][n] = (f32x4){0.f, 0.f, 0.f, 0.f};
        cur = nxt; cB = nB; ++ui;
#pragma unroll
        for (int h = 0; h < 2; ++h)
#pragma unroll
            for (int i = 0; i < 2; ++i) offC[h][i] = offN[h][i];
        if (wr == 1) PG8_BAR;
    }
    PG8_WAIT_V(0);
    PG8_BAR;
#undef PG8_SA
#undef PG8_SB
#undef PG8_STAGE_A
#undef PG8_STAGE_B
#undef PG8_LDA
#undef PG8_LDB
#undef PG8_MMA
#undef PG8_WAIT_V
#undef PG8_WAIT_L
#undef PG8_BAR
#undef PG8_SCHED
}
}

namespace {
struct Params { const float* in[20]; float* out; unsigned char* ws; };

struct Frame {
    LAS unsigned char* lds;
    int tid, lane, wave, G, vcu, gw, ngw;
};

__device__ __forceinline__ void transpose_item(const float* Wt  , int ldw, bf16_t* WTt  , int ldt, float scale, LAS float* scr, int lane) {
    const int r8 = lane >> 3, c4 = (lane & 7) * 4;
    f32x4 v[8];
#pragma unroll
    for (int i = 0; i < 8; ++i) v[i] = *(const f32x4*)(Wt + (size_t)(8 * i + r8) * ldw + c4);
#pragma unroll
    for (int i = 0; i < 8; ++i) { LAS float* d = scr + (8 * i + r8) * 33 + c4; d[0] = v[i][0]; d[1] = v[i][1]; d[2] = v[i][2]; d[3] = v[i][3]; }
    asm volatile("s_waitcnt lgkmcnt(0)" ::: "memory");
    const int c = lane & 7;
#pragma unroll
    for (int j = 0; j < 4; ++j) { const int n = (lane >> 3) + 8 * j; const LAS float* s = scr + (8 * c) * 33 + n;
        u32x4 o; o.x = pk2(s[0 * 33] * scale, s[1 * 33] * scale); o.y = pk2(s[2 * 33] * scale, s[3 * 33] * scale); o.z = pk2(s[4 * 33] * scale, s[5 * 33] * scale); o.w = pk2(s[6 * 33] * scale, s[7 * 33] * scale);
        *(u32x4*)(WTt + (size_t)n * ldt + 8 * c) = o; }
    asm volatile("s_waitcnt lgkmcnt(0)" ::: "memory");
}

__device__ __forceinline__ void p0_prologue(const Params& P, Frame& F) {
    unsigned char* ws = P.ws;
    const float* w_in = P.in[2];
    LAS float* scr = (LAS float*)(F.lds + F.wave * 8448);
    LAS float* gwl = (LAS float*)(F.lds + 73728);
    for (int i = F.tid; i < 1024 * 8; i += NTHR) gwl[i] = w_in[(size_t)(i >> 3) * DIN + NZ + (i & 7)];
    __syncthreads();
    constexpr int I_IN = 16 * 96, I_OUT = 16 * 32, I_QK = 8 * 2 * 4, I_GU = NE * 16 * 64, I_D = NE * 16 * 32, I_ZERO = 8 * 3;
    constexpr int NITEMS = I_IN + I_OUT + I_QK + I_ZERO + I_GU + I_D;
    bf16_t* WinT = (bf16_t*)(ws + WS_WIN); bf16_t* WoutT = (bf16_t*)(ws + WS_WOUT); bf16_t* WqkT = (bf16_t*)(ws + WS_WQK);
    bf16_t* WguT = (bf16_t*)(ws + WS_WGU); bf16_t* WdT = (bf16_t*)(ws + WS_WD);
    for (int it = F.gw; it < NITEMS; it += F.ngw) {
        int r = it;
        if (r < I_IN) { const int kb = r / 96, nb = r % 96; transpose_item(w_in + (size_t)(64 * kb) * DIN + 32 * nb, DIN, WinT + (size_t)(32 * nb) * DM + 64 * kb, DM, 1.f, scr, F.lane); continue; } r -= I_IN;
        if (r < I_OUT) { const int kb = r / 32, nb = r % 32; transpose_item(P.in[12] + (size_t)(64 * kb) * DM + 32 * nb, DM, WoutT + (size_t)(32 * nb) * DM + 64 * kb, DM, 1.f, scr, F.lane); continue; } r -= I_OUT;
        if (r < I_QK) { const int isk = r >> 5, h = (r >> 3) & 3, kb = (r >> 2) & 1, nb = r & 3;
            const float* src = P.in[isk ? 8 : 7] + (size_t)h * 16384 + (size_t)(64 * kb) * 128 + 32 * nb;
            transpose_item(src, 128, WqkT + (size_t)(isk * 512 + h * 128 + 32 * nb) * 512 + h * 128 + 64 * kb, 512, isk ? 0.08838834764831845f : 1.f, scr, F.lane); continue; } r -= I_QK;
        if (r < I_ZERO) {
            const int rb = r / 3, j = r % 3, cb = j + (j >= (rb & 3) ? 1 : 0);
            for (int q = F.lane; q < 128 * 16; q += 64) { const int rr = q >> 4, cc = q & 15; *(u32x4*)(WqkT + (size_t)(rb * 128 + rr) * 512 + cb * 128 + cc * 8) = (u32x4){0u, 0u, 0u, 0u}; }
            continue; } r -= I_ZERO;
        if (r < I_GU) { const int e = r >> 10, kb = (r >> 6) & 15, nb = r & 63, n0 = 32 * nb, f = n0 & 1023, up = n0 >> 10;
            const int drow = (f >> 7) * 256 + up * 128 + (f & 127);
            transpose_item(P.in[16] + (size_t)e * DM * 2 * DFF + (size_t)(64 * kb) * 2 * DFF + n0, 2 * DFF, WguT + (size_t)e * 2 * DFF * DM + (size_t)drow * DM + 64 * kb, DM, 1.f, scr, F.lane); continue; } r -= I_GU;
        { const int e = r >> 9, kb = (r >> 5) & 15, nb = r & 31;
            transpose_item(P.in[18] + (size_t)e * DFF * DM + (size_t)(64 * kb) * DM + 32 * nb, DM, WdT + (size_t)e * DM * DFF + (size_t)(32 * nb) * DFF + 64 * kb, DFF, 1.f, scr, F.lane); }
    }
    {
        const float* wr = P.in[14]; float* wrt = (float*)(ws + WS_WRT);
        for (int idx = F.vcu * NTHR + F.tid; idx < DM * NE; idx += F.G * NTHR) wrt[(idx & 31) * DM + (idx >> 5)] = wr[idx];
    }
    const float* x = P.in[0]; const float* g1 = P.in[1];
    bf16_t* XN = (bf16_t*)(ws + WS_XN); float* GATE = (float*)(ws + WS_GATE);
    for (int row = F.gw; row < T; row += F.ngw) {
        const f32x4* xr = (const f32x4*)(x + (size_t)row * DM);
        f32x4 v[4]; float s = 0.f;
#pragma unroll
        for (int j = 0; j < 4; ++j) { v[j] = xr[F.lane + 64 * j]; s += v[j][0] * v[j][0] + v[j][1] * v[j][1] + v[j][2] * v[j][2] + v[j][3] * v[j][3]; }
        s = wave_sum(s);
        const float rs = 1.0f / sqrtf(s * (1.0f / DM) + EPS);
        float ga[8];
#pragma unroll
        for (int c = 0; c < 8; ++c) ga[c] = 0.f;
#pragma unroll
        for (int j = 0; j < 4; ++j) { const f32x4 gg = ((const f32x4*)g1)[F.lane + 64 * j]; v[j] = v[j] * rs * gg;
            u32x2 w; w.x = pk2(v[j][0], v[j][1]); w.y = pk2(v[j][2], v[j][3]);
            *(u32x2*)(XN + (size_t)row * DM + 4 * (F.lane + 64 * j)) = w;
#pragma unroll
            for (int q = 0; q < 4; ++q) { const int k = 4 * (F.lane + 64 * j) + q; const f32x4 w0 = *(const LAS f32x4*)(gwl + k * 8), w1 = *(const LAS f32x4*)(gwl + k * 8 + 4);
                ga[0] += v[j][q] * w0[0]; ga[1] += v[j][q] * w0[1]; ga[2] += v[j][q] * w0[2]; ga[3] += v[j][q] * w0[3];
                ga[4] += v[j][q] * w1[0]; ga[5] += v[j][q] * w1[1]; ga[6] += v[j][q] * w1[2]; ga[7] += v[j][q] * w1[3]; } }
#pragma unroll
        for (int c = 0; c < 8; ++c) ga[c] = wave_sum(ga[c]);
        if (F.lane == 0) { *(f32x4*)(GATE + (size_t)row * 8) = (f32x4){ga[0], ga[1], ga[2], ga[3]}; *(f32x4*)(GATE + (size_t)row * 8 + 4) = (f32x4){ga[4], ga[5], ga[6], ga[7]}; }
    }
}

__device__ __forceinline__ void p2_tokprep(const Params& P, Frame& F) {
    bf16_t* Z = (bf16_t*)(P.ws + WS_Z); bf16_t* XC = (bf16_t*)(P.ws + WS_XC);
    const float* gq = P.in[3]; const float* gk = P.in[4]; const float* cw = P.in[5]; const float* cb = P.in[6];
    const int lane = F.lane;
    for (int tok = F.gw; tok < T; tok += F.ngw) {
        bf16_t* zr = Z + (size_t)tok * NZ;
#pragma unroll
        for (int part = 0; part < 2; ++part) {
            bf16_t* p = zr + (part ? ZK : ZQ) + lane * 8;
            const float* g = (part ? gk : gq) + (lane & 7) * 8;
            const u32x4 w = *(const u32x4*)p;
            float a[8] = {bflo(w.x), bfhi(w.x), bflo(w.y), bfhi(w.y), bflo(w.z), bfhi(w.z), bflo(w.w), bfhi(w.w)};
            float s = 0.f;
#pragma unroll
            for (int i = 0; i < 8; ++i) s += a[i] * a[i];
            s += __shfl_xor(s, 1); s += __shfl_xor(s, 2); s += __shfl_xor(s, 4);
            float r = 1.0f / sqrtf(s * (1.0f / 64.f) + EPS); if (!part) r *= 0.125f * LOG2E;
#pragma unroll
            for (int i = 0; i < 8; ++i) a[i] *= r * g[i];
            u32x4 o; o.x = pk2(a[0], a[1]); o.y = pk2(a[2], a[3]); o.z = pk2(a[4], a[5]); o.w = pk2(a[6], a[7]);
            *(u32x4*)p = o;
        }
        for (int crep = 0; crep < ((DUP & 2048) ? 2 : 1); ++crep) {
            const int tl = tok % SEQ; const int ch = lane * 8;
            float a[8];
#pragma unroll
            for (int i = 0; i < 8; ++i) a[i] = cb[ch + i];
#pragma unroll
            for (int j = 0; j < 4; ++j) { const int dt = 3 - j; if (tl - dt >= 0) {
                    const u32x4 w = *(const u32x4*)(Z + (size_t)(tok - dt) * NZ + ZXM + ch);
                    const float xv[8] = {bflo(w.x), bfhi(w.x), bflo(w.y), bfhi(w.y), bflo(w.z), bfhi(w.z), bflo(w.w), bfhi(w.w)};
#pragma unroll
                    for (int i = 0; i < 8; ++i) a[i] += cw[j * 512 + ch + i] * xv[i]; } }
#pragma unroll
            for (int i = 0; i < 8; ++i) a[i] = a[i] * sigmoidf_(a[i]);
            u32x4 o; o.x = pk2(a[0], a[1]); o.y = pk2(a[2], a[3]); o.z = pk2(a[4], a[5]); o.w = pk2(a[6], a[7]);
            *(u32x4*)(XC + (size_t)tok * 512 + ch) = o;
        }
    }
}

__device__ __forceinline__ void attn_phase(const Params& P, Frame& F) {
    const bf16_t* Z = (const bf16_t*)(P.ws + WS_Z); bf16_t* MIX = (bf16_t*)(P.ws + WS_MIX);
    const int lane = F.lane, i = lane & 15, g = lane >> 4;
    float gm = fabsf(P.in[4][lane]);
#pragma unroll
    for (int o = 1; o < 64; o <<= 1) gm = fmaxf(gm, __shfl_xor(gm, o));
    const float kmax = 8.0f * gm * 1.01f;
    LAS unsigned char* vb = F.lds + F.wave * 4608;
    const int vwr = (lane >> 3) * 144 + (lane & 7) * 16;
    const int vrd = (4 * g + (i >> 2)) * 144 + (i & 3) * 8;
    for (int tile = F.gw; tile < 8192; tile += F.ngw) {
        const int r = tile & 15, blk = (tile >> 4) & 31, h = (tile >> 9) & 7, b = tile >> 12;
        const int tl0 = blk * 256 + r, T0 = b * SEQ + tl0;
        const bf16_t* qrow = Z + (size_t)(T0 + 16 * i) * NZ + ZQ + h * 64;
        const bf16x8 qf0 = *(const bf16x8*)(qrow + 8 * g), qf1 = *(const bf16x8*)(qrow + 32 + 8 * g);
        float ss = 0.f;
#pragma unroll
        for (int j = 0; j < 8; ++j) { const float a = bf2f((unsigned short)qf0[j]), c = bf2f((unsigned short)qf1[j]); ss += a * a + c * c; }
        ss += __shfl_xor(ss, 16); ss += __shfl_xor(ss, 32);
        const float ref = sqrtf(ss) * kmax;
        const float slope2 = exp2f(-(float)(h + 1)) * LOG2E;
        f32x4 o[4];
#pragma unroll
        for (int dt = 0; dt < 4; ++dt) o[dt] = (f32x4){0.f, 0.f, 0.f, 0.f};
        float lsum = 0.f;
        const bf16_t* Kh = Z + (size_t)b * SEQ * NZ + ZK + h * 64 + 8 * g;
        const bf16_t* Vh = Z + (size_t)b * SEQ * NZ + ZV + h * 64 + 8 * (lane & 7);
        bf16x8 kfn[2][2]; u32x4 vrn[4];
#define ATT_LOAD(bi_) do { const int bi__ = (bi_); const int br_ = bi__ < 12 ? 0 : (bi__ < 18 ? 1 : 2); const int d_ = 1 << (2 * br_); const int nb_ = -128 + 32 * (bi__ - (br_ == 0 ? 0 : (br_ == 1 ? 12 : 18))); \
        _Pragma("unroll") for (int sb = 0; sb < 2; ++sb) { int kp = tl0 + (nb_ + 16 * sb + i) * d_; kp = kp < 0 ? 0 : (kp > SEQ - 1 ? SEQ - 1 : kp); const bf16_t* kr = Kh + (size_t)kp * NZ; kfn[sb][0] = *(const bf16x8*)kr; kfn[sb][1] = *(const bf16x8*)(kr + 32); } \
        _Pragma("unroll") for (int c = 0; c < 4; ++c) { int kp = tl0 + (nb_ + 8 * c + (lane >> 3)) * d_; kp = kp < 0 ? 0 : (kp > SEQ - 1 ? SEQ - 1 : kp); vrn[c] = *(const u32x4*)(Vh + (size_t)kp * NZ); } } while (0)
        ATT_LOAD(0);
        for (int bi = 0; bi < 23; ++bi) {
            bf16x8 kf[2][2]; u32x4 vr[4];
#pragma unroll
            for (int sb = 0; sb < 2; ++sb) { kf[sb][0] = kfn[sb][0]; kf[sb][1] = kfn[sb][1]; }
#pragma unroll
            for (int c = 0; c < 4; ++c) vr[c] = vrn[c];
            if (bi + 1 < 23) ATT_LOAD(bi + 1);
            const int br = bi < 12 ? 0 : (bi < 18 ? 1 : 2), dd = 1 << (2 * br), u = 16 / dd;
            const int nb = -128 + 32 * (bi - (br == 0 ? 0 : (br == 1 ? 12 : 18)));
#pragma unroll
            for (int c = 0; c < 4; ++c) *(LAS u32x4*)(vb + vwr + c * 8 * 144) = vr[c];
            f32x4 s[2];
#pragma unroll
            for (int sb = 0; sb < 2; ++sb) { s[sb] = __builtin_amdgcn_mfma_f32_16x16x32_bf16(kf[sb][0], qf0, (f32x4){0.f, 0.f, 0.f, 0.f}, 0, 0, 0);
                s[sb] = __builtin_amdgcn_mfma_f32_16x16x32_bf16(kf[sb][1], qf1, s[sb], 0, 0, 0); }
            float p[8];
#pragma unroll
            for (int sb = 0; sb < 2; ++sb)
#pragma unroll
                for (int j = 0; j < 4; ++j) { const int n = nb + 16 * sb + 4 * g + j, a = u * i - n;
                    const bool valid = (a >= 0) && (a <= 128) && (tl0 + n * dd >= 0);
                    const float e = s[sb][j] - slope2 * (float)(a * dd) - ref;
                    const float pv = valid ? __builtin_amdgcn_exp2f(e) : 0.f;
                    p[4 * sb + j] = pv; lsum += pv; }
            u32x4 pw; pw.x = pk2(p[0], p[1]); pw.y = pk2(p[2], p[3]); pw.z = pk2(p[4], p[5]); pw.w = pk2(p[6], p[7]);
            const bf16x8 pf = __builtin_bit_cast(bf16x8, pw);
#pragma unroll
            for (int dt = 0; dt < 4; ++dt) {
                const s16x4 v0 = __builtin_amdgcn_ds_read_tr16_b64_v4i16((LAS s16x4*)(vb + vrd + dt * 32));
                const s16x4 v1 = __builtin_amdgcn_ds_read_tr16_b64_v4i16((LAS s16x4*)(vb + vrd + 16 * 144 + dt * 32));
                const bf16x8 vf = (bf16x8){v0[0], v0[1], v0[2], v0[3], v1[0], v1[1], v1[2], v1[3]};
                o[dt] = __builtin_amdgcn_mfma_f32_16x16x32_bf16(vf, pf, o[dt], 0, 0, 0);
            }
        }
#undef ATT_LOAD
        lsum += __shfl_xor(lsum, 16); lsum += __shfl_xor(lsum, 32);
        const float inv = 1.0f / lsum;
        bf16_t* orow = MIX + (size_t)(T0 + 16 * i) * DM + h * 64 + 4 * g;
#pragma unroll
        for (int dt = 0; dt < 4; ++dt) { u32x2 w; w.x = pk2(o[dt][0] * inv, o[dt][1] * inv); w.y = pk2(o[dt][2] * inv, o[dt][3] * inv); *(u32x2*)(orow + 16 * dt) = w; }
    }
}

__device__ __forceinline__ bf16x8 tr2(LAS unsigned char* p0, LAS unsigned char* p1) {
    const s16x4 a = __builtin_amdgcn_ds_read_tr16_b64_v4i16((LAS s16x4*)p0);
    const s16x4 b = __builtin_amdgcn_ds_read_tr16_b64_v4i16((LAS s16x4*)p1);
    return (bf16x8){a[0], a[1], a[2], a[3], b[0], b[1], b[2], b[3]};
}
#define MFMA16(a, b, c) __builtin_amdgcn_mfma_f32_16x16x32_bf16((a), (b), (c), 0, 0, 0)

__device__ __forceinline__ void ml1_phase(const Params& P, Frame& F) {
    const bf16_t* Z = (const bf16_t*)(P.ws + WS_Z); const bf16_t* QK = (const bf16_t*)(P.ws + WS_QK); const float* GATE = (const float*)(P.ws + WS_GATE);
    float* BC = (float*)(P.ws + WS_BC); float* IG = (float*)(P.ws + WS_IG); float* BT = (float*)(P.ws + WS_BT); float* U = (float*)(P.ws + WS_U); float* NV = (float*)(P.ws + WS_NV);
    const float* bi = P.in[9]; const float* bf = P.in[10];
    constexpr int PIT = 272;
    LAS unsigned char* KIM = F.lds; LAS unsigned char* VIM = F.lds + 128 * PIT;
    LAS float* bc = (LAS float*)(F.lds + 2 * 128 * PIT); LAS float* wv = bc + 256;
    const int tid = F.tid, lane = F.lane, i = lane & 15, g = lane >> 4, w = F.wave;
    bf16x8 ones;
#pragma unroll
    for (int j = 0; j < 8; ++j) ones[j] = (i == 0) ? (short)0x3F80 : (short)0;
    for (int unit = F.vcu; unit < 256; unit += F.G) {
        const int bh = unit / NCH, c = unit % NCH, b = bh / NHM, h = bh % NHM, t0 = b * SEQ + c * CH;
        float ig = 0.f;
        __syncthreads();
        if (tid < 256) { const float f = GATE[(size_t)(t0 + tid) * 8 + 4 + h] + bf[h];
            bc[tid] = fminf(f, 0.f) - log1pf(__expf(-fabsf(f)));
            ig = GATE[(size_t)(t0 + tid) * 8 + h] + bi[h]; }
        __syncthreads();
        if (w == 0) {
            const f32x4 a = *(const LAS f32x4*)(bc + 4 * lane);
            const float s1 = a[0], s2 = s1 + a[1], s3 = s2 + a[2], s4 = s3 + a[3];
            float x = s4;
#pragma unroll
            for (int off = 1; off < 64; off <<= 1) { const float v = __shfl_up(x, off); if (lane >= off) x += v; }
            const float ex = x - s4;
            *(LAS f32x4*)(bc + 4 * lane) = (f32x4){ex + s1, ex + s2, ex + s3, ex + s4};
        }
        __syncthreads();
        if (tid < 256) { BC[(size_t)(t0 + tid) * 4 + h] = bc[tid]; IG[(size_t)(t0 + tid) * 4 + h] = ig; wv[tid] = __expf(bc[255] - bc[tid] + ig); }
        if (tid == 0) BT[unit] = bc[255];
        f32x4 acc[9];
#pragma unroll
        for (int q = 0; q < 9; ++q) acc[q] = (f32x4){0.f, 0.f, 0.f, 0.f};
        for (int half = 0; half < 2; ++half) {
            __syncthreads();
#pragma unroll
            for (int q = 0; q < 4; ++q) { const int id = tid + 512 * q, row = id >> 4, c8 = (id & 15) * 8, sidx = half * 128 + row;
                const u32x4 kw = *(const u32x4*)(QK + (size_t)(t0 + sidx) * 1024 + 512 + h * 128 + c8);
                const u32x4 vw = *(const u32x4*)(Z + (size_t)(t0 + sidx) * NZ + ZVM + h * 128 + c8);
                const float ws_ = wv[sidx];
                u32x4 ks; ks.x = pk2(bflo(kw.x) * ws_, bfhi(kw.x) * ws_); ks.y = pk2(bflo(kw.y) * ws_, bfhi(kw.y) * ws_); ks.z = pk2(bflo(kw.z) * ws_, bfhi(kw.z) * ws_); ks.w = pk2(bflo(kw.w) * ws_, bfhi(kw.w) * ws_);
                *(LAS u32x4*)(KIM + row * PIT + c8 * 2) = ks; *(LAS u32x4*)(VIM + row * PIT + c8 * 2) = vw; }
            __syncthreads();
#pragma unroll
            for (int kk = 0; kk < 4; ++kk) {
                const int ro = (32 * kk + 8 * g + (i >> 2)) * PIT + (i & 3) * 8;
                const bf16x8 af = tr2(KIM + ro + 32 * w, KIM + ro + 4 * PIT + 32 * w);
#pragma unroll
                for (int et = 0; et < 8; ++et) { const bf16x8 bfr = tr2(VIM + ro + 32 * et, VIM + ro + 4 * PIT + 32 * et); acc[et] = MFMA16(af, bfr, acc[et]); }
                acc[8] = MFMA16(af, ones, acc[8]);
            }
        }
        float* up = U + (size_t)unit * 16384 + (size_t)(16 * w + 4 * g) * 128 + i;
#pragma unroll
        for (int et = 0; et < 8; ++et)
#pragma unroll
            for (int j = 0; j < 4; ++j) up[j * 128 + 16 * et] = acc[et][j];
        if (i == 0) {
#pragma unroll
            for (int j = 0; j < 4; ++j) NV[unit * 128 + 16 * w + 4 * g + j] = acc[8][j];
        }
    }
}

__device__ __forceinline__ void ml3_phase(const Params& P, Frame& F) {
    const bf16_t* Z = (const bf16_t*)(P.ws + WS_Z); const bf16_t* QK = (const bf16_t*)(P.ws + WS_QK);
    const float* BC = (const float*)(P.ws + WS_BC); const float* IG = (const float*)(P.ws + WS_IG); const float* BT = (const float*)(P.ws + WS_BT);
    const float* U = (const float*)(P.ws + WS_U); const float* NV = (const float*)(P.ws + WS_NV); const float* gn = P.in[11];
    bf16_t* MIX = (bf16_t*)(P.ws + WS_MIX);
    constexpr int CP = 288, VP = 272;
    LAS unsigned char* CIM = F.lds;
    LAS unsigned char* VIM = F.lds + 128 * CP;
    LAS float* cs = (LAS float*)(F.lds + 128 * CP + 256 * VP);
    LAS float* bq = cs + 256;
    const int tid = F.tid, lane = F.lane, i = lane & 15, g = lane >> 4, w = F.wave;
    for (int unit = F.vcu; unit < 256; unit += F.G) {
        const int bh = unit / NCH, c = unit % NCH, b = bh / NHM, h = bh % NHM, t0 = b * SEQ + c * CH;
        __syncthreads();
#pragma unroll
        for (int q = 0; q < 8; ++q) { const int id = tid + 512 * q, row = id >> 4, c8 = (id & 15) * 8;
            *(LAS u32x4*)(VIM + row * VP + c8 * 2) = *(const u32x4*)(Z + (size_t)(t0 + row) * NZ + ZVM + h * 128 + c8); }
        if (tid < 256) { const float bb = BC[(size_t)(t0 + tid) * 4 + h]; bq[tid] = bb; cs[tid] = IG[(size_t)(t0 + tid) * 4 + h] - bb; }
        {   f32x4 cc[4][2]; float n = 0.f;
#pragma unroll
            for (int q = 0; q < 4; ++q) { cc[q][0] = (f32x4){0.f, 0.f, 0.f, 0.f}; cc[q][1] = (f32x4){0.f, 0.f, 0.f, 0.f}; }
            for (int j = 0; j < c; ++j) {
                const float dec = __expf(BT[bh * NCH + j]);
                const float* up = U + (size_t)(bh * NCH + j) * 16384;
#pragma unroll
                for (int q = 0; q < 4; ++q) { const int id = tid + 512 * q; const f32x4 u0 = *(const f32x4*)(up + id * 8), u1 = *(const f32x4*)(up + id * 8 + 4);
                    cc[q][0] = cc[q][0] * dec + u0; cc[q][1] = cc[q][1] * dec + u1; }
                if (tid < 128) n = dec * n + NV[(bh * NCH + j) * 128 + tid];
            }
#pragma unroll
            for (int q = 0; q < 4; ++q) { const int id = tid + 512 * q, d = id >> 4, e8 = (id & 15) * 8;
                u32x4 o; o.x = pk2(cc[q][0][0], cc[q][0][1]); o.y = pk2(cc[q][0][2], cc[q][0][3]); o.z = pk2(cc[q][1][0], cc[q][1][1]); o.w = pk2(cc[q][1][2], cc[q][1][3]);
                *(LAS u32x4*)(CIM + d * CP + e8 * 2) = o; }
            if (tid < 128) { *(LAS u32x4*)(CIM + tid * CP + 256) = (u32x4){f2bf(n), 0u, 0u, 0u}; *(LAS u32x4*)(CIM + tid * CP + 272) = (u32x4){0u, 0u, 0u, 0u}; }
        }
        __syncthreads();
#pragma unroll 1
        for (int a = 0; a < 2; ++a) {
            const int qt = a ? 15 - w : w;
            bf16x8 qf[4];
            { const bf16_t* qp = QK + (size_t)(t0 + 16 * qt + i) * 1024 + h * 128 + 8 * g;
#pragma unroll
                for (int ks = 0; ks < 4; ++ks) qf[ks] = *(const bf16x8*)(qp + 32 * ks); }
            const float bt = bq[16 * qt + i];
            f32x4 acc[8]; float den;
            {
                f32x4 a8 = (f32x4){0.f, 0.f, 0.f, 0.f};
#pragma unroll
                for (int et = 0; et < 8; ++et) acc[et] = (f32x4){0.f, 0.f, 0.f, 0.f};
#pragma unroll
                for (int ks = 0; ks < 4; ++ks) {
                    const int ro = (32 * ks + 8 * g + (i >> 2)) * CP + (i & 3) * 8;
#pragma unroll
                    for (int et = 0; et < 8; ++et) { const bf16x8 cf = tr2(CIM + ro + 32 * et, CIM + ro + 4 * CP + 32 * et); acc[et] = MFMA16(cf, qf[ks], acc[et]); }
                    const bf16x8 cf = tr2(CIM + ro + 256, CIM + ro + 4 * CP + 256);
                    a8 = MFMA16(cf, qf[ks], a8);
                }
                const float eb = __expf(bt);
#pragma unroll
                for (int et = 0; et < 8; ++et) acc[et] = acc[et] * eb;
                den = (g == 0) ? a8[0] * eb : 0.f;
            }
            const int kbhi = qt >> 1;
#pragma unroll 1
            for (int kb = 0; kb <= kbhi; ++kb) {
                float p[8];
#pragma unroll
                for (int sb = 0; sb < 2; ++sb) {
                    const bf16_t* kp = QK + (size_t)(t0 + 32 * kb + 16 * sb + i) * 1024 + 512 + h * 128 + 8 * g;
                    f32x4 sacc = (f32x4){0.f, 0.f, 0.f, 0.f};
#pragma unroll
                    for (int ks = 0; ks < 4; ++ks) { const bf16x8 kf = *(const bf16x8*)(kp + 32 * ks); sacc = MFMA16(kf, qf[ks], sacc); }
                    const f32x4 cv = *(const LAS f32x4*)(cs + 32 * kb + 16 * sb + 4 * g);
#pragma unroll
                    for (int j = 0; j < 4; ++j) { const int srow = 32 * kb + 16 * sb + 4 * g + j, tcol = 16 * qt + i;
                        const float pv = (srow <= tcol) ? sacc[j] * __expf(bt + cv[j]) : 0.f;
                        p[4 * sb + j] = pv; den += pv; } }
                u32x4 pw; pw.x = pk2(p[0], p[1]); pw.y = pk2(p[2], p[3]); pw.z = pk2(p[4], p[5]); pw.w = pk2(p[6], p[7]);
                const bf16x8 pf = __builtin_bit_cast(bf16x8, pw);
                const int ro = (32 * kb + 4 * g + (i >> 2)) * VP + (i & 3) * 8;
#pragma unroll
                for (int et = 0; et < 8; ++et) { const bf16x8 vf = tr2(VIM + ro + 32 * et, VIM + ro + 16 * VP + 32 * et); acc[et] = MFMA16(vf, pf, acc[et]); }
            }
            float dn = den; dn += __shfl_xor(dn, 16); dn += __shfl_xor(dn, 32);
            const float dd = 1.0f / fmaxf(fabsf(dn), 1.0f);
            float ss = 0.f;
#pragma unroll
            for (int et = 0; et < 8; ++et) { acc[et] = acc[et] * dd; ss += acc[et][0] * acc[et][0] + acc[et][1] * acc[et][1] + acc[et][2] * acc[et][2] + acc[et][3] * acc[et][3]; }
            ss += __shfl_xor(ss, 16); ss += __shfl_xor(ss, 32);
            const float rstd = 1.0f / sqrtf(ss * (1.0f / HDM) + EPS);
            const int tok = t0 + 16 * qt + i;
#pragma unroll
            for (int et = 0; et < 8; ++et) { const int e0 = 16 * et + 4 * g;
                const u32x2 ow = *(const u32x2*)(Z + (size_t)tok * NZ + ZOM + h * 128 + e0);
                const f32x4 gv = *(const f32x4*)(gn + h * 128 + e0);
                const float r0 = sigmoidf_(bflo(ow.x)) * acc[et][0] * rstd * gv[0], r1 = sigmoidf_(bfhi(ow.x)) * acc[et][1] * rstd * gv[1];
                const float r2 = sigmoidf_(bflo(ow.y)) * acc[et][2] * rstd * gv[2], r3 = sigmoidf_(bfhi(ow.y)) * acc[et][3] * rstd * gv[3];
                u32x2 o; o.x = pk2(r0, r1); o.y = pk2(r2, r3);
                *(u32x2*)(MIX + (size_t)tok * DM + 512 + h * 128 + e0) = o; }
        }
    }
}

__device__ __forceinline__ void router_phase(const Params& P, Frame& F, const bool commit) {
    const float* X1 = P.out; const float* g2 = P.in[13]; const float* wrt = (const float*)(P.ws + WS_WRT); const float* br = P.in[15];
    bf16_t* H2 = (bf16_t*)(P.ws + WS_XN); int* cnt = (int*)(P.ws + WS_CTL); int* ltok = (int*)(P.ws + WS_LTOK); float* lgate = (float*)(P.ws + WS_LGATE); int* tke = (int*)(P.ws + WS_TKE);
    LAS int* lcnt = (LAS int*)(F.lds);
    LAS int* pe = lcnt + 64;
    LAS float* pg = (LAS float*)(pe + 256);
    const int lane = F.lane, tid = F.tid;
    for (int chunk = F.vcu; chunk < T / 64; chunk += F.G) {
        __syncthreads();
        if (tid < 64) lcnt[tid] = 0;
        __syncthreads();
        for (int tt = 0; tt < 8; ++tt) {
            const int tl = F.wave * 8 + tt, tok = chunk * 64 + tl;
            const f32x4* xr = (const f32x4*)(X1 + (size_t)tok * DM);
            f32x4 v[4]; float s = 0.f;
#pragma unroll
            for (int j = 0; j < 4; ++j) { v[j] = xr[lane + 64 * j]; s += v[j][0] * v[j][0] + v[j][1] * v[j][1] + v[j][2] * v[j][2] + v[j][3] * v[j][3]; }
            s = wave_sum(s);
            const float r = 1.0f / sqrtf(s * (1.0f / DM) + EPS);
#pragma unroll
            for (int j = 0; j < 4; ++j) { const f32x4 gg = ((const f32x4*)g2)[lane + 64 * j]; v[j] = v[j] * r * gg;
                u32x2 w; w.x = pk2(v[j][0], v[j][1]); w.y = pk2(v[j][2], v[j][3]); *(u32x2*)(H2 + (size_t)tok * DM + 4 * (lane + 64 * j)) = w; }
            float mylogit = -INFINITY;
#pragma unroll 4
            for (int e = 0; e < NE; ++e) {
                const f32x4* wrow = (const f32x4*)(wrt + (size_t)e * DM);
                float pa = 0.f;
#pragma unroll
                for (int j = 0; j < 4; ++j) { const f32x4 wv4 = wrow[lane + 64 * j]; pa += v[j][0] * wv4[0] + v[j][1] * wv4[1] + v[j][2] * wv4[2] + v[j][3] * wv4[3]; }
                const float pq = wave_sum(pa) + br[e];
                if (lane == e) mylogit = pq;
            }
            float tv[4]; int te[4];
#pragma unroll
            for (int k = 0; k < 4; ++k) {
                float bv = mylogit; int bi = lane;
#pragma unroll
                for (int off = 1; off < 64; off <<= 1) { const float ov = __shfl_xor(bv, off); const int oi = __shfl_xor(bi, off);
                    if (ov > bv || (ov == bv && oi < bi)) { bv = ov; bi = oi; } }
                tv[k] = bv; te[k] = bi;
                if (lane == bi) mylogit = -INFINITY;
            }
            const float e1 = __expf(tv[1] - tv[0]), e2 = __expf(tv[2] - tv[0]), e3 = __expf(tv[3] - tv[0]);
            const float inv = 1.0f / (1.0f + e1 + e2 + e3);
            if (lane < 4) {
                const int ee = lane == 0 ? te[0] : (lane == 1 ? te[1] : (lane == 2 ? te[2] : te[3]));
                const float gg = (lane == 0 ? 1.0f : (lane == 1 ? e1 : (lane == 2 ? e2 : e3))) * inv;
                const int rk = __hip_atomic_fetch_add((int*)(lcnt + ee), 1, __ATOMIC_RELAXED, __HIP_MEMORY_SCOPE_WORKGROUP);
                pe[tl * 4 + lane] = ee | (rk << 8); pg[tl * 4 + lane] = gg;
            }
        }
        __syncthreads();
        if (tid < NE && commit) { const int n = lcnt[tid]; lcnt[32 + tid] = n ? atomicAdd(&cnt[64 * tid], n) : 0; }
        __syncthreads();
        if (tid < 256 && commit) { const int w = pe[tid], ee = w & 255, p = lcnt[32 + ee] + (w >> 8), tok = chunk * 64 + (tid >> 2);
            ltok[ee * T + p] = tok; lgate[ee * T + p] = pg[tid]; tke[tok * 4 + (tid & 3)] = ee | (p << 8); }
    }
}

__device__ __forceinline__ void build_tables(const Params& P, Frame& F) {
    LAS int* trs = (LAS int*)(F.lds + LDS_TAB); LAS int* cnts = trs + 64;
    const int* cnt = (const int*)(P.ws + WS_CTL);
    if (F.tid == 0) { int a = 0; for (int e = 0; e < NE; ++e) { const int n = cnt[64 * e]; trs[e] = a; cnts[e] = n; a += (n + 255) >> 8; } trs[NE] = a; }
    __syncthreads();
}

__device__ __forceinline__ void combine_phase(const Params& P, Frame& F, const bool commit) {
    const LAS int* trs = (const LAS int*)(F.lds + LDS_TAB);
    const bf16_t* Y = (const bf16_t*)(P.ws + WS_Y); const int* tke = (const int*)(P.ws + WS_TKE);
    float* out = P.out; const int lane = F.lane;
    for (int tok = F.gw; tok < T; tok += F.ngw) {
        f32x4 a[4];
#pragma unroll
        for (int j = 0; j < 4; ++j) a[j] = *(const f32x4*)(out + (size_t)tok * DM + 4 * (lane + 64 * j));
#pragma unroll
        for (int k = 0; k < 4; ++k) { const int w = tke[tok * 4 + k], e = w & 255, p = w >> 8; const size_t slot = (size_t)trs[e] * 256 + p;
#pragma unroll
            for (int j = 0; j < 4; ++j) { const u32x2 y = *(const u32x2*)(Y + slot * DM + 4 * (lane + 64 * j)); a[j][0] += bflo(y.x); a[j][1] += bfhi(y.x); a[j][2] += bflo(y.y); a[j][3] += bfhi(y.y); } }
#pragma unroll
        for (int j = 0; j < 4; ++j) if (commit || a[j][0] == 123456.789f) *(f32x4*)(out + (size_t)tok * DM + 4 * (lane + 64 * j)) = a[j];
    }
}


#define XB_TMO      128
#define XB_XCNT(j)  (256  + 64 * (j))
#define XB_XSUB(j)  (1280 + 64 * (j))
#define XB_XGEN(j)  (2304 + 64 * (j))
#define XB_TOP      3328
#define XB_TOPGEN   3392
#define XCD_BAR_WORDS 3456
#define XB_SPIN_CAP (1u << 18)
__device__ __forceinline__ unsigned xb_ld(unsigned* p)              { return __hip_atomic_load(p, __ATOMIC_RELAXED, __HIP_MEMORY_SCOPE_AGENT); }
__device__ __forceinline__ unsigned xb_add(unsigned* p, unsigned v) { return __hip_atomic_fetch_add(p, v, __ATOMIC_RELAXED, __HIP_MEMORY_SCOPE_AGENT); }
__device__ __forceinline__ unsigned xb_xcc_id() { return (unsigned)__builtin_amdgcn_s_getreg((3 << 11) | 20) & 0xFu; }
#define XB_SPIN(cond, bar) do { unsigned _sp = 0; while (cond) { __builtin_amdgcn_s_sleep(1); \
    if ((++_sp & 255u) == 0u) { if (xb_ld(&(bar)[XB_TMO])) break; if (_sp > XB_SPIN_CAP) { atomicAdd(&(bar)[XB_TMO], 1u); break; } } } } while (0)
struct XcdBarrier { unsigned* bar; unsigned x; volatile LAS unsigned* st; };
__device__ __forceinline__ XcdBarrier xcd_barrier_post(unsigned* bar, volatile LAS unsigned* st) {
    XcdBarrier b; b.bar = bar; b.x = xb_xcc_id(); b.st = st;
    if (threadIdx.x == 0) (void)xb_add(&bar[XB_XCNT(b.x)], 1u);
    return b;
}
__device__ __forceinline__ void xcd_barrier_complete(unsigned* bar, unsigned x, unsigned& nloc, unsigned& nx) {
    const unsigned G = gridDim.x * gridDim.y * gridDim.z;
    unsigned sum, cnt, mine, sp = 0u;
    for (;;) {
        sum = 0u; cnt = 0u; mine = 0u;
#pragma unroll
        for (unsigned j = 0; j < 16; ++j) { const unsigned c = xb_ld(&bar[XB_XCNT(j)]); sum += c; cnt += (c > 0u) ? 1u : 0u; mine = (j == x) ? c : mine; }
        if (sum == G) break;
        __builtin_amdgcn_s_sleep(1);
        if ((++sp & 255u) == 0u) { if (xb_ld(&bar[XB_TMO])) break; if (sp > XB_SPIN_CAP) { atomicAdd(&bar[XB_TMO], 1u); break; } }
    }
    nloc = mine > 0u ? mine : 1u; nx = cnt > 0u ? cnt : 1u;
}
__device__ __forceinline__ void xcd_barrier(const XcdBarrier& b) {
    asm volatile("s_waitcnt vmcnt(0)" ::: "memory");
    __syncthreads();
    if (threadIdx.x == 0) {
        unsigned* bar = b.bar;
        __builtin_amdgcn_s_waitcnt(0);
        unsigned nloc = b.st[0], nx = b.st[1];
        if (nloc == 0u) { xcd_barrier_complete(bar, b.x, nloc, nx); b.st[0] = nloc; b.st[1] = nx; }
        const unsigned old = xb_add(&bar[XB_XSUB(b.x)], 1u);
        const unsigned gen = old / nloc;
        if (old + 1u == (gen + 1u) * nloc) {
            __builtin_amdgcn_fence(__ATOMIC_RELEASE, "agent");
            asm volatile("s_waitcnt vmcnt(0)" ::: "memory");
            const unsigned og = xb_add(&bar[XB_TOP], 1u);
            const unsigned tg = og / nx;
            if (og + 1u == (tg + 1u) * nx) xb_add(&bar[XB_TOPGEN], 1u);
            else XB_SPIN(xb_ld(&bar[XB_TOPGEN]) == tg, bar);
            __builtin_amdgcn_fence(__ATOMIC_ACQUIRE, "agent");
            xb_add(&bar[XB_XGEN(b.x)], 1u);
            asm volatile("s_waitcnt vmcnt(0)" ::: "memory");
        } else {
            XB_SPIN(xb_ld(&bar[XB_XGEN(b.x)]) == gen, bar);
            __builtin_amdgcn_fence(__ATOMIC_ACQUIRE, "agent");
            asm volatile("s_waitcnt vmcnt(0)" ::: "memory");
        }
    }
    __syncthreads();
}

__global__ void __launch_bounds__(NTHR) fwd_megakernel(Params P) {
    extern __shared__ __attribute__((aligned(16))) unsigned char lds_raw[];
    Frame F;
    F.lds = (LAS unsigned char*)lds_raw;
    F.tid = threadIdx.x; F.lane = F.tid & 63; F.wave = __builtin_amdgcn_readfirstlane(F.tid >> 6);
    F.G = gridDim.x; { const int bx = blockIdx.x; F.vcu = (F.G % 8 == 0) ? (bx % 8) * (F.G / 8) + bx / 8 : bx; }
    F.gw = F.vcu * NWAVES + F.wave; F.ngw = F.G * NWAVES;
    unsigned char* ws = P.ws;
    LAS unsigned char* stage = F.lds + LDS_STAGE;
    volatile LAS unsigned* bst = (volatile LAS unsigned*)(F.lds + LDS_TAB + 512);
    if (F.tid < 2) bst[F.tid] = 0u;
    __syncthreads();
    const XcdBarrier bar = xcd_barrier_post((unsigned*)(ws + WS_CTL) + 4096, bst);
    LAS unsigned long long* tstamp = (LAS unsigned long long*)(F.lds + LDS_TAB + 640); int nstamp = 0;
    if (TPROBE >= 0 && blockIdx.x == 0 && F.tid == 0) tstamp[nstamp] = __builtin_amdgcn_s_memrealtime();
    ++nstamp;
#define GRID_SYNC() do { xcd_barrier(bar); if (TPROBE >= 0 && blockIdx.x == 0 && F.tid == 0) tstamp[nstamp] = __builtin_amdgcn_s_memrealtime(); ++nstamp; } while (0)

    p0_prologue(P, F);
    if (DUP & 1) p0_prologue(P, F);
    GRID_SYNC();
    {
        pg8::DenseSched S{T / 256, NZ / 256, F.G, (int)blockIdx.x, DM, (const char*)(ws + WS_WIN), (DUP & 2) ? 2 : 1};
        pg8::EpiBf16 E{(bf16_t*)(ws + WS_Z), NZ};
        pg8::gemm_phase(stage, (const char*)(ws + WS_XN), DM, S, E);
    }
    GRID_SYNC();
    p2_tokprep(P, F);
    GRID_SYNC();
    if (DUP & 4096) { for (int q = 0; q < 10; ++q) GRID_SYNC(); }
    {
        pg8::DenseSched S{T / 256, 1024 / 256, F.G, (int)blockIdx.x, 512, (const char*)(ws + WS_WQK), (DUP & 4) ? 2 : 1};
        pg8::EpiBf16 E{(bf16_t*)(ws + WS_QK), 1024};
        pg8::gemm_phase(stage, (const char*)(ws + WS_XC), 512, S, E);
    }
    attn_phase(P, F);
    if (DUP & 8) attn_phase(P, F);
    GRID_SYNC();
    ml1_phase(P, F);
    if (DUP & 16) ml1_phase(P, F);
    GRID_SYNC();
    ml3_phase(P, F);
    if (DUP & 32) ml3_phase(P, F);
    GRID_SYNC();
    {
        pg8::DenseSched S{T / 256, DM / 256, F.G, (int)blockIdx.x, DM, (const char*)(ws + WS_WOUT), (DUP & 64) ? 2 : 1};
        pg8::EpiResF32 E{P.out, P.in[0], DM};
        pg8::gemm_phase(stage, (const char*)(ws + WS_MIX), DM, S, E);
    }
    GRID_SYNC();
    if (DUP & 512) router_phase(P, F, false);
    router_phase(P, F, true);
    GRID_SYNC();
    build_tables(P, F);
    const LAS int* trs = (const LAS int*)(F.lds + LDS_TAB); const LAS int* cnts = trs + 64;
    {
        pg8::MoeSched<true> S{trs, cnts, 8, F.G, (int)blockIdx.x, DM, (const char*)(ws + WS_WGU), (size_t)2 * DFF * DM * 2, (const int*)(ws + WS_LTOK)};
        pg8::EpiSwiglu E{(bf16_t*)(ws + WS_ACT), P.in[17]};
        pg8::gemm_phase(stage, (const char*)(ws + WS_XN), DM, S, E);
    }
    GRID_SYNC();
    {
        pg8::MoeSched<false> S{trs, cnts, 4, F.G, (int)blockIdx.x, DFF, (const char*)(ws + WS_WD), (size_t)DM * DFF * 2, nullptr};
        pg8::EpiDown E{(bf16_t*)(ws + WS_Y), P.in[19], (const float*)(ws + WS_LGATE), cnts};
        pg8::gemm_phase(stage, (const char*)(ws + WS_ACT), DFF, S, E);
    }
    GRID_SYNC();
    if (DUP & 1024) combine_phase(P, F, false);
    combine_phase(P, F, true);
    if (TPROBE >= 0 && blockIdx.x == 0 && F.tid == 0) {
        tstamp[nstamp] = __builtin_amdgcn_s_memrealtime();
        const unsigned long long span = tstamp[TPROBE + 1] - tstamp[TPROBE], t0_ = __builtin_amdgcn_s_memrealtime();
        while (__builtin_amdgcn_s_memrealtime() - t0_ < 4ull * span) __builtin_amdgcn_s_sleep(8);
    }
}
}

extern "C" void kernel_launch(void* const* d_in, const int* in_sizes, int n_in, void* d_out, int out_size, void* d_ws, size_t ws_size, hipStream_t stream) {
    static int grid = 0;
    if (grid == 0) {
        if (n_in != 20 || out_size != T * DM || ws_size < WS_END) { fprintf(stderr, "kernel_launch: unexpected problem (n_in %d out %d ws %zu)\n", n_in, out_size, ws_size); grid = -1; return; }
        int dev = 0, cus = 0, per_cu = 0;
        (void)hipGetDevice(&dev);
        (void)hipDeviceGetAttribute(&cus, hipDeviceAttributeMultiprocessorCount, dev);
        (void)hipFuncSetAttribute((const void*)fwd_megakernel, hipFuncAttributeMaxDynamicSharedMemorySize, LDS_BYTES);
        (void)hipOccupancyMaxActiveBlocksPerMultiprocessor(&per_cu, (const void*)fwd_megakernel, NTHR, LDS_BYTES);
        if (per_cu < 1) { fprintf(stderr, "kernel_launch: occupancy query says %d blocks per CU\n", per_cu); per_cu = 1; }
        grid = cus;
    }
    if (grid < 0) return;
    (void)hipMemsetAsync((char*)d_ws + WS_CTL, 0, 65536, stream);
    Params p{};
    for (int i = 0; i < 20; ++i) p.in[i] = (const float*)d_in[i];
    p.out = (float*)d_out; p.ws = (unsigned char*)d_ws;
    hipLaunchKernelGGL(fwd_megakernel, dim3(grid), dim3(NTHR), LDS_BYTES, stream, p);
    const hipError_t e = hipPeekAtLastError();
    if (e != hipSuccess) fprintf(stderr, "launch failed: %s (grid %d)\n", hipGetErrorString(e), grid);
}
```

```cpp
#include <hip/hip_runtime.h>
#include <cstdio>
#include <cstdint>

#define LAS __attribute__((address_space(3)))
typedef unsigned short bf16_t;
typedef short bf16x8 __attribute__((ext_vector_type(8)));
typedef short s16x4 __attribute__((ext_vector_type(4)));
typedef float f32x4 __attribute__((ext_vector_type(4)));
typedef unsigned u32x4 __attribute__((ext_vector_type(4)));
typedef unsigned u32x2 __attribute__((ext_vector_type(2)));

namespace {
constexpr int BATCH = 2, SEQ = 8192, T = BATCH * SEQ, DM = 1024, DIN = 3080, NZ = 3072;
constexpr int NHA = 8, NHM = 4, HDM = 128;
constexpr int NE = 32, DFF = 1024;
constexpr int CH = 256, NCH = SEQ / CH;
constexpr float EPS = 1e-6f;
constexpr float LOG2E = 1.4426950408889634f;
constexpr int ZQ = 0, ZK = 512, ZV = 1024, ZXM = 1536, ZVM = 2048, ZOM = 2560;
constexpr int NWAVES = 8, NTHR = 512;
constexpr int MAXTR = 288;
constexpr int TPROBE = -1;
constexpr int DUP = 0;
constexpr size_t MiB = 1u << 20;
constexpr size_t WS_CTL = 0;
constexpr size_t WS_WIN = 1 * MiB;
constexpr size_t WS_WOUT = 7 * MiB;
constexpr size_t WS_WQK = 9 * MiB;
constexpr size_t WS_WGU = 16 * MiB;
constexpr size_t WS_WD = 144 * MiB;
constexpr size_t WS_XN = 208 * MiB;
constexpr size_t WS_Z = 240 * MiB;
constexpr size_t WS_GATE = 336 * MiB;
constexpr size_t WS_XC = 337 * MiB;
constexpr size_t WS_QK = 353 * MiB;
constexpr size_t WS_BC = 385 * MiB;
constexpr size_t WS_IG = 385 * MiB + 512 * 1024;
constexpr size_t WS_BT = 386 * MiB;
constexpr size_t WS_NV = 386 * MiB + 4096;
constexpr size_t WS_U = 387 * MiB;
constexpr size_t WS_MIX = 403 * MiB;
constexpr size_t WS_LTOK = 435 * MiB;
constexpr size_t WS_LGATE = 437 * MiB;
constexpr size_t WS_TKE = 439 * MiB;
constexpr size_t WS_WRT = 439 * MiB + 512 * 1024;
constexpr size_t WS_ACT = 440 * MiB;
constexpr size_t WS_Y = 584 * MiB;
constexpr size_t WS_END = 728 * MiB;
constexpr int LDS_STAGE = 0;
constexpr int LDS_TAB = 131072;
constexpr int LDS_BYTES = 131072 + 1024;

__device__ __forceinline__ unsigned f2bf(float f) { unsigned u = __builtin_bit_cast(unsigned, f); return (u + 0x7fffu + ((u >> 16) & 1u)) >> 16; }
__device__ __forceinline__ unsigned pk2(float lo, float hi) { return f2bf(lo) | (f2bf(hi) << 16); }
__device__ __forceinline__ float bf2f(unsigned b) { return __builtin_bit_cast(float, b << 16); }
__device__ __forceinline__ float bflo(unsigned w) { return __builtin_bit_cast(float, w << 16); }
__device__ __forceinline__ float bfhi(unsigned w) { return __builtin_bit_cast(float, w & 0xffff0000u); }
__device__ __forceinline__ float wave_sum(float v) {
#pragma unroll
    for (int o = 1; o < 64; o <<= 1) v += __shfl_xor(v, o);
    return v;
}
__device__ __forceinline__ float sigmoidf_(float x) { return 1.0f / (1.0f + __expf(-x)); }
}

namespace pg8 {
constexpr int BM = 256, BK = 64, HALF = 128, HTB = HALF * BK * 2, STAGE_BYTES = 8 * HTB, NXCD = 8, WGM = 8;
__host__ __device__ __forceinline__ int lds_byte(int r, int c) { const int st = (r >> 4) * 2 + (c >> 5), rr = r & 15, cc = c & 31, ob = rr * 64 + cc * 2; return st * 1024 + (ob ^ (((ob >> 9) & 1) << 5)); }
__host__ __device__ __forceinline__ void stage_rc(int b, int& R, int& C) { const int st = b / 1024, sb = b % 1024, swz = sb ^ (((sb >> 9) & 1) << 5); R = (st >> 1) * 16 + swz / 64; C = (st & 1) * 32 + (swz % 64) / 2; }
__host__ __device__ __forceinline__ int perm32(int rho) { const int n = rho >> 4, i = rho & 15; return 8 * (i >> 2) + 4 * n + (i & 3); }

__device__ __forceinline__ bool tile_order(int i, int G, int c, int nM, int nN, int& pm, int& pn) {
    const int nwg = nM * nN; const long L = (long)i * G + c; if (L >= nwg) return false;
    int wgid = (int)L; { const int q = nwg / NXCD, r = nwg % NXCD, xcd = wgid % NXCD, off = wgid / NXCD; wgid = (xcd < r ? xcd * (q + 1) : r * (q + 1) + (xcd - r) * q) + off; }
    const int nig = WGM * nN, gid = wgid / nig, fm = gid * WGM, gsz = (nM - fm) < WGM ? (nM - fm) : WGM;
    pm = fm + ((wgid % nig) % gsz); pn = (wgid % nig) / gsz; return true;
}

struct Unit { int pm, pn, e, mt; };

struct DenseSched {
    int nM, nN, G, c, K; const char* Bt; int reps;
    static constexpr bool DRAIN = false;
    __device__ __forceinline__ bool next(int i, Unit& u) const { u.e = 0; u.mt = 0; const int per = (nM * nN + G - 1) / G; if (i >= per * reps) return false; if (!tile_order(i % per, G, c, nM, nN, u.pm, u.pn)) return tile_order(0, G, c, nM, nN, u.pm, u.pn); return true; }
    __device__ __forceinline__ void a_off(const Unit& u, const int (&R)[2], const int (&C)[2], unsigned (&off)[2][2]) const {
#pragma unroll
        for (int h = 0; h < 2; ++h)
#pragma unroll
            for (int i = 0; i < 2; ++i) off[h][i] = (unsigned)(((u.pm * BM + h * HALF + R[i]) * K + C[i]) * 2);
    }
    __device__ __forceinline__ const char* b_ptr(const Unit& u) const { return Bt + (size_t)u.pn * BM * K * 2; }
};
template <bool GATHER> struct MoeSched {
    const LAS int* trs; const LAS int* cnts; int nN, G, c, K; const char* Bt; size_t bstride; const int* ltok;
    static constexpr bool DRAIN = GATHER;
    __device__ __forceinline__ bool next(int i, Unit& u) const {
        const int nM = __builtin_amdgcn_readfirstlane(trs[NE]);
        if (!tile_order(i, G, c, nM, nN, u.pm, u.pn)) return false;
        int e = 0;
        for (int j = 1; j < NE; ++j) e += (__builtin_amdgcn_readfirstlane(trs[j]) <= u.pm) ? 1 : 0;
        u.e = e; u.mt = u.pm - __builtin_amdgcn_readfirstlane(trs[e]); return true;
    }
    __device__ __forceinline__ void a_off(const Unit& u, const int (&R)[2], const int (&C)[2], unsigned (&off)[2][2]) const {
        const int n = __builtin_amdgcn_readfirstlane(cnts[u.e]);
#pragma unroll
        for (int h = 0; h < 2; ++h)
#pragma unroll
            for (int i = 0; i < 2; ++i) {
                int row;
                if (GATHER) { const int p = u.mt * BM + h * HALF + R[i]; row = (p < n) ? ltok[u.e * T + p] : 0; }
                else row = u.pm * BM + h * HALF + R[i];
                off[h][i] = (unsigned)((row * K + C[i]) * 2);
            }
    }
    __device__ __forceinline__ const char* b_ptr(const Unit& u) const { return Bt + (size_t)u.e * bstride + (size_t)u.pn * BM * K * 2; }
};

struct EpiBf16 {
    static constexpr bool PERM = true;
    bf16_t* O; int ldc;
    __device__ __forceinline__ void operator()(const f32x4 (&acc)[2][2][4][2], const Unit& u, int wr, int wc, int fr, int fq) const {
        const int row0 = u.pm * BM + wr * 64 + fr, col0 = u.pn * BM + wc * 32 + 8 * fq;
#pragma unroll
        for (int ai = 0; ai < 2; ++ai)
#pragma unroll
            for (int m = 0; m < 4; ++m) { bf16_t* rowp = O + (size_t)(row0 + ai * HALF + m * 16) * ldc + col0;
#pragma unroll
                for (int bj = 0; bj < 2; ++bj) { const f32x4 v0 = acc[ai][bj][m][0], v1 = acc[ai][bj][m][1];
                    u32x4 w; w.x = pk2(v0[0], v0[1]); w.y = pk2(v0[2], v0[3]); w.z = pk2(v1[0], v1[1]); w.w = pk2(v1[2], v1[3]);
                    *(u32x4*)(rowp + bj * HALF) = w; } }
    }
};
struct EpiResF32 {
    static constexpr bool PERM = false;
    float* C; const float* Rs; int ldc;
    __device__ __forceinline__ void operator()(const f32x4 (&acc)[2][2][4][2], const Unit& u, int wr, int wc, int fr, int fq) const {
        const int row0 = u.pm * BM + wr * 64 + fr, col0 = u.pn * BM + wc * 32 + 4 * fq;
#pragma unroll
        for (int ai = 0; ai < 2; ++ai)
#pragma unroll
            for (int m = 0; m < 4; ++m) { const size_t ro = (size_t)(row0 + ai * HALF + m * 16) * ldc + col0;
#pragma unroll
                for (int bj = 0; bj < 2; ++bj)
#pragma unroll
                    for (int n = 0; n < 2; ++n) { const f32x4 r = *(const f32x4*)(Rs + ro + bj * HALF + n * 16); *(f32x4*)(C + ro + bj * HALF + n * 16) = acc[ai][bj][m][n] + r; } }
    }
};
struct EpiSwiglu {
    static constexpr bool PERM = true;
    bf16_t* O; const float* bgu;
    __device__ __forceinline__ void operator()(const f32x4 (&acc)[2][2][4][2], const Unit& u, int wr, int wc, int fr, int fq) const {
        const int row0 = u.pm * BM + wr * 64 + fr, f0 = u.pn * HALF + wc * 32 + 8 * fq;
        const float* bg = bgu + (size_t)u.e * 2 * DFF + f0;
        f32x4 bgv[2], buv[2];
#pragma unroll
        for (int n = 0; n < 2; ++n) { bgv[n] = *(const f32x4*)(bg + 4 * n); buv[n] = *(const f32x4*)(bg + DFF + 4 * n); }
#pragma unroll
        for (int ai = 0; ai < 2; ++ai)
#pragma unroll
            for (int m = 0; m < 4; ++m) { bf16_t* rowp = O + (size_t)(row0 + ai * HALF + m * 16) * DFF + f0;
                float r[8];
#pragma unroll
                for (int n = 0; n < 2; ++n) { const f32x4 gv = acc[ai][0][m][n] + bgv[n], uv = acc[ai][1][m][n] + buv[n];
#pragma unroll
                    for (int j = 0; j < 4; ++j) { const float gg = fminf(gv[j], 7.0f), uu = fminf(fmaxf(uv[j], -7.0f), 7.0f);
                        r[4 * n + j] = gg * (uu + 1.0f) / (1.0f + __expf(-1.702f * gg)); } }
                u32x4 w; w.x = pk2(r[0], r[1]); w.y = pk2(r[2], r[3]); w.z = pk2(r[4], r[5]); w.w = pk2(r[6], r[7]);
                *(u32x4*)rowp = w; }
    }
};
struct EpiDown {
    static constexpr bool PERM = true;
    bf16_t* O; const float* bd; const float* lgate; const LAS int* cnts;
    __device__ __forceinline__ void operator()(const f32x4 (&acc)[2][2][4][2], const Unit& u, int wr, int wc, int fr, int fq) const {
        const int row0 = u.pm * BM + wr * 64 + fr, col0 = u.pn * BM + wc * 32 + 8 * fq;
        const int n_e = cnts[u.e];
        f32x4 bv[2][2];
#pragma unroll
        for (int bj = 0; bj < 2; ++bj)
#pragma unroll
            for (int n = 0; n < 2; ++n) bv[bj][n] = *(const f32x4*)(bd + (size_t)u.e * DM + col0 + bj * HALF + 4 * n);
#pragma unroll
        for (int ai = 0; ai < 2; ++ai)
#pragma unroll
            for (int m = 0; m < 4; ++m) { const int rt = wr * 64 + fr + ai * HALF + m * 16, p = u.mt * BM + rt;
                const float gt = (p < n_e) ? lgate[(size_t)u.e * T + p] : 0.f;
                bf16_t* rowp = O + (size_t)(row0 + ai * HALF + m * 16) * DM + col0;
#pragma unroll
                for (int bj = 0; bj < 2; ++bj) { const f32x4 v0 = (acc[ai][bj][m][0] + bv[bj][0]) * gt, v1 = (acc[ai][bj][m][1] + bv[bj][1]) * gt;
                    u32x4 w; w.x = pk2(v0[0], v0[1]); w.y = pk2(v0[2], v0[3]); w.z = pk2(v1[0], v1[1]); w.w = pk2(v1[2], v1[3]);
                    *(u32x4*)(rowp + bj * HALF) = w; } }
    }
};

template <class Epi, class Sched>
__device__ __forceinline__ void gemm_phase(LAS unsigned char* lds, const char* A0, const int K, const Sched& S, const Epi& E) {
    const int tid = threadIdx.x, wid = __builtin_amdgcn_readfirstlane(tid >> 6), lane = tid & 63, wr = wid >> 2, wc = wid & 3, fr = lane & 15, fq = lane >> 4;
    const int nt = K / BK;
    int Rr[2], Cc[2]; unsigned voffB[2];
#pragma unroll
    for (int i = 0; i < 2; ++i) { stage_rc(tid * 16 + i * 8192, Rr[i], Cc[i]); const int Rb = Epi::PERM ? ((Rr[i] & ~31) + perm32(Rr[i] & 31)) : Rr[i]; voffB[i] = (unsigned)(Rb * K + Cc[i]) * 2u; }
    const size_t kstep = (size_t)(BK * 2);
    const size_t hstep = (size_t)HALF * K * 2;
    const unsigned ldsw = (unsigned)wid * 1024u;
    const int aoff = lds_byte(wr * 64 + fr, fq * 8), boff = lds_byte(wc * 32 + fr, fq * 8);
#define PG8_SA(b, h) (((b) * 2 + (h)) * HTB)
#define PG8_SB(b, h) ((4 + (b) * 2 + (h)) * HTB)
#define PG8_STAGE_B(bufoff, gbase) do { _Pragma("unroll") for (int _i = 0; _i < 2; ++_i) \
        __builtin_amdgcn_global_load_lds((const unsigned*)((const char*)(gbase) + voffB[_i]), (LAS unsigned*)(lds + (bufoff) + ldsw + _i * 8192), 16, 0, 0); } while (0)
#define PG8_STAGE_A(bufoff, gbase, o0, o1) do { \
        __builtin_amdgcn_global_load_lds((const unsigned*)((const char*)(gbase) + (o0)), (LAS unsigned*)(lds + (bufoff) + ldsw), 16, 0, 0); \
        __builtin_amdgcn_global_load_lds((const unsigned*)((const char*)(gbase) + (o1)), (LAS unsigned*)(lds + (bufoff) + ldsw + 8192), 16, 0, 0); } while (0)
#define PG8_LDA(dst, b, h) do { _Pragma("unroll") for (int m = 0; m < 4; ++m) _Pragma("unroll") for (int k = 0; k < 2; ++k) dst[m][k] = *(const LAS bf16x8*)(lds + PG8_SA(b, h) + aoff + m * 2048 + k * 1024); } while (0)
#define PG8_LDB(dst, b, h) do { _Pragma("unroll") for (int n = 0; n < 2; ++n) _Pragma("unroll") for (int k = 0; k < 2; ++k) dst[n][k] = *(const LAS bf16x8*)(lds + PG8_SB(b, h) + boff + n * 2048 + k * 1024); } while (0)
#define PG8_MMA(ai, bj, At, Bt) do { __builtin_amdgcn_s_setprio(1); _Pragma("unroll") for (int m = 0; m < 4; ++m) _Pragma("unroll") for (int n = 0; n < 2; ++n) _Pragma("unroll") for (int k = 0; k < 2; ++k) \
        acc[ai][bj][m][n] = __builtin_amdgcn_mfma_f32_16x16x32_bf16(Bt[n][k], At[m][k], acc[ai][bj][m][n], 0, 0, 0); __builtin_amdgcn_s_setprio(0); } while (0)
#define PG8_WAIT_V(n) asm volatile("s_waitcnt vmcnt(" #n ")" ::: "memory")
#define PG8_WAIT_L(n) asm volatile("s_waitcnt lgkmcnt(" #n ")" ::: "memory")
#define PG8_BAR __builtin_amdgcn_s_barrier()
#define PG8_SCHED __builtin_amdgcn_sched_barrier(0)
    Unit cur, nxt; int ui = 0;
    if (!S.next(0, cur)) return;
    f32x4 acc[2][2][4][2];
#pragma unroll
    for (int a = 0; a < 2; ++a)
#pragma unroll
        for (int b = 0; b < 2; ++b)
#pragma unroll
            for (int m = 0; m < 4; ++m)
#pragma unroll
                for (int n = 0; n < 2; ++n) acc[a][b][m][n] = (f32x4){0.f, 0.f, 0.f, 0.f};
    bf16x8 At[4][2], B0[2][2], B1[2][2];
    unsigned offC[2][2], offN[2][2];
    S.a_off(cur, Rr, Cc, offC);
    const char* cB = S.b_ptr(cur);
    if (Sched::DRAIN) PG8_WAIT_V(0);
    PG8_STAGE_B(PG8_SB(0, 0), cB); PG8_STAGE_B(PG8_SB(0, 1), cB + hstep); PG8_STAGE_A(PG8_SA(0, 0), A0, offC[0][0], offC[0][1]); PG8_STAGE_A(PG8_SA(0, 1), A0, offC[1][0], offC[1][1]);
    if (wr == 1) PG8_BAR;
    PG8_WAIT_V(2); PG8_BAR;
    PG8_STAGE_B(PG8_SB(1, 0), cB + kstep); PG8_STAGE_A(PG8_SA(1, 0), A0 + kstep, offC[0][0], offC[0][1]); PG8_STAGE_B(PG8_SB(1, 1), cB + hstep + kstep);
    PG8_WAIT_V(6); PG8_BAR;
    for (;;) {
        const bool has_next = S.next(ui + 1, nxt);
        const char* nB = cB;
        if (has_next) { S.a_off(nxt, Rr, Cc, offN); nB = S.b_ptr(nxt); }
        else {
#pragma unroll
            for (int h = 0; h < 2; ++h)
#pragma unroll
                for (int i = 0; i < 2; ++i) offN[h][i] = offC[h][i];
        }
        if (Sched::DRAIN) PG8_WAIT_V(0);
        for (int t = 0; t < nt; t += 2) {
            const bool last = (t == nt - 2);
            const char* a1 = A0 + (size_t)(t + 1) * kstep;
            const char* a2 = last ? A0 : A0 + (size_t)(t + 2) * kstep; const char* b2 = last ? nB : cB + (size_t)(t + 2) * kstep;
            const char* a3 = a2 + kstep; const char* b3 = b2 + kstep;
            const unsigned o00 = last ? offN[0][0] : offC[0][0], o01 = last ? offN[0][1] : offC[0][1], o10 = last ? offN[1][0] : offC[1][0], o11 = last ? offN[1][1] : offC[1][1];
            PG8_LDB(B0, 0, 0); PG8_LDB(B1, 0, 1); PG8_SCHED; PG8_LDA(At, 0, 0); PG8_STAGE_A(PG8_SA(1, 1), a1, offC[1][0], offC[1][1]);
            PG8_WAIT_V(8); PG8_WAIT_L(0); PG8_BAR; PG8_MMA(0, 0, At, B0); PG8_MMA(0, 1, At, B1); PG8_BAR; PG8_SCHED;
            PG8_LDA(At, 0, 1); PG8_STAGE_B(PG8_SB(0, 0), b2); PG8_STAGE_B(PG8_SB(0, 1), b2 + hstep); PG8_STAGE_A(PG8_SA(0, 0), a2, o00, o01);
            PG8_WAIT_V(8); PG8_WAIT_L(0); PG8_BAR; PG8_MMA(1, 0, At, B0); PG8_MMA(1, 1, At, B1); PG8_BAR; PG8_SCHED;
            PG8_LDB(B0, 1, 0); PG8_LDB(B1, 1, 1); PG8_SCHED; PG8_LDA(At, 1, 0); PG8_STAGE_A(PG8_SA(0, 1), a2, o10, o11);
            PG8_WAIT_V(8); PG8_WAIT_L(0); PG8_BAR; PG8_MMA(0, 0, At, B0); PG8_MMA(0, 1, At, B1); PG8_BAR; PG8_SCHED;
            PG8_LDA(At, 1, 1); PG8_STAGE_B(PG8_SB(1, 0), b3); PG8_STAGE_B(PG8_SB(1, 1), b3 + hstep); PG8_STAGE_A(PG8_SA(1, 0), a3, o00, o01);
            PG8_WAIT_V(8); PG8_WAIT_L(0); PG8_BAR; PG8_MMA(1, 0, At, B0); PG8_MMA(1, 1, At, B1); PG8_BAR; PG8_SCHED;
        }
        if (wr == 0) PG8_BAR;
        E(acc, cur, wr, wc, fr, fq);
        if (!has_next) break;
#pragma unroll
        for (int a = 0; a < 2; ++a)
#pragma unroll
            for (int b = 0; b < 2; ++b)
#pragma unroll
                for (int m = 0; m < 4; ++m)
#pragma unroll
                    for (int n = 0; n < 2; ++n) acc[a][b][m][n] = (f32x4){0.f, 0.f, 0.f, 0.f};
        cur = nxt; cB = nB; ++ui;
#pragma unroll
        for (int h = 0; h < 2; ++h)
#pragma unroll
            for (int i = 0; i < 2; ++i) offC[h][i] = offN[h][i];
        if (wr == 1) PG8_BAR;
    }
    PG8_WAIT_V(0);
    PG8_BAR;
#undef PG8_SA
#undef PG8_SB
#undef PG8_STAGE_A
#undef PG8_STAGE_B
#undef PG8_LDA
#undef PG8_LDB
#undef PG8_MMA
#undef PG8_WAIT_V
#undef PG8_WAIT_L
#undef PG8_BAR
#undef PG8_SCHED
}
}

namespace {
struct Params { const float* in[20]; float* out; unsigned char* ws; };

struct Frame {
    LAS unsigned char* lds;
    int tid, lane, wave, G, vcu, gw, ngw;
};

__device__ __forceinline__ void transpose_item(const float* Wt  , int ldw, bf16_t* WTt  , int ldt, float scale, LAS float* scr, int lane) {
    const int r8 = lane >> 3, c4 = (lane & 7) * 4;
    f32x4 v[8];
#pragma unroll
    for (int i = 0; i < 8; ++i) v[i] = *(const f32x4*)(Wt + (size_t)(8 * i + r8) * ldw + c4);
#pragma unroll
    for (int i = 0; i < 8; ++i) { LAS float* d = scr + (8 * i + r8) * 33 + c4; d[0] = v[i][0]; d[1] = v[i][1]; d[2] = v[i][2]; d[3] = v[i][3]; }
    asm volatile("s_waitcnt lgkmcnt(0)" ::: "memory");
    const int c = lane & 7;
#pragma unroll
    for (int j = 0; j < 4; ++j) { const int n = (lane >> 3) + 8 * j; const LAS float* s = scr + (8 * c) * 33 + n;
        u32x4 o; o.x = pk2(s[0 * 33] * scale, s[1 * 33] * scale); o.y = pk2(s[2 * 33] * scale, s[3 * 33] * scale); o.z = pk2(s[4 * 33] * scale, s[5 * 33] * scale); o.w = pk2(s[6 * 33] * scale, s[7 * 33] * scale);
        *(u32x4*)(WTt + (size_t)n * ldt + 8 * c) = o; }
    asm volatile("s_waitcnt lgkmcnt(0)" ::: "memory");
}

__device__ __forceinline__ void p0_prologue(const Params& P, Frame& F) {
    unsigned char* ws = P.ws;
    const float* w_in = P.in[2];
    LAS float* scr = (LAS float*)(F.lds + F.wave * 8448);
    LAS float* gwl = (LAS float*)(F.lds + 73728);
    for (int i = F.tid; i < 1024 * 8; i += NTHR) gwl[i] = w_in[(size_t)(i >> 3) * DIN + NZ + (i & 7)];
    __syncthreads();
    constexpr int I_IN = 16 * 96, I_OUT = 16 * 32, I_QK = 8 * 2 * 4, I_GU = NE * 16 * 64, I_D = NE * 16 * 32, I_ZERO = 8 * 3;
    constexpr int NITEMS = I_IN + I_OUT + I_QK + I_ZERO + I_GU + I_D;
    bf16_t* WinT = (bf16_t*)(ws + WS_WIN); bf16_t* WoutT = (bf16_t*)(ws + WS_WOUT); bf16_t* WqkT = (bf16_t*)(ws + WS_WQK);
    bf16_t* WguT = (bf16_t*)(ws + WS_WGU); bf16_t* WdT = (bf16_t*)(ws + WS_WD);
    for (int it = F.gw; it < NITEMS; it += F.ngw) {
        int r = it;
        if (r < I_IN) { const int kb = r / 96, nb = r % 96; transpose_item(w_in + (size_t)(64 * kb) * DIN + 32 * nb, DIN, WinT + (size_t)(32 * nb) * DM + 64 * kb, DM, 1.f, scr, F.lane); continue; } r -= I_IN;
        if (r < I_OUT) { const int kb = r / 32, nb = r % 32; transpose_item(P.in[12] + (size_t)(64 * kb) * DM + 32 * nb, DM, WoutT + (size_t)(32 * nb) * DM + 64 * kb, DM, 1.f, scr, F.lane); continue; } r -= I_OUT;
        if (r < I_QK) { const int isk = r >> 5, h = (r >> 3) & 3, kb = (r >> 2) & 1, nb = r & 3;
            const float* src = P.in[isk ? 8 : 7] + (size_t)h * 16384 + (size_t)(64 * kb) * 128 + 32 * nb;
            transpose_item(src, 128, WqkT + (size_t)(isk * 512 + h * 128 + 32 * nb) * 512 + h * 128 + 64 * kb, 512, isk ? 0.08838834764831845f : 1.f, scr, F.lane); continue; } r -= I_QK;
        if (r < I_ZERO) {
            const int rb = r / 3, j = r % 3, cb = j + (j >= (rb & 3) ? 1 : 0);
            for (int q = F.lane; q < 128 * 16; q += 64) { const int rr = q >> 4, cc = q & 15; *(u32x4*)(WqkT + (size_t)(rb * 128 + rr) * 512 + cb * 128 + cc * 8) = (u32x4){0u, 0u, 0u, 0u}; }
            continue; } r -= I_ZERO;
        if (r < I_GU) { const int e = r >> 10, kb = (r >> 6) & 15, nb = r & 63, n0 = 32 * nb, f = n0 & 1023, up = n0 >> 10;
            const int drow = (f >> 7) * 256 + up * 128 + (f & 127);
            transpose_item(P.in[16] + (size_t)e * DM * 2 * DFF + (size_t)(64 * kb) * 2 * DFF + n0, 2 * DFF, WguT + (size_t)e * 2 * DFF * DM + (size_t)drow * DM + 64 * kb, DM, 1.f, scr, F.lane); continue; } r -= I_GU;
        { const int e = r >> 9, kb = (r >> 5) & 15, nb = r & 31;
            transpose_item(P.in[18] + (size_t)e * DFF * DM + (size_t)(64 * kb) * DM + 32 * nb, DM, WdT + (size_t)e * DM * DFF + (size_t)(32 * nb) * DFF + 64 * kb, DFF, 1.f, scr, F.lane); }
    }
    {
        const float* wr = P.in[14]; float* wrt = (float*)(ws + WS_WRT);
        for (int idx = F.vcu * NTHR + F.tid; idx < DM * NE; idx += F.G * NTHR) wrt[(idx & 31) * DM + (idx >> 5)] = wr[idx];
    }
    const float* x = P.in[0]; const float* g1 = P.in[1];
    bf16_t* XN = (bf16_t*)(ws + WS_XN); float* GATE = (float*)(ws + WS_GATE);
    for (int row = F.gw; row < T; row += F.ngw) {
        const f32x4* xr = (const f32x4*)(x + (size_t)row * DM);
        f32x4 v[4]; float s = 0.f;
#pragma unroll
        for (int j = 0; j < 4; ++j) { v[j] = xr[F.lane + 64 * j]; s += v[j][0] * v[j][0] + v[j][1] * v[j][1] + v[j][2] * v[j][2] + v[j][3] * v[j][3]; }
        s = wave_sum(s);
        const float rs = 1.0f / sqrtf(s * (1.0f / DM) + EPS);
        float ga[8];
#pragma unroll
        for (int c = 0; c < 8; ++c) ga[c] = 0.f;
#pragma unroll
        for (int j = 0; j < 4; ++j) { const f32x4 gg = ((const f32x4*)g1)[F.lane + 64 * j]; v[j] = v[j] * rs * gg;
            u32x2 w; w.x = pk2(v[j][0], v[j][1]); w.y = pk2(v[j][2], v[j][3]);
            *(u32x2*)(XN + (size_t)row * DM + 4 * (F.lane + 64 * j)) = w;
#pragma unroll
            for (int q = 0; q < 4; ++q) { const int k = 4 * (F.lane + 64 * j) + q; const f32x4 w0 = *(const LAS f32x4*)(gwl + k * 8), w1 = *(const LAS f32x4*)(gwl + k * 8 + 4);
                ga[0] += v[j][q] * w0[0]; ga[1] += v[j][q] * w0[1]; ga[2] += v[j][q] * w0[2]; ga[3] += v[j][q] * w0[3];
                ga[4] += v[j][q] * w1[0]; ga[5] += v[j][q] * w1[1]; ga[6] += v[j][q] * w1[2]; ga[7] += v[j][q] * w1[3]; } }
#pragma unroll
        for (int c = 0; c < 8; ++c) ga[c] = wave_sum(ga[c]);
        if (F.lane == 0) { *(f32x4*)(GATE + (size_t)row * 8) = (f32x4){ga[0], ga[1], ga[2], ga[3]}; *(f32x4*)(GATE + (size_t)row * 8 + 4) = (f32x4){ga[4], ga[5], ga[6], ga[7]}; }
    }
}

__device__ __forceinline__ void p2_tokprep(const Params& P, Frame& F) {
    bf16_t* Z = (bf16_t*)(P.ws + WS_Z); bf16_t* XC = (bf16_t*)(P.ws + WS_XC);
    const float* gq = P.in[3]; const float* gk = P.in[4]; const float* cw = P.in[5]; const float* cb = P.in[6];
    const int lane = F.lane;
    for (int tok = F.gw; tok < T; tok += F.ngw) {
        bf16_t* zr = Z + (size_t)tok * NZ;
#pragma unroll
        for (int part = 0; part < 2; ++part) {
            bf16_t* p = zr + (part ? ZK : ZQ) + lane * 8;
            const float* g = (part ? gk : gq) + (lane & 7) * 8;
            const u32x4 w = *(const u32x4*)p;
            float a[8] = {bflo(w.x), bfhi(w.x), bflo(w.y), bfhi(w.y), bflo(w.z), bfhi(w.z), bflo(w.w), bfhi(w.w)};
            float s = 0.f;
#pragma unroll
            for (int i = 0; i < 8; ++i) s += a[i] * a[i];
            s += __shfl_xor(s, 1); s += __shfl_xor(s, 2); s += __shfl_xor(s, 4);
            float r = 1.0f / sqrtf(s * (1.0f / 64.f) + EPS); if (!part) r *= 0.125f * LOG2E;
#pragma unroll
            for (int i = 0; i < 8; ++i) a[i] *= r * g[i];
            u32x4 o; o.x = pk2(a[0], a[1]); o.y = pk2(a[2], a[3]); o.z = pk2(a[4], a[5]); o.w = pk2(a[6], a[7]);
            *(u32x4*)p = o;
        }
        for (int crep = 0; crep < ((DUP & 2048) ? 2 : 1); ++crep) {
            const int tl = tok % SEQ; const int ch = lane * 8;
            float a[8];
#pragma unroll
            for (int i = 0; i < 8; ++i) a[i] = cb[ch + i];
#pragma unroll
            for (int j = 0; j < 4; ++j) { const int dt = 3 - j; if (tl - dt >= 0) {
                    const u32x4 w = *(const u32x4*)(Z + (size_t)(tok - dt) * NZ + ZXM + ch);
                    const float xv[8] = {bflo(w.x), bfhi(w.x), bflo(w.y), bfhi(w.y), bflo(w.z), bfhi(w.z), bflo(w.w), bfhi(w.w)};
#pragma unroll
                    for (int i = 0; i < 8; ++i) a[i] += cw[j * 512 + ch + i] * xv[i]; } }
#pragma unroll
            for (int i = 0; i < 8; ++i) a[i] = a[i] * sigmoidf_(a[i]);
            u32x4 o; o.x = pk2(a[0], a[1]); o.y = pk2(a[2], a[3]); o.z = pk2(a[4], a[5]); o.w = pk2(a[6], a[7]);
            *(u32x4*)(XC + (size_t)tok * 512 + ch) = o;
        }
    }
}

__device__ __forceinline__ void attn_phase(const Params& P, Frame& F) {
    const bf16_t* Z = (const bf16_t*)(P.ws + WS_Z); bf16_t* MIX = (bf16_t*)(P.ws + WS_MIX);
    const int lane = F.lane, i = lane & 15, g = lane >> 4;
    float gm = fabsf(P.in[4][lane]);
#pragma unroll
    for (int o = 1; o < 64; o <<= 1) gm = fmaxf(gm, __shfl_xor(gm, o));
    const float kmax = 8.0f * gm * 1.01f;
    LAS unsigned char* vb = F.lds + F.wave * 4608;
    const int vwr = (lane >> 3) * 144 + (lane & 7) * 16;
    const int vrd = (4 * g + (i >> 2)) * 144 + (i & 3) * 8;
    for (int tile = F.gw; tile < 8192; tile += F.ngw) {
        const int r = tile & 15, blk = (tile >> 4) & 31, h = (tile >> 9) & 7, b = tile >> 12;
        const int tl0 = blk * 256 + r, T0 = b * SEQ + tl0;
        const bf16_t* qrow = Z + (size_t)(T0 + 16 * i) * NZ + ZQ + h * 64;
        const bf16x8 qf0 = *(const bf16x8*)(qrow + 8 * g), qf1 = *(const bf16x8*)(qrow + 32 + 8 * g);
        float ss = 0.f;
#pragma unroll
        for (int j = 0; j < 8; ++j) { const float a = bf2f((unsigned short)qf0[j]), c = bf2f((unsigned short)qf1[j]); ss += a * a + c * c; }
        ss += __shfl_xor(ss, 16); ss += __shfl_xor(ss, 32);
        const float ref = sqrtf(ss) * kmax;
        const float slope2 = exp2f(-(float)(h + 1)) * LOG2E;
        f32x4 o[4];
#pragma unroll
        for (int dt = 0; dt < 4; ++dt) o[dt] = (f32x4){0.f, 0.f, 0.f, 0.f};
        float lsum = 0.f;
        const bf16_t* Kh = Z + (size_t)b * SEQ * NZ + ZK + h * 64 + 8 * g;
        const bf16_t* Vh = Z + (size_t)b * SEQ * NZ + ZV + h * 64 + 8 * (lane & 7);
        bf16x8 kfn[2][2]; u32x4 vrn[4];
#define ATT_LOAD(bi_) do { const int bi__ = (bi_); const int br_ = bi__ < 12 ? 0 : (bi__ < 18 ? 1 : 2); const int d_ = 1 << (2 * br_); const int nb_ = -128 + 32 * (bi__ - (br_ == 0 ? 0 : (br_ == 1 ? 12 : 18))); \
        _Pragma("unroll") for (int sb = 0; sb < 2; ++sb) { int kp = tl0 + (nb_ + 16 * sb + i) * d_; kp = kp < 0 ? 0 : (kp > SEQ - 1 ? SEQ - 1 : kp); const bf16_t* kr = Kh + (size_t)kp * NZ; kfn[sb][0] = *(const bf16x8*)kr; kfn[sb][1] = *(const bf16x8*)(kr + 32); } \
        _Pragma("unroll") for (int c = 0; c < 4; ++c) { int kp = tl0 + (nb_ + 8 * c + (lane >> 3)) * d_; kp = kp < 0 ? 0 : (kp > SEQ - 1 ? SEQ - 1 : kp); vrn[c] = *(const u32x4*)(Vh + (size_t)kp * NZ); } } while (0)
        ATT_LOAD(0);
        for (int bi = 0; bi < 23; ++bi) {
            bf16x8 kf[2][2]; u32x4 vr[4];
#pragma unroll
            for (int sb = 0; sb < 2; ++sb) { kf[sb][0] = kfn[sb][0]; kf[sb][1] = kfn[sb][1]; }
#pragma unroll
            for (int c = 0; c < 4; ++c) vr[c] = vrn[c];
            if (bi + 1 < 23) ATT_LOAD(bi + 1);
            const int br = bi < 12 ? 0 : (bi < 18 ? 1 : 2), dd = 1 << (2 * br), u = 16 / dd;
            const int nb = -128 + 32 * (bi - (br == 0 ? 0 : (br == 1 ? 12 : 18)));
#pragma unroll
            for (int c = 0; c < 4; ++c) *(LAS u32x4*)(vb + vwr + c * 8 * 144) = vr[c];
            f32x4 s[2];
#pragma unroll
            for (int sb = 0; sb < 2; ++sb) { s[sb] = __builtin_amdgcn_mfma_f32_16x16x32_bf16(kf[sb][0], qf0, (f32x4){0.f, 0.f, 0.f, 0.f}, 0, 0, 0);
                s[sb] = __builtin_amdgcn_mfma_f32_16x16x32_bf16(kf[sb][1], qf1, s[sb], 0, 0, 0); }
            float p[8];
#pragma unroll
            for (int sb = 0; sb < 2; ++sb)
#pragma unroll
                for (int j = 0; j < 4; ++j) { const int n = nb + 16 * sb + 4 * g + j, a = u * i - n;
                    const bool valid = (a >= 0) && (a <= 128) && (tl0 + n * dd >= 0);
                    const float e = s[sb][j] - slope2 * (float)(a * dd) - ref;
                    const float pv = valid ? __builtin_amdgcn_exp2f(e) : 0.f;
                    p[4 * sb + j] = pv; lsum += pv; }
            u32x4 pw; pw.x = pk2(p[0], p[1]); pw.y = pk2(p[2], p[3]); pw.z = pk2(p[4], p[5]); pw.w = pk2(p[6], p[7]);
            const bf16x8 pf = __builtin_bit_cast(bf16x8, pw);
#pragma unroll
            for (int dt = 0; dt < 4; ++dt) {
                const s16x4 v0 = __builtin_amdgcn_ds_read_tr16_b64_v4i16((LAS s16x4*)(vb + vrd + dt * 32));
                const s16x4 v1 = __builtin_amdgcn_ds_read_tr16_b64_v4i16((LAS s16x4*)(vb + vrd + 16 * 144 + dt * 32));
                const bf16x8 vf = (bf16x8){v0[0], v0[1], v0[2], v0[3], v1[0], v1[1], v1[2], v1[3]};
                o[dt] = __builtin_amdgcn_mfma_f32_16x16x32_bf16(vf, pf, o[dt], 0, 0, 0);
            }
        }
#undef ATT_LOAD
        lsum += __shfl_xor(lsum, 16); lsum += __shfl_xor(lsum, 32);
        const float inv = 1.0f / lsum;
        bf16_t* orow = MIX + (size_t)(T0 + 16 * i) * DM + h * 64 + 4 * g;
#pragma unroll
        for (int dt = 0; dt < 4; ++dt) { u32x2 w; w.x = pk2(o[dt][0] * inv, o[dt][1] * inv); w.y = pk2(o[dt][2] * inv, o[dt][3] * inv); *(u32x2*)(orow + 16 * dt) = w; }
    }
}

__device__ __forceinline__ bf16x8 tr2(LAS unsigned char* p0, LAS unsigned char* p1) {
    const s16x4 a = __builtin_amdgcn_ds_read_tr16_b64_v4i16((LAS s16x4*)p0);
    const s16x4 b = __builtin_amdgcn_ds_read_tr16_b64_v4i16((LAS s16x4*)p1);
    return (bf16x8){a[0], a[1], a[2], a[3], b[0], b[1], b[2], b[3]};
}
#define MFMA16(a, b, c) __builtin_amdgcn_mfma_f32_16x16x32_bf16((a), (b), (c), 0, 0, 0)

__device__ __forceinline__ void ml1_phase(const Params& P, Frame& F) {
    const bf16_t* Z = (const bf16_t*)(P.ws + WS_Z); const bf16_t* QK = (const bf16_t*)(P.ws + WS_QK); const float* GATE = (const float*)(P.ws + WS_GATE);
    float* BC = (float*)(P.ws + WS_BC); float* IG = (float*)(P.ws + WS_IG); float* BT = (float*)(P.ws + WS_BT); float* U = (float*)(P.ws + WS_U); float* NV = (float*)(P.ws + WS_NV);
    const float* bi = P.in[9]; const float* bf = P.in[10];
    constexpr int PIT = 272;
    LAS unsigned char* KIM = F.lds; LAS unsigned char* VIM = F.lds + 128 * PIT;
    LAS float* bc = (LAS float*)(F.lds + 2 * 128 * PIT); LAS float* wv = bc + 256;
    const int tid = F.tid, lane = F.lane, i = lane & 15, g = lane >> 4, w = F.wave;
    bf16x8 ones;
#pragma unroll
    for (int j = 0; j < 8; ++j) ones[j] = (i == 0) ? (short)0x3F80 : (short)0;
    for (int unit = F.vcu; unit < 256; unit += F.G) {
        const int bh = unit / NCH, c = unit % NCH, b = bh / NHM, h = bh % NHM, t0 = b * SEQ + c * CH;
        float ig = 0.f;
        __syncthreads();
        if (tid < 256) { const float f = GATE[(size_t)(t0 + tid) * 8 + 4 + h] + bf[h];
            bc[tid] = fminf(f, 0.f) - log1pf(__expf(-fabsf(f)));
            ig = GATE[(size_t)(t0 + tid) * 8 + h] + bi[h]; }
        __syncthreads();
        if (w == 0) {
            const f32x4 a = *(const LAS f32x4*)(bc + 4 * lane);
            const float s1 = a[0], s2 = s1 + a[1], s3 = s2 + a[2], s4 = s3 + a[3];
            float x = s4;
#pragma unroll
            for (int off = 1; off < 64; off <<= 1) { const float v = __shfl_up(x, off); if (lane >= off) x += v; }
            const float ex = x - s4;
            *(LAS f32x4*)(bc + 4 * lane) = (f32x4){ex + s1, ex + s2, ex + s3, ex + s4};
        }
        __syncthreads();
        if (tid < 256) { BC[(size_t)(t0 + tid) * 4 + h] = bc[tid]; IG[(size_t)(t0 + tid) * 4 + h] = ig; wv[tid] = __expf(bc[255] - bc[tid] + ig); }
        if (tid == 0) BT[unit] = bc[255];
        f32x4 acc[9];
#pragma unroll
        for (int q = 0; q < 9; ++q) acc[q] = (f32x4){0.f, 0.f, 0.f, 0.f};
        for (int half = 0; half < 2; ++half) {
            __syncthreads();
#pragma unroll
            for (int q = 0; q < 4; ++q) { const int id = tid + 512 * q, row = id >> 4, c8 = (id & 15) * 8, sidx = half * 128 + row;
                const u32x4 kw = *(const u32x4*)(QK + (size_t)(t0 + sidx) * 1024 + 512 + h * 128 + c8);
                const u32x4 vw = *(const u32x4*)(Z + (size_t)(t0 + sidx) * NZ + ZVM + h * 128 + c8);
                const float ws_ = wv[sidx];
                u32x4 ks; ks.x = pk2(bflo(kw.x) * ws_, bfhi(kw.x) * ws_); ks.y = pk2(bflo(kw.y) * ws_, bfhi(kw.y) * ws_); ks.z = pk2(bflo(kw.z) * ws_, bfhi(kw.z) * ws_); ks.w = pk2(bflo(kw.w) * ws_, bfhi(kw.w) * ws_);
                *(LAS u32x4*)(KIM + row * PIT + c8 * 2) = ks; *(LAS u32x4*)(VIM + row * PIT + c8 * 2) = vw; }
            __syncthreads();
#pragma unroll
            for (int kk = 0; kk < 4; ++kk) {
                const int ro = (32 * kk + 8 * g + (i >> 2)) * PIT + (i & 3) * 8;
                const bf16x8 af = tr2(KIM + ro + 32 * w, KIM + ro + 4 * PIT + 32 * w);
#pragma unroll
                for (int et = 0; et < 8; ++et) { const bf16x8 bfr = tr2(VIM + ro + 32 * et, VIM + ro + 4 * PIT + 32 * et); acc[et] = MFMA16(af, bfr, acc[et]); }
                acc[8] = MFMA16(af, ones, acc[8]);
            }
        }
        float* up = U + (size_t)unit * 16384 + (size_t)(16 * w + 4 * g) * 128 + i;
#pragma unroll
        for (int et = 0; et < 8; ++et)
#pragma unroll
            for (int j = 0; j < 4; ++j) up[j * 128 + 16 * et] = acc[et][j];
        if (i == 0) {
#pragma unroll
            for (int j = 0; j < 4; ++j) NV[unit * 128 + 16 * w + 4 * g + j] = acc[8][j];
        }
    }
}

__device__ __forceinline__ void ml3_phase(const Params& P, Frame& F) {
    const bf16_t* Z = (const bf16_t*)(P.ws + WS_Z); const bf16_t* QK = (const bf16_t*)(P.ws + WS_QK);
    const float* BC = (const float*)(P.ws + WS_BC); const float* IG = (const float*)(P.ws + WS_IG); const float* BT = (const float*)(P.ws + WS_BT);
    const float* U = (const float*)(P.ws + WS_U); const float* NV = (const float*)(P.ws + WS_NV); const float* gn = P.in[11];
    bf16_t* MIX = (bf16_t*)(P.ws + WS_MIX);
    constexpr int CP = 288, VP = 272;
    LAS unsigned char* CIM = F.lds;
    LAS unsigned char* VIM = F.lds + 128 * CP;
    LAS float* cs = (LAS float*)(F.lds + 128 * CP + 256 * VP);
    LAS float* bq = cs + 256;
    const int tid = F.tid, lane = F.lane, i = lane & 15, g = lane >> 4, w = F.wave;
    for (int unit = F.vcu; unit < 256; unit += F.G) {
        const int bh = unit / NCH, c = unit % NCH, b = bh / NHM, h = bh % NHM, t0 = b * SEQ + c * CH;
        __syncthreads();
#pragma unroll
        for (int q = 0; q < 8; ++q) { const int id = tid + 512 * q, row = id >> 4, c8 = (id & 15) * 8;
            *(LAS u32x4*)(VIM + row * VP + c8 * 2) = *(const u32x4*)(Z + (size_t)(t0 + row) * NZ + ZVM + h * 128 + c8); }
        if (tid < 256) { const float bb = BC[(size_t)(t0 + tid) * 4 + h]; bq[tid] = bb; cs[tid] = IG[(size_t)(t0 + tid) * 4 + h] - bb; }
        {   f32x4 cc[4][2]; float n = 0.f;
#pragma unroll
            for (int q = 0; q < 4; ++q) { cc[q][0] = (f32x4){0.f, 0.f, 0.f, 0.f}; cc[q][1] = (f32x4){0.f, 0.f, 0.f, 0.f}; }
            for (int j = 0; j < c; ++j) {
                const float dec = __expf(BT[bh * NCH + j]);
                const float* up = U + (size_t)(bh * NCH + j) * 16384;
#pragma unroll
                for (int q = 0; q < 4; ++q) { const int id = tid + 512 * q; const f32x4 u0 = *(const f32x4*)(up + id * 8), u1 = *(const f32x4*)(up + id * 8 + 4);
                    cc[q][0] = cc[q][0] * dec + u0; cc[q][1] = cc[q][1] * dec + u1; }
                if (tid < 128) n = dec * n + NV[(bh * NCH + j) * 128 + tid];
            }
#pragma unroll
            for (int q = 0; q < 4; ++q) { const int id = tid + 512 * q, d = id >> 4, e8 = (id & 15) * 8;
                u32x4 o; o.x = pk2(cc[q][0][0], cc[q][0][1]); o.y = pk2(cc[q][0][2], cc[q][0][3]); o.z = pk2(cc[q][1][0], cc[q][1][1]); o.w = pk2(cc[q][1][2], cc[q][1][3]);
                *(LAS u32x4*)(CIM + d * CP + e8 * 2) = o; }
            if (tid < 128) { *(LAS u32x4*)(CIM + tid * CP + 256) = (u32x4){f2bf(n), 0u, 0u, 0u}; *(LAS u32x4*)(CIM + tid * CP + 272) = (u32x4){0u, 0u, 0u, 0u}; }
        }
        __syncthreads();
#pragma unroll 1
        for (int a = 0; a < 2; ++a) {
            const int qt = a ? 15 - w : w;
            bf16x8 qf[4];
            { const bf16_t* qp = QK + (size_t)(t0 + 16 * qt + i) * 1024 + h * 128 + 8 * g;
#pragma unroll
                for (int ks = 0; ks < 4; ++ks) qf[ks] = *(const bf16x8*)(qp + 32 * ks); }
            const float bt = bq[16 * qt + i];
            f32x4 acc[8]; float den;
            {
                f32x4 a8 = (f32x4){0.f, 0.f, 0.f, 0.f};
#pragma unroll
                for (int et = 0; et < 8; ++et) acc[et] = (f32x4){0.f, 0.f, 0.f, 0.f};
#pragma unroll
                for (int ks = 0; ks < 4; ++ks) {
                    const int ro = (32 * ks + 8 * g + (i >> 2)) * CP + (i & 3) * 8;
#pragma unroll
                    for (int et = 0; et < 8; ++et) { const bf16x8 cf = tr2(CIM + ro + 32 * et, CIM + ro + 4 * CP + 32 * et); acc[et] = MFMA16(cf, qf[ks], acc[et]); }
                    const bf16x8 cf = tr2(CIM + ro + 256, CIM + ro + 4 * CP + 256);
                    a8 = MFMA16(cf, qf[ks], a8);
                }
                const float eb = __expf(bt);
#pragma unroll
                for (int et = 0; et < 8; ++et) acc[et] = acc[et] * eb;
                den = (g == 0) ? a8[0] * eb : 0.f;
            }
            const int kbhi = qt >> 1;
#pragma unroll 1
            for (int kb = 0; kb <= kbhi; ++kb) {
                float p[8];
#pragma unroll
                for (int sb = 0; sb < 2; ++sb) {
                    const bf16_t* kp = QK + (size_t)(t0 + 32 * kb + 16 * sb + i) * 1024 + 512 + h * 128 + 8 * g;
                    f32x4 sacc = (f32x4){0.f, 0.f, 0.f, 0.f};
#pragma unroll
                    for (int ks = 0; ks < 4; ++ks) { const bf16x8 kf = *(const bf16x8*)(kp + 32 * ks); sacc = MFMA16(kf, qf[ks], sacc); }
                    const f32x4 cv = *(const LAS f32x4*)(cs + 32 * kb + 16 * sb + 4 * g);
#pragma unroll
                    for (int j = 0; j < 4; ++j) { const int srow = 32 * kb + 16 * sb + 4 * g + j, tcol = 16 * qt + i;
                        const float pv = (srow <= tcol) ? sacc[j] * __expf(bt + cv[j]) : 0.f;
                        p[4 * sb + j] = pv; den += pv; } }
                u32x4 pw; pw.x = pk2(p[0], p[1]); pw.y = pk2(p[2], p[3]); pw.z = pk2(p[4], p[5]); pw.w = pk2(p[6], p[7]);
                const bf16x8 pf = __builtin_bit_cast(bf16x8, pw);
                const int ro = (32 * kb + 4 * g + (i >> 2)) * VP + (i & 3) * 8;
#pragma unroll
                for (int et = 0; et < 8; ++et) { const bf16x8 vf = tr2(VIM + ro + 32 * et, VIM + ro + 16 * VP + 32 * et); acc[et] = MFMA16(vf, pf, acc[et]); }
            }
            float dn = den; dn += __shfl_xor(dn, 16); dn += __shfl_xor(dn, 32);
            const float dd = 1.0f / fmaxf(fabsf(dn), 1.0f);
            float ss = 0.f;
#pragma unroll
            for (int et = 0; et < 8; ++et) { acc[et] = acc[et] * dd; ss += acc[et][0] * acc[et][0] + acc[et][1] * acc[et][1] + acc[et][2] * acc[et][2] + acc[et][3] * acc[et][3]; }
            ss += __shfl_xor(ss, 16); ss += __shfl_xor(ss, 32);
            const float rstd = 1.0f / sqrtf(ss * (1.0f / HDM) + EPS);
            const int tok = t0 + 16 * qt + i;
#pragma unroll
            for (int et = 0; et < 8; ++et) { const int e0 = 16 * et + 4 * g;
                const u32x2 ow = *(const u32x2*)(Z + (size_t)tok * NZ + ZOM + h * 128 + e0);
                const f32x4 gv = *(const f32x4*)(gn + h * 128 + e0);
                const float r0 = sigmoidf_(bflo(ow.x)) * acc[et][0] * rstd * gv[0], r1 = sigmoidf_(bfhi(ow.x)) * acc[et][1] * rstd * gv[1];
                const float r2 = sigmoidf_(bflo(ow.y)) * acc[et][2] * rstd * gv[2], r3 = sigmoidf_(bfhi(ow.y)) * acc[et][3] * rstd * gv[3];
                u32x2 o; o.x = pk2(r0, r1); o.y = pk2(r2, r3);
                *(u32x2*)(MIX + (size_t)tok * DM + 512 + h * 128 + e0) = o; }
        }
    }
}

__device__ __forceinline__ void router_phase(const Params& P, Frame& F, const bool commit) {
    const float* X1 = P.out; const float* g2 = P.in[13]; const float* wrt = (const float*)(P.ws + WS_WRT); const float* br = P.in[15];
    bf16_t* H2 = (bf16_t*)(P.ws + WS_XN); int* cnt = (int*)(P.ws + WS_CTL); int* ltok = (int*)(P.ws + WS_LTOK); float* lgate = (float*)(P.ws + WS_LGATE); int* tke = (int*)(P.ws + WS_TKE);
    LAS int* lcnt = (LAS int*)(F.lds);
    LAS int* pe = lcnt + 64;
    LAS float* pg = (LAS float*)(pe + 256);
    const int lane = F.lane, tid = F.tid;
    for (int chunk = F.vcu; chunk < T / 64; chunk += F.G) {
        __syncthreads();
        if (tid < 64) lcnt[tid] = 0;
        __syncthreads();
        {
            f32x4 v[8][4];
#pragma unroll
            for (int tt = 0; tt < 8; ++tt) {
                const int tok = chunk * 64 + F.wave * 8 + tt;
                const f32x4* xr = (const f32x4*)(X1 + (size_t)tok * DM);
                float s = 0.f;
#pragma unroll
                for (int j = 0; j < 4; ++j) { v[tt][j] = xr[lane + 64 * j]; s += v[tt][j][0] * v[tt][j][0] + v[tt][j][1] * v[tt][j][1] + v[tt][j][2] * v[tt][j][2] + v[tt][j][3] * v[tt][j][3]; }
                s = wave_sum(s);
                const float r = 1.0f / sqrtf(s * (1.0f / DM) + EPS);
#pragma unroll
                for (int j = 0; j < 4; ++j) { const f32x4 gg = ((const f32x4*)g2)[lane + 64 * j]; v[tt][j] = v[tt][j] * r * gg;
                    u32x2 w; w.x = pk2(v[tt][j][0], v[tt][j][1]); w.y = pk2(v[tt][j][2], v[tt][j][3]); *(u32x2*)(H2 + (size_t)tok * DM + 4 * (lane + 64 * j)) = w; }
            }
            const bool b0 = lane & 1, b1 = lane & 2, b2 = lane & 4;
            float tv0 = -INFINITY, tv1 = -INFINITY, tv2 = -INFINITY, tv3 = -INFINITY; int te0 = 0, te1 = 0, te2 = 0, te3 = 0;
#pragma unroll 2
            for (int e = 0; e < NE; ++e) {
                const f32x4* wrow = (const f32x4*)(wrt + (size_t)e * DM);
                f32x4 w4[4];
#pragma unroll
                for (int j = 0; j < 4; ++j) w4[j] = wrow[lane + 64 * j];
                float a[8];
#pragma unroll
                for (int tt = 0; tt < 8; ++tt) { float pa = 0.f;
#pragma unroll
                    for (int j = 0; j < 4; ++j) pa += v[tt][j][0] * w4[j][0] + v[tt][j][1] * w4[j][1] + v[tt][j][2] * w4[j][2] + v[tt][j][3] * w4[j][3];
                    a[tt] = pa; }
                float k0 = b0 ? a[4] : a[0], k1 = b0 ? a[5] : a[1], k2 = b0 ? a[6] : a[2], k3 = b0 ? a[7] : a[3];
                k0 += __shfl_xor(b0 ? a[0] : a[4], 1); k1 += __shfl_xor(b0 ? a[1] : a[5], 1); k2 += __shfl_xor(b0 ? a[2] : a[6], 1); k3 += __shfl_xor(b0 ? a[3] : a[7], 1);
                float m0 = b1 ? k2 : k0, m1 = b1 ? k3 : k1;
                m0 += __shfl_xor(b1 ? k0 : k2, 2); m1 += __shfl_xor(b1 ? k1 : k3, 2);
                float d = b2 ? m1 : m0;
                d += __shfl_xor(b2 ? m0 : m1, 4);
                d += __shfl_xor(d, 8); d += __shfl_xor(d, 16); d += __shfl_xor(d, 32);
                const float x = d + br[e];
                const bool g0 = x > tv0, g1 = x > tv1, g2_ = x > tv2, g3 = x > tv3;
                tv3 = g2_ ? tv2 : (g3 ? x : tv3); te3 = g2_ ? te2 : (g3 ? e : te3);
                tv2 = g1 ? tv1 : (g2_ ? x : tv2); te2 = g1 ? te1 : (g2_ ? e : te2);
                tv1 = g0 ? tv0 : (g1 ? x : tv1); te1 = g0 ? te0 : (g1 ? e : te1);
                tv0 = g0 ? x : tv0; te0 = g0 ? e : te0;
            }
            const float e1 = __expf(tv1 - tv0), e2 = __expf(tv2 - tv0), e3 = __expf(tv3 - tv0);
            const float inv = 1.0f / (1.0f + e1 + e2 + e3);
            if (lane < 8) {
                const int tl = F.wave * 8 + (b0 ? 4 : 0) + (b1 ? 2 : 0) + (b2 ? 1 : 0);
                const int rk0 = __hip_atomic_fetch_add((int*)(lcnt + te0), 1, __ATOMIC_RELAXED, __HIP_MEMORY_SCOPE_WORKGROUP);
                const int rk1 = __hip_atomic_fetch_add((int*)(lcnt + te1), 1, __ATOMIC_RELAXED, __HIP_MEMORY_SCOPE_WORKGROUP);
                const int rk2 = __hip_atomic_fetch_add((int*)(lcnt + te2), 1, __ATOMIC_RELAXED, __HIP_MEMORY_SCOPE_WORKGROUP);
                const int rk3 = __hip_atomic_fetch_add((int*)(lcnt + te3), 1, __ATOMIC_RELAXED, __HIP_MEMORY_SCOPE_WORKGROUP);
                pe[tl * 4 + 0] = te0 | (rk0 << 8); pe[tl * 4 + 1] = te1 | (rk1 << 8); pe[tl * 4 + 2] = te2 | (rk2 << 8); pe[tl * 4 + 3] = te3 | (rk3 << 8);
                pg[tl * 4 + 0] = inv; pg[tl * 4 + 1] = e1 * inv; pg[tl * 4 + 2] = e2 * inv; pg[tl * 4 + 3] = e3 * inv;
            }
        }
        __syncthreads();
        if (tid < NE && commit) { const int n = lcnt[tid]; lcnt[32 + tid] = n ? atomicAdd(&cnt[64 * tid], n) : 0; }
        __syncthreads();
        if (tid < 256 && commit) { const int w = pe[tid], ee = w & 255, p = lcnt[32 + ee] + (w >> 8), tok = chunk * 64 + (tid >> 2);
            ltok[ee * T + p] = tok; lgate[ee * T + p] = pg[tid]; tke[tok * 4 + (tid & 3)] = ee | (p << 8); }
    }
}

__device__ __forceinline__ void build_tables(const Params& P, Frame& F) {
    LAS int* trs = (LAS int*)(F.lds + LDS_TAB); LAS int* cnts = trs + 64;
    const int* cnt = (const int*)(P.ws + WS_CTL);
    if (F.tid == 0) { int a = 0; for (int e = 0; e < NE; ++e) { const int n = cnt[64 * e]; trs[e] = a; cnts[e] = n; a += (n + 255) >> 8; } trs[NE] = a; }
    __syncthreads();
}

__device__ __forceinline__ void combine_phase(const Params& P, Frame& F, const bool commit) {
    const LAS int* trs = (const LAS int*)(F.lds + LDS_TAB);
    const bf16_t* Y = (const bf16_t*)(P.ws + WS_Y); const int* tke = (const int*)(P.ws + WS_TKE);
    float* out = P.out; const int lane = F.lane;
    for (int tok = F.gw; tok < T; tok += F.ngw) {
        f32x4 a[4];
#pragma unroll
        for (int j = 0; j < 4; ++j) a[j] = *(const f32x4*)(out + (size_t)tok * DM + 4 * (lane + 64 * j));
#pragma unroll
        for (int k = 0; k < 4; ++k) { const int w = tke[tok * 4 + k], e = w & 255, p = w >> 8; const size_t slot = (size_t)trs[e] * 256 + p;
#pragma unroll
            for (int j = 0; j < 4; ++j) { const u32x2 y = *(const u32x2*)(Y + slot * DM + 4 * (lane + 64 * j)); a[j][0] += bflo(y.x); a[j][1] += bfhi(y.x); a[j][2] += bflo(y.y); a[j][3] += bfhi(y.y); } }
#pragma unroll
        for (int j = 0; j < 4; ++j) if (commit || a[j][0] == 123456.789f) *(f32x4*)(out + (size_t)tok * DM + 4 * (lane + 64 * j)) = a[j];
    }
}


#define XB_TMO      128
#define XB_XCNT(j)  (256  + 64 * (j))
#define XB_XSUB(j)  (1280 + 64 * (j))
#define XB_XGEN(j)  (2304 + 64 * (j))
#define XB_TOP      3328
#define XB_TOPGEN   3392
#define XCD_BAR_WORDS 3456
#define XB_SPIN_CAP (1u << 18)
__device__ __forceinline__ unsigned xb_ld(unsigned* p)              { return __hip_atomic_load(p, __ATOMIC_RELAXED, __HIP_MEMORY_SCOPE_AGENT); }
__device__ __forceinline__ unsigned xb_add(unsigned* p, unsigned v) { return __hip_atomic_fetch_add(p, v, __ATOMIC_RELAXED, __HIP_MEMORY_SCOPE_AGENT); }
__device__ __forceinline__ unsigned xb_xcc_id() { return (unsigned)__builtin_amdgcn_s_getreg((3 << 11) | 20) & 0xFu; }
#define XB_SPIN(cond, bar) do { unsigned _sp = 0; while (cond) { __builtin_amdgcn_s_sleep(1); \
    if ((++_sp & 255u) == 0u) { if (xb_ld(&(bar)[XB_TMO])) break; if (_sp > XB_SPIN_CAP) { atomicAdd(&(bar)[XB_TMO], 1u); break; } } } } while (0)
struct XcdBarrier { unsigned* bar; unsigned x; volatile LAS unsigned* st; };
__device__ __forceinline__ XcdBarrier xcd_barrier_post(unsigned* bar, volatile LAS unsigned* st) {
    XcdBarrier b; b.bar = bar; b.x = xb_xcc_id(); b.st = st;
    if (threadIdx.x == 0) (void)xb_add(&bar[XB_XCNT(b.x)], 1u);
    return b;
}
__device__ __forceinline__ void xcd_barrier_complete(unsigned* bar, unsigned x, unsigned& nloc, unsigned& nx) {
    const unsigned G = gridDim.x * gridDim.y * gridDim.z;
    unsigned sum, cnt, mine, sp = 0u;
    for (;;) {
        sum = 0u; cnt = 0u; mine = 0u;
#pragma unroll
        for (unsigned j = 0; j < 16; ++j) { const unsigned c = xb_ld(&bar[XB_XCNT(j)]); sum += c; cnt += (c > 0u) ? 1u : 0u; mine = (j == x) ? c : mine; }
        if (sum == G) break;
        __builtin_amdgcn_s_sleep(1);
        if ((++sp & 255u) == 0u) { if (xb_ld(&bar[XB_TMO])) break; if (sp > XB_SPIN_CAP) { atomicAdd(&bar[XB_TMO], 1u); break; } }
    }
    nloc = mine > 0u ? mine : 1u; nx = cnt > 0u ? cnt : 1u;
}
__device__ __forceinline__ void xcd_barrier(const XcdBarrier& b) {
    asm volatile("s_waitcnt vmcnt(0)" ::: "memory");
    __syncthreads();
    if (threadIdx.x == 0) {
        unsigned* bar = b.bar;
        __builtin_amdgcn_s_waitcnt(0);
        unsigned nloc = b.st[0], nx = b.st[1];
        if (nloc == 0u) { xcd_barrier_complete(bar, b.x, nloc, nx); b.st[0] = nloc; b.st[1] = nx; }
        const unsigned old = xb_add(&bar[XB_XSUB(b.x)], 1u);
        const unsigned gen = old / nloc;
        if (old + 1u == (gen + 1u) * nloc) {
            __builtin_amdgcn_fence(__ATOMIC_RELEASE, "agent");
            asm volatile("s_waitcnt vmcnt(0)" ::: "memory");
            const unsigned og = xb_add(&bar[XB_TOP], 1u);
            const unsigned tg = og / nx;
            if (og + 1u == (tg + 1u) * nx) xb_add(&bar[XB_TOPGEN], 1u);
            else XB_SPIN(xb_ld(&bar[XB_TOPGEN]) == tg, bar);
            __builtin_amdgcn_fence(__ATOMIC_ACQUIRE, "agent");
            xb_add(&bar[XB_XGEN(b.x)], 1u);
            asm volatile("s_waitcnt vmcnt(0)" ::: "memory");
        } else {
            XB_SPIN(xb_ld(&bar[XB_XGEN(b.x)]) == gen, bar);
            __builtin_amdgcn_fence(__ATOMIC_ACQUIRE, "agent");
            asm volatile("s_waitcnt vmcnt(0)" ::: "memory");
        }
    }
    __syncthreads();
}

__global__ void __launch_bounds__(NTHR) fwd_megakernel(Params P) {
    extern __shared__ __attribute__((aligned(16))) unsigned char lds_raw[];
    Frame F;
    F.lds = (LAS unsigned char*)lds_raw;
    F.tid = threadIdx.x; F.lane = F.tid & 63; F.wave = __builtin_amdgcn_readfirstlane(F.tid >> 6);
    F.G = gridDim.x; { const int bx = blockIdx.x; F.vcu = (F.G % 8 == 0) ? (bx % 8) * (F.G / 8) + bx / 8 : bx; }
    F.gw = F.vcu * NWAVES + F.wave; F.ngw = F.G * NWAVES;
    unsigned char* ws = P.ws;
    LAS unsigned char* stage = F.lds + LDS_STAGE;
    volatile LAS unsigned* bst = (volatile LAS unsigned*)(F.lds + LDS_TAB + 512);
    if (F.tid < 2) bst[F.tid] = 0u;
    __syncthreads();
    const XcdBarrier bar = xcd_barrier_post((unsigned*)(ws + WS_CTL) + 4096, bst);
    LAS unsigned long long* tstamp = (LAS unsigned long long*)(F.lds + LDS_TAB + 640); int nstamp = 0;
    if (TPROBE >= 0 && blockIdx.x == 0 && F.tid == 0) tstamp[nstamp] = __builtin_amdgcn_s_memrealtime();
    ++nstamp;
#define GRID_SYNC() do { xcd_barrier(bar); if (TPROBE >= 0 && blockIdx.x == 0 && F.tid == 0) tstamp[nstamp] = __builtin_amdgcn_s_memrealtime(); ++nstamp; } while (0)

    p0_prologue(P, F);
    if (DUP & 1) p0_prologue(P, F);
    GRID_SYNC();
    {
        pg8::DenseSched S{T / 256, NZ / 256, F.G, (int)blockIdx.x, DM, (const char*)(ws + WS_WIN), (DUP & 2) ? 2 : 1};
        pg8::EpiBf16 E{(bf16_t*)(ws + WS_Z), NZ};
        pg8::gemm_phase(stage, (const char*)(ws + WS_XN), DM, S, E);
    }
    GRID_SYNC();
    p2_tokprep(P, F);
    GRID_SYNC();
    if (DUP & 4096) { for (int q = 0; q < 10; ++q) GRID_SYNC(); }
    {
        pg8::DenseSched S{T / 256, 1024 / 256, F.G, (int)blockIdx.x, 512, (const char*)(ws + WS_WQK), (DUP & 4) ? 2 : 1};
        pg8::EpiBf16 E{(bf16_t*)(ws + WS_QK), 1024};
        pg8::gemm_phase(stage, (const char*)(ws + WS_XC), 512, S, E);
    }
    attn_phase(P, F);
    if (DUP & 8) attn_phase(P, F);
    GRID_SYNC();
    ml1_phase(P, F);
    if (DUP & 16) ml1_phase(P, F);
    GRID_SYNC();
    ml3_phase(P, F);
    if (DUP & 32) ml3_phase(P, F);
    GRID_SYNC();
    {
        pg8::DenseSched S{T / 256, DM / 256, F.G, (int)blockIdx.x, DM, (const char*)(ws + WS_WOUT), (DUP & 64) ? 2 : 1};
        pg8::EpiResF32 E{P.out, P.in[0], DM};
        pg8::gemm_phase(stage, (const char*)(ws + WS_MIX), DM, S, E);
    }
    GRID_SYNC();
    if (DUP & 512) router_phase(P, F, false);
    router_phase(P, F, true);
    GRID_SYNC();
    build_tables(P, F);
    const LAS int* trs = (const LAS int*)(F.lds + LDS_TAB); const LAS int* cnts = trs + 64;
    {
        pg8::MoeSched<true> S{trs, cnts, 8, F.G, (int)blockIdx.x, DM, (const char*)(ws + WS_WGU), (size_t)2 * DFF * DM * 2, (const int*)(ws + WS_LTOK)};
        pg8::EpiSwiglu E{(bf16_t*)(ws + WS_ACT), P.in[17]};
        pg8::gemm_phase(stage, (const char*)(ws + WS_XN), DM, S, E);
    }
    GRID_SYNC();
    {
        pg8::MoeSched<false> S{trs, cnts, 4, F.G, (int)blockIdx.x, DFF, (const char*)(ws + WS_WD), (size_t)DM * DFF * 2, nullptr};
        pg8::EpiDown E{(bf16_t*)(ws + WS_Y), P.in[19], (const float*)(ws + WS_LGATE), cnts};
        pg8::gemm_phase(stage, (const char*)(ws + WS_ACT), DFF, S, E);
    }
    GRID_SYNC();
    if (DUP & 1024) combine_phase(P, F, false);
    combine_phase(P, F, true);
    if (TPROBE >= 0 && blockIdx.x == 0 && F.tid == 0) {
        tstamp[nstamp] = __builtin_amdgcn_s_memrealtime();
        const unsigned long long span = tstamp[TPROBE + 1] - tstamp[TPROBE], t0_ = __builtin_amdgcn_s_memrealtime();
        while (__builtin_amdgcn_s_memrealtime() - t0_ < 4ull * span) __builtin_amdgcn_s_sleep(8);
    }
}
}

extern "C" void kernel_launch(void* const* d_in, const int* in_sizes, int n_in, void* d_out, int out_size, void* d_ws, size_t ws_size, hipStream_t stream) {
    static int grid = 0;
    if (grid == 0) {
        if (n_in != 20 || out_size != T * DM || ws_size < WS_END) { fprintf(stderr, "kernel_launch: unexpected problem (n_in %d out %d ws %zu)\n", n_in, out_size, ws_size); grid = -1; return; }
        int dev = 0, cus = 0, per_cu = 0;
        (void)hipGetDevice(&dev);
        (void)hipDeviceGetAttribute(&cus, hipDeviceAttributeMultiprocessorCount, dev);
        (void)hipFuncSetAttribute((const void*)fwd_megakernel, hipFuncAttributeMaxDynamicSharedMemorySize, LDS_BYTES);
        (void)hipOccupancyMaxActiveBlocksPerMultiprocessor(&per_cu, (const void*)fwd_megakernel, NTHR, LDS_BYTES);
        if (per_cu < 1) { fprintf(stderr, "kernel_launch: occupancy query says %d blocks per CU\n", per_cu); per_cu = 1; }
        grid = cus;
    }
    if (grid < 0) return;
    (void)hipMemsetAsync((char*)d_ws + WS_CTL, 0, 65536, stream);
    Params p{};
    for (int i = 0; i < 20; ++i) p.in[i] = (const float*)d_in[i];
    p.out = (float*)d_out; p.ws = (unsigned char*)d_ws;
    hipLaunchKernelGGL(fwd_megakernel, dim3(grid), dim3(NTHR), LDS_BYTES, stream, p);
    const hipError_t e = hipPeekAtLastError();
    if (e != hipSuccess) fprintf(stderr, "launch failed: %s (grid %d)\n", hipGetErrorString(e), grid);
}
```

```cpp
#include <hip/hip_runtime.h>
#include <cstdio>
#include <cstdint>

#define LAS __attribute__((address_space(3)))
typedef unsigned short bf16_t;
typedef short bf16x8 __attribute__((ext_vector_type(8)));
typedef short s16x4 __attribute__((ext_vector_type(4)));
typedef float f32x4 __attribute__((ext_vector_type(4)));
typedef unsigned u32x4 __attribute__((ext_vector_type(4)));
typedef unsigned u32x2 __attribute__((ext_vector_type(2)));
typedef int i32x4 __attribute__((ext_vector_type(4)));
typedef int i32x8 __attribute__((ext_vector_type(8)));

namespace {
constexpr int BATCH = 2, SEQ = 8192, T = BATCH * SEQ, DM = 1024, DIN = 3080, NZ = 3072;
constexpr int NHA = 8, NHM = 4, HDM = 128;
constexpr int NE = 32, DFF = 1024;
constexpr int CH = 256, NCH = SEQ / CH;
constexpr float EPS = 1e-6f;
constexpr float LOG2E = 1.4426950408889634f;
constexpr float SC_W = 32.f, SC_H = 8.f, SC_A = 4.f;
constexpr int ZQ = 0, ZK = 512, ZV = 1024, ZXM = 1536, ZVM = 2048, ZOM = 2560;
constexpr int NWAVES = 8, NTHR = 512;
constexpr int MAXTR = 288;
constexpr int TPROBE = -1;
constexpr int DUP = 0;
constexpr size_t MiB = 1u << 20;
constexpr size_t WS_CTL = 0;
constexpr size_t WS_WIN = 1 * MiB;
constexpr size_t WS_WOUT = 7 * MiB;
constexpr size_t WS_WQK = 9 * MiB;
constexpr size_t WS_WGU = 16 * MiB;
constexpr size_t WS_WD = 144 * MiB;
constexpr size_t WS_XN = 208 * MiB;
constexpr size_t WS_Z = 240 * MiB;
constexpr size_t WS_GATE = 336 * MiB;
constexpr size_t WS_XC = 337 * MiB;
constexpr size_t WS_QK = 353 * MiB;
constexpr size_t WS_BC = 385 * MiB;
constexpr size_t WS_IG = 385 * MiB + 512 * 1024;
constexpr size_t WS_BT = 386 * MiB;
constexpr size_t WS_NV = 386 * MiB + 4096;
constexpr size_t WS_U = 387 * MiB;
constexpr size_t WS_MIX = 403 * MiB;
constexpr size_t WS_LTOK = 435 * MiB;
constexpr size_t WS_LGATE = 437 * MiB;
constexpr size_t WS_TKE = 439 * MiB;
constexpr size_t WS_WRT = 439 * MiB + 512 * 1024;
constexpr size_t WS_H8 = 728 * MiB;
constexpr size_t WS_ACT = 440 * MiB;
constexpr size_t WS_Y = 584 * MiB;
constexpr size_t WS_END = 744 * MiB;
constexpr int LDS_STAGE = 0;
constexpr int LDS_TAB = 131072;
constexpr int LDS_BYTES = 131072 + 1024;

__device__ __forceinline__ unsigned f2bf(float f) { unsigned u = __builtin_bit_cast(unsigned, f); return (u + 0x7fffu + ((u >> 16) & 1u)) >> 16; }
__device__ __forceinline__ unsigned pk2(float lo, float hi) { return f2bf(lo) | (f2bf(hi) << 16); }
__device__ __forceinline__ unsigned pk4_fp8(float a, float b, float c, float d) { int w = 0; w = __builtin_amdgcn_cvt_pk_fp8_f32(a, b, w, false); w = __builtin_amdgcn_cvt_pk_fp8_f32(c, d, w, true); return (unsigned)w; }
__device__ __forceinline__ float bf2f(unsigned b) { return __builtin_bit_cast(float, b << 16); }
__device__ __forceinline__ float bflo(unsigned w) { return __builtin_bit_cast(float, w << 16); }
__device__ __forceinline__ float bfhi(unsigned w) { return __builtin_bit_cast(float, w & 0xffff0000u); }
__device__ __forceinline__ float wave_sum(float v) {
#pragma unroll
    for (int o = 1; o < 64; o <<= 1) v += __shfl_xor(v, o);
    return v;
}
__device__ __forceinline__ float sigmoidf_(float x) { return 1.0f / (1.0f + __expf(-x)); }
}

namespace pg8 {
constexpr int BM = 256, BK = 64, HALF = 128, HTB = HALF * BK * 2, STAGE_BYTES = 8 * HTB, NXCD = 8, WGM = 8;
__host__ __device__ __forceinline__ int lds_byte(int r, int c) { const int st = (r >> 4) * 2 + (c >> 5), rr = r & 15, cc = c & 31, ob = rr * 64 + cc * 2; return st * 1024 + (ob ^ (((ob >> 9) & 1) << 5)); }
__host__ __device__ __forceinline__ void stage_rc(int b, int& R, int& C) { const int st = b / 1024, sb = b % 1024, swz = sb ^ (((sb >> 9) & 1) << 5); R = (st >> 1) * 16 + swz / 64; C = (st & 1) * 32 + (swz % 64) / 2; }
__host__ __device__ __forceinline__ int perm32(int rho) { const int n = rho >> 4, i = rho & 15; return 8 * (i >> 2) + 4 * n + (i & 3); }

__device__ __forceinline__ bool tile_order(int i, int G, int c, int nM, int nN, int& pm, int& pn) {
    const int nwg = nM * nN; const long L = (long)i * G + c; if (L >= nwg) return false;
    int wgid = (int)L; { const int q = nwg / NXCD, r = nwg % NXCD, xcd = wgid % NXCD, off = wgid / NXCD; wgid = (xcd < r ? xcd * (q + 1) : r * (q + 1) + (xcd - r) * q) + off; }
    const int nig = WGM * nN, gid = wgid / nig, fm = gid * WGM, gsz = (nM - fm) < WGM ? (nM - fm) : WGM;
    pm = fm + ((wgid % nig) % gsz); pn = (wgid % nig) / gsz; return true;
}

struct Unit { int pm, pn, e, mt; };

struct DenseSched {
    int nM, nN, G, c, K; const char* Bt; int reps;
    static constexpr bool DRAIN = false;
    __device__ __forceinline__ bool next(int i, Unit& u) const { u.e = 0; u.mt = 0; const int per = (nM * nN + G - 1) / G; if (i >= per * reps) return false; if (!tile_order(i % per, G, c, nM, nN, u.pm, u.pn)) return tile_order(0, G, c, nM, nN, u.pm, u.pn); return true; }
    __device__ __forceinline__ void a_off(const Unit& u, const int (&R)[2], const int (&C)[2], unsigned (&off)[2][2]) const {
#pragma unroll
        for (int h = 0; h < 2; ++h)
#pragma unroll
            for (int i = 0; i < 2; ++i) off[h][i] = (unsigned)(((u.pm * BM + h * HALF + R[i]) * K + C[i]) * 2);
    }
    __device__ __forceinline__ const char* b_ptr(const Unit& u) const { return Bt + (size_t)u.pn * BM * K * 2; }
};
template <bool GATHER> struct MoeSched {
    const LAS int* trs; const LAS int* cnts; int nN, G, c, K; const char* Bt; size_t bstride; const int* ltok;
    static constexpr bool DRAIN = GATHER;
    __device__ __forceinline__ bool next(int i, Unit& u) const {
        const int nM = __builtin_amdgcn_readfirstlane(trs[NE]);
        if (!tile_order(i, G, c, nM, nN, u.pm, u.pn)) return false;
        int e = 0;
        for (int j = 1; j < NE; ++j) e += (__builtin_amdgcn_readfirstlane(trs[j]) <= u.pm) ? 1 : 0;
        u.e = e; u.mt = u.pm - __builtin_amdgcn_readfirstlane(trs[e]); return true;
    }
    __device__ __forceinline__ void a_off(const Unit& u, const int (&R)[2], const int (&C)[2], unsigned (&off)[2][2]) const {
        const int n = __builtin_amdgcn_readfirstlane(cnts[u.e]);
#pragma unroll
        for (int h = 0; h < 2; ++h)
#pragma unroll
            for (int i = 0; i < 2; ++i) {
                int row;
                if (GATHER) { const int p = u.mt * BM + h * HALF + R[i]; row = (p < n) ? ltok[u.e * T + p] : 0; }
                else row = u.pm * BM + h * HALF + R[i];
                off[h][i] = (unsigned)((row * K + C[i]) * 2);
            }
    }
    __device__ __forceinline__ const char* b_ptr(const Unit& u) const { return Bt + (size_t)u.e * bstride + (size_t)u.pn * BM * K * 2; }
};

struct EpiBf16 {
    static constexpr bool PERM = true;
    bf16_t* O; int ldc;
    __device__ __forceinline__ void operator()(const f32x4 (&acc)[2][2][4][2], const Unit& u, int wr, int wc, int fr, int fq) const {
        const int row0 = u.pm * BM + wr * 64 + fr, col0 = u.pn * BM + wc * 32 + 8 * fq;
#pragma unroll
        for (int ai = 0; ai < 2; ++ai)
#pragma unroll
            for (int m = 0; m < 4; ++m) { bf16_t* rowp = O + (size_t)(row0 + ai * HALF + m * 16) * ldc + col0;
#pragma unroll
                for (int bj = 0; bj < 2; ++bj) { const f32x4 v0 = acc[ai][bj][m][0], v1 = acc[ai][bj][m][1];
                    u32x4 w; w.x = pk2(v0[0], v0[1]); w.y = pk2(v0[2], v0[3]); w.z = pk2(v1[0], v1[1]); w.w = pk2(v1[2], v1[3]);
                    *(u32x4*)(rowp + bj * HALF) = w; } }
    }
};
struct EpiResF32 {
    static constexpr bool PERM = false;
    float* C; const float* Rs; int ldc;
    __device__ __forceinline__ void operator()(const f32x4 (&acc)[2][2][4][2], const Unit& u, int wr, int wc, int fr, int fq) const {
        const int row0 = u.pm * BM + wr * 64 + fr, col0 = u.pn * BM + wc * 32 + 4 * fq;
#pragma unroll
        for (int ai = 0; ai < 2; ++ai)
#pragma unroll
            for (int m = 0; m < 4; ++m) { const size_t ro = (size_t)(row0 + ai * HALF + m * 16) * ldc + col0;
#pragma unroll
                for (int bj = 0; bj < 2; ++bj)
#pragma unroll
                    for (int n = 0; n < 2; ++n) { const f32x4 r = *(const f32x4*)(Rs + ro + bj * HALF + n * 16); *(f32x4*)(C + ro + bj * HALF + n * 16) = acc[ai][bj][m][n] + r; } }
    }
};
struct EpiSwiglu {
    static constexpr bool PERM = true;
    unsigned char* O; const float* bgu;
    __device__ __forceinline__ void operator()(const f32x4 (&acc)[2][2][4][2], const Unit& u, int wr, int wc, int fr, int fq) const {
        const int row0 = u.pm * BM + wr * 64 + fr, f0 = u.pn * HALF + wc * 32 + 8 * fq;
        const float* bg = bgu + (size_t)u.e * 2 * DFF + f0;
        constexpr float inv = 1.0f / (SC_H * SC_W);
        f32x4 bgv[2], buv[2];
#pragma unroll
        for (int n = 0; n < 2; ++n) { bgv[n] = *(const f32x4*)(bg + 4 * n); buv[n] = *(const f32x4*)(bg + DFF + 4 * n); }
#pragma unroll
        for (int ai = 0; ai < 2; ++ai)
#pragma unroll
            for (int m = 0; m < 4; ++m) { unsigned char* rowp = O + (size_t)(row0 + ai * HALF + m * 16) * DFF + f0;
                float r[8];
#pragma unroll
                for (int n = 0; n < 2; ++n) { const f32x4 gv = acc[ai][0][m][n] * inv + bgv[n], uv = acc[ai][1][m][n] * inv + buv[n];
#pragma unroll
                    for (int j = 0; j < 4; ++j) { const float gg = fminf(gv[j], 7.0f), uu = fminf(fmaxf(uv[j], -7.0f), 7.0f);
                        r[4 * n + j] = SC_A * gg * (uu + 1.0f) / (1.0f + __expf(-1.702f * gg)); } }
                u32x2 w; w.x = pk4_fp8(r[0], r[1], r[2], r[3]); w.y = pk4_fp8(r[4], r[5], r[6], r[7]);
                *(u32x2*)rowp = w; }
    }
};
struct EpiDown {
    static constexpr bool PERM = true;
    bf16_t* O; const float* bd; const float* lgate; const LAS int* cnts;
    __device__ __forceinline__ void operator()(const f32x4 (&acc)[2][2][4][2], const Unit& u, int wr, int wc, int fr, int fq) const {
        const int row0 = u.pm * BM + wr * 64 + fr, col0 = u.pn * BM + wc * 32 + 8 * fq;
        const int n_e = cnts[u.e];
        f32x4 bv[2][2];
#pragma unroll
        for (int bj = 0; bj < 2; ++bj)
#pragma unroll
            for (int n = 0; n < 2; ++n) bv[bj][n] = *(const f32x4*)(bd + (size_t)u.e * DM + col0 + bj * HALF + 4 * n);
#pragma unroll
        for (int ai = 0; ai < 2; ++ai)
#pragma unroll
            for (int m = 0; m < 4; ++m) { const int rt = wr * 64 + fr + ai * HALF + m * 16, p = u.mt * BM + rt;
                const float gt = (p < n_e) ? lgate[(size_t)u.e * T + p] : 0.f;
                bf16_t* rowp = O + (size_t)(row0 + ai * HALF + m * 16) * DM + col0;
#pragma unroll
                for (int bj = 0; bj < 2; ++bj) { const f32x4 v0 = (acc[ai][bj][m][0] * (1.0f / (SC_A * SC_W)) + bv[bj][0]) * gt, v1 = (acc[ai][bj][m][1] * (1.0f / (SC_A * SC_W)) + bv[bj][1]) * gt;
                    u32x4 w; w.x = pk2(v0[0], v0[1]); w.y = pk2(v0[2], v0[3]); w.z = pk2(v1[0], v1[1]); w.w = pk2(v1[2], v1[3]);
                    *(u32x4*)(rowp + bj * HALF) = w; } }
    }
};

template <bool FP8, class Epi, class Sched>
__device__ __forceinline__ void gemm_phase(LAS unsigned char* lds, const char* A0, const int K, const Sched& S, const Epi& E) {
    const int tid = threadIdx.x, wid = __builtin_amdgcn_readfirstlane(tid >> 6), lane = tid & 63, wr = wid >> 2, wc = wid & 3, fr = lane & 15, fq = lane >> 4;
    const int nt = K / BK;
    int Rr[2], Cc[2]; unsigned voffB[2];
#pragma unroll
    for (int i = 0; i < 2; ++i) { stage_rc(tid * 16 + i * 8192, Rr[i], Cc[i]); const int Rb = Epi::PERM ? ((Rr[i] & ~31) + perm32(Rr[i] & 31)) : Rr[i]; voffB[i] = (unsigned)(Rb * K + Cc[i]) * 2u; }
    const size_t kstep = (size_t)(BK * 2);
    const size_t hstep = (size_t)HALF * K * 2;
    const unsigned ldsw = (unsigned)wid * 1024u;
    const int aoff = lds_byte(wr * 64 + fr, fq * 8), boff = lds_byte(wc * 32 + fr, fq * 8);
#define PG8_SA(b, h) (((b) * 2 + (h)) * HTB)
#define PG8_SB(b, h) ((4 + (b) * 2 + (h)) * HTB)
#define PG8_STAGE_B(bufoff, gbase) do { _Pragma("unroll") for (int _i = 0; _i < 2; ++_i) \
        __builtin_amdgcn_global_load_lds((const unsigned*)((const char*)(gbase) + voffB[_i]), (LAS unsigned*)(lds + (bufoff) + ldsw + _i * 8192), 16, 0, 0); } while (0)
#define PG8_STAGE_A(bufoff, gbase, o0, o1) do { \
        __builtin_amdgcn_global_load_lds((const unsigned*)((const char*)(gbase) + (o0)), (LAS unsigned*)(lds + (bufoff) + ldsw), 16, 0, 0); \
        __builtin_amdgcn_global_load_lds((const unsigned*)((const char*)(gbase) + (o1)), (LAS unsigned*)(lds + (bufoff) + ldsw + 8192), 16, 0, 0); } while (0)
#define PG8_LDA(dst, b, h) do { if constexpr (FP8) { _Pragma("unroll") for (int m = 0; m < 4; ++m) { const i32x4 lo_ = *(const LAS i32x4*)(lds + PG8_SA(b, h) + aoff + m * 2048), hi_ = *(const LAS i32x4*)(lds + PG8_SA(b, h) + aoff + m * 2048 + 1024); \
            dst##8[m] = __builtin_shufflevector(lo_, hi_, 0, 1, 2, 3, 4, 5, 6, 7); } } \
        else { _Pragma("unroll") for (int m = 0; m < 4; ++m) _Pragma("unroll") for (int k = 0; k < 2; ++k) dst[m][k] = *(const LAS bf16x8*)(lds + PG8_SA(b, h) + aoff + m * 2048 + k * 1024); } } while (0)
#define PG8_LDB(dst, b, h) do { if constexpr (FP8) { _Pragma("unroll") for (int n = 0; n < 2; ++n) { const i32x4 lo_ = *(const LAS i32x4*)(lds + PG8_SB(b, h) + boff + n * 2048), hi_ = *(const LAS i32x4*)(lds + PG8_SB(b, h) + boff + n * 2048 + 1024); \
            dst##8[n] = __builtin_shufflevector(lo_, hi_, 0, 1, 2, 3, 4, 5, 6, 7); } } \
        else { _Pragma("unroll") for (int n = 0; n < 2; ++n) _Pragma("unroll") for (int k = 0; k < 2; ++k) dst[n][k] = *(const LAS bf16x8*)(lds + PG8_SB(b, h) + boff + n * 2048 + k * 1024); } } while (0)
#define PG8_MMA(ai, bj, At, Bt) do { __builtin_amdgcn_s_setprio(1); \
        if constexpr (FP8) { _Pragma("unroll") for (int m = 0; m < 4; ++m) _Pragma("unroll") for (int n = 0; n < 2; ++n) \
            asm volatile("s_nop 1\n\tv_mfma_f32_16x16x128_f8f6f4 %0, %1, %2, %0" : "+v"(acc[ai][bj][m][n]) : "v"(Bt##8[n]), "v"(At##8[m])); } \
        else { _Pragma("unroll") for (int m = 0; m < 4; ++m) _Pragma("unroll") for (int n = 0; n < 2; ++n) _Pragma("unroll") for (int k = 0; k < 2; ++k) \
            acc[ai][bj][m][n] = __builtin_amdgcn_mfma_f32_16x16x32_bf16(Bt[n][k], At[m][k], acc[ai][bj][m][n], 0, 0, 0); } \
        __builtin_amdgcn_s_setprio(0); } while (0)
#define PG8_WAIT_V(n) asm volatile("s_waitcnt vmcnt(" #n ")" ::: "memory")
#define PG8_WAIT_L(n) asm volatile("s_waitcnt lgkmcnt(" #n ")" ::: "memory")
#define PG8_BAR __builtin_amdgcn_s_barrier()
#define PG8_SCHED __builtin_amdgcn_sched_barrier(0)
    Unit cur, nxt; int ui = 0;
    if (!S.next(0, cur)) return;
    f32x4 acc[2][2][4][2];
#pragma unroll
    for (int a = 0; a < 2; ++a)
#pragma unroll
        for (int b = 0; b < 2; ++b)
#pragma unroll
            for (int m = 0; m < 4; ++m)
#pragma unroll
                for (int n = 0; n < 2; ++n) acc[a][b][m][n] = (f32x4){0.f, 0.f, 0.f, 0.f};
    bf16x8 At[4][2], B0[2][2], B1[2][2]; i32x8 At8[4], B08[2], B18[2];
    unsigned offC[2][2], offN[2][2];
    S.a_off(cur, Rr, Cc, offC);
    const char* cB = S.b_ptr(cur);
    if (Sched::DRAIN) PG8_WAIT_V(0);
    PG8_STAGE_B(PG8_SB(0, 0), cB); PG8_STAGE_B(PG8_SB(0, 1), cB + hstep); PG8_STAGE_A(PG8_SA(0, 0), A0, offC[0][0], offC[0][1]); PG8_STAGE_A(PG8_SA(0, 1), A0, offC[1][0], offC[1][1]);
    if (wr == 1) PG8_BAR;
    PG8_WAIT_V(2); PG8_BAR;
    PG8_STAGE_B(PG8_SB(1, 0), cB + kstep); PG8_STAGE_A(PG8_SA(1, 0), A0 + kstep, offC[0][0], offC[0][1]); PG8_STAGE_B(PG8_SB(1, 1), cB + hstep + kstep);
    PG8_WAIT_V(6); PG8_BAR;
    for (;;) {
        const bool has_next = S.next(ui + 1, nxt);
        const char* nB = cB;
        if (has_next) { S.a_off(nxt, Rr, Cc, offN); nB = S.b_ptr(nxt); }
        else {
#pragma unroll
            for (int h = 0; h < 2; ++h)
#pragma unroll
                for (int i = 0; i < 2; ++i) offN[h][i] = offC[h][i];
        }
        if (Sched::DRAIN) PG8_WAIT_V(0);
        for (int t = 0; t < nt; t += 2) {
            const bool last = (t == nt - 2);
            const char* a1 = A0 + (size_t)(t + 1) * kstep;
            const char* a2 = last ? A0 : A0 + (size_t)(t + 2) * kstep; const char* b2 = last ? nB : cB + (size_t)(t + 2) * kstep;
            const char* a3 = a2 + kstep; const char* b3 = b2 + kstep;
            const unsigned o00 = last ? offN[0][0] : offC[0][0], o01 = last ? offN[0][1] : offC[0][1], o10 = last ? offN[1][0] : offC[1][0], o11 = last ? offN[1][1] : offC[1][1];
            PG8_LDB(B0, 0, 0); PG8_LDB(B1, 0, 1); PG8_SCHED; PG8_LDA(At, 0, 0); PG8_STAGE_A(PG8_SA(1, 1), a1, offC[1][0], offC[1][1]);
            PG8_WAIT_V(8); PG8_WAIT_L(0); PG8_BAR; PG8_MMA(0, 0, At, B0); PG8_MMA(0, 1, At, B1); PG8_BAR; PG8_SCHED;
            PG8_LDA(At, 0, 1); PG8_STAGE_B(PG8_SB(0, 0), b2); PG8_STAGE_B(PG8_SB(0, 1), b2 + hstep); PG8_STAGE_A(PG8_SA(0, 0), a2, o00, o01);
            PG8_WAIT_V(8); PG8_WAIT_L(0); PG8_BAR; PG8_MMA(1, 0, At, B0); PG8_MMA(1, 1, At, B1); PG8_BAR; PG8_SCHED;
            PG8_LDB(B0, 1, 0); PG8_LDB(B1, 1, 1); PG8_SCHED; PG8_LDA(At, 1, 0); PG8_STAGE_A(PG8_SA(0, 1), a2, o10, o11);
            PG8_WAIT_V(8); PG8_WAIT_L(0); PG8_BAR; PG8_MMA(0, 0, At, B0); PG8_MMA(0, 1, At, B1); PG8_BAR; PG8_SCHED;
            PG8_LDA(At, 1, 1); PG8_STAGE_B(PG8_SB(1, 0), b3); PG8_STAGE_B(PG8_SB(1, 1), b3 + hstep); PG8_STAGE_A(PG8_SA(1, 0), a3, o00, o01);
            PG8_WAIT_V(8); PG8_WAIT_L(0); PG8_BAR; PG8_MMA(1, 0, At, B0); PG8_MMA(1, 1, At, B1); PG8_BAR; PG8_SCHED;
        }
        if (wr == 0) PG8_BAR;
        if constexpr (FP8) {
            asm volatile("s_nop 15\n\ts_nop 15" : "+v"(acc[0][0][0][0]), "+v"(acc[0][0][0][1]), "+v"(acc[0][0][1][0]), "+v"(acc[0][0][1][1]), "+v"(acc[0][0][2][0]), "+v"(acc[0][0][2][1]), "+v"(acc[0][0][3][0]), "+v"(acc[0][0][3][1]),
                                                    "+v"(acc[0][1][0][0]), "+v"(acc[0][1][0][1]), "+v"(acc[0][1][1][0]), "+v"(acc[0][1][1][1]), "+v"(acc[0][1][2][0]), "+v"(acc[0][1][2][1]), "+v"(acc[0][1][3][0]), "+v"(acc[0][1][3][1]));
            asm volatile("s_nop 0" : "+v"(acc[1][0][0][0]), "+v"(acc[1][0][0][1]), "+v"(acc[1][0][1][0]), "+v"(acc[1][0][1][1]), "+v"(acc[1][0][2][0]), "+v"(acc[1][0][2][1]), "+v"(acc[1][0][3][0]), "+v"(acc[1][0][3][1]),
                                   "+v"(acc[1][1][0][0]), "+v"(acc[1][1][0][1]), "+v"(acc[1][1][1][0]), "+v"(acc[1][1][1][1]), "+v"(acc[1][1][2][0]), "+v"(acc[1][1][2][1]), "+v"(acc[1][1][3][0]), "+v"(acc[1][1][3][1]));
        }
        E(acc, cur, wr, wc, fr, fq);
        if (!has_next) break;
#pragma unroll
        for (int a = 0; a < 2; ++a)
#pragma unroll
            for (int b = 0; b < 2; ++b)
#pragma unroll
                for (int m = 0; m < 4; ++m)
#pragma unroll
                    for (int n = 0; n < 2; ++n) acc[a][b][m][n] = (f32x4){0.f, 0.f, 0.f, 0.f};
        cur = nxt; cB = nB; ++ui;
#pragma unroll
        for (int h = 0; h < 2; ++h)
#pragma unroll
            for (int i = 0; i < 2; ++i) offC[h][i] = offN[h][i];
        if (wr == 1) PG8_BAR;
    }
    PG8_WAIT_V(0);
    PG8_BAR;
#undef PG8_SA
#undef PG8_SB
#undef PG8_STAGE_A
#undef PG8_STAGE_B
#undef PG8_LDA
#undef PG8_LDB
#undef PG8_MMA
#undef PG8_WAIT_V
#undef PG8_WAIT_L
#undef PG8_BAR
#undef PG8_SCHED
}
}

namespace {
struct Params { const float* in[20]; float* out; unsigned char* ws; };

struct Frame {
    LAS unsigned char* lds;
    int tid, lane, wave, G, vcu, gw, ngw;
};

__device__ __forceinline__ void transpose_item(const float* Wt  , int ldw, bf16_t* WTt  , int ldt, float scale, LAS float* scr, int lane) {
    const int r8 = lane >> 3, c4 = (lane & 7) * 4;
    f32x4 v[8];
#pragma unroll
    for (int i = 0; i < 8; ++i) v[i] = *(const f32x4*)(Wt + (size_t)(8 * i + r8) * ldw + c4);
#pragma unroll
    for (int i = 0; i < 8; ++i) { LAS float* d = scr + (8 * i + r8) * 33 + c4; d[0] = v[i][0]; d[1] = v[i][1]; d[2] = v[i][2]; d[3] = v[i][3]; }
    asm volatile("s_waitcnt lgkmcnt(0)" ::: "memory");
    const int c = lane & 7;
#pragma unroll
    for (int j = 0; j < 4; ++j) { const int n = (lane >> 3) + 8 * j; const LAS float* s = scr + (8 * c) * 33 + n;
        u32x4 o; o.x = pk2(s[0 * 33] * scale, s[1 * 33] * scale); o.y = pk2(s[2 * 33] * scale, s[3 * 33] * scale); o.z = pk2(s[4 * 33] * scale, s[5 * 33] * scale); o.w = pk2(s[6 * 33] * scale, s[7 * 33] * scale);
        *(u32x4*)(WTt + (size_t)n * ldt + 8 * c) = o; }
    asm volatile("s_waitcnt lgkmcnt(0)" ::: "memory");
}

__device__ __forceinline__ void transpose_item8(const float* Wt, int ldw, unsigned char* WTt  , int ldt, float scale, LAS float* scr, int lane) {
    const int r8 = lane >> 3, c4 = (lane & 7) * 4;
    f32x4 v[8];
#pragma unroll
    for (int i = 0; i < 8; ++i) v[i] = *(const f32x4*)(Wt + (size_t)(8 * i + r8) * ldw + c4);
#pragma unroll
    for (int i = 0; i < 8; ++i) { LAS float* d = scr + (8 * i + r8) * 33 + c4; d[0] = v[i][0]; d[1] = v[i][1]; d[2] = v[i][2]; d[3] = v[i][3]; }
    asm volatile("s_waitcnt lgkmcnt(0)" ::: "memory");
    const int n = lane >> 1, kh = lane & 1; const LAS float* s = scr + (32 * kh) * 33 + n;
    unsigned w[8];
#pragma unroll
    for (int q = 0; q < 8; ++q) w[q] = pk4_fp8(s[(4 * q) * 33] * scale, s[(4 * q + 1) * 33] * scale, s[(4 * q + 2) * 33] * scale, s[(4 * q + 3) * 33] * scale);
    unsigned char* d = WTt + (size_t)n * ldt + 32 * kh;
    *(u32x4*)d = (u32x4){w[0], w[1], w[2], w[3]}; *(u32x4*)(d + 16) = (u32x4){w[4], w[5], w[6], w[7]};
    asm volatile("s_waitcnt lgkmcnt(0)" ::: "memory");
}

__device__ __forceinline__ void p0_prologue(const Params& P, Frame& F) {
    unsigned char* ws = P.ws;
    const float* w_in = P.in[2];
    LAS float* scr = (LAS float*)(F.lds + F.wave * 8448);
    LAS float* gwl = (LAS float*)(F.lds + 73728);
    for (int i = F.tid; i < 1024 * 8; i += NTHR) gwl[i] = w_in[(size_t)(i >> 3) * DIN + NZ + (i & 7)];
    __syncthreads();
    constexpr int I_IN = 16 * 96, I_OUT = 16 * 32, I_QK = 8 * 2 * 4, I_GU = NE * 16 * 64, I_D = NE * 16 * 32, I_ZERO = 8 * 3;
    constexpr int NITEMS = I_IN + I_OUT + I_QK + I_ZERO + I_GU + I_D;
    bf16_t* WinT = (bf16_t*)(ws + WS_WIN); bf16_t* WoutT = (bf16_t*)(ws + WS_WOUT); bf16_t* WqkT = (bf16_t*)(ws + WS_WQK);
    unsigned char* WguT = ws + WS_WGU; unsigned char* WdT = ws + WS_WD;
    for (int it = F.gw; it < NITEMS; it += F.ngw) {
        int r = it;
        if (r < I_IN) { const int kb = r / 96, nb = r % 96; transpose_item(w_in + (size_t)(64 * kb) * DIN + 32 * nb, DIN, WinT + (size_t)(32 * nb) * DM + 64 * kb, DM, 1.f, scr, F.lane); continue; } r -= I_IN;
        if (r < I_OUT) { const int kb = r / 32, nb = r % 32; transpose_item(P.in[12] + (size_t)(64 * kb) * DM + 32 * nb, DM, WoutT + (size_t)(32 * nb) * DM + 64 * kb, DM, 1.f, scr, F.lane); continue; } r -= I_OUT;
        if (r < I_QK) { const int isk = r >> 5, h = (r >> 3) & 3, kb = (r >> 2) & 1, nb = r & 3;
            const float* src = P.in[isk ? 8 : 7] + (size_t)h * 16384 + (size_t)(64 * kb) * 128 + 32 * nb;
            transpose_item(src, 128, WqkT + (size_t)(isk * 512 + h * 128 + 32 * nb) * 512 + h * 128 + 64 * kb, 512, isk ? 0.08838834764831845f : 1.f, scr, F.lane); continue; } r -= I_QK;
        if (r < I_ZERO) {
            const int rb = r / 3, j = r % 3, cb = j + (j >= (rb & 3) ? 1 : 0);
            for (int q = F.lane; q < 128 * 16; q += 64) { const int rr = q >> 4, cc = q & 15; *(u32x4*)(WqkT + (size_t)(rb * 128 + rr) * 512 + cb * 128 + cc * 8) = (u32x4){0u, 0u, 0u, 0u}; }
            continue; } r -= I_ZERO;
        if (r < I_GU) { const int e = r >> 10, kb = (r >> 6) & 15, nb = r & 63, n0 = 32 * nb, f = n0 & 1023, up = n0 >> 10;
            const int drow = (f >> 7) * 256 + up * 128 + (f & 127);
            transpose_item8(P.in[16] + (size_t)e * DM * 2 * DFF + (size_t)(64 * kb) * 2 * DFF + n0, 2 * DFF, WguT + (size_t)e * 2 * DFF * DM + (size_t)drow * DM + 64 * kb, DM, SC_W, scr, F.lane); continue; } r -= I_GU;
        { const int e = r >> 9, kb = (r >> 5) & 15, nb = r & 31;
            transpose_item8(P.in[18] + (size_t)e * DFF * DM + (size_t)(64 * kb) * DM + 32 * nb, DM, WdT + (size_t)e * DM * DFF + (size_t)(32 * nb) * DFF + 64 * kb, DFF, SC_W, scr, F.lane); }
    }
    {
        const float* wr = P.in[14]; float* wrt = (float*)(ws + WS_WRT);
        for (int idx = F.vcu * NTHR + F.tid; idx < DM * NE; idx += F.G * NTHR) wrt[(idx & 31) * DM + (idx >> 5)] = wr[idx];
    }
    const float* x = P.in[0]; const float* g1 = P.in[1];
    bf16_t* XN = (bf16_t*)(ws + WS_XN); float* GATE = (float*)(ws + WS_GATE);
    for (int row = F.gw; row < T; row += F.ngw) {
        const f32x4* xr = (const f32x4*)(x + (size_t)row * DM);
        f32x4 v[4]; float s = 0.f;
#pragma unroll
        for (int j = 0; j < 4; ++j) { v[j] = xr[F.lane + 64 * j]; s += v[j][0] * v[j][0] + v[j][1] * v[j][1] + v[j][2] * v[j][2] + v[j][3] * v[j][3]; }
        s = wave_sum(s);
        const float rs = 1.0f / sqrtf(s * (1.0f / DM) + EPS);
        float ga[8];
#pragma unroll
        for (int c = 0; c < 8; ++c) ga[c] = 0.f;
#pragma unroll
        for (int j = 0; j < 4; ++j) { const f32x4 gg = ((const f32x4*)g1)[F.lane + 64 * j]; v[j] = v[j] * rs * gg;
            u32x2 w; w.x = pk2(v[j][0], v[j][1]); w.y = pk2(v[j][2], v[j][3]);
            *(u32x2*)(XN + (size_t)row * DM + 4 * (F.lane + 64 * j)) = w;
#pragma unroll
            for (int q = 0; q < 4; ++q) { const int k = 4 * (F.lane + 64 * j) + q; const f32x4 w0 = *(const LAS f32x4*)(gwl + k * 8), w1 = *(const LAS f32x4*)(gwl + k * 8 + 4);
                ga[0] += v[j][q] * w0[0]; ga[1] += v[j][q] * w0[1]; ga[2] += v[j][q] * w0[2]; ga[3] += v[j][q] * w0[3];
                ga[4] += v[j][q] * w1[0]; ga[5] += v[j][q] * w1[1]; ga[6] += v[j][q] * w1[2]; ga[7] += v[j][q] * w1[3]; } }
#pragma unroll
        for (int c = 0; c < 8; ++c) ga[c] = wave_sum(ga[c]);
        if (F.lane == 0) { *(f32x4*)(GATE + (size_t)row * 8) = (f32x4){ga[0], ga[1], ga[2], ga[3]}; *(f32x4*)(GATE + (size_t)row * 8 + 4) = (f32x4){ga[4], ga[5], ga[6], ga[7]}; }
    }
}

__device__ __forceinline__ void p2_tokprep(const Params& P, Frame& F) {
    bf16_t* Z = (bf16_t*)(P.ws + WS_Z); bf16_t* XC = (bf16_t*)(P.ws + WS_XC);
    const float* gq = P.in[3]; const float* gk = P.in[4]; const float* cw = P.in[5]; const float* cb = P.in[6];
    const int lane = F.lane;
    for (int tok = F.gw; tok < T; tok += F.ngw) {
        bf16_t* zr = Z + (size_t)tok * NZ;
#pragma unroll
        for (int part = 0; part < 2; ++part) {
            bf16_t* p = zr + (part ? ZK : ZQ) + lane * 8;
            const float* g = (part ? gk : gq) + (lane & 7) * 8;
            const u32x4 w = *(const u32x4*)p;
            float a[8] = {bflo(w.x), bfhi(w.x), bflo(w.y), bfhi(w.y), bflo(w.z), bfhi(w.z), bflo(w.w), bfhi(w.w)};
            float s = 0.f;
#pragma unroll
            for (int i = 0; i < 8; ++i) s += a[i] * a[i];
            s += __shfl_xor(s, 1); s += __shfl_xor(s, 2); s += __shfl_xor(s, 4);
            float r = 1.0f / sqrtf(s * (1.0f / 64.f) + EPS); if (!part) r *= 0.125f * LOG2E;
#pragma unroll
            for (int i = 0; i < 8; ++i) a[i] *= r * g[i];
            u32x4 o; o.x = pk2(a[0], a[1]); o.y = pk2(a[2], a[3]); o.z = pk2(a[4], a[5]); o.w = pk2(a[6], a[7]);
            *(u32x4*)p = o;
        }
        for (int crep = 0; crep < ((DUP & 2048) ? 2 : 1); ++crep) {
            const int tl = tok % SEQ; const int ch = lane * 8;
            float a[8];
#pragma unroll
            for (int i = 0; i < 8; ++i) a[i] = cb[ch + i];
#pragma unroll
            for (int j = 0; j < 4; ++j) { const int dt = 3 - j; if (tl - dt >= 0) {
                    const u32x4 w = *(const u32x4*)(Z + (size_t)(tok - dt) * NZ + ZXM + ch);
                    const float xv[8] = {bflo(w.x), bfhi(w.x), bflo(w.y), bfhi(w.y), bflo(w.z), bfhi(w.z), bflo(w.w), bfhi(w.w)};
#pragma unroll
                    for (int i = 0; i < 8; ++i) a[i] += cw[j * 512 + ch + i] * xv[i]; } }
#pragma unroll
            for (int i = 0; i < 8; ++i) a[i] = a[i] * sigmoidf_(a[i]);
            u32x4 o; o.x = pk2(a[0], a[1]); o.y = pk2(a[2], a[3]); o.z = pk2(a[4], a[5]); o.w = pk2(a[6], a[7]);
            *(u32x4*)(XC + (size_t)tok * 512 + ch) = o;
        }
    }
}

__device__ __forceinline__ void attn_phase(const Params& P, Frame& F) {
    const bf16_t* Z = (const bf16_t*)(P.ws + WS_Z); bf16_t* MIX = (bf16_t*)(P.ws + WS_MIX);
    const int lane = F.lane, i = lane & 15, g = lane >> 4;
    float gm = fabsf(P.in[4][lane]);
#pragma unroll
    for (int o = 1; o < 64; o <<= 1) gm = fmaxf(gm, __shfl_xor(gm, o));
    const float kmax = 8.0f * gm * 1.01f;
    LAS unsigned char* vb = F.lds + F.wave * 4608;
    const int vwr = (lane >> 3) * 144 + (lane & 7) * 16;
    const int vrd = (4 * g + (i >> 2)) * 144 + (i & 3) * 8;
    for (int tile = F.gw; tile < 8192; tile += F.ngw) {
        const int r = tile & 15, blk = (tile >> 4) & 31, h = (tile >> 9) & 7, b = tile >> 12;
        const int tl0 = blk * 256 + r, T0 = b * SEQ + tl0;
        const bf16_t* qrow = Z + (size_t)(T0 + 16 * i) * NZ + ZQ + h * 64;
        const bf16x8 qf0 = *(const bf16x8*)(qrow + 8 * g), qf1 = *(const bf16x8*)(qrow + 32 + 8 * g);
        float ss = 0.f;
#pragma unroll
        for (int j = 0; j < 8; ++j) { const float a = bf2f((unsigned short)qf0[j]), c = bf2f((unsigned short)qf1[j]); ss += a * a + c * c; }
        ss += __shfl_xor(ss, 16); ss += __shfl_xor(ss, 32);
        const float ref = sqrtf(ss) * kmax;
        const float slope2 = exp2f(-(float)(h + 1)) * LOG2E;
        f32x4 o[4];
#pragma unroll
        for (int dt = 0; dt < 4; ++dt) o[dt] = (f32x4){0.f, 0.f, 0.f, 0.f};
        float lsum = 0.f;
        const bf16_t* Kh = Z + (size_t)b * SEQ * NZ + ZK + h * 64 + 8 * g;
        const bf16_t* Vh = Z + (size_t)b * SEQ * NZ + ZV + h * 64 + 8 * (lane & 7);
        bf16x8 kfn[2][2]; u32x4 vrn[4];
#define ATT_LOAD(bi_) do { const int bi__ = (bi_); const int br_ = bi__ < 12 ? 0 : (bi__ < 18 ? 1 : 2); const int d_ = 1 << (2 * br_); const int nb_ = -128 + 32 * (bi__ - (br_ == 0 ? 0 : (br_ == 1 ? 12 : 18))); \
        _Pragma("unroll") for (int sb = 0; sb < 2; ++sb) { int kp = tl0 + (nb_ + 16 * sb + i) * d_; kp = kp < 0 ? 0 : (kp > SEQ - 1 ? SEQ - 1 : kp); const bf16_t* kr = Kh + (size_t)kp * NZ; kfn[sb][0] = *(const bf16x8*)kr; kfn[sb][1] = *(const bf16x8*)(kr + 32); } \
        _Pragma("unroll") for (int c = 0; c < 4; ++c) { int kp = tl0 + (nb_ + 8 * c + (lane >> 3)) * d_; kp = kp < 0 ? 0 : (kp > SEQ - 1 ? SEQ - 1 : kp); vrn[c] = *(const u32x4*)(Vh + (size_t)kp * NZ); } } while (0)
        ATT_LOAD(0);
        for (int bi = 0; bi < 23; ++bi) {
            bf16x8 kf[2][2]; u32x4 vr[4];
#pragma unroll
            for (int sb = 0; sb < 2; ++sb) { kf[sb][0] = kfn[sb][0]; kf[sb][1] = kfn[sb][1]; }
#pragma unroll
            for (int c = 0; c < 4; ++c) vr[c] = vrn[c];
            if (bi + 1 < 23) ATT_LOAD(bi + 1);
            const int br = bi < 12 ? 0 : (bi < 18 ? 1 : 2), dd = 1 << (2 * br), u = 16 / dd;
            const int nb = -128 + 32 * (bi - (br == 0 ? 0 : (br == 1 ? 12 : 18)));
#pragma unroll
            for (int c = 0; c < 4; ++c) *(LAS u32x4*)(vb + vwr + c * 8 * 144) = vr[c];
            f32x4 s[2];
#pragma unroll
            for (int sb = 0; sb < 2; ++sb) { s[sb] = __builtin_amdgcn_mfma_f32_16x16x32_bf16(kf[sb][0], qf0, (f32x4){0.f, 0.f, 0.f, 0.f}, 0, 0, 0);
                s[sb] = __builtin_amdgcn_mfma_f32_16x16x32_bf16(kf[sb][1], qf1, s[sb], 0, 0, 0); }
            float p[8];
#pragma unroll
            for (int sb = 0; sb < 2; ++sb)
#pragma unroll
                for (int j = 0; j < 4; ++j) { const int n = nb + 16 * sb + 4 * g + j, a = u * i - n;
                    const bool valid = (a >= 0) && (a <= 128) && (tl0 + n * dd >= 0);
                    const float e = s[sb][j] - slope2 * (float)(a * dd) - ref;
                    const float pv = valid ? __builtin_amdgcn_exp2f(e) : 0.f;
                    p[4 * sb + j] = pv; lsum += pv; }
            u32x4 pw; pw.x = pk2(p[0], p[1]); pw.y = pk2(p[2], p[3]); pw.z = pk2(p[4], p[5]); pw.w = pk2(p[6], p[7]);
            const bf16x8 pf = __builtin_bit_cast(bf16x8, pw);
#pragma unroll
            for (int dt = 0; dt < 4; ++dt) {
                const s16x4 v0 = __builtin_amdgcn_ds_read_tr16_b64_v4i16((LAS s16x4*)(vb + vrd + dt * 32));
                const s16x4 v1 = __builtin_amdgcn_ds_read_tr16_b64_v4i16((LAS s16x4*)(vb + vrd + 16 * 144 + dt * 32));
                const bf16x8 vf = (bf16x8){v0[0], v0[1], v0[2], v0[3], v1[0], v1[1], v1[2], v1[3]};
                o[dt] = __builtin_amdgcn_mfma_f32_16x16x32_bf16(vf, pf, o[dt], 0, 0, 0);
            }
        }
#undef ATT_LOAD
        lsum += __shfl_xor(lsum, 16); lsum += __shfl_xor(lsum, 32);
        const float inv = 1.0f / lsum;
        bf16_t* orow = MIX + (size_t)(T0 + 16 * i) * DM + h * 64 + 4 * g;
#pragma unroll
        for (int dt = 0; dt < 4; ++dt) { u32x2 w; w.x = pk2(o[dt][0] * inv, o[dt][1] * inv); w.y = pk2(o[dt][2] * inv, o[dt][3] * inv); *(u32x2*)(orow + 16 * dt) = w; }
    }
}

__device__ __forceinline__ bf16x8 tr2(LAS unsigned char* p0, LAS unsigned char* p1) {
    const s16x4 a = __builtin_amdgcn_ds_read_tr16_b64_v4i16((LAS s16x4*)p0);
    const s16x4 b = __builtin_amdgcn_ds_read_tr16_b64_v4i16((LAS s16x4*)p1);
    return (bf16x8){a[0], a[1], a[2], a[3], b[0], b[1], b[2], b[3]};
}
#define MFMA16(a, b, c) __builtin_amdgcn_mfma_f32_16x16x32_bf16((a), (b), (c), 0, 0, 0)

__device__ __forceinline__ void ml1_phase(const Params& P, Frame& F) {
    const bf16_t* Z = (const bf16_t*)(P.ws + WS_Z); const bf16_t* QK = (const bf16_t*)(P.ws + WS_QK); const float* GATE = (const float*)(P.ws + WS_GATE);
    float* BC = (float*)(P.ws + WS_BC); float* IG = (float*)(P.ws + WS_IG); float* BT = (float*)(P.ws + WS_BT); float* U = (float*)(P.ws + WS_U); float* NV = (float*)(P.ws + WS_NV);
    const float* bi = P.in[9]; const float* bf = P.in[10];
    constexpr int PIT = 272;
    LAS unsigned char* KIM = F.lds; LAS unsigned char* VIM = F.lds + 128 * PIT;
    LAS float* bc = (LAS float*)(F.lds + 2 * 128 * PIT); LAS float* wv = bc + 256;
    const int tid = F.tid, lane = F.lane, i = lane & 15, g = lane >> 4, w = F.wave;
    bf16x8 ones;
#pragma unroll
    for (int j = 0; j < 8; ++j) ones[j] = (i == 0) ? (short)0x3F80 : (short)0;
    for (int unit = F.vcu; unit < 256; unit += F.G) {
        const int bh = unit / NCH, c = unit % NCH, b = bh / NHM, h = bh % NHM, t0 = b * SEQ + c * CH;
        float ig = 0.f;
        __syncthreads();
        if (tid < 256) { const float f = GATE[(size_t)(t0 + tid) * 8 + 4 + h] + bf[h];
            bc[tid] = fminf(f, 0.f) - log1pf(__expf(-fabsf(f)));
            ig = GATE[(size_t)(t0 + tid) * 8 + h] + bi[h]; }
        __syncthreads();
        if (w == 0) {
            const f32x4 a = *(const LAS f32x4*)(bc + 4 * lane);
            const float s1 = a[0], s2 = s1 + a[1], s3 = s2 + a[2], s4 = s3 + a[3];
            float x = s4;
#pragma unroll
            for (int off = 1; off < 64; off <<= 1) { const float v = __shfl_up(x, off); if (lane >= off) x += v; }
            const float ex = x - s4;
            *(LAS f32x4*)(bc + 4 * lane) = (f32x4){ex + s1, ex + s2, ex + s3, ex + s4};
        }
        __syncthreads();
        if (tid < 256) { BC[(size_t)(t0 + tid) * 4 + h] = bc[tid]; IG[(size_t)(t0 + tid) * 4 + h] = ig; wv[tid] = __expf(bc[255] - bc[tid] + ig); }
        if (tid == 0) BT[unit] = bc[255];
        f32x4 acc[9];
#pragma unroll
        for (int q = 0; q < 9; ++q) acc[q] = (f32x4){0.f, 0.f, 0.f, 0.f};
        for (int half = 0; half < 2; ++half) {
            __syncthreads();
#pragma unroll
            for (int q = 0; q < 4; ++q) { const int id = tid + 512 * q, row = id >> 4, c8 = (id & 15) * 8, sidx = half * 128 + row;
                const u32x4 kw = *(const u32x4*)(QK + (size_t)(t0 + sidx) * 1024 + 512 + h * 128 + c8);
                const u32x4 vw = *(const u32x4*)(Z + (size_t)(t0 + sidx) * NZ + ZVM + h * 128 + c8);
                const float ws_ = wv[sidx];
                u32x4 ks; ks.x = pk2(bflo(kw.x) * ws_, bfhi(kw.x) * ws_); ks.y = pk2(bflo(kw.y) * ws_, bfhi(kw.y) * ws_); ks.z = pk2(bflo(kw.z) * ws_, bfhi(kw.z) * ws_); ks.w = pk2(bflo(kw.w) * ws_, bfhi(kw.w) * ws_);
                *(LAS u32x4*)(KIM + row * PIT + c8 * 2) = ks; *(LAS u32x4*)(VIM + row * PIT + c8 * 2) = vw; }
            __syncthreads();
#pragma unroll
            for (int kk = 0; kk < 4; ++kk) {
                const int ro = (32 * kk + 8 * g + (i >> 2)) * PIT + (i & 3) * 8;
                const bf16x8 af = tr2(KIM + ro + 32 * w, KIM + ro + 4 * PIT + 32 * w);
#pragma unroll
                for (int et = 0; et < 8; ++et) { const bf16x8 bfr = tr2(VIM + ro + 32 * et, VIM + ro + 4 * PIT + 32 * et); acc[et] = MFMA16(af, bfr, acc[et]); }
                acc[8] = MFMA16(af, ones, acc[8]);
            }
        }
        float* up = U + (size_t)unit * 16384 + (size_t)(16 * w + 4 * g) * 128 + i;
#pragma unroll
        for (int et = 0; et < 8; ++et)
#pragma unroll
            for (int j = 0; j < 4; ++j) up[j * 128 + 16 * et] = acc[et][j];
        if (i == 0) {
#pragma unroll
            for (int j = 0; j < 4; ++j) NV[unit * 128 + 16 * w + 4 * g + j] = acc[8][j];
        }
    }
}

__device__ __forceinline__ void ml3_phase(const Params& P, Frame& F) {
    const bf16_t* Z = (const bf16_t*)(P.ws + WS_Z); const bf16_t* QK = (const bf16_t*)(P.ws + WS_QK);
    const float* BC = (const float*)(P.ws + WS_BC); const float* IG = (const float*)(P.ws + WS_IG); const float* BT = (const float*)(P.ws + WS_BT);
    const float* U = (const float*)(P.ws + WS_U); const float* NV = (const float*)(P.ws + WS_NV); const float* gn = P.in[11];
    bf16_t* MIX = (bf16_t*)(P.ws + WS_MIX);
    constexpr int CP = 288, VP = 272;
    LAS unsigned char* CIM = F.lds;
    LAS unsigned char* VIM = F.lds + 128 * CP;
    LAS float* cs = (LAS float*)(F.lds + 128 * CP + 256 * VP);
    LAS float* bq = cs + 256;
    const int tid = F.tid, lane = F.lane, i = lane & 15, g = lane >> 4, w = F.wave;
    for (int unit = F.vcu; unit < 256; unit += F.G) {
        const int bh = unit / NCH, c = unit % NCH, b = bh / NHM, h = bh % NHM, t0 = b * SEQ + c * CH;
        __syncthreads();
#pragma unroll
        for (int q = 0; q < 8; ++q) { const int id = tid + 512 * q, row = id >> 4, c8 = (id & 15) * 8;
            *(LAS u32x4*)(VIM + row * VP + c8 * 2) = *(const u32x4*)(Z + (size_t)(t0 + row) * NZ + ZVM + h * 128 + c8); }
        if (tid < 256) { const float bb = BC[(size_t)(t0 + tid) * 4 + h]; bq[tid] = bb; cs[tid] = IG[(size_t)(t0 + tid) * 4 + h] - bb; }
        {   f32x4 cc[4][2]; float n = 0.f;
#pragma unroll
            for (int q = 0; q < 4; ++q) { cc[q][0] = (f32x4){0.f, 0.f, 0.f, 0.f}; cc[q][1] = (f32x4){0.f, 0.f, 0.f, 0.f}; }
            for (int j = 0; j < c; ++j) {
                const float dec = __expf(BT[bh * NCH + j]);
                const float* up = U + (size_t)(bh * NCH + j) * 16384;
#pragma unroll
                for (int q = 0; q < 4; ++q) { const int id = tid + 512 * q; const f32x4 u0 = *(const f32x4*)(up + id * 8), u1 = *(const f32x4*)(up + id * 8 + 4);
                    cc[q][0] = cc[q][0] * dec + u0; cc[q][1] = cc[q][1] * dec + u1; }
                if (tid < 128) n = dec * n + NV[(bh * NCH + j) * 128 + tid];
            }
#pragma unroll
            for (int q = 0; q < 4; ++q) { const int id = tid + 512 * q, d = id >> 4, e8 = (id & 15) * 8;
                u32x4 o; o.x = pk2(cc[q][0][0], cc[q][0][1]); o.y = pk2(cc[q][0][2], cc[q][0][3]); o.z = pk2(cc[q][1][0], cc[q][1][1]); o.w = pk2(cc[q][1][2], cc[q][1][3]);
                *(LAS u32x4*)(CIM + d * CP + e8 * 2) = o; }
            if (tid < 128) { *(LAS u32x4*)(CIM + tid * CP + 256) = (u32x4){f2bf(n), 0u, 0u, 0u}; *(LAS u32x4*)(CIM + tid * CP + 272) = (u32x4){0u, 0u, 0u, 0u}; }
        }
        __syncthreads();
#pragma unroll 1
        for (int a = 0; a < 2; ++a) {
            const int qt = a ? 15 - w : w;
            bf16x8 qf[4];
            { const bf16_t* qp = QK + (size_t)(t0 + 16 * qt + i) * 1024 + h * 128 + 8 * g;
#pragma unroll
                for (int ks = 0; ks < 4; ++ks) qf[ks] = *(const bf16x8*)(qp + 32 * ks); }
            const float bt = bq[16 * qt + i];
            f32x4 acc[8]; float den;
            {
                f32x4 a8 = (f32x4){0.f, 0.f, 0.f, 0.f};
#pragma unroll
                for (int et = 0; et < 8; ++et) acc[et] = (f32x4){0.f, 0.f, 0.f, 0.f};
#pragma unroll
                for (int ks = 0; ks < 4; ++ks) {
                    const int ro = (32 * ks + 8 * g + (i >> 2)) * CP + (i & 3) * 8;
#pragma unroll
                    for (int et = 0; et < 8; ++et) { const bf16x8 cf = tr2(CIM + ro + 32 * et, CIM + ro + 4 * CP + 32 * et); acc[et] = MFMA16(cf, qf[ks], acc[et]); }
                    const bf16x8 cf = tr2(CIM + ro + 256, CIM + ro + 4 * CP + 256);
                    a8 = MFMA16(cf, qf[ks], a8);
                }
                const float eb = __expf(bt);
#pragma unroll
                for (int et = 0; et < 8; ++et) acc[et] = acc[et] * eb;
                den = (g == 0) ? a8[0] * eb : 0.f;
            }
            const int kbhi = qt >> 1;
#pragma unroll 1
            for (int kb = 0; kb <= kbhi; ++kb) {
                float p[8];
#pragma unroll
                for (int sb = 0; sb < 2; ++sb) {
                    const bf16_t* kp = QK + (size_t)(t0 + 32 * kb + 16 * sb + i) * 1024 + 512 + h * 128 + 8 * g;
                    f32x4 sacc = (f32x4){0.f, 0.f, 0.f, 0.f};
#pragma unroll
                    for (int ks = 0; ks < 4; ++ks) { const bf16x8 kf = *(const bf16x8*)(kp + 32 * ks); sacc = MFMA16(kf, qf[ks], sacc); }
                    const f32x4 cv = *(const LAS f32x4*)(cs + 32 * kb + 16 * sb + 4 * g);
#pragma unroll
                    for (int j = 0; j < 4; ++j) { const int srow = 32 * kb + 16 * sb + 4 * g + j, tcol = 16 * qt + i;
                        const float pv = (srow <= tcol) ? sacc[j] * __expf(bt + cv[j]) : 0.f;
                        p[4 * sb + j] = pv; den += pv; } }
                u32x4 pw; pw.x = pk2(p[0], p[1]); pw.y = pk2(p[2], p[3]); pw.z = pk2(p[4], p[5]); pw.w = pk2(p[6], p[7]);
                const bf16x8 pf = __builtin_bit_cast(bf16x8, pw);
                const int ro = (32 * kb + 4 * g + (i >> 2)) * VP + (i & 3) * 8;
#pragma unroll
                for (int et = 0; et < 8; ++et) { const bf16x8 vf = tr2(VIM + ro + 32 * et, VIM + ro + 16 * VP + 32 * et); acc[et] = MFMA16(vf, pf, acc[et]); }
            }
            float dn = den; dn += __shfl_xor(dn, 16); dn += __shfl_xor(dn, 32);
            const float dd = 1.0f / fmaxf(fabsf(dn), 1.0f);
            float ss = 0.f;
#pragma unroll
            for (int et = 0; et < 8; ++et) { acc[et] = acc[et] * dd; ss += acc[et][0] * acc[et][0] + acc[et][1] * acc[et][1] + acc[et][2] * acc[et][2] + acc[et][3] * acc[et][3]; }
            ss += __shfl_xor(ss, 16); ss += __shfl_xor(ss, 32);
            const float rstd = 1.0f / sqrtf(ss * (1.0f / HDM) + EPS);
            const int tok = t0 + 16 * qt + i;
#pragma unroll
            for (int et = 0; et < 8; ++et) { const int e0 = 16 * et + 4 * g;
                const u32x2 ow = *(const u32x2*)(Z + (size_t)tok * NZ + ZOM + h * 128 + e0);
                const f32x4 gv = *(const f32x4*)(gn + h * 128 + e0);
                const float r0 = sigmoidf_(bflo(ow.x)) * acc[et][0] * rstd * gv[0], r1 = sigmoidf_(bfhi(ow.x)) * acc[et][1] * rstd * gv[1];
                const float r2 = sigmoidf_(bflo(ow.y)) * acc[et][2] * rstd * gv[2], r3 = sigmoidf_(bfhi(ow.y)) * acc[et][3] * rstd * gv[3];
                u32x2 o; o.x = pk2(r0, r1); o.y = pk2(r2, r3);
                *(u32x2*)(MIX + (size_t)tok * DM + 512 + h * 128 + e0) = o; }
        }
    }
}

__device__ __forceinline__ void router_phase(const Params& P, Frame& F, const bool commit) {
    const float* X1 = P.out; const float* g2 = P.in[13]; const float* wrt = (const float*)(P.ws + WS_WRT); const float* br = P.in[15];
    unsigned char* H8 = P.ws + WS_H8; int* cnt = (int*)(P.ws + WS_CTL); int* ltok = (int*)(P.ws + WS_LTOK); float* lgate = (float*)(P.ws + WS_LGATE); int* tke = (int*)(P.ws + WS_TKE);
    LAS int* lcnt = (LAS int*)(F.lds);
    LAS int* pe = lcnt + 64;
    LAS float* pg = (LAS float*)(pe + 256);
    const int lane = F.lane, tid = F.tid;
    for (int chunk = F.vcu; chunk < T / 64; chunk += F.G) {
        __syncthreads();
        if (tid < 64) lcnt[tid] = 0;
        __syncthreads();
        {
            f32x4 v[8][4];
#pragma unroll
            for (int tt = 0; tt < 8; ++tt) {
                const int tok = chunk * 64 + F.wave * 8 + tt;
                const f32x4* xr = (const f32x4*)(X1 + (size_t)tok * DM);
                float s = 0.f;
#pragma unroll
                for (int j = 0; j < 4; ++j) { v[tt][j] = xr[lane + 64 * j]; s += v[tt][j][0] * v[tt][j][0] + v[tt][j][1] * v[tt][j][1] + v[tt][j][2] * v[tt][j][2] + v[tt][j][3] * v[tt][j][3]; }
                s = wave_sum(s);
                const float r = 1.0f / sqrtf(s * (1.0f / DM) + EPS);
#pragma unroll
                for (int j = 0; j < 4; ++j) { const f32x4 gg = ((const f32x4*)g2)[lane + 64 * j]; v[tt][j] = v[tt][j] * r * gg;
                    *(unsigned*)(H8 + (size_t)tok * DM + 4 * (lane + 64 * j)) = pk4_fp8(v[tt][j][0] * SC_H, v[tt][j][1] * SC_H, v[tt][j][2] * SC_H, v[tt][j][3] * SC_H); }
            }
            const bool b0 = lane & 1, b1 = lane & 2, b2 = lane & 4;
            float tv0 = -INFINITY, tv1 = -INFINITY, tv2 = -INFINITY, tv3 = -INFINITY; int te0 = 0, te1 = 0, te2 = 0, te3 = 0;
#pragma unroll 2
            for (int e = 0; e < NE; ++e) {
                const f32x4* wrow = (const f32x4*)(wrt + (size_t)e * DM);
                f32x4 w4[4];
#pragma unroll
                for (int j = 0; j < 4; ++j) w4[j] = wrow[lane + 64 * j];
                float a[8];
#pragma unroll
                for (int tt = 0; tt < 8; ++tt) { float pa = 0.f;
#pragma unroll
                    for (int j = 0; j < 4; ++j) pa += v[tt][j][0] * w4[j][0] + v[tt][j][1] * w4[j][1] + v[tt][j][2] * w4[j][2] + v[tt][j][3] * w4[j][3];
                    a[tt] = pa; }
                float k0 = b0 ? a[4] : a[0], k1 = b0 ? a[5] : a[1], k2 = b0 ? a[6] : a[2], k3 = b0 ? a[7] : a[3];
                k0 += __shfl_xor(b0 ? a[0] : a[4], 1); k1 += __shfl_xor(b0 ? a[1] : a[5], 1); k2 += __shfl_xor(b0 ? a[2] : a[6], 1); k3 += __shfl_xor(b0 ? a[3] : a[7], 1);
                float m0 = b1 ? k2 : k0, m1 = b1 ? k3 : k1;
                m0 += __shfl_xor(b1 ? k0 : k2, 2); m1 += __shfl_xor(b1 ? k1 : k3, 2);
                float d = b2 ? m1 : m0;
                d += __shfl_xor(b2 ? m0 : m1, 4);
                d += __shfl_xor(d, 8); d += __shfl_xor(d, 16); d += __shfl_xor(d, 32);
                const float x = d + br[e];
                const bool g0 = x > tv0, g1 = x > tv1, g2_ = x > tv2, g3 = x > tv3;
                tv3 = g2_ ? tv2 : (g3 ? x : tv3); te3 = g2_ ? te2 : (g3 ? e : te3);
                tv2 = g1 ? tv1 : (g2_ ? x : tv2); te2 = g1 ? te1 : (g2_ ? e : te2);
                tv1 = g0 ? tv0 : (g1 ? x : tv1); te1 = g0 ? te0 : (g1 ? e : te1);
                tv0 = g0 ? x : tv0; te0 = g0 ? e : te0;
            }
            const float e1 = __expf(tv1 - tv0), e2 = __expf(tv2 - tv0), e3 = __expf(tv3 - tv0);
            const float inv = 1.0f / (1.0f + e1 + e2 + e3);
            if (lane < 8) {
                const int tl = F.wave * 8 + (b0 ? 4 : 0) + (b1 ? 2 : 0) + (b2 ? 1 : 0);
                const int rk0 = __hip_atomic_fetch_add((int*)(lcnt + te0), 1, __ATOMIC_RELAXED, __HIP_MEMORY_SCOPE_WORKGROUP);
                const int rk1 = __hip_atomic_fetch_add((int*)(lcnt + te1), 1, __ATOMIC_RELAXED, __HIP_MEMORY_SCOPE_WORKGROUP);
                const int rk2 = __hip_atomic_fetch_add((int*)(lcnt + te2), 1, __ATOMIC_RELAXED, __HIP_MEMORY_SCOPE_WORKGROUP);
                const int rk3 = __hip_atomic_fetch_add((int*)(lcnt + te3), 1, __ATOMIC_RELAXED, __HIP_MEMORY_SCOPE_WORKGROUP);
                pe[tl * 4 + 0] = te0 | (rk0 << 8); pe[tl * 4 + 1] = te1 | (rk1 << 8); pe[tl * 4 + 2] = te2 | (rk2 << 8); pe[tl * 4 + 3] = te3 | (rk3 << 8);
                pg[tl * 4 + 0] = inv; pg[tl * 4 + 1] = e1 * inv; pg[tl * 4 + 2] = e2 * inv; pg[tl * 4 + 3] = e3 * inv;
            }
        }
        __syncthreads();
        if (tid < NE && commit) { const int n = lcnt[tid]; lcnt[32 + tid] = n ? atomicAdd(&cnt[64 * tid], n) : 0; }
        __syncthreads();
        if (tid < 256 && commit) { const int w = pe[tid], ee = w & 255, p = lcnt[32 + ee] + (w >> 8), tok = chunk * 64 + (tid >> 2);
            ltok[ee * T + p] = tok; lgate[ee * T + p] = pg[tid]; tke[tok * 4 + (tid & 3)] = ee | (p << 8); }
    }
}

__device__ __forceinline__ void build_tables(const Params& P, Frame& F) {
    LAS int* trs = (LAS int*)(F.lds + LDS_TAB); LAS int* cnts = trs + 64;
    const int* cnt = (const int*)(P.ws + WS_CTL);
    if (F.tid == 0) { int a = 0; for (int e = 0; e < NE; ++e) { const int n = cnt[64 * e]; trs[e] = a; cnts[e] = n; a += (n + 255) >> 8; } trs[NE] = a; }
    __syncthreads();
}

__device__ __forceinline__ void combine_phase(const Params& P, Frame& F, const bool commit) {
    const LAS int* trs = (const LAS int*)(F.lds + LDS_TAB);
    const bf16_t* Y = (const bf16_t*)(P.ws + WS_Y); const int* tke = (const int*)(P.ws + WS_TKE);
    float* out = P.out; const int lane = F.lane;
    for (int tok = F.gw; tok < T; tok += F.ngw) {
        f32x4 a[4];
#pragma unroll
        for (int j = 0; j < 4; ++j) a[j] = *(const f32x4*)(out + (size_t)tok * DM + 4 * (lane + 64 * j));
#pragma unroll
        for (int k = 0; k < 4; ++k) { const int w = tke[tok * 4 + k], e = w & 255, p = w >> 8; const size_t slot = (size_t)trs[e] * 256 + p;
#pragma unroll
            for (int j = 0; j < 4; ++j) { const u32x2 y = *(const u32x2*)(Y + slot * DM + 4 * (lane + 64 * j)); a[j][0] += bflo(y.x); a[j][1] += bfhi(y.x); a[j][2] += bflo(y.y); a[j][3] += bfhi(y.y); } }
#pragma unroll
        for (int j = 0; j < 4; ++j) if (commit || a[j][0] == 123456.789f) *(f32x4*)(out + (size_t)tok * DM + 4 * (lane + 64 * j)) = a[j];
    }
}


#define XB_TMO      128
#define XB_XCNT(j)  (256  + 64 * (j))
#define XB_XSUB(j)  (1280 + 64 * (j))
#define XB_XGEN(j)  (2304 + 64 * (j))
#define XB_TOP      3328
#define XB_TOPGEN   3392
#define XCD_BAR_WORDS 3456
#define XB_SPIN_CAP (1u << 18)
__device__ __forceinline__ unsigned xb_ld(unsigned* p)              { return __hip_atomic_load(p, __ATOMIC_RELAXED, __HIP_MEMORY_SCOPE_AGENT); }
__device__ __forceinline__ unsigned xb_add(unsigned* p, unsigned v) { return __hip_atomic_fetch_add(p, v, __ATOMIC_RELAXED, __HIP_MEMORY_SCOPE_AGENT); }
__device__ __forceinline__ unsigned xb_xcc_id() { return (unsigned)__builtin_amdgcn_s_getreg((3 << 11) | 20) & 0xFu; }
#define XB_SPIN(cond, bar) do { unsigned _sp = 0; while (cond) { __builtin_amdgcn_s_sleep(1); \
    if ((++_sp & 255u) == 0u) { if (xb_ld(&(bar)[XB_TMO])) break; if (_sp > XB_SPIN_CAP) { atomicAdd(&(bar)[XB_TMO], 1u); break; } } } } while (0)
struct XcdBarrier { unsigned* bar; unsigned x; volatile LAS unsigned* st; };
__device__ __forceinline__ XcdBarrier xcd_barrier_post(unsigned* bar, volatile LAS unsigned* st) {
    XcdBarrier b; b.bar = bar; b.x = xb_xcc_id(); b.st = st;
    if (threadIdx.x == 0) (void)xb_add(&bar[XB_XCNT(b.x)], 1u);
    return b;
}
__device__ __forceinline__ void xcd_barrier_complete(unsigned* bar, unsigned x, unsigned& nloc, unsigned& nx) {
    const unsigned G = gridDim.x * gridDim.y * gridDim.z;
    unsigned sum, cnt, mine, sp = 0u;
    for (;;) {
        sum = 0u; cnt = 0u; mine = 0u;
#pragma unroll
        for (unsigned j = 0; j < 16; ++j) { const unsigned c = xb_ld(&bar[XB_XCNT(j)]); sum += c; cnt += (c > 0u) ? 1u : 0u; mine = (j == x) ? c : mine; }
        if (sum == G) break;
        __builtin_amdgcn_s_sleep(1);
        if ((++sp & 255u) == 0u) { if (xb_ld(&bar[XB_TMO])) break; if (sp > XB_SPIN_CAP) { atomicAdd(&bar[XB_TMO], 1u); break; } }
    }
    nloc = mine > 0u ? mine : 1u; nx = cnt > 0u ? cnt : 1u;
}
__device__ __forceinline__ void xcd_barrier(const XcdBarrier& b) {
    asm volatile("s_waitcnt vmcnt(0)" ::: "memory");
    __syncthreads();
    if (threadIdx.x == 0) {
        unsigned* bar = b.bar;
        __builtin_amdgcn_s_waitcnt(0);
        unsigned nloc = b.st[0], nx = b.st[1];
        if (nloc == 0u) { xcd_barrier_complete(bar, b.x, nloc, nx); b.st[0] = nloc; b.st[1] = nx; }
        const unsigned old = xb_add(&bar[XB_XSUB(b.x)], 1u);
        const unsigned gen = old / nloc;
        if (old + 1u == (gen + 1u) * nloc) {
            __builtin_amdgcn_fence(__ATOMIC_RELEASE, "agent");
            asm volatile("s_waitcnt vmcnt(0)" ::: "memory");
            const unsigned og = xb_add(&bar[XB_TOP], 1u);
            const unsigned tg = og / nx;
            if (og + 1u == (tg + 1u) * nx) xb_add(&bar[XB_TOPGEN], 1u);
            else XB_SPIN(xb_ld(&bar[XB_TOPGEN]) == tg, bar);
            __builtin_amdgcn_fence(__ATOMIC_ACQUIRE, "agent");
            xb_add(&bar[XB_XGEN(b.x)], 1u);
            asm volatile("s_waitcnt vmcnt(0)" ::: "memory");
        } else {
            XB_SPIN(xb_ld(&bar[XB_XGEN(b.x)]) == gen, bar);
            __builtin_amdgcn_fence(__ATOMIC_ACQUIRE, "agent");
            asm volatile("s_waitcnt vmcnt(0)" ::: "memory");
        }
    }
    __syncthreads();
}

__global__ void __launch_bounds__(NTHR) fwd_megakernel(Params P) {
    extern __shared__ __attribute__((aligned(16))) unsigned char lds_raw[];
    Frame F;
    F.lds = (LAS unsigned char*)lds_raw;
    F.tid = threadIdx.x; F.lane = F.tid & 63; F.wave = __builtin_amdgcn_readfirstlane(F.tid >> 6);
    F.G = gridDim.x; { const int bx = blockIdx.x; F.vcu = (F.G % 8 == 0) ? (bx % 8) * (F.G / 8) + bx / 8 : bx; }
    F.gw = F.vcu * NWAVES + F.wave; F.ngw = F.G * NWAVES;
    unsigned char* ws = P.ws;
    LAS unsigned char* stage = F.lds + LDS_STAGE;
    volatile LAS unsigned* bst = (volatile LAS unsigned*)(F.lds + LDS_TAB + 512);
    if (F.tid < 2) bst[F.tid] = 0u;
    __syncthreads();
    const XcdBarrier bar = xcd_barrier_post((unsigned*)(ws + WS_CTL) + 4096, bst);
    LAS unsigned long long* tstamp = (LAS unsigned long long*)(F.lds + LDS_TAB + 640); int nstamp = 0;
    if (TPROBE >= 0 && blockIdx.x == 0 && F.tid == 0) tstamp[nstamp] = __builtin_amdgcn_s_memrealtime();
    ++nstamp;
#define GRID_SYNC() do { xcd_barrier(bar); if (TPROBE >= 0 && blockIdx.x == 0 && F.tid == 0) tstamp[nstamp] = __builtin_amdgcn_s_memrealtime(); ++nstamp; } while (0)

    p0_prologue(P, F);
    if (DUP & 1) p0_prologue(P, F);
    GRID_SYNC();
    {
        pg8::DenseSched S{T / 256, NZ / 256, F.G, (int)blockIdx.x, DM, (const char*)(ws + WS_WIN), (DUP & 2) ? 2 : 1};
        pg8::EpiBf16 E{(bf16_t*)(ws + WS_Z), NZ};
        pg8::gemm_phase<false>(stage, (const char*)(ws + WS_XN), DM, S, E);
    }
    GRID_SYNC();
    p2_tokprep(P, F);
    GRID_SYNC();
    if (DUP & 4096) { for (int q = 0; q < 10; ++q) GRID_SYNC(); }
    {
        pg8::DenseSched S{T / 256, 1024 / 256, F.G, (int)blockIdx.x, 512, (const char*)(ws + WS_WQK), (DUP & 4) ? 2 : 1};
        pg8::EpiBf16 E{(bf16_t*)(ws + WS_QK), 1024};
        pg8::gemm_phase<false>(stage, (const char*)(ws + WS_XC), 512, S, E);
    }
    attn_phase(P, F);
    if (DUP & 8) attn_phase(P, F);
    GRID_SYNC();
    ml1_phase(P, F);
    if (DUP & 16) ml1_phase(P, F);
    GRID_SYNC();
    ml3_phase(P, F);
    if (DUP & 32) ml3_phase(P, F);
    GRID_SYNC();
    {
        pg8::DenseSched S{T / 256, DM / 256, F.G, (int)blockIdx.x, DM, (const char*)(ws + WS_WOUT), (DUP & 64) ? 2 : 1};
        pg8::EpiResF32 E{P.out, P.in[0], DM};
        pg8::gemm_phase<false>(stage, (const char*)(ws + WS_MIX), DM, S, E);
    }
    GRID_SYNC();
    if (DUP & 512) router_phase(P, F, false);
    router_phase(P, F, true);
    GRID_SYNC();
    build_tables(P, F);
    const LAS int* trs = (const LAS int*)(F.lds + LDS_TAB); const LAS int* cnts = trs + 64;
    {
        pg8::MoeSched<true> S{trs, cnts, 8, F.G, (int)blockIdx.x, DM / 2, (const char*)(ws + WS_WGU), (size_t)2 * DFF * DM, (const int*)(ws + WS_LTOK)};
        pg8::EpiSwiglu E{(unsigned char*)(ws + WS_ACT), P.in[17]};
        pg8::gemm_phase<true>(stage, (const char*)(ws + WS_H8), DM / 2, S, E);
    }
    GRID_SYNC();
    {
        pg8::MoeSched<false> S{trs, cnts, 4, F.G, (int)blockIdx.x, DFF / 2, (const char*)(ws + WS_WD), (size_t)DM * DFF, nullptr};
        pg8::EpiDown E{(bf16_t*)(ws + WS_Y), P.in[19], (const float*)(ws + WS_LGATE), cnts};
        pg8::gemm_phase<true>(stage, (const char*)(ws + WS_ACT), DFF / 2, S, E);
    }
    GRID_SYNC();
    if (DUP & 1024) combine_phase(P, F, false);
    combine_phase(P, F, true);
    if (TPROBE >= 0 && blockIdx.x == 0 && F.tid == 0) {
        tstamp[nstamp] = __builtin_amdgcn_s_memrealtime();
        const unsigned long long span = tstamp[TPROBE + 1] - tstamp[TPROBE], t0_ = __builtin_amdgcn_s_memrealtime();
        while (__builtin_amdgcn_s_memrealtime() - t0_ < 4ull * span) __builtin_amdgcn_s_sleep(8);
    }
}
}

extern "C" void kernel_launch(void* const* d_in, const int* in_sizes, int n_in, void* d_out, int out_size, void* d_ws, size_t ws_size, hipStream_t stream) {
    static int grid = 0;
    if (grid == 0) {
        if (n_in != 20 || out_size != T * DM || ws_size < WS_END) { fprintf(stderr, "kernel_launch: unexpected problem (n_in %d out %d ws %zu)\n", n_in, out_size, ws_size); grid = -1; return; }
        int dev = 0, cus = 0, per_cu = 0;
        (void)hipGetDevice(&dev);
        (void)hipDeviceGetAttribute(&cus, hipDeviceAttributeMultiprocessorCount, dev);
        (void)hipFuncSetAttribute((const void*)fwd_megakernel, hipFuncAttributeMaxDynamicSharedMemorySize, LDS_BYTES);
        (void)hipOccupancyMaxActiveBlocksPerMultiprocessor(&per_cu, (const void*)fwd_megakernel, NTHR, LDS_BYTES);
        if (per_cu < 1) { fprintf(stderr, "kernel_launch: occupancy query says %d blocks per CU\n", per_cu); per_cu = 1; }
        grid = cus;
    }
    if (grid < 0) return;
    (void)hipMemsetAsync((char*)d_ws + WS_CTL, 0, 65536, stream);
    Params p{};
    for (int i = 0; i < 20; ++i) p.in[i] = (const float*)d_in[i];
    p.out = (float*)d_out; p.ws = (unsigned char*)d_ws;
    hipLaunchKernelGGL(fwd_megakernel, dim3(grid), dim3(NTHR), LDS_BYTES, stream, p);
    const hipError_t e = hipPeekAtLastError();
    if (e != hipSuccess) fprintf(stderr, "launch failed: %s (grid %d)\n", hipGetErrorString(e), grid);
}
```

```cpp
#include <hip/hip_runtime.h>
#include <cstdio>
#include <cstdint>

#define LAS __attribute__((address_space(3)))
typedef unsigned short bf16_t;
typedef short bf16x8 __attribute__((ext_vector_type(8)));
typedef short s16x4 __attribute__((ext_vector_type(4)));
typedef float f32x4 __attribute__((ext_vector_type(4)));
typedef unsigned u32x4 __attribute__((ext_vector_type(4)));
typedef unsigned u32x2 __attribute__((ext_vector_type(2)));
typedef int i32x4 __attribute__((ext_vector_type(4)));
typedef int i32x8 __attribute__((ext_vector_type(8)));

namespace {
constexpr int BATCH = 2, SEQ = 8192, T = BATCH * SEQ, DM = 1024, DIN = 3080, NZ = 3072;
constexpr int NHA = 8, NHM = 4, HDM = 128;
constexpr int NE = 32, DFF = 1024;
constexpr int CH = 256, NCH = SEQ / CH;
constexpr float EPS = 1e-6f;
constexpr float LOG2E = 1.4426950408889634f;
constexpr float SC_W = 32.f, SC_H = 8.f, SC_A = 4.f;
constexpr int ZQ = 0, ZK = 512, ZV = 1024, ZXM = 1536, ZVM = 2048, ZOM = 2560;
constexpr int NWAVES = 8, NTHR = 512;
constexpr int MAXTR = 288;
constexpr int TPROBE = -1;
constexpr int DUP = 0;
constexpr size_t MiB = 1u << 20;
constexpr size_t WS_CTL = 0;
constexpr size_t WS_WIN = 1 * MiB;
constexpr size_t WS_WOUT = 7 * MiB;
constexpr size_t WS_WQK = 9 * MiB;
constexpr size_t WS_WGU = 16 * MiB;
constexpr size_t WS_WD = 144 * MiB;
constexpr size_t WS_XN = 208 * MiB;
constexpr size_t WS_Z = 240 * MiB;
constexpr size_t WS_GATE = 336 * MiB;
constexpr size_t WS_XC = 337 * MiB;
constexpr size_t WS_QK = 353 * MiB;
constexpr size_t WS_BC = 385 * MiB;
constexpr size_t WS_IG = 385 * MiB + 512 * 1024;
constexpr size_t WS_BT = 386 * MiB;
constexpr size_t WS_NV = 386 * MiB + 4096;
constexpr size_t WS_U = 387 * MiB;
constexpr size_t WS_MIX = 403 * MiB;
constexpr size_t WS_LTOK = 435 * MiB;
constexpr size_t WS_LGATE = 437 * MiB;
constexpr size_t WS_TKE = 439 * MiB;
constexpr size_t WS_WRT = 439 * MiB + 512 * 1024;
constexpr size_t WS_H8 = 728 * MiB;
constexpr size_t WS_ACT = 440 * MiB;
constexpr size_t WS_Y = 584 * MiB;
constexpr size_t WS_END = 744 * MiB;
constexpr int LDS_STAGE = 0;
constexpr int LDS_TAB = 131072;
constexpr int LDS_BYTES = 131072 + 1024;

__device__ __forceinline__ unsigned f2bf(float f) { unsigned u = __builtin_bit_cast(unsigned, f); return (u + 0x7fffu + ((u >> 16) & 1u)) >> 16; }
__device__ __forceinline__ unsigned pk2(float lo, float hi) { return f2bf(lo) | (f2bf(hi) << 16); }
__device__ __forceinline__ unsigned pk4_fp8(float a, float b, float c, float d) { int w = 0; w = __builtin_amdgcn_cvt_pk_fp8_f32(a, b, w, false); w = __builtin_amdgcn_cvt_pk_fp8_f32(c, d, w, true); return (unsigned)w; }
__device__ __forceinline__ float bf2f(unsigned b) { return __builtin_bit_cast(float, b << 16); }
__device__ __forceinline__ float bflo(unsigned w) { return __builtin_bit_cast(float, w << 16); }
__device__ __forceinline__ float bfhi(unsigned w) { return __builtin_bit_cast(float, w & 0xffff0000u); }
__device__ __forceinline__ float wave_sum(float v) {
#pragma unroll
    for (int o = 1; o < 64; o <<= 1) v += __shfl_xor(v, o);
    return v;
}
__device__ __forceinline__ float sigmoidf_(float x) { return 1.0f / (1.0f + __expf(-x)); }
}

namespace pg8 {
constexpr int BM = 256, BK = 64, HALF = 128, HTB = HALF * BK * 2, STAGE_BYTES = 8 * HTB, NXCD = 8, WGM = 8;
__host__ __device__ __forceinline__ int lds_byte(int r, int c) { const int st = (r >> 4) * 2 + (c >> 5), rr = r & 15, cc = c & 31, ob = rr * 64 + cc * 2; return st * 1024 + (ob ^ (((ob >> 9) & 1) << 5)); }
__host__ __device__ __forceinline__ void stage_rc(int b, int& R, int& C) { const int st = b / 1024, sb = b % 1024, swz = sb ^ (((sb >> 9) & 1) << 5); R = (st >> 1) * 16 + swz / 64; C = (st & 1) * 32 + (swz % 64) / 2; }
__host__ __device__ __forceinline__ int perm32(int rho) { const int n = rho >> 4, i = rho & 15; return 8 * (i >> 2) + 4 * n + (i & 3); }

__device__ __forceinline__ bool tile_order(int i, int G, int c, int nM, int nN, int& pm, int& pn) {
    const int nwg = nM * nN; const long L = (long)i * G + c; if (L >= nwg) return false;
    int wgid = (int)L; { const int q = nwg / NXCD, r = nwg % NXCD, xcd = wgid % NXCD, off = wgid / NXCD; wgid = (xcd < r ? xcd * (q + 1) : r * (q + 1) + (xcd - r) * q) + off; }
    const int nig = WGM * nN, gid = wgid / nig, fm = gid * WGM, gsz = (nM - fm) < WGM ? (nM - fm) : WGM;
    pm = fm + ((wgid % nig) % gsz); pn = (wgid % nig) / gsz; return true;
}

struct Unit { int pm, pn, e, mt; };

struct DenseSched {
    int nM, nN, G, c, K; const char* Bt; int reps;
    static constexpr bool DRAIN = false;
    __device__ __forceinline__ bool next(int i, Unit& u) const { u.e = 0; u.mt = 0; const int per = (nM * nN + G - 1) / G; if (i >= per * reps) return false; if (!tile_order(i % per, G, c, nM, nN, u.pm, u.pn)) return tile_order(0, G, c, nM, nN, u.pm, u.pn); return true; }
    __device__ __forceinline__ void a_off(const Unit& u, const int (&R)[2], const int (&C)[2], unsigned (&off)[2][2]) const {
#pragma unroll
        for (int h = 0; h < 2; ++h)
#pragma unroll
            for (int i = 0; i < 2; ++i) off[h][i] = (unsigned)(((u.pm * BM + h * HALF + R[i]) * K + C[i]) * 2);
    }
    __device__ __forceinline__ const char* b_ptr(const Unit& u) const { return Bt + (size_t)u.pn * BM * K * 2; }
};
template <bool GATHER> struct MoeSched {
    const LAS int* trs; const LAS int* cnts; int nN, G, c, K; const char* Bt; size_t bstride; const int* ltok;
    static constexpr bool DRAIN = GATHER;
    __device__ __forceinline__ bool next(int i, Unit& u) const {
        const int nM = __builtin_amdgcn_readfirstlane(trs[NE]);
        if (!tile_order(i, G, c, nM, nN, u.pm, u.pn)) return false;
        int e = 0;
        for (int j = 1; j < NE; ++j) e += (__builtin_amdgcn_readfirstlane(trs[j]) <= u.pm) ? 1 : 0;
        u.e = e; u.mt = u.pm - __builtin_amdgcn_readfirstlane(trs[e]); return true;
    }
    __device__ __forceinline__ void a_off(const Unit& u, const int (&R)[2], const int (&C)[2], unsigned (&off)[2][2]) const {
        const int n = __builtin_amdgcn_readfirstlane(cnts[u.e]);
#pragma unroll
        for (int h = 0; h < 2; ++h)
#pragma unroll
            for (int i = 0; i < 2; ++i) {
                int row;
                if (GATHER) { const int p = u.mt * BM + h * HALF + R[i]; row = (p < n) ? ltok[u.e * T + p] : 0; }
                else row = u.pm * BM + h * HALF + R[i];
                off[h][i] = (unsigned)((row * K + C[i]) * 2);
            }
    }
    __device__ __forceinline__ const char* b_ptr(const Unit& u) const { return Bt + (size_t)u.e * bstride + (size_t)u.pn * BM * K * 2; }
};

struct EpiBf16 {
    static constexpr bool PERM = true;
    bf16_t* O; int ldc;
    __device__ __forceinline__ void operator()(const f32x4 (&acc)[2][2][4][2], const Unit& u, int wr, int wc, int fr, int fq) const {
        const int row0 = u.pm * BM + wr * 64 + fr, col0 = u.pn * BM + wc * 32 + 8 * fq;
#pragma unroll
        for (int ai = 0; ai < 2; ++ai)
#pragma unroll
            for (int m = 0; m < 4; ++m) { bf16_t* rowp = O + (size_t)(row0 + ai * HALF + m * 16) * ldc + col0;
#pragma unroll
                for (int bj = 0; bj < 2; ++bj) { const f32x4 v0 = acc[ai][bj][m][0], v1 = acc[ai][bj][m][1];
                    u32x4 w; w.x = pk2(v0[0], v0[1]); w.y = pk2(v0[2], v0[3]); w.z = pk2(v1[0], v1[1]); w.w = pk2(v1[2], v1[3]);
                    *(u32x4*)(rowp + bj * HALF) = w; } }
    }
};
struct EpiResF32 {
    static constexpr bool PERM = false;
    float* C; const float* Rs; int ldc;
    __device__ __forceinline__ void operator()(const f32x4 (&acc)[2][2][4][2], const Unit& u, int wr, int wc, int fr, int fq) const {
        const int row0 = u.pm * BM + wr * 64 + fr, col0 = u.pn * BM + wc * 32 + 4 * fq;
#pragma unroll
        for (int ai = 0; ai < 2; ++ai)
#pragma unroll
            for (int m = 0; m < 4; ++m) { const size_t ro = (size_t)(row0 + ai * HALF + m * 16) * ldc + col0;
#pragma unroll
                for (int bj = 0; bj < 2; ++bj)
#pragma unroll
                    for (int n = 0; n < 2; ++n) { const f32x4 r = *(const f32x4*)(Rs + ro + bj * HALF + n * 16); *(f32x4*)(C + ro + bj * HALF + n * 16) = acc[ai][bj][m][n] + r; } }
    }
};
struct EpiSwiglu {
    static constexpr bool PERM = true;
    unsigned char* O; const float* bgu;
    __device__ __forceinline__ void operator()(const f32x4 (&acc)[2][2][4][2], const Unit& u, int wr, int wc, int fr, int fq) const {
        const int row0 = u.pm * BM + wr * 64 + fr, f0 = u.pn * HALF + wc * 32 + 8 * fq;
        const float* bg = bgu + (size_t)u.e * 2 * DFF + f0;
        constexpr float inv = 1.0f / (SC_H * SC_W);
        f32x4 bgv[2], buv[2];
#pragma unroll
        for (int n = 0; n < 2; ++n) { bgv[n] = *(const f32x4*)(bg + 4 * n); buv[n] = *(const f32x4*)(bg + DFF + 4 * n); }
#pragma unroll
        for (int ai = 0; ai < 2; ++ai)
#pragma unroll
            for (int m = 0; m < 4; ++m) { unsigned char* rowp = O + (size_t)(row0 + ai * HALF + m * 16) * DFF + f0;
                float r[8];
#pragma unroll
                for (int n = 0; n < 2; ++n) { const f32x4 gv = acc[ai][0][m][n] * inv + bgv[n], uv = acc[ai][1][m][n] * inv + buv[n];
#pragma unroll
                    for (int j = 0; j < 4; ++j) { const float gg = fminf(gv[j], 7.0f), uu = fminf(fmaxf(uv[j], -7.0f), 7.0f);
                        r[4 * n + j] = SC_A * gg * (uu + 1.0f) / (1.0f + __expf(-1.702f * gg)); } }
                u32x2 w; w.x = pk4_fp8(r[0], r[1], r[2], r[3]); w.y = pk4_fp8(r[4], r[5], r[6], r[7]);
                *(u32x2*)rowp = w; }
    }
};
struct EpiDown {
    static constexpr bool PERM = true;
    bf16_t* O; const float* bd; const float* lgate; const LAS int* cnts;
    __device__ __forceinline__ void operator()(const f32x4 (&acc)[2][2][4][2], const Unit& u, int wr, int wc, int fr, int fq) const {
        const int row0 = u.pm * BM + wr * 64 + fr, col0 = u.pn * BM + wc * 32 + 8 * fq;
        const int n_e = cnts[u.e];
        f32x4 bv[2][2];
#pragma unroll
        for (int bj = 0; bj < 2; ++bj)
#pragma unroll
            for (int n = 0; n < 2; ++n) bv[bj][n] = *(const f32x4*)(bd + (size_t)u.e * DM + col0 + bj * HALF + 4 * n);
#pragma unroll
        for (int ai = 0; ai < 2; ++ai)
#pragma unroll
            for (int m = 0; m < 4; ++m) { const int rt = wr * 64 + fr + ai * HALF + m * 16, p = u.mt * BM + rt;
                const float gt = (p < n_e) ? lgate[(size_t)u.e * T + p] : 0.f;
                bf16_t* rowp = O + (size_t)(row0 + ai * HALF + m * 16) * DM + col0;
#pragma unroll
                for (int bj = 0; bj < 2; ++bj) { const f32x4 v0 = (acc[ai][bj][m][0] * (1.0f / (SC_A * SC_W)) + bv[bj][0]) * gt, v1 = (acc[ai][bj][m][1] * (1.0f / (SC_A * SC_W)) + bv[bj][1]) * gt;
                    u32x4 w; w.x = pk2(v0[0], v0[1]); w.y = pk2(v0[2], v0[3]); w.z = pk2(v1[0], v1[1]); w.w = pk2(v1[2], v1[3]);
                    *(u32x4*)(rowp + bj * HALF) = w; } }
    }
};

template <bool FP8, class Epi, class Sched>
__device__ __forceinline__ void gemm_phase(LAS unsigned char* lds, const char* A0, const int K, const Sched& S, const Epi& E) {
    const int tid = threadIdx.x, wid = __builtin_amdgcn_readfirstlane(tid >> 6), lane = tid & 63, wr = wid >> 2, wc = wid & 3, fr = lane & 15, fq = lane >> 4;
    const int nt = K / BK;
    int Rr[2], Cc[2]; unsigned voffB[2];
#pragma unroll
    for (int i = 0; i < 2; ++i) { stage_rc(tid * 16 + i * 8192, Rr[i], Cc[i]); const int Rb = Epi::PERM ? ((Rr[i] & ~31) + perm32(Rr[i] & 31)) : Rr[i]; voffB[i] = (unsigned)(Rb * K + Cc[i]) * 2u; }
    const size_t kstep = (size_t)(BK * 2);
    const size_t hstep = (size_t)HALF * K * 2;
    const unsigned ldsw = (unsigned)wid * 1024u;
    const int aoff = lds_byte(wr * 64 + fr, fq * 8), boff = lds_byte(wc * 32 + fr, fq * 8);
#define PG8_SA(b, h) (((b) * 2 + (h)) * HTB)
#define PG8_SB(b, h) ((4 + (b) * 2 + (h)) * HTB)
#define PG8_STAGE_B(bufoff, gbase) do { _Pragma("unroll") for (int _i = 0; _i < 2; ++_i) \
        __builtin_amdgcn_global_load_lds((const unsigned*)((const char*)(gbase) + voffB[_i]), (LAS unsigned*)(lds + (bufoff) + ldsw + _i * 8192), 16, 0, 0); } while (0)
#define PG8_STAGE_A(bufoff, gbase, o0, o1) do { \
        __builtin_amdgcn_global_load_lds((const unsigned*)((const char*)(gbase) + (o0)), (LAS unsigned*)(lds + (bufoff) + ldsw), 16, 0, 0); \
        __builtin_amdgcn_global_load_lds((const unsigned*)((const char*)(gbase) + (o1)), (LAS unsigned*)(lds + (bufoff) + ldsw + 8192), 16, 0, 0); } while (0)
#define PG8_LDA(dst, b, h) do { if constexpr (FP8) { _Pragma("unroll") for (int m = 0; m < 4; ++m) { const i32x4 lo_ = *(const LAS i32x4*)(lds + PG8_SA(b, h) + aoff + m * 2048), hi_ = *(const LAS i32x4*)(lds + PG8_SA(b, h) + aoff + m * 2048 + 1024); \
            dst##8[m] = __builtin_shufflevector(lo_, hi_, 0, 1, 2, 3, 4, 5, 6, 7); } } \
        else { _Pragma("unroll") for (int m = 0; m < 4; ++m) _Pragma("unroll") for (int k = 0; k < 2; ++k) dst[m][k] = *(const LAS bf16x8*)(lds + PG8_SA(b, h) + aoff + m * 2048 + k * 1024); } } while (0)
#define PG8_LDB(dst, b, h) do { if constexpr (FP8) { _Pragma("unroll") for (int n = 0; n < 2; ++n) { const i32x4 lo_ = *(const LAS i32x4*)(lds + PG8_SB(b, h) + boff + n * 2048), hi_ = *(const LAS i32x4*)(lds + PG8_SB(b, h) + boff + n * 2048 + 1024); \
            dst##8[n] = __builtin_shufflevector(lo_, hi_, 0, 1, 2, 3, 4, 5, 6, 7); } } \
        else { _Pragma("unroll") for (int n = 0; n < 2; ++n) _Pragma("unroll") for (int k = 0; k < 2; ++k) dst[n][k] = *(const LAS bf16x8*)(lds + PG8_SB(b, h) + boff + n * 2048 + k * 1024); } } while (0)
#define PG8_MMA(ai, bj, At, Bt) do { __builtin_amdgcn_s_setprio(1); \
        if constexpr (FP8) { _Pragma("unroll") for (int m = 0; m < 4; ++m) _Pragma("unroll") for (int n = 0; n < 2; ++n) \
            asm volatile("s_nop 1\n\tv_mfma_f32_16x16x128_f8f6f4 %0, %1, %2, %0" : "+v"(acc[ai][bj][m][n]) : "v"(Bt##8[n]), "v"(At##8[m])); } \
        else { _Pragma("unroll") for (int m = 0; m < 4; ++m) _Pragma("unroll") for (int n = 0; n < 2; ++n) _Pragma("unroll") for (int k = 0; k < 2; ++k) \
            acc[ai][bj][m][n] = __builtin_amdgcn_mfma_f32_16x16x32_bf16(Bt[n][k], At[m][k], acc[ai][bj][m][n], 0, 0, 0); } \
        __builtin_amdgcn_s_setprio(0); } while (0)
#define PG8_WAIT_V(n) asm volatile("s_waitcnt vmcnt(" #n ")" ::: "memory")
#define PG8_WAIT_L(n) asm volatile("s_waitcnt lgkmcnt(" #n ")" ::: "memory")
#define PG8_BAR __builtin_amdgcn_s_barrier()
#define PG8_SCHED __builtin_amdgcn_sched_barrier(0)
    Unit cur, nxt; int ui = 0;
    if (!S.next(0, cur)) return;
    f32x4 acc[2][2][4][2];
#pragma unroll
    for (int a = 0; a < 2; ++a)
#pragma unroll
        for (int b = 0; b < 2; ++b)
#pragma unroll
            for (int m = 0; m < 4; ++m)
#pragma unroll
                for (int n = 0; n < 2; ++n) acc[a][b][m][n] = (f32x4){0.f, 0.f, 0.f, 0.f};
    bf16x8 At[4][2], B0[2][2], B1[2][2]; i32x8 At8[4], B08[2], B18[2];
    unsigned offC[2][2], offN[2][2];
    S.a_off(cur, Rr, Cc, offC);
    const char* cB = S.b_ptr(cur);
    if (Sched::DRAIN) PG8_WAIT_V(0);
    PG8_STAGE_B(PG8_SB(0, 0), cB); PG8_STAGE_B(PG8_SB(0, 1), cB + hstep); PG8_STAGE_A(PG8_SA(0, 0), A0, offC[0][0], offC[0][1]); PG8_STAGE_A(PG8_SA(0, 1), A0, offC[1][0], offC[1][1]);
    if (wr == 1) PG8_BAR;
    PG8_WAIT_V(2); PG8_BAR;
    PG8_STAGE_B(PG8_SB(1, 0), cB + kstep); PG8_STAGE_A(PG8_SA(1, 0), A0 + kstep, offC[0][0], offC[0][1]); PG8_STAGE_B(PG8_SB(1, 1), cB + hstep + kstep);
    PG8_WAIT_V(6); PG8_BAR;
    for (;;) {
        const bool has_next = S.next(ui + 1, nxt);
        const char* nB = cB;
        if (has_next) { S.a_off(nxt, Rr, Cc, offN); nB = S.b_ptr(nxt); }
        else {
#pragma unroll
            for (int h = 0; h < 2; ++h)
#pragma unroll
                for (int i = 0; i < 2; ++i) offN[h][i] = offC[h][i];
        }
        if (Sched::DRAIN) PG8_WAIT_V(0);
        for (int t = 0; t < nt; t += 2) {
            const bool last = (t == nt - 2);
            const char* a1 = A0 + (size_t)(t + 1) * kstep;
            const char* a2 = last ? A0 : A0 + (size_t)(t + 2) * kstep; const char* b2 = last ? nB : cB + (size_t)(t + 2) * kstep;
            const char* a3 = a2 + kstep; const char* b3 = b2 + kstep;
            const unsigned o00 = last ? offN[0][0] : offC[0][0], o01 = last ? offN[0][1] : offC[0][1], o10 = last ? offN[1][0] : offC[1][0], o11 = last ? offN[1][1] : offC[1][1];
            PG8_LDB(B0, 0, 0); PG8_LDB(B1, 0, 1); PG8_SCHED; PG8_LDA(At, 0, 0); PG8_STAGE_A(PG8_SA(1, 1), a1, offC[1][0], offC[1][1]);
            PG8_WAIT_V(8); PG8_WAIT_L(0); PG8_BAR; PG8_MMA(0, 0, At, B0); PG8_MMA(0, 1, At, B1); PG8_BAR; PG8_SCHED;
            PG8_LDA(At, 0, 1); PG8_STAGE_B(PG8_SB(0, 0), b2); PG8_STAGE_B(PG8_SB(0, 1), b2 + hstep); PG8_STAGE_A(PG8_SA(0, 0), a2, o00, o01);
            PG8_WAIT_V(8); PG8_WAIT_L(0); PG8_BAR; PG8_MMA(1, 0, At, B0); PG8_MMA(1, 1, At, B1); PG8_BAR; PG8_SCHED;
            PG8_LDB(B0, 1, 0); PG8_LDB(B1, 1, 1); PG8_SCHED; PG8_LDA(At, 1, 0); PG8_STAGE_A(PG8_SA(0, 1), a2, o10, o11);
            PG8_WAIT_V(8); PG8_WAIT_L(0); PG8_BAR; PG8_MMA(0, 0, At, B0); PG8_MMA(0, 1, At, B1); PG8_BAR; PG8_SCHED;
            PG8_LDA(At, 1, 1); PG8_STAGE_B(PG8_SB(1, 0), b3); PG8_STAGE_B(PG8_SB(1, 1), b3 + hstep); PG8_STAGE_A(PG8_SA(1, 0), a3, o00, o01);
            PG8_WAIT_V(8); PG8_WAIT_L(0); PG8_BAR; PG8_MMA(1, 0, At, B0); PG8_MMA(1, 1, At, B1); PG8_BAR; PG8_SCHED;
        }
        if (wr == 0) PG8_BAR;
        if constexpr (FP8) {
            asm volatile("s_nop 15\n\ts_nop 15" : "+v"(acc[0][0][0][0]), "+v"(acc[0][0][0][1]), "+v"(acc[0][0][1][0]), "+v"(acc[0][0][1][1]), "+v"(acc[0][0][2][0]), "+v"(acc[0][0][2][1]), "+v"(acc[0][0][3][0]), "+v"(acc[0][0][3][1]),
                                                    "+v"(acc[0][1][0][0]), "+v"(acc[0][1][0][1]), "+v"(acc[0][1][1][0]), "+v"(acc[0][1][1][1]), "+v"(acc[0][1][2][0]), "+v"(acc[0][1][2][1]), "+v"(acc[0][1][3][0]), "+v"(acc[0][1][3][1]));
            asm volatile("s_nop 0" : "+v"(acc[1][0][0][0]), "+v"(acc[1][0][0][1]), "+v"(acc[1][0][1][0]), "+v"(acc[1][0][1][1]), "+v"(acc[1][0][2][0]), "+v"(acc[1][0][2][1]), "+v"(acc[1][0][3][0]), "+v"(acc[1][0][3][1]),
                                   "+v"(acc[1][1][0][0]), "+v"(acc[1][1][0][1]), "+v"(acc[1][1][1][0]), "+v"(acc[1][1][1][1]), "+v"(acc[1][1][2][0]), "+v"(acc[1][1][2][1]), "+v"(acc[1][1][3][0]), "+v"(acc[1][1][3][1]));
        }
        E(acc, cur, wr, wc, fr, fq);
        if (!has_next) break;
#pragma unroll
        for (int a = 0; a < 2; ++a)
#pragma unroll
            for (int b = 0; b < 2; ++b)
#pragma unroll
                for (int m = 0; m < 4; ++m)
#pragma unroll
                    for (int n = 0; n < 2; ++n) acc[a][b][m][n] = (f32x4){0.f, 0.f, 0.f, 0.f};
        cur = nxt; cB = nB; ++ui;
#pragma unroll
        for (int h = 0; h < 2; ++h)
#pragma unroll
            for (int i = 0; i < 2; ++i) offC[h][i] = offN[h][i];
        if (wr == 1) PG8_BAR;
    }
    PG8_WAIT_V(0);
    PG8_BAR;
#undef PG8_SA
#undef PG8_SB
#undef PG8_STAGE_A
#undef PG8_STAGE_B
#undef PG8_LDA
#undef PG8_LDB
#undef PG8_MMA
#undef PG8_WAIT_V
#undef PG8_WAIT_L
#undef PG8_BAR
#undef PG8_SCHED
}
}

namespace {
struct Params { const float* in[20]; float* out; unsigned char* ws; };

struct Frame {
    LAS unsigned char* lds;
    int tid, lane, wave, G, vcu, gw, ngw;
};

struct ConvItem { const float* src; unsigned char* dst; int ldw, ldt, kind; float scale; };
__device__ __forceinline__ void conv_load(const ConvItem& I, f32x4 (&v)[8], int lane) {
    const int r8 = lane >> 3, c4 = (lane & 7) * 4;
#pragma unroll
    for (int i = 0; i < 8; ++i) v[i] = __builtin_nontemporal_load((const f32x4*)(I.src + (size_t)(8 * i + r8) * I.ldw + c4));
}
__device__ __forceinline__ void conv_store(const ConvItem& I, const f32x4 (&v)[8], LAS float* scr, int lane) {
    const int r8 = lane >> 3, c4 = (lane & 7) * 4;
#pragma unroll
    for (int i = 0; i < 8; ++i) { LAS float* d = scr + (8 * i + r8) * 33 + c4; d[0] = v[i][0]; d[1] = v[i][1]; d[2] = v[i][2]; d[3] = v[i][3]; }
    asm volatile("s_waitcnt lgkmcnt(0)" ::: "memory");
    const float scale = I.scale;
    if (I.kind == 0) {
        const int c = lane & 7;
#pragma unroll
        for (int j = 0; j < 4; ++j) { const int n = (lane >> 3) + 8 * j; const LAS float* s = scr + (8 * c) * 33 + n;
            u32x4 o; o.x = pk2(s[0 * 33] * scale, s[1 * 33] * scale); o.y = pk2(s[2 * 33] * scale, s[3 * 33] * scale); o.z = pk2(s[4 * 33] * scale, s[5 * 33] * scale); o.w = pk2(s[6 * 33] * scale, s[7 * 33] * scale);
            *(u32x4*)(I.dst + ((size_t)n * I.ldt + 8 * c) * 2) = o; }
    } else {
        const int n = lane >> 1, kh = lane & 1; const LAS float* s = scr + (32 * kh) * 33 + n;
        unsigned w[8];
#pragma unroll
        for (int q = 0; q < 8; ++q) w[q] = pk4_fp8(s[(4 * q) * 33] * scale, s[(4 * q + 1) * 33] * scale, s[(4 * q + 2) * 33] * scale, s[(4 * q + 3) * 33] * scale);
        unsigned char* d = I.dst + (size_t)n * I.ldt + 32 * kh;
        *(u32x4*)d = (u32x4){w[0], w[1], w[2], w[3]}; *(u32x4*)(d + 16) = (u32x4){w[4], w[5], w[6], w[7]};
    }
    asm volatile("s_waitcnt lgkmcnt(0)" ::: "memory");
}
template <class GetItem>
__device__ __forceinline__ void conv_run(GetItem get, int first, int n, int stride, LAS float* scr, int lane) {
    if (first >= n) return;
    ConvItem A, B, C; f32x4 va[8], vb[8], vc[8];
    get(first, A); conv_load(A, va, lane);
    const bool hb = first + stride < n, hc = first + 2 * stride < n;
    B = A; C = A;
    if (hb) { get(first + stride, B); conv_load(B, vb, lane); }
    if (hc) { get(first + 2 * stride, C); conv_load(C, vc, lane); }
    for (int it = first; it < n; it += stride) {
        conv_store(A, va, scr, lane);
        A = B; B = C;
#pragma unroll
        for (int i = 0; i < 8; ++i) { va[i] = vb[i]; vb[i] = vc[i]; }
        const int nx = it + 3 * stride;
        if (nx < n) { get(nx, C); conv_load(C, vc, lane); }
    }
}
constexpr int I_GU = NE * 16 * 64, I_D = NE * 16 * 32;
__device__ __forceinline__ void moe_item(const Params& P, int r, ConvItem& I) {
    I.kind = 1; I.scale = SC_W; I.ldt = DM;
    if (r < I_GU) { const int e = r >> 10, kb = (r >> 6) & 15, nb = r & 63, n0 = 32 * nb, f = n0 & 1023, up = n0 >> 10;
        const int drow = (f >> 7) * 256 + up * 128 + (f & 127);
        I.src = P.in[16] + (size_t)e * DM * 2 * DFF + (size_t)(64 * kb) * 2 * DFF + n0; I.ldw = 2 * DFF;
        I.dst = P.ws + WS_WGU + (size_t)e * 2 * DFF * DM + (size_t)drow * DM + 64 * kb;
    } else { r -= I_GU; const int e = r >> 9, kb = (r >> 5) & 15, nb = r & 31;
        I.src = P.in[18] + (size_t)e * DFF * DM + (size_t)(64 * kb) * DM + 32 * nb; I.ldw = DM;
        I.dst = P.ws + WS_WD + (size_t)e * DM * DFF + (size_t)(32 * nb) * DFF + 64 * kb; }
}
__device__ __forceinline__ void moe_convert(const Params& P, Frame& F, int cw, int ncw) {
    LAS float* scr = (LAS float*)(F.lds + F.wave * 8448);
    conv_run([&](int r, ConvItem& I) { moe_item(P, r, I); }, cw, I_GU + I_D, ncw, scr, F.lane);
}

__device__ __forceinline__ void p0_prologue(const Params& P, Frame& F) {
    unsigned char* ws = P.ws;
    const float* w_in = P.in[2];
    LAS float* scr = (LAS float*)(F.lds + F.wave * 8448);
    LAS float* gwl = (LAS float*)(F.lds + 73728);
    for (int i = F.tid; i < 1024 * 8; i += NTHR) gwl[i] = w_in[(size_t)(i >> 3) * DIN + NZ + (i & 7)];
    __syncthreads();
    constexpr int I_IN = 16 * 96, I_OUT = 16 * 32, I_QK = 8 * 2 * 4, I_ZERO = 8 * 3;
    bf16_t* WqkT = (bf16_t*)(ws + WS_WQK);
    conv_run([&](int r, ConvItem& I) {
        I.kind = 0; I.scale = 1.f;
        if (r < I_IN) { const int kb = r / 96, nb = r % 96; I.src = w_in + (size_t)(64 * kb) * DIN + 32 * nb; I.ldw = DIN; I.dst = ws + WS_WIN + ((size_t)(32 * nb) * DM + 64 * kb) * 2; I.ldt = DM; return; }
        r -= I_IN;
        if (r < I_OUT) { const int kb = r / 32, nb = r % 32; I.src = P.in[12] + (size_t)(64 * kb) * DM + 32 * nb; I.ldw = DM; I.dst = ws + WS_WOUT + ((size_t)(32 * nb) * DM + 64 * kb) * 2; I.ldt = DM; return; }
        r -= I_OUT;
        { const int isk = r >> 5, h = (r >> 3) & 3, kb = (r >> 2) & 1, nb = r & 3;
            I.src = P.in[isk ? 8 : 7] + (size_t)h * 16384 + (size_t)(64 * kb) * 128 + 32 * nb; I.ldw = 128;
            I.dst = ws + WS_WQK + ((size_t)(isk * 512 + h * 128 + 32 * nb) * 512 + h * 128 + 64 * kb) * 2; I.ldt = 512; I.scale = isk ? 0.08838834764831845f : 1.f; }
    }, F.gw, I_IN + I_OUT + I_QK, F.ngw, scr, F.lane);
    moe_convert(P, F, F.gw, F.ngw);
    for (int r = F.gw; r < I_ZERO; r += F.ngw) {
        const int rb = r / 3, j = r % 3, cb = j + (j >= (rb & 3) ? 1 : 0);
        for (int q = F.lane; q < 128 * 16; q += 64) { const int rr = q >> 4, cc = q & 15; *(u32x4*)(WqkT + (size_t)(rb * 128 + rr) * 512 + cb * 128 + cc * 8) = (u32x4){0u, 0u, 0u, 0u}; }
    }
    {
        const float* wr = P.in[14]; float* wrt = (float*)(ws + WS_WRT);
        for (int idx = F.vcu * NTHR + F.tid; idx < DM * NE; idx += F.G * NTHR) wrt[(idx & 31) * DM + (idx >> 5)] = wr[idx];
    }
    const float* x = P.in[0]; const float* g1 = P.in[1];
    bf16_t* XN = (bf16_t*)(ws + WS_XN); float* GATE = (float*)(ws + WS_GATE);
    for (int row = F.gw; row < T; row += F.ngw) {
        const f32x4* xr = (const f32x4*)(x + (size_t)row * DM);
        f32x4 v[4]; float s = 0.f;
#pragma unroll
        for (int j = 0; j < 4; ++j) { v[j] = xr[F.lane + 64 * j]; s += v[j][0] * v[j][0] + v[j][1] * v[j][1] + v[j][2] * v[j][2] + v[j][3] * v[j][3]; }
        s = wave_sum(s);
        const float rs = 1.0f / sqrtf(s * (1.0f / DM) + EPS);
        float ga[8];
#pragma unroll
        for (int c = 0; c < 8; ++c) ga[c] = 0.f;
#pragma unroll
        for (int j = 0; j < 4; ++j) { const f32x4 gg = ((const f32x4*)g1)[F.lane + 64 * j]; v[j] = v[j] * rs * gg;
            u32x2 w; w.x = pk2(v[j][0], v[j][1]); w.y = pk2(v[j][2], v[j][3]);
            *(u32x2*)(XN + (size_t)row * DM + 4 * (F.lane + 64 * j)) = w;
#pragma unroll
            for (int q = 0; q < 4; ++q) { const int k = 4 * (F.lane + 64 * j) + q; const f32x4 w0 = *(const LAS f32x4*)(gwl + k * 8), w1 = *(const LAS f32x4*)(gwl + k * 8 + 4);
                ga[0] += v[j][q] * w0[0]; ga[1] += v[j][q] * w0[1]; ga[2] += v[j][q] * w0[2]; ga[3] += v[j][q] * w0[3];
                ga[4] += v[j][q] * w1[0]; ga[5] += v[j][q] * w1[1]; ga[6] += v[j][q] * w1[2]; ga[7] += v[j][q] * w1[3]; } }
#pragma unroll
        for (int c = 0; c < 8; ++c) ga[c] = wave_sum(ga[c]);
        if (F.lane == 0) { *(f32x4*)(GATE + (size_t)row * 8) = (f32x4){ga[0], ga[1], ga[2], ga[3]}; *(f32x4*)(GATE + (size_t)row * 8 + 4) = (f32x4){ga[4], ga[5], ga[6], ga[7]}; }
    }
}

__device__ __forceinline__ void p2_tokprep(const Params& P, Frame& F) {
    bf16_t* Z = (bf16_t*)(P.ws + WS_Z); bf16_t* XC = (bf16_t*)(P.ws + WS_XC);
    const float* gq = P.in[3]; const float* gk = P.in[4]; const float* cw = P.in[5]; const float* cb = P.in[6];
    const int lane = F.lane;
    for (int tok = F.gw; tok < T; tok += F.ngw) {
        bf16_t* zr = Z + (size_t)tok * NZ;
#pragma unroll
        for (int part = 0; part < 2; ++part) {
            bf16_t* p = zr + (part ? ZK : ZQ) + lane * 8;
            const float* g = (part ? gk : gq) + (lane & 7) * 8;
            const u32x4 w = *(const u32x4*)p;
            float a[8] = {bflo(w.x), bfhi(w.x), bflo(w.y), bfhi(w.y), bflo(w.z), bfhi(w.z), bflo(w.w), bfhi(w.w)};
            float s = 0.f;
#pragma unroll
            for (int i = 0; i < 8; ++i) s += a[i] * a[i];
            s += __shfl_xor(s, 1); s += __shfl_xor(s, 2); s += __shfl_xor(s, 4);
            float r = 1.0f / sqrtf(s * (1.0f / 64.f) + EPS); if (!part) r *= 0.125f * LOG2E;
#pragma unroll
            for (int i = 0; i < 8; ++i) a[i] *= r * g[i];
            u32x4 o; o.x = pk2(a[0], a[1]); o.y = pk2(a[2], a[3]); o.z = pk2(a[4], a[5]); o.w = pk2(a[6], a[7]);
            *(u32x4*)p = o;
        }
        for (int crep = 0; crep < ((DUP & 2048) ? 2 : 1); ++crep) {
            const int tl = tok % SEQ; const int ch = lane * 8;
            float a[8];
#pragma unroll
            for (int i = 0; i < 8; ++i) a[i] = cb[ch + i];
#pragma unroll
            for (int j = 0; j < 4; ++j) { const int dt = 3 - j; if (tl - dt >= 0) {
                    const u32x4 w = *(const u32x4*)(Z + (size_t)(tok - dt) * NZ + ZXM + ch);
                    const float xv[8] = {bflo(w.x), bfhi(w.x), bflo(w.y), bfhi(w.y), bflo(w.z), bfhi(w.z), bflo(w.w), bfhi(w.w)};
#pragma unroll
                    for (int i = 0; i < 8; ++i) a[i] += cw[j * 512 + ch + i] * xv[i]; } }
#pragma unroll
            for (int i = 0; i < 8; ++i) a[i] = a[i] * sigmoidf_(a[i]);
            u32x4 o; o.x = pk2(a[0], a[1]); o.y = pk2(a[2], a[3]); o.z = pk2(a[4], a[5]); o.w = pk2(a[6], a[7]);
            *(u32x4*)(XC + (size_t)tok * 512 + ch) = o;
        }
    }
}

__device__ __forceinline__ void attn_phase(const Params& P, Frame& F) {
    const bf16_t* Z = (const bf16_t*)(P.ws + WS_Z); bf16_t* MIX = (bf16_t*)(P.ws + WS_MIX);
    const int lane = F.lane, i = lane & 15, g = lane >> 4;
    float gm = fabsf(P.in[4][lane]);
#pragma unroll
    for (int o = 1; o < 64; o <<= 1) gm = fmaxf(gm, __shfl_xor(gm, o));
    const float kmax = 8.0f * gm * 1.01f;
    LAS unsigned char* vb = F.lds + F.wave * 4608;
    const int vwr = (lane >> 3) * 144 + (lane & 7) * 16;
    const int vrd = (4 * g + (i >> 2)) * 144 + (i & 3) * 8;
    for (int tile = F.gw; tile < 8192; tile += F.ngw) {
        const int r = tile & 15, blk = (tile >> 4) & 31, h = (tile >> 9) & 7, b = tile >> 12;
        const int tl0 = blk * 256 + r, T0 = b * SEQ + tl0;
        const bf16_t* qrow = Z + (size_t)(T0 + 16 * i) * NZ + ZQ + h * 64;
        const bf16x8 qf0 = *(const bf16x8*)(qrow + 8 * g), qf1 = *(const bf16x8*)(qrow + 32 + 8 * g);
        float ss = 0.f;
#pragma unroll
        for (int j = 0; j < 8; ++j) { const float a = bf2f((unsigned short)qf0[j]), c = bf2f((unsigned short)qf1[j]); ss += a * a + c * c; }
        ss += __shfl_xor(ss, 16); ss += __shfl_xor(ss, 32);
        const float ref = sqrtf(ss) * kmax;
        const float slope2 = exp2f(-(float)(h + 1)) * LOG2E;
        f32x4 o[4];
#pragma unroll
        for (int dt = 0; dt < 4; ++dt) o[dt] = (f32x4){0.f, 0.f, 0.f, 0.f};
        float lsum = 0.f;
        const bf16_t* Kh = Z + (size_t)b * SEQ * NZ + ZK + h * 64 + 8 * g;
        const bf16_t* Vh = Z + (size_t)b * SEQ * NZ + ZV + h * 64 + 8 * (lane & 7);
        bf16x8 kfa[2][2], kfb[2][2]; u32x4 vra[4], vrb[4];
#define ATT_LOAD(bi_, kfn, vrn) do { const int bi__ = (bi_); const int br_ = bi__ < 12 ? 0 : (bi__ < 18 ? 1 : 2); const int d_ = 1 << (2 * br_); const int nb_ = -128 + 32 * (bi__ - (br_ == 0 ? 0 : (br_ == 1 ? 12 : 18))); \
        _Pragma("unroll") for (int sb = 0; sb < 2; ++sb) { int kp = tl0 + (nb_ + 16 * sb + i) * d_; kp = kp < 0 ? 0 : (kp > SEQ - 1 ? SEQ - 1 : kp); const bf16_t* kr = Kh + (size_t)kp * NZ; kfn[sb][0] = *(const bf16x8*)kr; kfn[sb][1] = *(const bf16x8*)(kr + 32); } \
        _Pragma("unroll") for (int c = 0; c < 4; ++c) { int kp = tl0 + (nb_ + 8 * c + (lane >> 3)) * d_; kp = kp < 0 ? 0 : (kp > SEQ - 1 ? SEQ - 1 : kp); vrn[c] = *(const u32x4*)(Vh + (size_t)kp * NZ); } } while (0)
        ATT_LOAD(0, kfa, vra); ATT_LOAD(1, kfb, vrb);
        for (int bi = 0; bi < 23; ++bi) {
            bf16x8 kf[2][2]; u32x4 vr[4];
#pragma unroll
            for (int sb = 0; sb < 2; ++sb) { kf[sb][0] = kfa[sb][0]; kf[sb][1] = kfa[sb][1]; kfa[sb][0] = kfb[sb][0]; kfa[sb][1] = kfb[sb][1]; }
#pragma unroll
            for (int c = 0; c < 4; ++c) { vr[c] = vra[c]; vra[c] = vrb[c]; }
            if (bi + 2 < 23) ATT_LOAD(bi + 2, kfb, vrb);
            const int br = bi < 12 ? 0 : (bi < 18 ? 1 : 2), dd = 1 << (2 * br), u = 16 / dd;
            const int nb = -128 + 32 * (bi - (br == 0 ? 0 : (br == 1 ? 12 : 18)));
#pragma unroll
            for (int c = 0; c < 4; ++c) *(LAS u32x4*)(vb + vwr + c * 8 * 144) = vr[c];
            f32x4 s[2];
#pragma unroll
            for (int sb = 0; sb < 2; ++sb) { s[sb] = __builtin_amdgcn_mfma_f32_16x16x32_bf16(kf[sb][0], qf0, (f32x4){0.f, 0.f, 0.f, 0.f}, 0, 0, 0);
                s[sb] = __builtin_amdgcn_mfma_f32_16x16x32_bf16(kf[sb][1], qf1, s[sb], 0, 0, 0); }
            float p[8];
#pragma unroll
            for (int sb = 0; sb < 2; ++sb)
#pragma unroll
                for (int j = 0; j < 4; ++j) { const int n = nb + 16 * sb + 4 * g + j, a = u * i - n;
                    const bool valid = (a >= 0) && (a <= 128) && (tl0 + n * dd >= 0);
                    const float e = s[sb][j] - slope2 * (float)(a * dd) - ref;
                    const float pv = valid ? __builtin_amdgcn_exp2f(e) : 0.f;
                    p[4 * sb + j] = pv; lsum += pv; }
            u32x4 pw; pw.x = pk2(p[0], p[1]); pw.y = pk2(p[2], p[3]); pw.z = pk2(p[4], p[5]); pw.w = pk2(p[6], p[7]);
            const bf16x8 pf = __builtin_bit_cast(bf16x8, pw);
#pragma unroll
            for (int dt = 0; dt < 4; ++dt) {
                const s16x4 v0 = __builtin_amdgcn_ds_read_tr16_b64_v4i16((LAS s16x4*)(vb + vrd + dt * 32));
                const s16x4 v1 = __builtin_amdgcn_ds_read_tr16_b64_v4i16((LAS s16x4*)(vb + vrd + 16 * 144 + dt * 32));
                const bf16x8 vf = (bf16x8){v0[0], v0[1], v0[2], v0[3], v1[0], v1[1], v1[2], v1[3]};
                o[dt] = __builtin_amdgcn_mfma_f32_16x16x32_bf16(vf, pf, o[dt], 0, 0, 0);
            }
        }
#undef ATT_LOAD
        lsum += __shfl_xor(lsum, 16); lsum += __shfl_xor(lsum, 32);
        const float inv = 1.0f / lsum;
        bf16_t* orow = MIX + (size_t)(T0 + 16 * i) * DM + h * 64 + 4 * g;
#pragma unroll
        for (int dt = 0; dt < 4; ++dt) { u32x2 w; w.x = pk2(o[dt][0] * inv, o[dt][1] * inv); w.y = pk2(o[dt][2] * inv, o[dt][3] * inv); *(u32x2*)(orow + 16 * dt) = w; }
    }
}

__device__ __forceinline__ bf16x8 tr2(LAS unsigned char* p0, LAS unsigned char* p1) {
    const s16x4 a = __builtin_amdgcn_ds_read_tr16_b64_v4i16((LAS s16x4*)p0);
    const s16x4 b = __builtin_amdgcn_ds_read_tr16_b64_v4i16((LAS s16x4*)p1);
    return (bf16x8){a[0], a[1], a[2], a[3], b[0], b[1], b[2], b[3]};
}
#define MFMA16(a, b, c) __builtin_amdgcn_mfma_f32_16x16x32_bf16((a), (b), (c), 0, 0, 0)

__device__ __forceinline__ void ml1_phase(const Params& P, Frame& F) {
    const bf16_t* Z = (const bf16_t*)(P.ws + WS_Z); const bf16_t* QK = (const bf16_t*)(P.ws + WS_QK); const float* GATE = (const float*)(P.ws + WS_GATE);
    float* BC = (float*)(P.ws + WS_BC); float* IG = (float*)(P.ws + WS_IG); float* BT = (float*)(P.ws + WS_BT); float* U = (float*)(P.ws + WS_U); float* NV = (float*)(P.ws + WS_NV);
    const float* bi = P.in[9]; const float* bf = P.in[10];
    constexpr int PIT = 272;
    LAS unsigned char* KIM = F.lds; LAS unsigned char* VIM = F.lds + 128 * PIT;
    LAS float* bc = (LAS float*)(F.lds + 2 * 128 * PIT); LAS float* wv = bc + 256;
    const int tid = F.tid, lane = F.lane, i = lane & 15, g = lane >> 4, w = F.wave;
    bf16x8 ones;
#pragma unroll
    for (int j = 0; j < 8; ++j) ones[j] = (i == 0) ? (short)0x3F80 : (short)0;
    for (int unit = F.vcu; unit < 256; unit += F.G) {
        const int bh = unit / NCH, c = unit % NCH, b = bh / NHM, h = bh % NHM, t0 = b * SEQ + c * CH;
        float ig = 0.f;
        __syncthreads();
        if (tid < 256) { const float f = GATE[(size_t)(t0 + tid) * 8 + 4 + h] + bf[h];
            bc[tid] = fminf(f, 0.f) - log1pf(__expf(-fabsf(f)));
            ig = GATE[(size_t)(t0 + tid) * 8 + h] + bi[h]; }
        __syncthreads();
        if (w == 0) {
            const f32x4 a = *(const LAS f32x4*)(bc + 4 * lane);
            const float s1 = a[0], s2 = s1 + a[1], s3 = s2 + a[2], s4 = s3 + a[3];
            float x = s4;
#pragma unroll
            for (int off = 1; off < 64; off <<= 1) { const float v = __shfl_up(x, off); if (lane >= off) x += v; }
            const float ex = x - s4;
            *(LAS f32x4*)(bc + 4 * lane) = (f32x4){ex + s1, ex + s2, ex + s3, ex + s4};
        }
        __syncthreads();
        if (tid < 256) { BC[(size_t)(t0 + tid) * 4 + h] = bc[tid]; IG[(size_t)(t0 + tid) * 4 + h] = ig; wv[tid] = __expf(bc[255] - bc[tid] + ig); }
        if (tid == 0) BT[unit] = bc[255];
        f32x4 acc[9];
#pragma unroll
        for (int q = 0; q < 9; ++q) acc[q] = (f32x4){0.f, 0.f, 0.f, 0.f};
        for (int half = 0; half < 2; ++half) {
            __syncthreads();
#pragma unroll
            for (int q = 0; q < 4; ++q) { const int id = tid + 512 * q, row = id >> 4, c8 = (id & 15) * 8, sidx = half * 128 + row;
                const u32x4 kw = *(const u32x4*)(QK + (size_t)(t0 + sidx) * 1024 + 512 + h * 128 + c8);
                const u32x4 vw = *(const u32x4*)(Z + (size_t)(t0 + sidx) * NZ + ZVM + h * 128 + c8);
                const float ws_ = wv[sidx];
                u32x4 ks; ks.x = pk2(bflo(kw.x) * ws_, bfhi(kw.x) * ws_); ks.y = pk2(bflo(kw.y) * ws_, bfhi(kw.y) * ws_); ks.z = pk2(bflo(kw.z) * ws_, bfhi(kw.z) * ws_); ks.w = pk2(bflo(kw.w) * ws_, bfhi(kw.w) * ws_);
                *(LAS u32x4*)(KIM + row * PIT + c8 * 2) = ks; *(LAS u32x4*)(VIM + row * PIT + c8 * 2) = vw; }
            __syncthreads();
#pragma unroll
            for (int kk = 0; kk < 4; ++kk) {
                const int ro = (32 * kk + 8 * g + (i >> 2)) * PIT + (i & 3) * 8;
                const bf16x8 af = tr2(KIM + ro + 32 * w, KIM + ro + 4 * PIT + 32 * w);
#pragma unroll
                for (int et = 0; et < 8; ++et) { const bf16x8 bfr = tr2(VIM + ro + 32 * et, VIM + ro + 4 * PIT + 32 * et); acc[et] = MFMA16(af, bfr, acc[et]); }
                acc[8] = MFMA16(af, ones, acc[8]);
            }
        }
        float* up = U + (size_t)unit * 16384 + (size_t)(16 * w + 4 * g) * 128 + i;
#pragma unroll
        for (int et = 0; et < 8; ++et)
#pragma unroll
            for (int j = 0; j < 4; ++j) up[j * 128 + 16 * et] = acc[et][j];
        if (i == 0) {
#pragma unroll
            for (int j = 0; j < 4; ++j) NV[unit * 128 + 16 * w + 4 * g + j] = acc[8][j];
        }
    }
}

__device__ __forceinline__ void ml3_phase(const Params& P, Frame& F) {
    const bf16_t* Z = (const bf16_t*)(P.ws + WS_Z); const bf16_t* QK = (const bf16_t*)(P.ws + WS_QK);
    const float* BC = (const float*)(P.ws + WS_BC); const float* IG = (const float*)(P.ws + WS_IG); const float* BT = (const float*)(P.ws + WS_BT);
    const float* U = (const float*)(P.ws + WS_U); const float* NV = (const float*)(P.ws + WS_NV); const float* gn = P.in[11];
    bf16_t* MIX = (bf16_t*)(P.ws + WS_MIX);
    constexpr int CP = 288, VP = 272;
    LAS unsigned char* CIM = F.lds;
    LAS unsigned char* VIM = F.lds + 128 * CP;
    LAS float* cs = (LAS float*)(F.lds + 128 * CP + 256 * VP);
    LAS float* bq = cs + 256;
    const int tid = F.tid, lane = F.lane, i = lane & 15, g = lane >> 4, w = F.wave;
    for (int unit = F.vcu; unit < 256; unit += F.G) {
        const int bh = unit / NCH, c = unit % NCH, b = bh / NHM, h = bh % NHM, t0 = b * SEQ + c * CH;
        __syncthreads();
#pragma unroll
        for (int q = 0; q < 8; ++q) { const int id = tid + 512 * q, row = id >> 4, c8 = (id & 15) * 8;
            *(LAS u32x4*)(VIM + row * VP + c8 * 2) = *(const u32x4*)(Z + (size_t)(t0 + row) * NZ + ZVM + h * 128 + c8); }
        if (tid < 256) { const float bb = BC[(size_t)(t0 + tid) * 4 + h]; bq[tid] = bb; cs[tid] = IG[(size_t)(t0 + tid) * 4 + h] - bb; }
        {   f32x4 cc[4][2]; float n = 0.f;
#pragma unroll
            for (int q = 0; q < 4; ++q) { cc[q][0] = (f32x4){0.f, 0.f, 0.f, 0.f}; cc[q][1] = (f32x4){0.f, 0.f, 0.f, 0.f}; }
            for (int j = 0; j < c; ++j) {
                const float dec = __expf(BT[bh * NCH + j]);
                const float* up = U + (size_t)(bh * NCH + j) * 16384;
#pragma unroll
                for (int q = 0; q < 4; ++q) { const int id = tid + 512 * q; const f32x4 u0 = *(const f32x4*)(up + id * 8), u1 = *(const f32x4*)(up + id * 8 + 4);
                    cc[q][0] = cc[q][0] * dec + u0; cc[q][1] = cc[q][1] * dec + u1; }
                if (tid < 128) n = dec * n + NV[(bh * NCH + j) * 128 + tid];
            }
#pragma unroll
            for (int q = 0; q < 4; ++q) { const int id = tid + 512 * q, d = id >> 4, e8 = (id & 15) * 8;
                u32x4 o; o.x = pk2(cc[q][0][0], cc[q][0][1]); o.y = pk2(cc[q][0][2], cc[q][0][3]); o.z = pk2(cc[q][1][0], cc[q][1][1]); o.w = pk2(cc[q][1][2], cc[q][1][3]);
                *(LAS u32x4*)(CIM + d * CP + e8 * 2) = o; }
            if (tid < 128) { *(LAS u32x4*)(CIM + tid * CP + 256) = (u32x4){f2bf(n), 0u, 0u, 0u}; *(LAS u32x4*)(CIM + tid * CP + 272) = (u32x4){0u, 0u, 0u, 0u}; }
        }
        __syncthreads();
#pragma unroll 1
        for (int a = 0; a < 2; ++a) {
            const int qt = a ? 15 - w : w;
            bf16x8 qf[4];
            { const bf16_t* qp = QK + (size_t)(t0 + 16 * qt + i) * 1024 + h * 128 + 8 * g;
#pragma unroll
                for (int ks = 0; ks < 4; ++ks) qf[ks] = *(const bf16x8*)(qp + 32 * ks); }
            const float bt = bq[16 * qt + i];
            f32x4 acc[8]; float den;
            {
                f32x4 a8 = (f32x4){0.f, 0.f, 0.f, 0.f};
#pragma unroll
                for (int et = 0; et < 8; ++et) acc[et] = (f32x4){0.f, 0.f, 0.f, 0.f};
#pragma unroll
                for (int ks = 0; ks < 4; ++ks) {
                    const int ro = (32 * ks + 8 * g + (i >> 2)) * CP + (i & 3) * 8;
#pragma unroll
                    for (int et = 0; et < 8; ++et) { const bf16x8 cf = tr2(CIM + ro + 32 * et, CIM + ro + 4 * CP + 32 * et); acc[et] = MFMA16(cf, qf[ks], acc[et]); }
                    const bf16x8 cf = tr2(CIM + ro + 256, CIM + ro + 4 * CP + 256);
                    a8 = MFMA16(cf, qf[ks], a8);
                }
                const float eb = __expf(bt);
#pragma unroll
                for (int et = 0; et < 8; ++et) acc[et] = acc[et] * eb;
                den = (g == 0) ? a8[0] * eb : 0.f;
            }
            const int kbhi = qt >> 1;
#pragma unroll 1
            for (int kb = 0; kb <= kbhi; ++kb) {
                float p[8];
#pragma unroll
                for (int sb = 0; sb < 2; ++sb) {
                    const bf16_t* kp = QK + (size_t)(t0 + 32 * kb + 16 * sb + i) * 1024 + 512 + h * 128 + 8 * g;
                    f32x4 sacc = (f32x4){0.f, 0.f, 0.f, 0.f};
#pragma unroll
                    for (int ks = 0; ks < 4; ++ks) { const bf16x8 kf = *(const bf16x8*)(kp + 32 * ks); sacc = MFMA16(kf, qf[ks], sacc); }
                    const f32x4 cv = *(const LAS f32x4*)(cs + 32 * kb + 16 * sb + 4 * g);
#pragma unroll
                    for (int j = 0; j < 4; ++j) { const int srow = 32 * kb + 16 * sb + 4 * g + j, tcol = 16 * qt + i;
                        const float pv = (srow <= tcol) ? sacc[j] * __expf(bt + cv[j]) : 0.f;
                        p[4 * sb + j] = pv; den += pv; } }
                u32x4 pw; pw.x = pk2(p[0], p[1]); pw.y = pk2(p[2], p[3]); pw.z = pk2(p[4], p[5]); pw.w = pk2(p[6], p[7]);
                const bf16x8 pf = __builtin_bit_cast(bf16x8, pw);
                const int ro = (32 * kb + 4 * g + (i >> 2)) * VP + (i & 3) * 8;
#pragma unroll
                for (int et = 0; et < 8; ++et) { const bf16x8 vf = tr2(VIM + ro + 32 * et, VIM + ro + 16 * VP + 32 * et); acc[et] = MFMA16(vf, pf, acc[et]); }
            }
            float dn = den; dn += __shfl_xor(dn, 16); dn += __shfl_xor(dn, 32);
            const float dd = 1.0f / fmaxf(fabsf(dn), 1.0f);
            float ss = 0.f;
#pragma unroll
            for (int et = 0; et < 8; ++et) { acc[et] = acc[et] * dd; ss += acc[et][0] * acc[et][0] + acc[et][1] * acc[et][1] + acc[et][2] * acc[et][2] + acc[et][3] * acc[et][3]; }
            ss += __shfl_xor(ss, 16); ss += __shfl_xor(ss, 32);
            const float rstd = 1.0f / sqrtf(ss * (1.0f / HDM) + EPS);
            const int tok = t0 + 16 * qt + i;
#pragma unroll
            for (int et = 0; et < 8; ++et) { const int e0 = 16 * et + 4 * g;
                const u32x2 ow = *(const u32x2*)(Z + (size_t)tok * NZ + ZOM + h * 128 + e0);
                const f32x4 gv = *(const f32x4*)(gn + h * 128 + e0);
                const float r0 = sigmoidf_(bflo(ow.x)) * acc[et][0] * rstd * gv[0], r1 = sigmoidf_(bfhi(ow.x)) * acc[et][1] * rstd * gv[1];
                const float r2 = sigmoidf_(bflo(ow.y)) * acc[et][2] * rstd * gv[2], r3 = sigmoidf_(bfhi(ow.y)) * acc[et][3] * rstd * gv[3];
                u32x2 o; o.x = pk2(r0, r1); o.y = pk2(r2, r3);
                *(u32x2*)(MIX + (size_t)tok * DM + 512 + h * 128 + e0) = o; }
        }
    }
}

__device__ __forceinline__ void router_phase(const Params& P, Frame& F, const bool commit) {
    const float* X1 = P.out; const float* g2 = P.in[13]; const float* wrt = (const float*)(P.ws + WS_WRT); const float* br = P.in[15];
    unsigned char* H8 = P.ws + WS_H8; int* cnt = (int*)(P.ws + WS_CTL); int* ltok = (int*)(P.ws + WS_LTOK); float* lgate = (float*)(P.ws + WS_LGATE); int* tke = (int*)(P.ws + WS_TKE);
    LAS int* lcnt = (LAS int*)(F.lds);
    LAS int* pe = lcnt + 64;
    LAS float* pg = (LAS float*)(pe + 256);
    const int lane = F.lane, tid = F.tid;
    for (int chunk = F.vcu; chunk < T / 64; chunk += F.G) {
        __syncthreads();
        if (tid < 64) lcnt[tid] = 0;
        __syncthreads();
        {
            f32x4 v[8][4];
#pragma unroll
            for (int tt = 0; tt < 8; ++tt) {
                const int tok = chunk * 64 + F.wave * 8 + tt;
                const f32x4* xr = (const f32x4*)(X1 + (size_t)tok * DM);
                float s = 0.f;
#pragma unroll
                for (int j = 0; j < 4; ++j) { v[tt][j] = xr[lane + 64 * j]; s += v[tt][j][0] * v[tt][j][0] + v[tt][j][1] * v[tt][j][1] + v[tt][j][2] * v[tt][j][2] + v[tt][j][3] * v[tt][j][3]; }
                s = wave_sum(s);
                const float r = 1.0f / sqrtf(s * (1.0f / DM) + EPS);
#pragma unroll
                for (int j = 0; j < 4; ++j) { const f32x4 gg = ((const f32x4*)g2)[lane + 64 * j]; v[tt][j] = v[tt][j] * r * gg;
                    *(unsigned*)(H8 + (size_t)tok * DM + 4 * (lane + 64 * j)) = pk4_fp8(v[tt][j][0] * SC_H, v[tt][j][1] * SC_H, v[tt][j][2] * SC_H, v[tt][j][3] * SC_H); }
            }
            const bool b0 = lane & 1, b1 = lane & 2, b2 = lane & 4;
            float tv0 = -INFINITY, tv1 = -INFINITY, tv2 = -INFINITY, tv3 = -INFINITY; int te0 = 0, te1 = 0, te2 = 0, te3 = 0;
#pragma unroll 2
            for (int e = 0; e < NE; ++e) {
                const f32x4* wrow = (const f32x4*)(wrt + (size_t)e * DM);
                f32x4 w4[4];
#pragma unroll
                for (int j = 0; j < 4; ++j) w4[j] = wrow[lane + 64 * j];
                float a[8];
#pragma unroll
                for (int tt = 0; tt < 8; ++tt) { float pa = 0.f;
#pragma unroll
                    for (int j = 0; j < 4; ++j) pa += v[tt][j][0] * w4[j][0] + v[tt][j][1] * w4[j][1] + v[tt][j][2] * w4[j][2] + v[tt][j][3] * w4[j][3];
                    a[tt] = pa; }
                float k0 = b0 ? a[4] : a[0], k1 = b0 ? a[5] : a[1], k2 = b0 ? a[6] : a[2], k3 = b0 ? a[7] : a[3];
                k0 += __shfl_xor(b0 ? a[0] : a[4], 1); k1 += __shfl_xor(b0 ? a[1] : a[5], 1); k2 += __shfl_xor(b0 ? a[2] : a[6], 1); k3 += __shfl_xor(b0 ? a[3] : a[7], 1);
                float m0 = b1 ? k2 : k0, m1 = b1 ? k3 : k1;
                m0 += __shfl_xor(b1 ? k0 : k2, 2); m1 += __shfl_xor(b1 ? k1 : k3, 2);
                float d = b2 ? m1 : m0;
                d += __shfl_xor(b2 ? m0 : m1, 4);
                d += __shfl_xor(d, 8); d += __shfl_xor(d, 16); d += __shfl_xor(d, 32);
                const float x = d + br[e];
                const bool g0 = x > tv0, g1 = x > tv1, g2_ = x > tv2, g3 = x > tv3;
                tv3 = g2_ ? tv2 : (g3 ? x : tv3); te3 = g2_ ? te2 : (g3 ? e : te3);
                tv2 = g1 ? tv1 : (g2_ ? x : tv2); te2 = g1 ? te1 : (g2_ ? e : te2);
                tv1 = g0 ? tv0 : (g1 ? x : tv1); te1 = g0 ? te0 : (g1 ? e : te1);
                tv0 = g0 ? x : tv0; te0 = g0 ? e : te0;
            }
            const float e1 = __expf(tv1 - tv0), e2 = __expf(tv2 - tv0), e3 = __expf(tv3 - tv0);
            const float inv = 1.0f / (1.0f + e1 + e2 + e3);
            if (lane < 8) {
                const int tl = F.wave * 8 + (b0 ? 4 : 0) + (b1 ? 2 : 0) + (b2 ? 1 : 0);
                const int rk0 = __hip_atomic_fetch_add((int*)(lcnt + te0), 1, __ATOMIC_RELAXED, __HIP_MEMORY_SCOPE_WORKGROUP);
                const int rk1 = __hip_atomic_fetch_add((int*)(lcnt + te1), 1, __ATOMIC_RELAXED, __HIP_MEMORY_SCOPE_WORKGROUP);
                const int rk2 = __hip_atomic_fetch_add((int*)(lcnt + te2), 1, __ATOMIC_RELAXED, __HIP_MEMORY_SCOPE_WORKGROUP);
                const int rk3 = __hip_atomic_fetch_add((int*)(lcnt + te3), 1, __ATOMIC_RELAXED, __HIP_MEMORY_SCOPE_WORKGROUP);
                pe[tl * 4 + 0] = te0 | (rk0 << 8); pe[tl * 4 + 1] = te1 | (rk1 << 8); pe[tl * 4 + 2] = te2 | (rk2 << 8); pe[tl * 4 + 3] = te3 | (rk3 << 8);
                pg[tl * 4 + 0] = inv; pg[tl * 4 + 1] = e1 * inv; pg[tl * 4 + 2] = e2 * inv; pg[tl * 4 + 3] = e3 * inv;
            }
        }
        __syncthreads();
        if (tid < NE && commit) { const int n = lcnt[tid]; lcnt[32 + tid] = n ? atomicAdd(&cnt[64 * tid], n) : 0; }
        __syncthreads();
        if (tid < 256 && commit) { const int w = pe[tid], ee = w & 255, p = lcnt[32 + ee] + (w >> 8), tok = chunk * 64 + (tid >> 2);
            ltok[ee * T + p] = tok; lgate[ee * T + p] = pg[tid]; tke[tok * 4 + (tid & 3)] = ee | (p << 8); }
    }
}

__device__ __forceinline__ void build_tables(const Params& P, Frame& F) {
    LAS int* trs = (LAS int*)(F.lds + LDS_TAB); LAS int* cnts = trs + 64;
    const int* cnt = (const int*)(P.ws + WS_CTL);
    if (F.tid == 0) { int a = 0; for (int e = 0; e < NE; ++e) { const int n = cnt[64 * e]; trs[e] = a; cnts[e] = n; a += (n + 255) >> 8; } trs[NE] = a; }
    __syncthreads();
}

__device__ __forceinline__ void combine_phase(const Params& P, Frame& F, const bool commit) {
    const LAS int* trs = (const LAS int*)(F.lds + LDS_TAB);
    const bf16_t* Y = (const bf16_t*)(P.ws + WS_Y); const int* tke = (const int*)(P.ws + WS_TKE);
    float* out = P.out; const int lane = F.lane;
    for (int tok = F.gw; tok < T; tok += F.ngw) {
        f32x4 a[4];
#pragma unroll
        for (int j = 0; j < 4; ++j) a[j] = *(const f32x4*)(out + (size_t)tok * DM + 4 * (lane + 64 * j));
#pragma unroll
        for (int k = 0; k < 4; ++k) { const int w = tke[tok * 4 + k], e = w & 255, p = w >> 8; const size_t slot = (size_t)trs[e] * 256 + p;
#pragma unroll
            for (int j = 0; j < 4; ++j) { const u32x2 y = *(const u32x2*)(Y + slot * DM + 4 * (lane + 64 * j)); a[j][0] += bflo(y.x); a[j][1] += bfhi(y.x); a[j][2] += bflo(y.y); a[j][3] += bfhi(y.y); } }
#pragma unroll
        for (int j = 0; j < 4; ++j) if (commit || a[j][0] == 123456.789f) *(f32x4*)(out + (size_t)tok * DM + 4 * (lane + 64 * j)) = a[j];
    }
}


#define XB_TMO      128
#define XB_XCNT(j)  (256  + 64 * (j))
#define XB_XSUB(j)  (1280 + 64 * (j))
#define XB_XGEN(j)  (2304 + 64 * (j))
#define XB_TOP      3328
#define XB_TOPGEN   3392
#define XCD_BAR_WORDS 3456
#define XB_SPIN_CAP (1u << 18)
__device__ __forceinline__ unsigned xb_ld(unsigned* p)              { return __hip_atomic_load(p, __ATOMIC_RELAXED, __HIP_MEMORY_SCOPE_AGENT); }
__device__ __forceinline__ unsigned xb_add(unsigned* p, unsigned v) { return __hip_atomic_fetch_add(p, v, __ATOMIC_RELAXED, __HIP_MEMORY_SCOPE_AGENT); }
__device__ __forceinline__ unsigned xb_xcc_id() { return (unsigned)__builtin_amdgcn_s_getreg((3 << 11) | 20) & 0xFu; }
#define XB_SPIN(cond, bar) do { unsigned _sp = 0; while (cond) { __builtin_amdgcn_s_sleep(1); \
    if ((++_sp & 255u) == 0u) { if (xb_ld(&(bar)[XB_TMO])) break; if (_sp > XB_SPIN_CAP) { atomicAdd(&(bar)[XB_TMO], 1u); break; } } } } while (0)
struct XcdBarrier { unsigned* bar; unsigned x; volatile LAS unsigned* st; };
__device__ __forceinline__ XcdBarrier xcd_barrier_post(unsigned* bar, volatile LAS unsigned* st) {
    XcdBarrier b; b.bar = bar; b.x = xb_xcc_id(); b.st = st;
    if (threadIdx.x == 0) (void)xb_add(&bar[XB_XCNT(b.x)], 1u);
    return b;
}
__device__ __forceinline__ void xcd_barrier_complete(unsigned* bar, unsigned x, unsigned& nloc, unsigned& nx) {
    const unsigned G = gridDim.x * gridDim.y * gridDim.z;
    unsigned sum, cnt, mine, sp = 0u;
    for (;;) {
        sum = 0u; cnt = 0u; mine = 0u;
#pragma unroll
        for (unsigned j = 0; j < 16; ++j) { const unsigned c = xb_ld(&bar[XB_XCNT(j)]); sum += c; cnt += (c > 0u) ? 1u : 0u; mine = (j == x) ? c : mine; }
        if (sum == G) break;
        __builtin_amdgcn_s_sleep(1);
        if ((++sp & 255u) == 0u) { if (xb_ld(&bar[XB_TMO])) break; if (sp > XB_SPIN_CAP) { atomicAdd(&bar[XB_TMO], 1u); break; } }
    }
    nloc = mine > 0u ? mine : 1u; nx = cnt > 0u ? cnt : 1u;
}
__device__ __forceinline__ void xcd_barrier(const XcdBarrier& b) {
    asm volatile("s_waitcnt vmcnt(0)" ::: "memory");
    __syncthreads();
    if (threadIdx.x == 0) {
        unsigned* bar = b.bar;
        __builtin_amdgcn_s_waitcnt(0);
        unsigned nloc = b.st[0], nx = b.st[1];
        if (nloc == 0u) { xcd_barrier_complete(bar, b.x, nloc, nx); b.st[0] = nloc; b.st[1] = nx; }
        const unsigned old = xb_add(&bar[XB_XSUB(b.x)], 1u);
        const unsigned gen = old / nloc;
        if (old + 1u == (gen + 1u) * nloc) {
            __builtin_amdgcn_fence(__ATOMIC_RELEASE, "agent");
            asm volatile("s_waitcnt vmcnt(0)" ::: "memory");
            const unsigned og = xb_add(&bar[XB_TOP], 1u);
            const unsigned tg = og / nx;
            if (og + 1u == (tg + 1u) * nx) xb_add(&bar[XB_TOPGEN], 1u);
            else XB_SPIN(xb_ld(&bar[XB_TOPGEN]) == tg, bar);
            __builtin_amdgcn_fence(__ATOMIC_ACQUIRE, "agent");
            xb_add(&bar[XB_XGEN(b.x)], 1u);
            asm volatile("s_waitcnt vmcnt(0)" ::: "memory");
        } else {
            XB_SPIN(xb_ld(&bar[XB_XGEN(b.x)]) == gen, bar);
            __builtin_amdgcn_fence(__ATOMIC_ACQUIRE, "agent");
            asm volatile("s_waitcnt vmcnt(0)" ::: "memory");
        }
    }
    __syncthreads();
}

__global__ void __launch_bounds__(NTHR) fwd_megakernel(Params P) {
    extern __shared__ __attribute__((aligned(16))) unsigned char lds_raw[];
    Frame F;
    F.lds = (LAS unsigned char*)lds_raw;
    F.tid = threadIdx.x; F.lane = F.tid & 63; F.wave = __builtin_amdgcn_readfirstlane(F.tid >> 6);
    F.G = gridDim.x; { const int bx = blockIdx.x; F.vcu = (F.G % 8 == 0) ? (bx % 8) * (F.G / 8) + bx / 8 : bx; }
    F.gw = F.vcu * NWAVES + F.wave; F.ngw = F.G * NWAVES;
    unsigned char* ws = P.ws;
    LAS unsigned char* stage = F.lds + LDS_STAGE;
    volatile LAS unsigned* bst = (volatile LAS unsigned*)(F.lds + LDS_TAB + 512);
    if (F.tid < 2) bst[F.tid] = 0u;
    __syncthreads();
    const XcdBarrier bar = xcd_barrier_post((unsigned*)(ws + WS_CTL) + 4096, bst);
    LAS unsigned long long* tstamp = (LAS unsigned long long*)(F.lds + LDS_TAB + 640); int nstamp = 0;
    if (TPROBE >= 0 && blockIdx.x == 0 && F.tid == 0) tstamp[nstamp] = __builtin_amdgcn_s_memrealtime();
    ++nstamp;
#define GRID_SYNC() do { xcd_barrier(bar); if (TPROBE >= 0 && blockIdx.x == 0 && F.tid == 0) tstamp[nstamp] = __builtin_amdgcn_s_memrealtime(); ++nstamp; } while (0)

    p0_prologue(P, F);
    if (DUP & 1) p0_prologue(P, F);
    GRID_SYNC();
    {
        pg8::DenseSched S{T / 256, NZ / 256, F.G, (int)blockIdx.x, DM, (const char*)(ws + WS_WIN), (DUP & 2) ? 2 : 1};
        pg8::EpiBf16 E{(bf16_t*)(ws + WS_Z), NZ};
        pg8::gemm_phase<false>(stage, (const char*)(ws + WS_XN), DM, S, E);
    }
    GRID_SYNC();
    p2_tokprep(P, F);
    GRID_SYNC();
    if (DUP & 4096) { for (int q = 0; q < 10; ++q) GRID_SYNC(); }
    {
        pg8::DenseSched S{T / 256, 1024 / 256, F.G, (int)blockIdx.x, 512, (const char*)(ws + WS_WQK), (DUP & 4) ? 2 : 1};
        pg8::EpiBf16 E{(bf16_t*)(ws + WS_QK), 1024};
        pg8::gemm_phase<false>(stage, (const char*)(ws + WS_XC), 512, S, E);
    }
    attn_phase(P, F);
    if (DUP & 8) attn_phase(P, F);
    GRID_SYNC();
    ml1_phase(P, F);
    if (DUP & 16) ml1_phase(P, F);
    GRID_SYNC();
    ml3_phase(P, F);
    if (DUP & 32) ml3_phase(P, F);
    GRID_SYNC();
    {
        pg8::DenseSched S{T / 256, DM / 256, F.G, (int)blockIdx.x, DM, (const char*)(ws + WS_WOUT), (DUP & 64) ? 2 : 1};
        pg8::EpiResF32 E{P.out, P.in[0], DM};
        pg8::gemm_phase<false>(stage, (const char*)(ws + WS_MIX), DM, S, E);
    }
    GRID_SYNC();
    if (DUP & 512) router_phase(P, F, false);
    router_phase(P, F, true);
    GRID_SYNC();
    build_tables(P, F);
    const LAS int* trs = (const LAS int*)(F.lds + LDS_TAB); const LAS int* cnts = trs + 64;
    {
        pg8::MoeSched<true> S{trs, cnts, 8, F.G, (int)blockIdx.x, DM / 2, (const char*)(ws + WS_WGU), (size_t)2 * DFF * DM, (const int*)(ws + WS_LTOK)};
        pg8::EpiSwiglu E{(unsigned char*)(ws + WS_ACT), P.in[17]};
        pg8::gemm_phase<true>(stage, (const char*)(ws + WS_H8), DM / 2, S, E);
    }
    GRID_SYNC();
    {
        pg8::MoeSched<false> S{trs, cnts, 4, F.G, (int)blockIdx.x, DFF / 2, (const char*)(ws + WS_WD), (size_t)DM * DFF, nullptr};
        pg8::EpiDown E{(bf16_t*)(ws + WS_Y), P.in[19], (const float*)(ws + WS_LGATE), cnts};
        pg8::gemm_phase<true>(stage, (const char*)(ws + WS_ACT), DFF / 2, S, E);
    }
    GRID_SYNC();
    if (DUP & 1024) combine_phase(P, F, false);
    combine_phase(P, F, true);
    if (TPROBE >= 0 && blockIdx.x == 0 && F.tid == 0) {
        tstamp[nstamp] = __builtin_amdgcn_s_memrealtime();
        const unsigned long long span = tstamp[TPROBE + 1] - tstamp[TPROBE], t0_ = __builtin_amdgcn_s_memrealtime();
        while (__builtin_amdgcn_s_memrealtime() - t0_ < 4ull * span) __builtin_amdgcn_s_sleep(8);
    }
}
}

extern "C" void kernel_launch(void* const* d_in, const int* in_sizes, int n_in, void* d_out, int out_size, void* d_ws, size_t ws_size, hipStream_t stream) {
    static int grid = 0;
    if (grid == 0) {
        if (n_in != 20 || out_size != T * DM || ws_size < WS_END) { fprintf(stderr, "kernel_launch: unexpected problem (n_in %d out %d ws %zu)\n", n_in, out_size, ws_size); grid = -1; return; }
        int dev = 0, cus = 0, per_cu = 0;
        (void)hipGetDevice(&dev);
        (void)hipDeviceGetAttribute(&cus, hipDeviceAttributeMultiprocessorCount, dev);
        (void)hipFuncSetAttribute((const void*)fwd_megakernel, hipFuncAttributeMaxDynamicSharedMemorySize, LDS_BYTES);
        (void)hipOccupancyMaxActiveBlocksPerMultiprocessor(&per_cu, (const void*)fwd_megakernel, NTHR, LDS_BYTES);
        if (per_cu < 1) { fprintf(stderr, "kernel_launch: occupancy query says %d blocks per CU\n", per_cu); per_cu = 1; }
        grid = cus;
    }
    if (grid < 0) return;
    (void)hipMemsetAsync((char*)d_ws + WS_CTL, 0, 65536, stream);
    Params p{};
    for (int i = 0; i < 20; ++i) p.in[i] = (const float*)d_in[i];
    p.out = (float*)d_out; p.ws = (unsigned char*)d_ws;
    hipLaunchKernelGGL(fwd_megakernel, dim3(grid), dim3(NTHR), LDS_BYTES, stream, p);
    const hipError_t e = hipPeekAtLastError();
    if (e != hipSuccess) fprintf(stderr, "launch failed: %s (grid %d)\n", hipGetErrorString(e), grid);
}
```

```cpp
#include <hip/hip_runtime.h>
#include <cstdio>
#include <cstdint>

#define LAS __attribute__((address_space(3)))
typedef unsigned short bf16_t;
typedef short bf16x8 __attribute__((ext_vector_type(8)));
typedef short s16x4 __attribute__((ext_vector_type(4)));
typedef float f32x4 __attribute__((ext_vector_type(4)));
typedef unsigned u32x4 __attribute__((ext_vector_type(4)));
typedef unsigned u32x2 __attribute__((ext_vector_type(2)));
typedef int i32x4 __attribute__((ext_vector_type(4)));
typedef int i32x8 __attribute__((ext_vector_type(8)));

namespace {
constexpr int BATCH = 2, SEQ = 8192, T = BATCH * SEQ, DM = 1024, DIN = 3080, NZ = 3072;
constexpr int NHA = 8, NHM = 4, HDM = 128;
constexpr int NE = 32, DFF = 1024;
constexpr int CH = 256, NCH = SEQ / CH;
constexpr float EPS = 1e-6f;
constexpr float LOG2E = 1.4426950408889634f;
constexpr float SC_W = 32.f, SC_H = 8.f, SC_A = 4.f;
constexpr int ZQ = 0, ZK = 512, ZV = 1024, ZXM = 1536, ZVM = 2048, ZOM = 2560;
constexpr int NWAVES = 8, NTHR = 512;
constexpr int MAXTR = 288;
constexpr int TPROBE = -1;
constexpr int DUP = 0;
constexpr size_t MiB = 1u << 20;
constexpr size_t WS_CTL = 0;
constexpr size_t WS_WIN = 1 * MiB;
constexpr size_t WS_WOUT = 7 * MiB;
constexpr size_t WS_WQK = 9 * MiB;
constexpr size_t WS_WGU = 16 * MiB;
constexpr size_t WS_WD = 144 * MiB;
constexpr size_t WS_XN = 208 * MiB;
constexpr size_t WS_Z = 240 * MiB;
constexpr size_t WS_GATE = 336 * MiB;
constexpr size_t WS_XC = 337 * MiB;
constexpr size_t WS_QK = 353 * MiB;
constexpr size_t WS_BC = 385 * MiB;
constexpr size_t WS_IG = 385 * MiB + 512 * 1024;
constexpr size_t WS_BT = 386 * MiB;
constexpr size_t WS_NV = 386 * MiB + 4096;
constexpr size_t WS_U = 387 * MiB;
constexpr size_t WS_MIX = 403 * MiB;
constexpr size_t WS_LTOK = 435 * MiB;
constexpr size_t WS_LGATE = 437 * MiB;
constexpr size_t WS_TKE = 439 * MiB;
constexpr size_t WS_WRT = 439 * MiB + 512 * 1024;
constexpr size_t WS_H8 = 728 * MiB;
constexpr size_t WS_ACT = 440 * MiB;
constexpr size_t WS_Y = 584 * MiB;
constexpr size_t WS_END = 744 * MiB;
constexpr int LDS_STAGE = 0;
constexpr int LDS_TAB = 131072;
constexpr int LDS_BYTES = 131072 + 1024;

__device__ __forceinline__ unsigned f2bf(float f) { unsigned u = __builtin_bit_cast(unsigned, f); return (u + 0x7fffu + ((u >> 16) & 1u)) >> 16; }
__device__ __forceinline__ unsigned pk2(float lo, float hi) { return f2bf(lo) | (f2bf(hi) << 16); }
__device__ __forceinline__ unsigned pk4_fp8(float a, float b, float c, float d) { int w = 0; w = __builtin_amdgcn_cvt_pk_fp8_f32(a, b, w, false); w = __builtin_amdgcn_cvt_pk_fp8_f32(c, d, w, true); return (unsigned)w; }
__device__ __forceinline__ float bf2f(unsigned b) { return __builtin_bit_cast(float, b << 16); }
__device__ __forceinline__ float bflo(unsigned w) { return __builtin_bit_cast(float, w << 16); }
__device__ __forceinline__ float bfhi(unsigned w) { return __builtin_bit_cast(float, w & 0xffff0000u); }
__device__ __forceinline__ float wave_sum(float v) {
#pragma unroll
    for (int o = 1; o < 64; o <<= 1) v += __shfl_xor(v, o);
    return v;
}
__device__ __forceinline__ float sigmoidf_(float x) { return 1.0f / (1.0f + __expf(-x)); }
}

namespace pg8 {
constexpr int BM = 256, BK = 64, HALF = 128, HTB = HALF * BK * 2, STAGE_BYTES = 8 * HTB, NXCD = 8, WGM = 8;
__host__ __device__ __forceinline__ int lds_byte(int r, int c) { const int st = (r >> 4) * 2 + (c >> 5), rr = r & 15, cc = c & 31, ob = rr * 64 + cc * 2; return st * 1024 + (ob ^ (((ob >> 9) & 1) << 5)); }
__host__ __device__ __forceinline__ void stage_rc(int b, int& R, int& C) { const int st = b / 1024, sb = b % 1024, swz = sb ^ (((sb >> 9) & 1) << 5); R = (st >> 1) * 16 + swz / 64; C = (st & 1) * 32 + (swz % 64) / 2; }
__host__ __device__ __forceinline__ int perm32(int rho) { const int n = rho >> 4, i = rho & 15; return 8 * (i >> 2) + 4 * n + (i & 3); }

__device__ __forceinline__ bool tile_order(int i, int G, int c, int nM, int nN, int& pm, int& pn) {
    const int nwg = nM * nN; const long L = (long)i * G + c; if (L >= nwg) return false;
    int wgid = (int)L; { const int q = nwg / NXCD, r = nwg % NXCD, xcd = wgid % NXCD, off = wgid / NXCD; wgid = (xcd < r ? xcd * (q + 1) : r * (q + 1) + (xcd - r) * q) + off; }
    const int nig = WGM * nN, gid = wgid / nig, fm = gid * WGM, gsz = (nM - fm) < WGM ? (nM - fm) : WGM;
    pm = fm + ((wgid % nig) % gsz); pn = (wgid % nig) / gsz; return true;
}

struct Unit { int pm, pn, e, mt; };

struct DenseSched {
    int nM, nN, G, c, K; const char* Bt; int reps;
    static constexpr bool DRAIN = false;
    __device__ __forceinline__ bool next(int i, Unit& u) const { u.e = 0; u.mt = 0; const int per = (nM * nN + G - 1) / G; if (i >= per * reps) return false; if (!tile_order(i % per, G, c, nM, nN, u.pm, u.pn)) return tile_order(0, G, c, nM, nN, u.pm, u.pn); return true; }
    __device__ __forceinline__ void a_off(const Unit& u, const int (&R)[2], const int (&C)[2], unsigned (&off)[2][2]) const {
#pragma unroll
        for (int h = 0; h < 2; ++h)
#pragma unroll
            for (int i = 0; i < 2; ++i) off[h][i] = (unsigned)(((u.pm * BM + h * HALF + R[i]) * K + C[i]) * 2);
    }
    __device__ __forceinline__ const char* b_ptr(const Unit& u) const { return Bt + (size_t)u.pn * BM * K * 2; }
};
template <bool GATHER> struct MoeSched {
    const LAS int* trs; const LAS int* cnts; int nN, G, c, K; const char* Bt; size_t bstride; const int* ltok;
    static constexpr bool DRAIN = GATHER;
    __device__ __forceinline__ bool next(int i, Unit& u) const {
        const int nM = __builtin_amdgcn_readfirstlane(trs[NE]);
        if (!tile_order(i, G, c, nM, nN, u.pm, u.pn)) return false;
        int e = 0;
        for (int j = 1; j < NE; ++j) e += (__builtin_amdgcn_readfirstlane(trs[j]) <= u.pm) ? 1 : 0;
        u.e = e; u.mt = u.pm - __builtin_amdgcn_readfirstlane(trs[e]); return true;
    }
    __device__ __forceinline__ void a_off(const Unit& u, const int (&R)[2], const int (&C)[2], unsigned (&off)[2][2]) const {
        const int n = __builtin_amdgcn_readfirstlane(cnts[u.e]);
#pragma unroll
        for (int h = 0; h < 2; ++h)
#pragma unroll
            for (int i = 0; i < 2; ++i) {
                int row;
                if (GATHER) { const int p = u.mt * BM + h * HALF + R[i]; row = (p < n) ? ltok[u.e * T + p] : 0; }
                else row = u.pm * BM + h * HALF + R[i];
                off[h][i] = (unsigned)((row * K + C[i]) * 2);
            }
    }
    __device__ __forceinline__ const char* b_ptr(const Unit& u) const { return Bt + (size_t)u.e * bstride + (size_t)u.pn * BM * K * 2; }
};

struct EpiBf16 {
    static constexpr bool PERM = true; static constexpr int BMAP = 0;
    bf16_t* O; int ldc;
    __device__ __forceinline__ void operator()(const f32x4 (&acc)[2][2][4][2], const Unit& u, int wr, int wc, int fr, int fq) const {
        const int row0 = u.pm * BM + wr * 64 + fr, col0 = u.pn * BM + wc * 32 + 8 * fq;
#pragma unroll
        for (int ai = 0; ai < 2; ++ai)
#pragma unroll
            for (int m = 0; m < 4; ++m) { bf16_t* rowp = O + (size_t)(row0 + ai * HALF + m * 16) * ldc + col0;
#pragma unroll
                for (int bj = 0; bj < 2; ++bj) { const f32x4 v0 = acc[ai][bj][m][0], v1 = acc[ai][bj][m][1];
                    u32x4 w; w.x = pk2(v0[0], v0[1]); w.y = pk2(v0[2], v0[3]); w.z = pk2(v1[0], v1[1]); w.w = pk2(v1[2], v1[3]);
                    *(u32x4*)(rowp + bj * HALF) = w; } }
    }
};
struct EpiQKNorm {
    static constexpr bool PERM = true; static constexpr int BMAP = 1;
    bf16_t* O; const float* gq; const float* gk;
    __device__ __forceinline__ void operator()(const f32x4 (&acc)[2][2][4][2], const Unit& u, int wr, int wc, int fr, int fq) const {
        const int row0 = u.pm * BM + wr * 64 + fr, col0 = u.pn * BM + wc * 64 + 8 * fq;
        const bool nrm = u.pn < 4; const float* g = (u.pn < 2) ? gq : gk; const float qs = (u.pn < 2) ? 0.125f * LOG2E : 1.0f;
        f32x4 gv[2][2];
#pragma unroll
        for (int bj = 0; bj < 2; ++bj)
#pragma unroll
            for (int n = 0; n < 2; ++n) gv[bj][n] = nrm ? *(const f32x4*)(g + 32 * bj + 8 * fq + 4 * n) : (f32x4){1.f, 1.f, 1.f, 1.f};
#pragma unroll
        for (int ai = 0; ai < 2; ++ai)
#pragma unroll
            for (int m = 0; m < 4; ++m) { bf16_t* rowp = O + (size_t)(row0 + ai * HALF + m * 16) * NZ + col0;
                float sc = 1.0f;
                if (nrm) { float ss = 0.f;
#pragma unroll
                    for (int bj = 0; bj < 2; ++bj)
#pragma unroll
                        for (int n = 0; n < 2; ++n) { const f32x4 v = acc[ai][bj][m][n]; ss += v[0] * v[0] + v[1] * v[1] + v[2] * v[2] + v[3] * v[3]; }
                    ss += __shfl_xor(ss, 16); ss += __shfl_xor(ss, 32);
                    sc = qs / sqrtf(ss * (1.0f / 64.f) + EPS); }
#pragma unroll
                for (int bj = 0; bj < 2; ++bj) { const f32x4 v0 = acc[ai][bj][m][0] * gv[bj][0] * sc, v1 = acc[ai][bj][m][1] * gv[bj][1] * sc;
                    u32x4 w; w.x = pk2(v0[0], v0[1]); w.y = pk2(v0[2], v0[3]); w.z = pk2(v1[0], v1[1]); w.w = pk2(v1[2], v1[3]);
                    *(u32x4*)(rowp + bj * 32) = w; } }
    }
};
struct EpiResF32 {
    static constexpr bool PERM = false; static constexpr int BMAP = 0;
    float* C; const float* Rs; int ldc;
    __device__ __forceinline__ void operator()(const f32x4 (&acc)[2][2][4][2], const Unit& u, int wr, int wc, int fr, int fq) const {
        const int row0 = u.pm * BM + wr * 64 + fr, col0 = u.pn * BM + wc * 32 + 4 * fq;
#pragma unroll
        for (int ai = 0; ai < 2; ++ai)
#pragma unroll
            for (int m = 0; m < 4; ++m) { const size_t ro = (size_t)(row0 + ai * HALF + m * 16) * ldc + col0;
#pragma unroll
                for (int bj = 0; bj < 2; ++bj)
#pragma unroll
                    for (int n = 0; n < 2; ++n) { const f32x4 r = *(const f32x4*)(Rs + ro + bj * HALF + n * 16); *(f32x4*)(C + ro + bj * HALF + n * 16) = acc[ai][bj][m][n] + r; } }
    }
};
struct EpiSwiglu {
    static constexpr bool PERM = true; static constexpr int BMAP = 0;
    unsigned char* O; const float* bgu;
    __device__ __forceinline__ void operator()(const f32x4 (&acc)[2][2][4][2], const Unit& u, int wr, int wc, int fr, int fq) const {
        const int row0 = u.pm * BM + wr * 64 + fr, f0 = u.pn * HALF + wc * 32 + 8 * fq;
        const float* bg = bgu + (size_t)u.e * 2 * DFF + f0;
        constexpr float inv = 1.0f / (SC_H * SC_W);
        f32x4 bgv[2], buv[2];
#pragma unroll
        for (int n = 0; n < 2; ++n) { bgv[n] = *(const f32x4*)(bg + 4 * n); buv[n] = *(const f32x4*)(bg + DFF + 4 * n); }
#pragma unroll
        for (int ai = 0; ai < 2; ++ai)
#pragma unroll
            for (int m = 0; m < 4; ++m) { unsigned char* rowp = O + (size_t)(row0 + ai * HALF + m * 16) * DFF + f0;
                float r[8];
#pragma unroll
                for (int n = 0; n < 2; ++n) { const f32x4 gv = acc[ai][0][m][n] * inv + bgv[n], uv = acc[ai][1][m][n] * inv + buv[n];
#pragma unroll
                    for (int j = 0; j < 4; ++j) { const float gg = fminf(gv[j], 7.0f), uu = fminf(fmaxf(uv[j], -7.0f), 7.0f);
                        r[4 * n + j] = SC_A * gg * (uu + 1.0f) / (1.0f + __expf(-1.702f * gg)); } }
                u32x2 w; w.x = pk4_fp8(r[0], r[1], r[2], r[3]); w.y = pk4_fp8(r[4], r[5], r[6], r[7]);
                *(u32x2*)rowp = w; }
    }
};
struct EpiDown {
    static constexpr bool PERM = true; static constexpr int BMAP = 0;
    bf16_t* O; const float* bd; const float* lgate; const LAS int* cnts;
    __device__ __forceinline__ void operator()(const f32x4 (&acc)[2][2][4][2], const Unit& u, int wr, int wc, int fr, int fq) const {
        const int row0 = u.pm * BM + wr * 64 + fr, col0 = u.pn * BM + wc * 32 + 8 * fq;
        const int n_e = cnts[u.e];
        f32x4 bv[2][2];
#pragma unroll
        for (int bj = 0; bj < 2; ++bj)
#pragma unroll
            for (int n = 0; n < 2; ++n) bv[bj][n] = *(const f32x4*)(bd + (size_t)u.e * DM + col0 + bj * HALF + 4 * n);
#pragma unroll
        for (int ai = 0; ai < 2; ++ai)
#pragma unroll
            for (int m = 0; m < 4; ++m) { const int rt = wr * 64 + fr + ai * HALF + m * 16, p = u.mt * BM + rt;
                const float gt = (p < n_e) ? lgate[(size_t)u.e * T + p] : 0.f;
                bf16_t* rowp = O + (size_t)(row0 + ai * HALF + m * 16) * DM + col0;
#pragma unroll
                for (int bj = 0; bj < 2; ++bj) { const f32x4 v0 = (acc[ai][bj][m][0] * (1.0f / (SC_A * SC_W)) + bv[bj][0]) * gt, v1 = (acc[ai][bj][m][1] * (1.0f / (SC_A * SC_W)) + bv[bj][1]) * gt;
                    u32x4 w; w.x = pk2(v0[0], v0[1]); w.y = pk2(v0[2], v0[3]); w.z = pk2(v1[0], v1[1]); w.w = pk2(v1[2], v1[3]);
                    *(u32x4*)(rowp + bj * HALF) = w; } }
    }
};

template <bool FP8, class Epi, class Sched>
__device__ __forceinline__ void gemm_phase(LAS unsigned char* lds, const char* A0, const int K, const Sched& S, const Epi& E) {
    const int tid = threadIdx.x, wid = __builtin_amdgcn_readfirstlane(tid >> 6), lane = tid & 63, wr = wid >> 2, wc = wid & 3, fr = lane & 15, fq = lane >> 4;
    const int nt = K / BK;
    int Rr[2], Cc[2]; unsigned voffB[2];
#pragma unroll
    for (int i = 0; i < 2; ++i) { stage_rc(tid * 16 + i * 8192, Rr[i], Cc[i]); const int r5 = Epi::PERM ? perm32(Rr[i] & 31) : (Rr[i] & 31); const int Rb = Epi::BMAP ? (64 * (Rr[i] >> 5) + r5) : ((Rr[i] & ~31) + r5); voffB[i] = (unsigned)(Rb * K + Cc[i]) * 2u; }
    const size_t kstep = (size_t)(BK * 2);
    const size_t hstep = (size_t)(Epi::BMAP ? 32 : HALF) * K * 2;
    const unsigned ldsw = (unsigned)wid * 1024u;
    const int aoff = lds_byte(wr * 64 + fr, fq * 8), boff = lds_byte(wc * 32 + fr, fq * 8);
#define PG8_SA(b, h) (((b) * 2 + (h)) * HTB)
#define PG8_SB(b, h) ((4 + (b) * 2 + (h)) * HTB)
#define PG8_STAGE_B(bufoff, gbase) do { _Pragma("unroll") for (int _i = 0; _i < 2; ++_i) \
        __builtin_amdgcn_global_load_lds((const unsigned*)((const char*)(gbase) + voffB[_i]), (LAS unsigned*)(lds + (bufoff) + ldsw + _i * 8192), 16, 0, 0); } while (0)
#define PG8_STAGE_A(bufoff, gbase, o0, o1) do { \
        __builtin_amdgcn_global_load_lds((const unsigned*)((const char*)(gbase) + (o0)), (LAS unsigned*)(lds + (bufoff) + ldsw), 16, 0, 0); \
        __builtin_amdgcn_global_load_lds((const unsigned*)((const char*)(gbase) + (o1)), (LAS unsigned*)(lds + (bufoff) + ldsw + 8192), 16, 0, 0); } while (0)
#define PG8_LDA(dst, b, h) do { if constexpr (FP8) { _Pragma("unroll") for (int m = 0; m < 4; ++m) { const i32x4 lo_ = *(const LAS i32x4*)(lds + PG8_SA(b, h) + aoff + m * 2048), hi_ = *(const LAS i32x4*)(lds + PG8_SA(b, h) + aoff + m * 2048 + 1024); \
            dst##8[m] = __builtin_shufflevector(lo_, hi_, 0, 1, 2, 3, 4, 5, 6, 7); } } \
        else { _Pragma("unroll") for (int m = 0; m < 4; ++m) _Pragma("unroll") for (int k = 0; k < 2; ++k) dst[m][k] = *(const LAS bf16x8*)(lds + PG8_SA(b, h) + aoff + m * 2048 + k * 1024); } } while (0)
#define PG8_LDB(dst, b, h) do { if constexpr (FP8) { _Pragma("unroll") for (int n = 0; n < 2; ++n) { const i32x4 lo_ = *(const LAS i32x4*)(lds + PG8_SB(b, h) + boff + n * 2048), hi_ = *(const LAS i32x4*)(lds + PG8_SB(b, h) + boff + n * 2048 + 1024); \
            dst##8[n] = __builtin_shufflevector(lo_, hi_, 0, 1, 2, 3, 4, 5, 6, 7); } } \
        else { _Pragma("unroll") for (int n = 0; n < 2; ++n) _Pragma("unroll") for (int k = 0; k < 2; ++k) dst[n][k] = *(const LAS bf16x8*)(lds + PG8_SB(b, h) + boff + n * 2048 + k * 1024); } } while (0)
#define PG8_MMA(ai, bj, At, Bt) do { __builtin_amdgcn_s_setprio(1); \
        if constexpr (FP8) { _Pragma("unroll") for (int m = 0; m < 4; ++m) _Pragma("unroll") for (int n = 0; n < 2; ++n) \
            asm volatile("s_nop 1\n\tv_mfma_f32_16x16x128_f8f6f4 %0, %1, %2, %0" : "+v"(acc[ai][bj][m][n]) : "v"(Bt##8[n]), "v"(At##8[m])); } \
        else { _Pragma("unroll") for (int m = 0; m < 4; ++m) _Pragma("unroll") for (int n = 0; n < 2; ++n) _Pragma("unroll") for (int k = 0; k < 2; ++k) \
            acc[ai][bj][m][n] = __builtin_amdgcn_mfma_f32_16x16x32_bf16(Bt[n][k], At[m][k], acc[ai][bj][m][n], 0, 0, 0); } \
        __builtin_amdgcn_s_setprio(0); } while (0)
#define PG8_WAIT_V(n) asm volatile("s_waitcnt vmcnt(" #n ")" ::: "memory")
#define PG8_WAIT_L(n) asm volatile("s_waitcnt lgkmcnt(" #n ")" ::: "memory")
#define PG8_BAR __builtin_amdgcn_s_barrier()
#define PG8_SCHED __builtin_amdgcn_sched_barrier(0)
    Unit cur, nxt; int ui = 0;
    if (!S.next(0, cur)) return;
    f32x4 acc[2][2][4][2];
#pragma unroll
    for (int a = 0; a < 2; ++a)
#pragma unroll
        for (int b = 0; b < 2; ++b)
#pragma unroll
            for (int m = 0; m < 4; ++m)
#pragma unroll
                for (int n = 0; n < 2; ++n) acc[a][b][m][n] = (f32x4){0.f, 0.f, 0.f, 0.f};
    bf16x8 At[4][2], B0[2][2], B1[2][2]; i32x8 At8[4], B08[2], B18[2];
    unsigned offC[2][2], offN[2][2];
    S.a_off(cur, Rr, Cc, offC);
    const char* cB = S.b_ptr(cur);
    if (Sched::DRAIN) PG8_WAIT_V(0);
    PG8_STAGE_B(PG8_SB(0, 0), cB); PG8_STAGE_B(PG8_SB(0, 1), cB + hstep); PG8_STAGE_A(PG8_SA(0, 0), A0, offC[0][0], offC[0][1]); PG8_STAGE_A(PG8_SA(0, 1), A0, offC[1][0], offC[1][1]);
    if (wr == 1) PG8_BAR;
    PG8_WAIT_V(2); PG8_BAR;
    PG8_STAGE_B(PG8_SB(1, 0), cB + kstep); PG8_STAGE_A(PG8_SA(1, 0), A0 + kstep, offC[0][0], offC[0][1]); PG8_STAGE_B(PG8_SB(1, 1), cB + hstep + kstep);
    PG8_WAIT_V(6); PG8_BAR;
    for (;;) {
        const bool has_next = S.next(ui + 1, nxt);
        const char* nB = cB;
        if (has_next) { S.a_off(nxt, Rr, Cc, offN); nB = S.b_ptr(nxt); }
        else {
#pragma unroll
            for (int h = 0; h < 2; ++h)
#pragma unroll
                for (int i = 0; i < 2; ++i) offN[h][i] = offC[h][i];
        }
        if (Sched::DRAIN) PG8_WAIT_V(0);
        for (int t = 0; t < nt; t += 2) {
            const bool last = (t == nt - 2);
            const char* a1 = A0 + (size_t)(t + 1) * kstep;
            const char* a2 = last ? A0 : A0 + (size_t)(t + 2) * kstep; const char* b2 = last ? nB : cB + (size_t)(t + 2) * kstep;
            const char* a3 = a2 + kstep; const char* b3 = b2 + kstep;
            const unsigned o00 = last ? offN[0][0] : offC[0][0], o01 = last ? offN[0][1] : offC[0][1], o10 = last ? offN[1][0] : offC[1][0], o11 = last ? offN[1][1] : offC[1][1];
            PG8_LDB(B0, 0, 0); PG8_LDB(B1, 0, 1); PG8_SCHED; PG8_LDA(At, 0, 0); PG8_STAGE_A(PG8_SA(1, 1), a1, offC[1][0], offC[1][1]);
            PG8_WAIT_V(8); PG8_WAIT_L(0); PG8_BAR; PG8_MMA(0, 0, At, B0); PG8_MMA(0, 1, At, B1); PG8_BAR; PG8_SCHED;
            PG8_LDA(At, 0, 1); PG8_STAGE_B(PG8_SB(0, 0), b2); PG8_STAGE_B(PG8_SB(0, 1), b2 + hstep); PG8_STAGE_A(PG8_SA(0, 0), a2, o00, o01);
            PG8_WAIT_V(8); PG8_WAIT_L(0); PG8_BAR; PG8_MMA(1, 0, At, B0); PG8_MMA(1, 1, At, B1); PG8_BAR; PG8_SCHED;
            PG8_LDB(B0, 1, 0); PG8_LDB(B1, 1, 1); PG8_SCHED; PG8_LDA(At, 1, 0); PG8_STAGE_A(PG8_SA(0, 1), a2, o10, o11);
            PG8_WAIT_V(8); PG8_WAIT_L(0); PG8_BAR; PG8_MMA(0, 0, At, B0); PG8_MMA(0, 1, At, B1); PG8_BAR; PG8_SCHED;
            PG8_LDA(At, 1, 1); PG8_STAGE_B(PG8_SB(1, 0), b3); PG8_STAGE_B(PG8_SB(1, 1), b3 + hstep); PG8_STAGE_A(PG8_SA(1, 0), a3, o00, o01);
            PG8_WAIT_V(8); PG8_WAIT_L(0); PG8_BAR; PG8_MMA(1, 0, At, B0); PG8_MMA(1, 1, At, B1); PG8_BAR; PG8_SCHED;
        }
        if (wr == 0) PG8_BAR;
        if constexpr (FP8) {
            asm volatile("s_nop 15\n\ts_nop 15" : "+v"(acc[0][0][0][0]), "+v"(acc[0][0][0][1]), "+v"(acc[0][0][1][0]), "+v"(acc[0][0][1][1]), "+v"(acc[0][0][2][0]), "+v"(acc[0][0][2][1]), "+v"(acc[0][0][3][0]), "+v"(acc[0][0][3][1]),
                                                    "+v"(acc[0][1][0][0]), "+v"(acc[0][1][0][1]), "+v"(acc[0][1][1][0]), "+v"(acc[0][1][1][1]), "+v"(acc[0][1][2][0]), "+v"(acc[0][1][2][1]), "+v"(acc[0][1][3][0]), "+v"(acc[0][1][3][1]));
            asm volatile("s_nop 0" : "+v"(acc[1][0][0][0]), "+v"(acc[1][0][0][1]), "+v"(acc[1][0][1][0]), "+v"(acc[1][0][1][1]), "+v"(acc[1][0][2][0]), "+v"(acc[1][0][2][1]), "+v"(acc[1][0][3][0]), "+v"(acc[1][0][3][1]),
                                   "+v"(acc[1][1][0][0]), "+v"(acc[1][1][0][1]), "+v"(acc[1][1][1][0]), "+v"(acc[1][1][1][1]), "+v"(acc[1][1][2][0]), "+v"(acc[1][1][2][1]), "+v"(acc[1][1][3][0]), "+v"(acc[1][1][3][1]));
        }
        E(acc, cur, wr, wc, fr, fq);
        if (!has_next) break;
#pragma unroll
        for (int a = 0; a < 2; ++a)
#pragma unroll
            for (int b = 0; b < 2; ++b)
#pragma unroll
                for (int m = 0; m < 4; ++m)
#pragma unroll
                    for (int n = 0; n < 2; ++n) acc[a][b][m][n] = (f32x4){0.f, 0.f, 0.f, 0.f};
        cur = nxt; cB = nB; ++ui;
#pragma unroll
        for (int h = 0; h < 2; ++h)
#pragma unroll
            for (int i = 0; i < 2; ++i) offC[h][i] = offN[h][i];
        if (wr == 1) PG8_BAR;
    }
    PG8_WAIT_V(0);
    PG8_BAR;
#undef PG8_SA
#undef PG8_SB
#undef PG8_STAGE_A
#undef PG8_STAGE_B
#undef PG8_LDA
#undef PG8_LDB
#undef PG8_MMA
#undef PG8_WAIT_V
#undef PG8_WAIT_L
#undef PG8_BAR
#undef PG8_SCHED
}
}

namespace {
struct Params { const float* in[20]; float* out; unsigned char* ws; };

struct Frame {
    LAS unsigned char* lds;
    int tid, lane, wave, G, vcu, gw, ngw;
};

struct ConvItem { const float* src; unsigned char* dst; int ldw, ldt, kind; float scale; };
__device__ __forceinline__ void conv_load(const ConvItem& I, f32x4 (&v)[8], int lane) {
    const int r8 = lane >> 3, c4 = (lane & 7) * 4;
#pragma unroll
    for (int i = 0; i < 8; ++i) v[i] = __builtin_nontemporal_load((const f32x4*)(I.src + (size_t)(8 * i + r8) * I.ldw + c4));
}
__device__ __forceinline__ void conv_store(const ConvItem& I, const f32x4 (&v)[8], LAS float* scr, int lane) {
    const int r8 = lane >> 3, c4 = (lane & 7) * 4;
#pragma unroll
    for (int i = 0; i < 8; ++i) { LAS float* d = scr + (8 * i + r8) * 33 + c4; d[0] = v[i][0]; d[1] = v[i][1]; d[2] = v[i][2]; d[3] = v[i][3]; }
    asm volatile("s_waitcnt lgkmcnt(0)" ::: "memory");
    const float scale = I.scale;
    if (I.kind == 0) {
        const int c = lane & 7;
#pragma unroll
        for (int j = 0; j < 4; ++j) { const int n = (lane >> 3) + 8 * j; const LAS float* s = scr + (8 * c) * 33 + n;
            u32x4 o; o.x = pk2(s[0 * 33] * scale, s[1 * 33] * scale); o.y = pk2(s[2 * 33] * scale, s[3 * 33] * scale); o.z = pk2(s[4 * 33] * scale, s[5 * 33] * scale); o.w = pk2(s[6 * 33] * scale, s[7 * 33] * scale);
            *(u32x4*)(I.dst + ((size_t)n * I.ldt + 8 * c) * 2) = o; }
    } else {
        const int n = lane >> 1, kh = lane & 1; const LAS float* s = scr + (32 * kh) * 33 + n;
        unsigned w[8];
#pragma unroll
        for (int q = 0; q < 8; ++q) w[q] = pk4_fp8(s[(4 * q) * 33] * scale, s[(4 * q + 1) * 33] * scale, s[(4 * q + 2) * 33] * scale, s[(4 * q + 3) * 33] * scale);
        unsigned char* d = I.dst + (size_t)n * I.ldt + 32 * kh;
        *(u32x4*)d = (u32x4){w[0], w[1], w[2], w[3]}; *(u32x4*)(d + 16) = (u32x4){w[4], w[5], w[6], w[7]};
    }
    asm volatile("s_waitcnt lgkmcnt(0)" ::: "memory");
}
template <class GetItem>
__device__ __forceinline__ void conv_run(GetItem get, int first, int n, int stride, LAS float* scr, int lane) {
    if (first >= n) return;
    ConvItem A, B, C; f32x4 va[8], vb[8], vc[8];
    get(first, A); conv_load(A, va, lane);
    const bool hb = first + stride < n, hc = first + 2 * stride < n;
    B = A; C = A;
    if (hb) { get(first + stride, B); conv_load(B, vb, lane); }
    if (hc) { get(first + 2 * stride, C); conv_load(C, vc, lane); }
    for (int it = first; it < n; it += stride) {
        conv_store(A, va, scr, lane);
        A = B; B = C;
#pragma unroll
        for (int i = 0; i < 8; ++i) { va[i] = vb[i]; vb[i] = vc[i]; }
        const int nx = it + 3 * stride;
        if (nx < n) { get(nx, C); conv_load(C, vc, lane); }
    }
}
constexpr int I_GU = NE * 16 * 64, I_D = NE * 16 * 32;
__device__ __forceinline__ void moe_item(const Params& P, int r, ConvItem& I) {
    I.kind = 1; I.scale = SC_W; I.ldt = DM;
    if (r < I_GU) { const int e = r >> 10, kb = (r >> 6) & 15, nb = r & 63, n0 = 32 * nb, f = n0 & 1023, up = n0 >> 10;
        const int drow = (f >> 7) * 256 + up * 128 + (f & 127);
        I.src = P.in[16] + (size_t)e * DM * 2 * DFF + (size_t)(64 * kb) * 2 * DFF + n0; I.ldw = 2 * DFF;
        I.dst = P.ws + WS_WGU + (size_t)e * 2 * DFF * DM + (size_t)drow * DM + 64 * kb;
    } else { r -= I_GU; const int e = r >> 9, kb = (r >> 5) & 15, nb = r & 31;
        I.src = P.in[18] + (size_t)e * DFF * DM + (size_t)(64 * kb) * DM + 32 * nb; I.ldw = DM;
        I.dst = P.ws + WS_WD + (size_t)e * DM * DFF + (size_t)(32 * nb) * DFF + 64 * kb; }
}
__device__ __forceinline__ void moe_convert(const Params& P, Frame& F, int cw, int ncw) {
    LAS float* scr = (LAS float*)(F.lds + F.wave * 8448);
    conv_run([&](int r, ConvItem& I) { moe_item(P, r, I); }, cw, I_GU + I_D, ncw, scr, F.lane);
}

__device__ __forceinline__ void p0_prologue(const Params& P, Frame& F) {
    unsigned char* ws = P.ws;
    const float* w_in = P.in[2];
    LAS float* scr = (LAS float*)(F.lds + F.wave * 8448);
    LAS float* gwl = (LAS float*)(F.lds + 73728);
    for (int i = F.tid; i < 1024 * 8; i += NTHR) gwl[i] = w_in[(size_t)(i >> 3) * DIN + NZ + (i & 7)];
    __syncthreads();
    constexpr int I_IN = 16 * 96, I_OUT = 16 * 32, I_QK = 8 * 2 * 4, I_ZERO = 8 * 3;
    bf16_t* WqkT = (bf16_t*)(ws + WS_WQK);
    conv_run([&](int r, ConvItem& I) {
        I.kind = 0; I.scale = 1.f;
        if (r < I_IN) { const int kb = r / 96, nb = r % 96; I.src = w_in + (size_t)(64 * kb) * DIN + 32 * nb; I.ldw = DIN; I.dst = ws + WS_WIN + ((size_t)(32 * nb) * DM + 64 * kb) * 2; I.ldt = DM; return; }
        r -= I_IN;
        if (r < I_OUT) { const int kb = r / 32, nb = r % 32; I.src = P.in[12] + (size_t)(64 * kb) * DM + 32 * nb; I.ldw = DM; I.dst = ws + WS_WOUT + ((size_t)(32 * nb) * DM + 64 * kb) * 2; I.ldt = DM; return; }
        r -= I_OUT;
        { const int isk = r >> 5, h = (r >> 3) & 3, kb = (r >> 2) & 1, nb = r & 3;
            I.src = P.in[isk ? 8 : 7] + (size_t)h * 16384 + (size_t)(64 * kb) * 128 + 32 * nb; I.ldw = 128;
            I.dst = ws + WS_WQK + ((size_t)(isk * 512 + h * 128 + 32 * nb) * 512 + h * 128 + 64 * kb) * 2; I.ldt = 512; I.scale = isk ? 0.08838834764831845f : 1.f; }
    }, F.gw, I_IN + I_OUT + I_QK, F.ngw, scr, F.lane);
    moe_convert(P, F, F.gw, F.ngw);
    for (int r = F.gw; r < I_ZERO; r += F.ngw) {
        const int rb = r / 3, j = r % 3, cb = j + (j >= (rb & 3) ? 1 : 0);
        for (int q = F.lane; q < 128 * 16; q += 64) { const int rr = q >> 4, cc = q & 15; *(u32x4*)(WqkT + (size_t)(rb * 128 + rr) * 512 + cb * 128 + cc * 8) = (u32x4){0u, 0u, 0u, 0u}; }
    }
    {
        const float* wr = P.in[14]; float* wrt = (float*)(ws + WS_WRT);
        for (int idx = F.vcu * NTHR + F.tid; idx < DM * NE; idx += F.G * NTHR) wrt[(idx & 31) * DM + (idx >> 5)] = wr[idx];
    }
    const float* x = P.in[0]; const float* g1 = P.in[1];
    bf16_t* XN = (bf16_t*)(ws + WS_XN); float* GATE = (float*)(ws + WS_GATE);
    for (int row = F.gw; row < T; row += F.ngw) {
        const f32x4* xr = (const f32x4*)(x + (size_t)row * DM);
        f32x4 v[4]; float s = 0.f;
#pragma unroll
        for (int j = 0; j < 4; ++j) { v[j] = xr[F.lane + 64 * j]; s += v[j][0] * v[j][0] + v[j][1] * v[j][1] + v[j][2] * v[j][2] + v[j][3] * v[j][3]; }
        s = wave_sum(s);
        const float rs = 1.0f / sqrtf(s * (1.0f / DM) + EPS);
        float ga[8];
#pragma unroll
        for (int c = 0; c < 8; ++c) ga[c] = 0.f;
#pragma unroll
        for (int j = 0; j < 4; ++j) { const f32x4 gg = ((const f32x4*)g1)[F.lane + 64 * j]; v[j] = v[j] * rs * gg;
            u32x2 w; w.x = pk2(v[j][0], v[j][1]); w.y = pk2(v[j][2], v[j][3]);
            *(u32x2*)(XN + (size_t)row * DM + 4 * (F.lane + 64 * j)) = w;
#pragma unroll
            for (int q = 0; q < 4; ++q) { const int k = 4 * (F.lane + 64 * j) + q; const f32x4 w0 = *(const LAS f32x4*)(gwl + k * 8), w1 = *(const LAS f32x4*)(gwl + k * 8 + 4);
                ga[0] += v[j][q] * w0[0]; ga[1] += v[j][q] * w0[1]; ga[2] += v[j][q] * w0[2]; ga[3] += v[j][q] * w0[3];
                ga[4] += v[j][q] * w1[0]; ga[5] += v[j][q] * w1[1]; ga[6] += v[j][q] * w1[2]; ga[7] += v[j][q] * w1[3]; } }
#pragma unroll
        for (int c = 0; c < 8; ++c) ga[c] = wave_sum(ga[c]);
        if (F.lane == 0) { *(f32x4*)(GATE + (size_t)row * 8) = (f32x4){ga[0], ga[1], ga[2], ga[3]}; *(f32x4*)(GATE + (size_t)row * 8 + 4) = (f32x4){ga[4], ga[5], ga[6], ga[7]}; }
    }
}

__device__ __forceinline__ void attn_phase(const Params& P, Frame& F) {
    const bf16_t* Z = (const bf16_t*)(P.ws + WS_Z); bf16_t* MIX = (bf16_t*)(P.ws + WS_MIX);
    const int lane = F.lane, i = lane & 15, g = lane >> 4;
    float gm = fabsf(P.in[4][lane]);
#pragma unroll
    for (int o = 1; o < 64; o <<= 1) gm = fmaxf(gm, __shfl_xor(gm, o));
    const float kmax = 8.0f * gm * 1.01f;
    LAS unsigned char* vb = F.lds + F.wave * 4608;
    const int vwr = (lane >> 3) * 144 + (lane & 7) * 16;
    const int vrd = (4 * g + (i >> 2)) * 144 + (i & 3) * 8;
    for (int tile = F.gw; tile < 8192; tile += F.ngw) {
        const int r = tile & 15, blk = (tile >> 4) & 31, h = (tile >> 9) & 7, b = tile >> 12;
        const int tl0 = blk * 256 + r, T0 = b * SEQ + tl0;
        const bf16_t* qrow = Z + (size_t)(T0 + 16 * i) * NZ + ZQ + h * 64;
        const bf16x8 qf0 = *(const bf16x8*)(qrow + 8 * g), qf1 = *(const bf16x8*)(qrow + 32 + 8 * g);
        float ss = 0.f;
#pragma unroll
        for (int j = 0; j < 8; ++j) { const float a = bf2f((unsigned short)qf0[j]), c = bf2f((unsigned short)qf1[j]); ss += a * a + c * c; }
        ss += __shfl_xor(ss, 16); ss += __shfl_xor(ss, 32);
        const float ref = sqrtf(ss) * kmax;
        const float slope2 = exp2f(-(float)(h + 1)) * LOG2E;
        f32x4 o[4];
#pragma unroll
        for (int dt = 0; dt < 4; ++dt) o[dt] = (f32x4){0.f, 0.f, 0.f, 0.f};
        float lsum = 0.f;
        const bf16_t* Kh = Z + (size_t)b * SEQ * NZ + ZK + h * 64 + 8 * g;
        const bf16_t* Vh = Z + (size_t)b * SEQ * NZ + ZV + h * 64 + 8 * (lane & 7);
        bf16x8 kfa[2][2], kfb[2][2]; u32x4 vra[4], vrb[4];
#define ATT_LOAD(bi_, kfn, vrn) do { const int bi__ = (bi_); const int br_ = bi__ < 12 ? 0 : (bi__ < 18 ? 1 : 2); const int d_ = 1 << (2 * br_); const int nb_ = -128 + 32 * (bi__ - (br_ == 0 ? 0 : (br_ == 1 ? 12 : 18))); \
        _Pragma("unroll") for (int sb = 0; sb < 2; ++sb) { int kp = tl0 + (nb_ + 16 * sb + i) * d_; kp = kp < 0 ? 0 : (kp > SEQ - 1 ? SEQ - 1 : kp); const bf16_t* kr = Kh + (size_t)kp * NZ; kfn[sb][0] = *(const bf16x8*)kr; kfn[sb][1] = *(const bf16x8*)(kr + 32); } \
        _Pragma("unroll") for (int c = 0; c < 4; ++c) { int kp = tl0 + (nb_ + 8 * c + (lane >> 3)) * d_; kp = kp < 0 ? 0 : (kp > SEQ - 1 ? SEQ - 1 : kp); vrn[c] = *(const u32x4*)(Vh + (size_t)kp * NZ); } } while (0)
        ATT_LOAD(0, kfa, vra); ATT_LOAD(1, kfb, vrb);
        for (int bi = 0; bi < 23; ++bi) {
            bf16x8 kf[2][2]; u32x4 vr[4];
#pragma unroll
            for (int sb = 0; sb < 2; ++sb) { kf[sb][0] = kfa[sb][0]; kf[sb][1] = kfa[sb][1]; kfa[sb][0] = kfb[sb][0]; kfa[sb][1] = kfb[sb][1]; }
#pragma unroll
            for (int c = 0; c < 4; ++c) { vr[c] = vra[c]; vra[c] = vrb[c]; }
            if (bi + 2 < 23) ATT_LOAD(bi + 2, kfb, vrb);
            const int br = bi < 12 ? 0 : (bi < 18 ? 1 : 2), dd = 1 << (2 * br), u = 16 / dd;
            const int nb = -128 + 32 * (bi - (br == 0 ? 0 : (br == 1 ? 12 : 18)));
#pragma unroll
            for (int c = 0; c < 4; ++c) *(LAS u32x4*)(vb + vwr + c * 8 * 144) = vr[c];
            f32x4 s[2];
#pragma unroll
            for (int sb = 0; sb < 2; ++sb) { s[sb] = __builtin_amdgcn_mfma_f32_16x16x32_bf16(kf[sb][0], qf0, (f32x4){0.f, 0.f, 0.f, 0.f}, 0, 0, 0);
                s[sb] = __builtin_amdgcn_mfma_f32_16x16x32_bf16(kf[sb][1], qf1, s[sb], 0, 0, 0); }
            float p[8];
#pragma unroll
            for (int sb = 0; sb < 2; ++sb)
#pragma unroll
                for (int j = 0; j < 4; ++j) { const int n = nb + 16 * sb + 4 * g + j, a = u * i - n;
                    const bool valid = (a >= 0) && (a <= 128) && (tl0 + n * dd >= 0);
                    const float e = s[sb][j] - slope2 * (float)(a * dd) - ref;
                    const float pv = valid ? __builtin_amdgcn_exp2f(e) : 0.f;
                    p[4 * sb + j] = pv; lsum += pv; }
            u32x4 pw; pw.x = pk2(p[0], p[1]); pw.y = pk2(p[2], p[3]); pw.z = pk2(p[4], p[5]); pw.w = pk2(p[6], p[7]);
            const bf16x8 pf = __builtin_bit_cast(bf16x8, pw);
#pragma unroll
            for (int dt = 0; dt < 4; ++dt) {
                const s16x4 v0 = __builtin_amdgcn_ds_read_tr16_b64_v4i16((LAS s16x4*)(vb + vrd + dt * 32));
                const s16x4 v1 = __builtin_amdgcn_ds_read_tr16_b64_v4i16((LAS s16x4*)(vb + vrd + 16 * 144 + dt * 32));
                const bf16x8 vf = (bf16x8){v0[0], v0[1], v0[2], v0[3], v1[0], v1[1], v1[2], v1[3]};
                o[dt] = __builtin_amdgcn_mfma_f32_16x16x32_bf16(vf, pf, o[dt], 0, 0, 0);
            }
        }
#undef ATT_LOAD
        lsum += __shfl_xor(lsum, 16); lsum += __shfl_xor(lsum, 32);
        const float inv = 1.0f / lsum;
        bf16_t* orow = MIX + (size_t)(T0 + 16 * i) * DM + h * 64 + 4 * g;
#pragma unroll
        for (int dt = 0; dt < 4; ++dt) { u32x2 w; w.x = pk2(o[dt][0] * inv, o[dt][1] * inv); w.y = pk2(o[dt][2] * inv, o[dt][3] * inv); *(u32x2*)(orow + 16 * dt) = w; }
    }
}

__device__ __forceinline__ bf16x8 tr2(LAS unsigned char* p0, LAS unsigned char* p1) {
    const s16x4 a = __builtin_amdgcn_ds_read_tr16_b64_v4i16((LAS s16x4*)p0);
    const s16x4 b = __builtin_amdgcn_ds_read_tr16_b64_v4i16((LAS s16x4*)p1);
    return (bf16x8){a[0], a[1], a[2], a[3], b[0], b[1], b[2], b[3]};
}
#define MFMA16(a, b, c) __builtin_amdgcn_mfma_f32_16x16x32_bf16((a), (b), (c), 0, 0, 0)

__device__ __forceinline__ void ml1_phase(const Params& P, Frame& F) {
    const bf16_t* Z = (const bf16_t*)(P.ws + WS_Z); bf16_t* QK = (bf16_t*)(P.ws + WS_QK); const float* GATE = (const float*)(P.ws + WS_GATE);
    const bf16_t* WqkT = (const bf16_t*)(P.ws + WS_WQK);
    float* BC = (float*)(P.ws + WS_BC); float* IG = (float*)(P.ws + WS_IG); float* BT = (float*)(P.ws + WS_BT); float* U = (float*)(P.ws + WS_U); float* NV = (float*)(P.ws + WS_NV);
    const float* bi = P.in[9]; const float* bf = P.in[10]; const float* cw = P.in[5]; const float* cb = P.in[6];
    constexpr int PIT = 272;
    LAS unsigned char* KIM = F.lds; LAS unsigned char* VIM = F.lds + 128 * PIT; LAS unsigned char* XIM = F.lds + 2 * 128 * PIT;
    LAS float* bc = (LAS float*)(F.lds + 3 * 128 * PIT); LAS float* wv = bc + 256;
    const int tid = F.tid, lane = F.lane, i = lane & 15, g = lane >> 4, w = F.wave;
    bf16x8 ones;
#pragma unroll
    for (int j = 0; j < 8; ++j) ones[j] = (i == 0) ? (short)0x3F80 : (short)0;
    for (int unit = F.vcu; unit < 256; unit += F.G) {
        const int bh = unit / NCH, c = unit % NCH, b = bh / NHM, h = bh % NHM, t0 = b * SEQ + c * CH;
        float ig = 0.f;
        __syncthreads();
        if (tid < 256) { const float f = GATE[(size_t)(t0 + tid) * 8 + 4 + h] + bf[h];
            bc[tid] = fminf(f, 0.f) - log1pf(__expf(-fabsf(f)));
            ig = GATE[(size_t)(t0 + tid) * 8 + h] + bi[h]; }
        __syncthreads();
        if (w == 0) {
            const f32x4 a = *(const LAS f32x4*)(bc + 4 * lane);
            const float s1 = a[0], s2 = s1 + a[1], s3 = s2 + a[2], s4 = s3 + a[3];
            float x = s4;
#pragma unroll
            for (int off = 1; off < 64; off <<= 1) { const float v = __shfl_up(x, off); if (lane >= off) x += v; }
            const float ex = x - s4;
            *(LAS f32x4*)(bc + 4 * lane) = (f32x4){ex + s1, ex + s2, ex + s3, ex + s4};
        }
        __syncthreads();
        if (tid < 256) { BC[(size_t)(t0 + tid) * 4 + h] = bc[tid]; IG[(size_t)(t0 + tid) * 4 + h] = ig; wv[tid] = __expf(bc[255] - bc[tid] + ig); }
        if (tid == 0) BT[unit] = bc[255];
        bf16x8 wf[2][4];
#pragma unroll
        for (int e2 = 0; e2 < 2; ++e2) { const bf16_t* wp = WqkT + (size_t)((w >> 2) * 512 + h * 128 + 32 * (w & 3) + 16 * e2 + i) * 512 + h * 128 + 8 * g;
#pragma unroll
            for (int ks = 0; ks < 4; ++ks) wf[e2][ks] = *(const bf16x8*)(wp + 32 * ks); }
        f32x4 acc[9];
#pragma unroll
        for (int q = 0; q < 9; ++q) acc[q] = (f32x4){0.f, 0.f, 0.f, 0.f};
        for (int half = 0; half < 2; ++half) {
            __syncthreads();
#pragma unroll
            for (int q = 0; q < 4; ++q) { const int id = tid + 512 * q, row = id >> 4, c8 = (id & 15) * 8, sidx = half * 128 + row, tok = t0 + sidx, tl = c * CH + sidx;
                const int ch = h * 128 + c8;
                float a[8];
                { const f32x4 b0 = *(const f32x4*)(cb + ch), b1 = *(const f32x4*)(cb + ch + 4); a[0] = b0[0]; a[1] = b0[1]; a[2] = b0[2]; a[3] = b0[3]; a[4] = b1[0]; a[5] = b1[1]; a[6] = b1[2]; a[7] = b1[3]; }
#pragma unroll
                for (int j = 0; j < 4; ++j) { const int dt = 3 - j; if (tl - dt >= 0) {
                        const u32x4 xw = *(const u32x4*)(Z + (size_t)(tok - dt) * NZ + ZXM + ch);
                        const f32x4 w0 = *(const f32x4*)(cw + j * 512 + ch), w1 = *(const f32x4*)(cw + j * 512 + ch + 4);
                        a[0] += w0[0] * bflo(xw.x); a[1] += w0[1] * bfhi(xw.x); a[2] += w0[2] * bflo(xw.y); a[3] += w0[3] * bfhi(xw.y);
                        a[4] += w1[0] * bflo(xw.z); a[5] += w1[1] * bfhi(xw.z); a[6] += w1[2] * bflo(xw.w); a[7] += w1[3] * bfhi(xw.w); } }
#pragma unroll
                for (int j = 0; j < 8; ++j) a[j] = a[j] * sigmoidf_(a[j]);
                u32x4 o; o.x = pk2(a[0], a[1]); o.y = pk2(a[2], a[3]); o.z = pk2(a[4], a[5]); o.w = pk2(a[6], a[7]);
                *(LAS u32x4*)(XIM + row * PIT + c8 * 2) = o;
                *(LAS u32x4*)(VIM + row * PIT + c8 * 2) = *(const u32x4*)(Z + (size_t)tok * NZ + ZVM + ch); }
            __syncthreads();
#pragma unroll 2
            for (int tt = 0; tt < 8; ++tt) {
                bf16x8 xf[4];
#pragma unroll
                for (int ks = 0; ks < 4; ++ks) xf[ks] = *(const LAS bf16x8*)(XIM + (16 * tt + i) * PIT + (32 * ks + 8 * g) * 2);
                const int trow = 16 * tt + i, sidx = half * 128 + trow; const float ws_ = wv[sidx];
                bf16_t* qkrow = QK + (size_t)(t0 + sidx) * 1024 + (w >> 2) * 512 + h * 128 + 32 * (w & 3) + 4 * g;
#pragma unroll
                for (int e2 = 0; e2 < 2; ++e2) {
                    f32x4 d = (f32x4){0.f, 0.f, 0.f, 0.f};
#pragma unroll
                    for (int ks = 0; ks < 4; ++ks) d = MFMA16(wf[e2][ks], xf[ks], d);
                    u32x2 o; o.x = pk2(d[0], d[1]); o.y = pk2(d[2], d[3]);
                    *(u32x2*)(qkrow + 16 * e2) = o;
                    if (w >= 4) { u32x2 ok; ok.x = pk2(d[0] * ws_, d[1] * ws_); ok.y = pk2(d[2] * ws_, d[3] * ws_); *(LAS u32x2*)(KIM + trow * PIT + (32 * (w & 3) + 16 * e2 + 4 * g) * 2) = ok; }
                }
            }
            __syncthreads();
#pragma unroll
            for (int kk = 0; kk < 4; ++kk) {
                const int ro = (32 * kk + 8 * g + (i >> 2)) * PIT + (i & 3) * 8;
                const bf16x8 af = tr2(KIM + ro + 32 * w, KIM + ro + 4 * PIT + 32 * w);
#pragma unroll
                for (int et = 0; et < 8; ++et) { const bf16x8 bfr = tr2(VIM + ro + 32 * et, VIM + ro + 4 * PIT + 32 * et); acc[et] = MFMA16(af, bfr, acc[et]); }
                acc[8] = MFMA16(af, ones, acc[8]);
            }
        }
        float* up = U + (size_t)unit * 16384 + (size_t)(16 * w + 4 * g) * 128 + i;
#pragma unroll
        for (int et = 0; et < 8; ++et)
#pragma unroll
            for (int j = 0; j < 4; ++j) up[j * 128 + 16 * et] = acc[et][j];
        if (i == 0) {
#pragma unroll
            for (int j = 0; j < 4; ++j) NV[unit * 128 + 16 * w + 4 * g + j] = acc[8][j];
        }
    }
}

__device__ __forceinline__ void ml3_phase(const Params& P, Frame& F) {
    const bf16_t* Z = (const bf16_t*)(P.ws + WS_Z); const bf16_t* QK = (const bf16_t*)(P.ws + WS_QK);
    const float* BC = (const float*)(P.ws + WS_BC); const float* IG = (const float*)(P.ws + WS_IG); const float* BT = (const float*)(P.ws + WS_BT);
    const float* U = (const float*)(P.ws + WS_U); const float* NV = (const float*)(P.ws + WS_NV); const float* gn = P.in[11];
    bf16_t* MIX = (bf16_t*)(P.ws + WS_MIX);
    constexpr int CP = 288, VP = 272;
    LAS unsigned char* CIM = F.lds;
    LAS unsigned char* VIM = F.lds + 128 * CP;
    LAS float* cs = (LAS float*)(F.lds + 128 * CP + 256 * VP);
    LAS float* bq = cs + 256;
    const int tid = F.tid, lane = F.lane, i = lane & 15, g = lane >> 4, w = F.wave;
    for (int unit = F.vcu; unit < 256; unit += F.G) {
        const int bh = unit / NCH, c = unit % NCH, b = bh / NHM, h = bh % NHM, t0 = b * SEQ + c * CH;
        __syncthreads();
#pragma unroll
        for (int q = 0; q < 8; ++q) { const int id = tid + 512 * q, row = id >> 4, c8 = (id & 15) * 8;
            *(LAS u32x4*)(VIM + row * VP + c8 * 2) = *(const u32x4*)(Z + (size_t)(t0 + row) * NZ + ZVM + h * 128 + c8); }
        if (tid < 256) { const float bb = BC[(size_t)(t0 + tid) * 4 + h]; bq[tid] = bb; cs[tid] = IG[(size_t)(t0 + tid) * 4 + h] - bb; }
        {   f32x4 cc[4][2]; float n = 0.f;
#pragma unroll
            for (int q = 0; q < 4; ++q) { cc[q][0] = (f32x4){0.f, 0.f, 0.f, 0.f}; cc[q][1] = (f32x4){0.f, 0.f, 0.f, 0.f}; }
            for (int j = 0; j < c; ++j) {
                const float dec = __expf(BT[bh * NCH + j]);
                const float* up = U + (size_t)(bh * NCH + j) * 16384;
#pragma unroll
                for (int q = 0; q < 4; ++q) { const int id = tid + 512 * q; const f32x4 u0 = *(const f32x4*)(up + id * 8), u1 = *(const f32x4*)(up + id * 8 + 4);
                    cc[q][0] = cc[q][0] * dec + u0; cc[q][1] = cc[q][1] * dec + u1; }
                if (tid < 128) n = dec * n + NV[(bh * NCH + j) * 128 + tid];
            }
#pragma unroll
            for (int q = 0; q < 4; ++q) { const int id = tid + 512 * q, d = id >> 4, e8 = (id & 15) * 8;
                u32x4 o; o.x = pk2(cc[q][0][0], cc[q][0][1]); o.y = pk2(cc[q][0][2], cc[q][0][3]); o.z = pk2(cc[q][1][0], cc[q][1][1]); o.w = pk2(cc[q][1][2], cc[q][1][3]);
                *(LAS u32x4*)(CIM + d * CP + e8 * 2) = o; }
            if (tid < 128) { *(LAS u32x4*)(CIM + tid * CP + 256) = (u32x4){f2bf(n), 0u, 0u, 0u}; *(LAS u32x4*)(CIM + tid * CP + 272) = (u32x4){0u, 0u, 0u, 0u}; }
        }
        __syncthreads();
#pragma unroll 1
        for (int a = 0; a < 2; ++a) {
            const int qt = a ? 15 - w : w;
            bf16x8 qf[4];
            { const bf16_t* qp = QK + (size_t)(t0 + 16 * qt + i) * 1024 + h * 128 + 8 * g;
#pragma unroll
                for (int ks = 0; ks < 4; ++ks) qf[ks] = *(const bf16x8*)(qp + 32 * ks); }
            const float bt = bq[16 * qt + i];
            f32x4 acc[8]; float den;
            {
                f32x4 a8 = (f32x4){0.f, 0.f, 0.f, 0.f};
#pragma unroll
                for (int et = 0; et < 8; ++et) acc[et] = (f32x4){0.f, 0.f, 0.f, 0.f};
#pragma unroll
                for (int ks = 0; ks < 4; ++ks) {
                    const int ro = (32 * ks + 8 * g + (i >> 2)) * CP + (i & 3) * 8;
#pragma unroll
                    for (int et = 0; et < 8; ++et) { const bf16x8 cf = tr2(CIM + ro + 32 * et, CIM + ro + 4 * CP + 32 * et); acc[et] = MFMA16(cf, qf[ks], acc[et]); }
                    const bf16x8 cf = tr2(CIM + ro + 256, CIM + ro + 4 * CP + 256);
                    a8 = MFMA16(cf, qf[ks], a8);
                }
                const float eb = __expf(bt);
#pragma unroll
                for (int et = 0; et < 8; ++et) acc[et] = acc[et] * eb;
                den = (g == 0) ? a8[0] * eb : 0.f;
            }
            const int kbhi = qt >> 1;
#pragma unroll 1
            for (int kb = 0; kb <= kbhi; ++kb) {
                float p[8];
#pragma unroll
                for (int sb = 0; sb < 2; ++sb) {
                    const bf16_t* kp = QK + (size_t)(t0 + 32 * kb + 16 * sb + i) * 1024 + 512 + h * 128 + 8 * g;
                    f32x4 sacc = (f32x4){0.f, 0.f, 0.f, 0.f};
#pragma unroll
                    for (int ks = 0; ks < 4; ++ks) { const bf16x8 kf = *(const bf16x8*)(kp + 32 * ks); sacc = MFMA16(kf, qf[ks], sacc); }
                    const f32x4 cv = *(const LAS f32x4*)(cs + 32 * kb + 16 * sb + 4 * g);
#pragma unroll
                    for (int j = 0; j < 4; ++j) { const int srow = 32 * kb + 16 * sb + 4 * g + j, tcol = 16 * qt + i;
                        const float pv = (srow <= tcol) ? sacc[j] * __expf(bt + cv[j]) : 0.f;
                        p[4 * sb + j] = pv; den += pv; } }
                u32x4 pw; pw.x = pk2(p[0], p[1]); pw.y = pk2(p[2], p[3]); pw.z = pk2(p[4], p[5]); pw.w = pk2(p[6], p[7]);
                const bf16x8 pf = __builtin_bit_cast(bf16x8, pw);
                const int ro = (32 * kb + 4 * g + (i >> 2)) * VP + (i & 3) * 8;
#pragma unroll
                for (int et = 0; et < 8; ++et) { const bf16x8 vf = tr2(VIM + ro + 32 * et, VIM + ro + 16 * VP + 32 * et); acc[et] = MFMA16(vf, pf, acc[et]); }
            }
            float dn = den; dn += __shfl_xor(dn, 16); dn += __shfl_xor(dn, 32);
            const float dd = 1.0f / fmaxf(fabsf(dn), 1.0f);
            float ss = 0.f;
#pragma unroll
            for (int et = 0; et < 8; ++et) { acc[et] = acc[et] * dd; ss += acc[et][0] * acc[et][0] + acc[et][1] * acc[et][1] + acc[et][2] * acc[et][2] + acc[et][3] * acc[et][3]; }
            ss += __shfl_xor(ss, 16); ss += __shfl_xor(ss, 32);
            const float rstd = 1.0f / sqrtf(ss * (1.0f / HDM) + EPS);
            const int tok = t0 + 16 * qt + i;
#pragma unroll
            for (int et = 0; et < 8; ++et) { const int e0 = 16 * et + 4 * g;
                const u32x2 ow = *(const u32x2*)(Z + (size_t)tok * NZ + ZOM + h * 128 + e0);
                const f32x4 gv = *(const f32x4*)(gn + h * 128 + e0);
                const float r0 = sigmoidf_(bflo(ow.x)) * acc[et][0] * rstd * gv[0], r1 = sigmoidf_(bfhi(ow.x)) * acc[et][1] * rstd * gv[1];
                const float r2 = sigmoidf_(bflo(ow.y)) * acc[et][2] * rstd * gv[2], r3 = sigmoidf_(bfhi(ow.y)) * acc[et][3] * rstd * gv[3];
                u32x2 o; o.x = pk2(r0, r1); o.y = pk2(r2, r3);
                *(u32x2*)(MIX + (size_t)tok * DM + 512 + h * 128 + e0) = o; }
        }
    }
}

__device__ __forceinline__ void router_phase(const Params& P, Frame& F, const bool commit) {
    const float* X1 = P.out; const float* g2 = P.in[13]; const float* wrt = (const float*)(P.ws + WS_WRT); const float* br = P.in[15];
    unsigned char* H8 = P.ws + WS_H8; int* cnt = (int*)(P.ws + WS_CTL); int* ltok = (int*)(P.ws + WS_LTOK); float* lgate = (float*)(P.ws + WS_LGATE); int* tke = (int*)(P.ws + WS_TKE);
    LAS int* lcnt = (LAS int*)(F.lds);
    LAS int* pe = lcnt + 64;
    LAS float* pg = (LAS float*)(pe + 256);
    const int lane = F.lane, tid = F.tid;
    for (int chunk = F.vcu; chunk < T / 64; chunk += F.G) {
        __syncthreads();
        if (tid < 64) lcnt[tid] = 0;
        __syncthreads();
        {
            f32x4 v[8][4];
#pragma unroll
            for (int tt = 0; tt < 8; ++tt) {
                const int tok = chunk * 64 + F.wave * 8 + tt;
                const f32x4* xr = (const f32x4*)(X1 + (size_t)tok * DM);
                float s = 0.f;
#pragma unroll
                for (int j = 0; j < 4; ++j) { v[tt][j] = xr[lane + 64 * j]; s += v[tt][j][0] * v[tt][j][0] + v[tt][j][1] * v[tt][j][1] + v[tt][j][2] * v[tt][j][2] + v[tt][j][3] * v[tt][j][3]; }
                s = wave_sum(s);
                const float r = 1.0f / sqrtf(s * (1.0f / DM) + EPS);
#pragma unroll
                for (int j = 0; j < 4; ++j) { const f32x4 gg = ((const f32x4*)g2)[lane + 64 * j]; v[tt][j] = v[tt][j] * r * gg;
                    *(unsigned*)(H8 + (size_t)tok * DM + 4 * (lane + 64 * j)) = pk4_fp8(v[tt][j][0] * SC_H, v[tt][j][1] * SC_H, v[tt][j][2] * SC_H, v[tt][j][3] * SC_H); }
            }
            const bool b0 = lane & 1, b1 = lane & 2, b2 = lane & 4;
            float tv0 = -INFINITY, tv1 = -INFINITY, tv2 = -INFINITY, tv3 = -INFINITY; int te0 = 0, te1 = 0, te2 = 0, te3 = 0;
#pragma unroll 2
            for (int e = 0; e < NE; ++e) {
                const f32x4* wrow = (const f32x4*)(wrt + (size_t)e * DM);
                f32x4 w4[4];
#pragma unroll
                for (int j = 0; j < 4; ++j) w4[j] = wrow[lane + 64 * j];
                float a[8];
#pragma unroll
                for (int tt = 0; tt < 8; ++tt) { float pa = 0.f;
#pragma unroll
                    for (int j = 0; j < 4; ++j) pa += v[tt][j][0] * w4[j][0] + v[tt][j][1] * w4[j][1] + v[tt][j][2] * w4[j][2] + v[tt][j][3] * w4[j][3];
                    a[tt] = pa; }
                float k0 = b0 ? a[4] : a[0], k1 = b0 ? a[5] : a[1], k2 = b0 ? a[6] : a[2], k3 = b0 ? a[7] : a[3];
                k0 += __shfl_xor(b0 ? a[0] : a[4], 1); k1 += __shfl_xor(b0 ? a[1] : a[5], 1); k2 += __shfl_xor(b0 ? a[2] : a[6], 1); k3 += __shfl_xor(b0 ? a[3] : a[7], 1);
                float m0 = b1 ? k2 : k0, m1 = b1 ? k3 : k1;
                m0 += __shfl_xor(b1 ? k0 : k2, 2); m1 += __shfl_xor(b1 ? k1 : k3, 2);
                float d = b2 ? m1 : m0;
                d += __shfl_xor(b2 ? m0 : m1, 4);
                d += __shfl_xor(d, 8); d += __shfl_xor(d, 16); d += __shfl_xor(d, 32);
                const float x = d + br[e];
                const bool g0 = x > tv0, g1 = x > tv1, g2_ = x > tv2, g3 = x > tv3;
                tv3 = g2_ ? tv2 : (g3 ? x : tv3); te3 = g2_ ? te2 : (g3 ? e : te3);
                tv2 = g1 ? tv1 : (g2_ ? x : tv2); te2 = g1 ? te1 : (g2_ ? e : te2);
                tv1 = g0 ? tv0 : (g1 ? x : tv1); te1 = g0 ? te0 : (g1 ? e : te1);
                tv0 = g0 ? x : tv0; te0 = g0 ? e : te0;
            }
            const float e1 = __expf(tv1 - tv0), e2 = __expf(tv2 - tv0), e3 = __expf(tv3 - tv0);
            const float inv = 1.0f / (1.0f + e1 + e2 + e3);
            if (lane < 8) {
                const int tl = F.wave * 8 + (b0 ? 4 : 0) + (b1 ? 2 : 0) + (b2 ? 1 : 0);
                const int rk0 = __hip_atomic_fetch_add((int*)(lcnt + te0), 1, __ATOMIC_RELAXED, __HIP_MEMORY_SCOPE_WORKGROUP);
                const int rk1 = __hip_atomic_fetch_add((int*)(lcnt + te1), 1, __ATOMIC_RELAXED, __HIP_MEMORY_SCOPE_WORKGROUP);
                const int rk2 = __hip_atomic_fetch_add((int*)(lcnt + te2), 1, __ATOMIC_RELAXED, __HIP_MEMORY_SCOPE_WORKGROUP);
                const int rk3 = __hip_atomic_fetch_add((int*)(lcnt + te3), 1, __ATOMIC_RELAXED, __HIP_MEMORY_SCOPE_WORKGROUP);
                pe[tl * 4 + 0] = te0 | (rk0 << 8); pe[tl * 4 + 1] = te1 | (rk1 << 8); pe[tl * 4 + 2] = te2 | (rk2 << 8); pe[tl * 4 + 3] = te3 | (rk3 << 8);
                pg[tl * 4 + 0] = inv; pg[tl * 4 + 1] = e1 * inv; pg[tl * 4 + 2] = e2 * inv; pg[tl * 4 + 3] = e3 * inv;
            }
        }
        __syncthreads();
        if (tid < NE && commit) { const int n = lcnt[tid]; lcnt[32 + tid] = n ? atomicAdd(&cnt[64 * tid], n) : 0; }
        __syncthreads();
        if (tid < 256 && commit) { const int w = pe[tid], ee = w & 255, p = lcnt[32 + ee] + (w >> 8), tok = chunk * 64 + (tid >> 2);
            ltok[ee * T + p] = tok; lgate[ee * T + p] = pg[tid]; tke[tok * 4 + (tid & 3)] = ee | (p << 8); }
    }
}

__device__ __forceinline__ void build_tables(const Params& P, Frame& F) {
    LAS int* trs = (LAS int*)(F.lds + LDS_TAB); LAS int* cnts = trs + 64;
    const int* cnt = (const int*)(P.ws + WS_CTL);
    if (F.tid == 0) { int a = 0; for (int e = 0; e < NE; ++e) { const int n = cnt[64 * e]; trs[e] = a; cnts[e] = n; a += (n + 255) >> 8; } trs[NE] = a; }
    __syncthreads();
}

__device__ __forceinline__ void combine_phase(const Params& P, Frame& F, const bool commit) {
    const LAS int* trs = (const LAS int*)(F.lds + LDS_TAB);
    const bf16_t* Y = (const bf16_t*)(P.ws + WS_Y); const int* tke = (const int*)(P.ws + WS_TKE);
    float* out = P.out; const int lane = F.lane;
    for (int tok = F.gw; tok < T; tok += F.ngw) {
        f32x4 a[4];
#pragma unroll
        for (int j = 0; j < 4; ++j) a[j] = *(const f32x4*)(out + (size_t)tok * DM + 4 * (lane + 64 * j));
#pragma unroll
        for (int k = 0; k < 4; ++k) { const int w = tke[tok * 4 + k], e = w & 255, p = w >> 8; const size_t slot = (size_t)trs[e] * 256 + p;
#pragma unroll
            for (int j = 0; j < 4; ++j) { const u32x2 y = *(const u32x2*)(Y + slot * DM + 4 * (lane + 64 * j)); a[j][0] += bflo(y.x); a[j][1] += bfhi(y.x); a[j][2] += bflo(y.y); a[j][3] += bfhi(y.y); } }
#pragma unroll
        for (int j = 0; j < 4; ++j) if (commit || a[j][0] == 123456.789f) *(f32x4*)(out + (size_t)tok * DM + 4 * (lane + 64 * j)) = a[j];
    }
}


#define XB_TMO      128
#define XB_XCNT(j)  (256  + 64 * (j))
#define XB_XSUB(j)  (1280 + 64 * (j))
#define XB_XGEN(j)  (2304 + 64 * (j))
#define XB_TOP      3328
#define XB_TOPGEN   3392
#define XCD_BAR_WORDS 3456
#define XB_SPIN_CAP (1u << 18)
__device__ __forceinline__ unsigned xb_ld(unsigned* p)              { return __hip_atomic_load(p, __ATOMIC_RELAXED, __HIP_MEMORY_SCOPE_AGENT); }
__device__ __forceinline__ unsigned xb_add(unsigned* p, unsigned v) { return __hip_atomic_fetch_add(p, v, __ATOMIC_RELAXED, __HIP_MEMORY_SCOPE_AGENT); }
__device__ __forceinline__ unsigned xb_xcc_id() { return (unsigned)__builtin_amdgcn_s_getreg((3 << 11) | 20) & 0xFu; }
#define XB_SPIN(cond, bar) do { unsigned _sp = 0; while (cond) { __builtin_amdgcn_s_sleep(1); \
    if ((++_sp & 255u) == 0u) { if (xb_ld(&(bar)[XB_TMO])) break; if (_sp > XB_SPIN_CAP) { atomicAdd(&(bar)[XB_TMO], 1u); break; } } } } while (0)
struct XcdBarrier { unsigned* bar; unsigned x; volatile LAS unsigned* st; };
__device__ __forceinline__ XcdBarrier xcd_barrier_post(unsigned* bar, volatile LAS unsigned* st) {
    XcdBarrier b; b.bar = bar; b.x = xb_xcc_id(); b.st = st;
    if (threadIdx.x == 0) (void)xb_add(&bar[XB_XCNT(b.x)], 1u);
    return b;
}
__device__ __forceinline__ void xcd_barrier_complete(unsigned* bar, unsigned x, unsigned& nloc, unsigned& nx) {
    const unsigned G = gridDim.x * gridDim.y * gridDim.z;
    unsigned sum, cnt, mine, sp = 0u;
    for (;;) {
        sum = 0u; cnt = 0u; mine = 0u;
#pragma unroll
        for (unsigned j = 0; j < 16; ++j) { const unsigned c = xb_ld(&bar[XB_XCNT(j)]); sum += c; cnt += (c > 0u) ? 1u : 0u; mine = (j == x) ? c : mine; }
        if (sum == G) break;
        __builtin_amdgcn_s_sleep(1);
        if ((++sp & 255u) == 0u) { if (xb_ld(&bar[XB_TMO])) break; if (sp > XB_SPIN_CAP) { atomicAdd(&bar[XB_TMO], 1u); break; } }
    }
    nloc = mine > 0u ? mine : 1u; nx = cnt > 0u ? cnt : 1u;
}
__device__ __forceinline__ void xcd_barrier(const XcdBarrier& b) {
    asm volatile("s_waitcnt vmcnt(0)" ::: "memory");
    __syncthreads();
    if (threadIdx.x == 0) {
        unsigned* bar = b.bar;
        __builtin_amdgcn_s_waitcnt(0);
        unsigned nloc = b.st[0], nx = b.st[1];
        if (nloc == 0u) { xcd_barrier_complete(bar, b.x, nloc, nx); b.st[0] = nloc; b.st[1] = nx; }
        const unsigned old = xb_add(&bar[XB_XSUB(b.x)], 1u);
        const unsigned gen = old / nloc;
        if (old + 1u == (gen + 1u) * nloc) {
            __builtin_amdgcn_fence(__ATOMIC_RELEASE, "agent");
            asm volatile("s_waitcnt vmcnt(0)" ::: "memory");
            const unsigned og = xb_add(&bar[XB_TOP], 1u);
            const unsigned tg = og / nx;
            if (og + 1u == (tg + 1u) * nx) xb_add(&bar[XB_TOPGEN], 1u);
            else XB_SPIN(xb_ld(&bar[XB_TOPGEN]) == tg, bar);
            __builtin_amdgcn_fence(__ATOMIC_ACQUIRE, "agent");
            xb_add(&bar[XB_XGEN(b.x)], 1u);
            asm volatile("s_waitcnt vmcnt(0)" ::: "memory");
        } else {
            XB_SPIN(xb_ld(&bar[XB_XGEN(b.x)]) == gen, bar);
            __builtin_amdgcn_fence(__ATOMIC_ACQUIRE, "agent");
            asm volatile("s_waitcnt vmcnt(0)" ::: "memory");
        }
    }
    __syncthreads();
}

__global__ void __launch_bounds__(NTHR) fwd_megakernel(Params P) {
    extern __shared__ __attribute__((aligned(16))) unsigned char lds_raw[];
    Frame F;
    F.lds = (LAS unsigned char*)lds_raw;
    F.tid = threadIdx.x; F.lane = F.tid & 63; F.wave = __builtin_amdgcn_readfirstlane(F.tid >> 6);
    F.G = gridDim.x; { const int bx = blockIdx.x; F.vcu = (F.G % 8 == 0) ? (bx % 8) * (F.G / 8) + bx / 8 : bx; }
    F.gw = F.vcu * NWAVES + F.wave; F.ngw = F.G * NWAVES;
    unsigned char* ws = P.ws;
    LAS unsigned char* stage = F.lds + LDS_STAGE;
    volatile LAS unsigned* bst = (volatile LAS unsigned*)(F.lds + LDS_TAB + 512);
    if (F.tid < 2) bst[F.tid] = 0u;
    __syncthreads();
    const XcdBarrier bar = xcd_barrier_post((unsigned*)(ws + WS_CTL) + 4096, bst);
    LAS unsigned long long* tstamp = (LAS unsigned long long*)(F.lds + LDS_TAB + 640); int nstamp = 0;
    if (TPROBE >= 0 && blockIdx.x == 0 && F.tid == 0) tstamp[nstamp] = __builtin_amdgcn_s_memrealtime();
    ++nstamp;
#define GRID_SYNC() do { xcd_barrier(bar); if (TPROBE >= 0 && blockIdx.x == 0 && F.tid == 0) tstamp[nstamp] = __builtin_amdgcn_s_memrealtime(); ++nstamp; } while (0)

    p0_prologue(P, F);
    if (DUP & 1) p0_prologue(P, F);
    GRID_SYNC();
    {
        pg8::DenseSched S{T / 256, NZ / 256, F.G, (int)blockIdx.x, DM, (const char*)(ws + WS_WIN), (DUP & 2) ? 2 : 1};
        pg8::EpiQKNorm E{(bf16_t*)(ws + WS_Z), P.in[3], P.in[4]};
        pg8::gemm_phase<false>(stage, (const char*)(ws + WS_XN), DM, S, E);
    }
    GRID_SYNC();
    if (DUP & 4096) { for (int q = 0; q < 10; ++q) GRID_SYNC(); }
    attn_phase(P, F);
    if (DUP & 8) attn_phase(P, F);
    ml1_phase(P, F);
    if (DUP & 16) ml1_phase(P, F);
    GRID_SYNC();
    ml3_phase(P, F);
    if (DUP & 32) ml3_phase(P, F);
    GRID_SYNC();
    {
        pg8::DenseSched S{T / 256, DM / 256, F.G, (int)blockIdx.x, DM, (const char*)(ws + WS_WOUT), (DUP & 64) ? 2 : 1};
        pg8::EpiResF32 E{P.out, P.in[0], DM};
        pg8::gemm_phase<false>(stage, (const char*)(ws + WS_MIX), DM, S, E);
    }
    GRID_SYNC();
    if (DUP & 512) router_phase(P, F, false);
    router_phase(P, F, true);
    GRID_SYNC();
    build_tables(P, F);
    const LAS int* trs = (const LAS int*)(F.lds + LDS_TAB); const LAS int* cnts = trs + 64;
    {
        pg8::MoeSched<true> S{trs, cnts, 8, F.G, (int)blockIdx.x, DM / 2, (const char*)(ws + WS_WGU), (size_t)2 * DFF * DM, (const int*)(ws + WS_LTOK)};
        pg8::EpiSwiglu E{(unsigned char*)(ws + WS_ACT), P.in[17]};
        pg8::gemm_phase<true>(stage, (const char*)(ws + WS_H8), DM / 2, S, E);
    }
    GRID_SYNC();
    {
        pg8::MoeSched<false> S{trs, cnts, 4, F.G, (int)blockIdx.x, DFF / 2, (const char*)(ws + WS_WD), (size_t)DM * DFF, nullptr};
        pg8::EpiDown E{(bf16_t*)(ws + WS_Y), P.in[19], (const float*)(ws + WS_LGATE), cnts};
        pg8::gemm_phase<true>(stage, (const char*)(ws + WS_ACT), DFF / 2, S, E);
    }
    GRID_SYNC();
    if (DUP & 1024) combine_phase(P, F, false);
    combine_phase(P, F, true);
    if (TPROBE >= 0 && blockIdx.x == 0 && F.tid == 0) {
        tstamp[nstamp] = __builtin_amdgcn_s_memrealtime();
        const unsigned long long span = tstamp[TPROBE + 1] - tstamp[TPROBE], t0_ = __builtin_amdgcn_s_memrealtime();
        while (__builtin_amdgcn_s_memrealtime() - t0_ < 4ull * span) __builtin_amdgcn_s_sleep(8);
    }
}
}

extern "C" void kernel_launch(void* const* d_in, const int* in_sizes, int n_in, void* d_out, int out_size, void* d_ws, size_t ws_size, hipStream_t stream) {
    static int grid = 0;
    if (grid == 0) {
        if (n_in != 20 || out_size != T * DM || ws_size < WS_END) { fprintf(stderr, "kernel_launch: unexpected problem (n_in %d out %d ws %zu)\n", n_in, out_size, ws_size); grid = -1; return; }
        int dev = 0, cus = 0, per_cu = 0;
        (void)hipGetDevice(&dev);
        (void)hipDeviceGetAttribute(&cus, hipDeviceAttributeMultiprocessorCount, dev);
        (void)hipFuncSetAttribute((const void*)fwd_megakernel, hipFuncAttributeMaxDynamicSharedMemorySize, LDS_BYTES);
        (void)hipOccupancyMaxActiveBlocksPerMultiprocessor(&per_cu, (const void*)fwd_megakernel, NTHR, LDS_BYTES);
        if (per_cu < 1) { fprintf(stderr, "kernel_launch: occupancy query says %d blocks per CU\n", per_cu); per_cu = 1; }
        grid = cus;
    }
    if (grid < 0) return;
    (void)hipMemsetAsync((char*)d_ws + WS_CTL, 0, 65536, stream);
    Params p{};
    for (int i = 0; i < 20; ++i) p.in[i] = (const float*)d_in[i];
    p.out = (float*)d_out; p.ws = (unsigned char*)d_ws;
    hipLaunchKernelGGL(fwd_megakernel, dim3(grid), dim3(NTHR), LDS_BYTES, stream, p);
    const hipError_t e = hipPeekAtLastError();
    if (e != hipSuccess) fprintf(stderr, "launch failed: %s (grid %d)\n", hipGetErrorString(e), grid);
}
```

```cpp
#include <hip/hip_runtime.h>
#include <cstdio>
#include <cstdint>

#define LAS __attribute__((address_space(3)))
typedef unsigned short bf16_t;
typedef short bf16x8 __attribute__((ext_vector_type(8)));
typedef short s16x4 __attribute__((ext_vector_type(4)));
typedef float f32x4 __attribute__((ext_vector_type(4)));
typedef unsigned u32x4 __attribute__((ext_vector_type(4)));
typedef unsigned u32x2 __attribute__((ext_vector_type(2)));
typedef int i32x4 __attribute__((ext_vector_type(4)));
typedef int i32x8 __attribute__((ext_vector_type(8)));

namespace {
constexpr int BATCH = 2, SEQ = 8192, T = BATCH * SEQ, DM = 1024, DIN = 3080, NZ = 3072;
constexpr int NHA = 8, NHM = 4, HDM = 128;
constexpr int NE = 32, DFF = 1024;
constexpr int CH = 256, NCH = SEQ / CH;
constexpr float EPS = 1e-6f;
constexpr float LOG2E = 1.4426950408889634f;
constexpr float SC_W = 32.f, SC_H = 8.f, SC_A = 4.f;
constexpr int ZQ = 0, ZK = 512, ZV = 1024, ZXM = 1536, ZVM = 2048, ZOM = 2560;
constexpr int NWAVES = 8, NTHR = 512;
constexpr int MAXTR = 288;
constexpr int TPROBE = -1;
constexpr int DUP = 0;
constexpr size_t MiB = 1u << 20;
constexpr size_t WS_CTL = 0;
constexpr size_t WS_WIN = 1 * MiB;
constexpr size_t WS_WOUT = 7 * MiB;
constexpr size_t WS_WQK = 9 * MiB;
constexpr size_t WS_WGU = 16 * MiB;
constexpr size_t WS_WD = 144 * MiB;
constexpr size_t WS_XN = 208 * MiB;
constexpr size_t WS_Z = 240 * MiB;
constexpr size_t WS_GATE = 336 * MiB;
constexpr size_t WS_XC = 337 * MiB;
constexpr size_t WS_QK = 353 * MiB;
constexpr size_t WS_BC = 385 * MiB;
constexpr size_t WS_IG = 385 * MiB + 512 * 1024;
constexpr size_t WS_BT = 386 * MiB;
constexpr size_t WS_NV = 386 * MiB + 4096;
constexpr size_t WS_U = 387 * MiB;
constexpr size_t WS_MIX = 403 * MiB;
constexpr size_t WS_LTOK = 435 * MiB;
constexpr size_t WS_LGATE = 437 * MiB;
constexpr size_t WS_TKE = 439 * MiB;
constexpr size_t WS_WRT = 439 * MiB + 512 * 1024;
constexpr size_t WS_H8 = 728 * MiB;
constexpr size_t WS_ACT = 440 * MiB;
constexpr size_t WS_Y = 584 * MiB;
constexpr size_t WS_END = 744 * MiB;
constexpr int LDS_STAGE = 0;
constexpr int LDS_TAB = 131072;
constexpr int LDS_BYTES = 131072 + 1024;

__device__ __forceinline__ unsigned f2bf(float f) { unsigned u = __builtin_bit_cast(unsigned, f); return (u + 0x7fffu + ((u >> 16) & 1u)) >> 16; }
__device__ __forceinline__ unsigned pk2(float lo, float hi) { return f2bf(lo) | (f2bf(hi) << 16); }
__device__ __forceinline__ unsigned pk4_fp8(float a, float b, float c, float d) { int w = 0; w = __builtin_amdgcn_cvt_pk_fp8_f32(a, b, w, false); w = __builtin_amdgcn_cvt_pk_fp8_f32(c, d, w, true); return (unsigned)w; }
__device__ __forceinline__ float bf2f(unsigned b) { return __builtin_bit_cast(float, b << 16); }
__device__ __forceinline__ float bflo(unsigned w) { return __builtin_bit_cast(float, w << 16); }
__device__ __forceinline__ float bfhi(unsigned w) { return __builtin_bit_cast(float, w & 0xffff0000u); }
__device__ __forceinline__ float wave_sum(float v) {
#pragma unroll
    for (int o = 1; o < 64; o <<= 1) v += __shfl_xor(v, o);
    return v;
}
__device__ __forceinline__ float sigmoidf_(float x) { return 1.0f / (1.0f + __expf(-x)); }
}

namespace pg8 {
constexpr int BM = 256, BK = 64, HALF = 128, HTB = HALF * BK * 2, STAGE_BYTES = 8 * HTB, NXCD = 8, WGM = 8;
__host__ __device__ __forceinline__ int lds_byte(int r, int c) { const int st = (r >> 4) * 2 + (c >> 5), rr = r & 15, cc = c & 31, ob = rr * 64 + cc * 2; return st * 1024 + (ob ^ (((ob >> 9) & 1) << 5)); }
__host__ __device__ __forceinline__ void stage_rc(int b, int& R, int& C) { const int st = b / 1024, sb = b % 1024, swz = sb ^ (((sb >> 9) & 1) << 5); R = (st >> 1) * 16 + swz / 64; C = (st & 1) * 32 + (swz % 64) / 2; }
__host__ __device__ __forceinline__ int perm32(int rho) { const int n = rho >> 4, i = rho & 15; return 8 * (i >> 2) + 4 * n + (i & 3); }

__device__ __forceinline__ bool tile_order(int i, int G, int c, int nM, int nN, int& pm, int& pn) {
    const int nwg = nM * nN; const long L = (long)i * G + c; if (L >= nwg) return false;
    int wgid = (int)L; { const int q = nwg / NXCD, r = nwg % NXCD, xcd = wgid % NXCD, off = wgid / NXCD; wgid = (xcd < r ? xcd * (q + 1) : r * (q + 1) + (xcd - r) * q) + off; }
    const int nig = WGM * nN, gid = wgid / nig, fm = gid * WGM, gsz = (nM - fm) < WGM ? (nM - fm) : WGM;
    pm = fm + ((wgid % nig) % gsz); pn = (wgid % nig) / gsz; return true;
}

struct Unit { int pm, pn, e, mt; };

struct DenseSched {
    int nM, nN, G, c, K; const char* Bt; int reps;
    static constexpr bool DRAIN = false, AFFINE = true;
    __device__ __forceinline__ bool next(int i, Unit& u) const { u.e = 0; u.mt = 0; const int per = (nM * nN + G - 1) / G; if (i >= per * reps) return false; if (!tile_order(i % per, G, c, nM, nN, u.pm, u.pn)) return tile_order(0, G, c, nM, nN, u.pm, u.pn); return true; }
    __device__ __forceinline__ void a_off(const Unit& u, const int (&R)[2], const int (&C)[2], unsigned (&off)[2][2]) const {
#pragma unroll
        for (int h = 0; h < 2; ++h)
#pragma unroll
            for (int i = 0; i < 2; ++i) off[h][i] = (unsigned)(((u.pm * BM + h * HALF + R[i]) * K + C[i]) * 2);
    }
    __device__ __forceinline__ const char* b_ptr(const Unit& u) const { return Bt + (size_t)u.pn * BM * K * 2; }
};
template <bool GATHER> struct MoeSched {
    const LAS int* trs; const LAS int* cnts; int nN, G, c, K; const char* Bt; size_t bstride; const int* ltok;
    static constexpr bool DRAIN = GATHER, AFFINE = !GATHER;
    __device__ __forceinline__ bool next(int i, Unit& u) const {
        const int nM = __builtin_amdgcn_readfirstlane(trs[NE]);
        if (!tile_order(i, G, c, nM, nN, u.pm, u.pn)) return false;
        int e = 0;
        for (int j = 1; j < NE; ++j) e += (__builtin_amdgcn_readfirstlane(trs[j]) <= u.pm) ? 1 : 0;
        u.e = e; u.mt = u.pm - __builtin_amdgcn_readfirstlane(trs[e]); return true;
    }
    __device__ __forceinline__ void a_off(const Unit& u, const int (&R)[2], const int (&C)[2], unsigned (&off)[2][2]) const {
        const int n = __builtin_amdgcn_readfirstlane(cnts[u.e]);
#pragma unroll
        for (int h = 0; h < 2; ++h)
#pragma unroll
            for (int i = 0; i < 2; ++i) {
                int row;
                if (GATHER) { const int p = u.mt * BM + h * HALF + R[i]; row = (p < n) ? ltok[u.e * T + p] : 0; }
                else row = u.pm * BM + h * HALF + R[i];
                off[h][i] = (unsigned)((row * K + C[i]) * 2);
            }
    }
    __device__ __forceinline__ const char* b_ptr(const Unit& u) const { return Bt + (size_t)u.e * bstride + (size_t)u.pn * BM * K * 2; }
};

struct EpiBf16 {
    static constexpr bool PERM = true; static constexpr int BMAP = 0;
    bf16_t* O; int ldc;
    __device__ __forceinline__ void operator()(const f32x4 (&acc)[2][2][4][2], const Unit& u, int wr, int wc, int fr, int fq) const {
        const int row0 = u.pm * BM + wr * 64 + fr, col0 = u.pn * BM + wc * 32 + 8 * fq;
#pragma unroll
        for (int ai = 0; ai < 2; ++ai)
#pragma unroll
            for (int m = 0; m < 4; ++m) { bf16_t* rowp = O + (size_t)(row0 + ai * HALF + m * 16) * ldc + col0;
#pragma unroll
                for (int bj = 0; bj < 2; ++bj) { const f32x4 v0 = acc[ai][bj][m][0], v1 = acc[ai][bj][m][1];
                    u32x4 w; w.x = pk2(v0[0], v0[1]); w.y = pk2(v0[2], v0[3]); w.z = pk2(v1[0], v1[1]); w.w = pk2(v1[2], v1[3]);
                    *(u32x4*)(rowp + bj * HALF) = w; } }
    }
};
struct EpiQKNorm {
    static constexpr bool PERM = true; static constexpr int BMAP = 1;
    bf16_t* O; const float* gq; const float* gk;
    __device__ __forceinline__ void operator()(const f32x4 (&acc)[2][2][4][2], const Unit& u, int wr, int wc, int fr, int fq) const {
        const int row0 = u.pm * BM + wr * 64 + fr, col0 = u.pn * BM + wc * 64 + 8 * fq;
        const bool nrm = u.pn < 4; const float* g = (u.pn < 2) ? gq : gk; const float qs = (u.pn < 2) ? 0.125f * LOG2E : 1.0f;
        f32x4 gv[2][2];
#pragma unroll
        for (int bj = 0; bj < 2; ++bj)
#pragma unroll
            for (int n = 0; n < 2; ++n) gv[bj][n] = nrm ? *(const f32x4*)(g + 32 * bj + 8 * fq + 4 * n) : (f32x4){1.f, 1.f, 1.f, 1.f};
#pragma unroll
        for (int ai = 0; ai < 2; ++ai)
#pragma unroll
            for (int m = 0; m < 4; ++m) { bf16_t* rowp = O + (size_t)(row0 + ai * HALF + m * 16) * NZ + col0;
                float sc = 1.0f;
                if (nrm) { float ss = 0.f;
#pragma unroll
                    for (int bj = 0; bj < 2; ++bj)
#pragma unroll
                        for (int n = 0; n < 2; ++n) { const f32x4 v = acc[ai][bj][m][n]; ss += v[0] * v[0] + v[1] * v[1] + v[2] * v[2] + v[3] * v[3]; }
                    ss += __shfl_xor(ss, 16); ss += __shfl_xor(ss, 32);
                    sc = qs / sqrtf(ss * (1.0f / 64.f) + EPS); }
#pragma unroll
                for (int bj = 0; bj < 2; ++bj) { const f32x4 v0 = acc[ai][bj][m][0] * gv[bj][0] * sc, v1 = acc[ai][bj][m][1] * gv[bj][1] * sc;
                    u32x4 w; w.x = pk2(v0[0], v0[1]); w.y = pk2(v0[2], v0[3]); w.z = pk2(v1[0], v1[1]); w.w = pk2(v1[2], v1[3]);
                    *(u32x4*)(rowp + bj * 32) = w; } }
    }
};
struct EpiResF32 {
    static constexpr bool PERM = false; static constexpr int BMAP = 0;
    float* C; const float* Rs; int ldc;
    __device__ __forceinline__ void operator()(const f32x4 (&acc)[2][2][4][2], const Unit& u, int wr, int wc, int fr, int fq) const {
        const int row0 = u.pm * BM + wr * 64 + fr, col0 = u.pn * BM + wc * 32 + 4 * fq;
#pragma unroll
        for (int ai = 0; ai < 2; ++ai)
#pragma unroll
            for (int m = 0; m < 4; ++m) { const size_t ro = (size_t)(row0 + ai * HALF + m * 16) * ldc + col0;
#pragma unroll
                for (int bj = 0; bj < 2; ++bj)
#pragma unroll
                    for (int n = 0; n < 2; ++n) { const f32x4 r = *(const f32x4*)(Rs + ro + bj * HALF + n * 16); *(f32x4*)(C + ro + bj * HALF + n * 16) = acc[ai][bj][m][n] + r; } }
    }
};
struct EpiSwiglu {
    static constexpr bool PERM = true; static constexpr int BMAP = 0;
    unsigned char* O; const float* bgu;
    __device__ __forceinline__ void operator()(const f32x4 (&acc)[2][2][4][2], const Unit& u, int wr, int wc, int fr, int fq) const {
        const int row0 = u.pm * BM + wr * 64 + fr, f0 = u.pn * HALF + wc * 32 + 8 * fq;
        const float* bg = bgu + (size_t)u.e * 2 * DFF + f0;
        constexpr float inv = 1.0f / (SC_H * SC_W);
        f32x4 bgv[2], buv[2];
#pragma unroll
        for (int n = 0; n < 2; ++n) { bgv[n] = *(const f32x4*)(bg + 4 * n); buv[n] = *(const f32x4*)(bg + DFF + 4 * n); }
#pragma unroll
        for (int ai = 0; ai < 2; ++ai)
#pragma unroll
            for (int m = 0; m < 4; ++m) { unsigned char* rowp = O + (size_t)(row0 + ai * HALF + m * 16) * DFF + f0;
                float r[8];
#pragma unroll
                for (int n = 0; n < 2; ++n) { const f32x4 gv = acc[ai][0][m][n] * inv + bgv[n], uv = acc[ai][1][m][n] * inv + buv[n];
#pragma unroll
                    for (int j = 0; j < 4; ++j) { const float gg = fminf(gv[j], 7.0f), uu = fminf(fmaxf(uv[j], -7.0f), 7.0f);
                        r[4 * n + j] = SC_A * gg * (uu + 1.0f) / (1.0f + __expf(-1.702f * gg)); } }
                u32x2 w; w.x = pk4_fp8(r[0], r[1], r[2], r[3]); w.y = pk4_fp8(r[4], r[5], r[6], r[7]);
                *(u32x2*)rowp = w; }
    }
};
struct EpiDown {
    static constexpr bool PERM = true; static constexpr int BMAP = 0;
    bf16_t* O; const float* bd; const float* lgate; const LAS int* cnts;
    __device__ __forceinline__ void operator()(const f32x4 (&acc)[2][2][4][2], const Unit& u, int wr, int wc, int fr, int fq) const {
        const int row0 = u.pm * BM + wr * 64 + fr, col0 = u.pn * BM + wc * 32 + 8 * fq;
        const int n_e = cnts[u.e];
        f32x4 bv[2][2];
#pragma unroll
        for (int bj = 0; bj < 2; ++bj)
#pragma unroll
            for (int n = 0; n < 2; ++n) bv[bj][n] = *(const f32x4*)(bd + (size_t)u.e * DM + col0 + bj * HALF + 4 * n);
#pragma unroll
        for (int ai = 0; ai < 2; ++ai)
#pragma unroll
            for (int m = 0; m < 4; ++m) { const int rt = wr * 64 + fr + ai * HALF + m * 16, p = u.mt * BM + rt;
                const float gt = (p < n_e) ? lgate[(size_t)u.e * T + p] : 0.f;
                bf16_t* rowp = O + (size_t)(row0 + ai * HALF + m * 16) * DM + col0;
#pragma unroll
                for (int bj = 0; bj < 2; ++bj) { const f32x4 v0 = (acc[ai][bj][m][0] * (1.0f / (SC_A * SC_W)) + bv[bj][0]) * gt, v1 = (acc[ai][bj][m][1] * (1.0f / (SC_A * SC_W)) + bv[bj][1]) * gt;
                    u32x4 w; w.x = pk2(v0[0], v0[1]); w.y = pk2(v0[2], v0[3]); w.z = pk2(v1[0], v1[1]); w.w = pk2(v1[2], v1[3]);
                    *(u32x4*)(rowp + bj * HALF) = w; } }
    }
};

template <bool FP8, class Epi, class Sched>
__device__ __forceinline__ void gemm_phase(LAS unsigned char* lds, const char* A0, const int K, const Sched& S, const Epi& E) {
    int tid = threadIdx.x; asm volatile("" : "+v"(tid));
    const int wid = __builtin_amdgcn_readfirstlane(tid >> 6), lane = tid & 63, wr = wid >> 2, wc = wid & 3, fr = lane & 15, fq = lane >> 4;
    const int nt = K / BK;
    int Rr[2], Cc[2]; unsigned voffB[2];
#pragma unroll
    for (int i = 0; i < 2; ++i) { stage_rc(tid * 16 + i * 8192, Rr[i], Cc[i]); const int r5 = Epi::PERM ? perm32(Rr[i] & 31) : (Rr[i] & 31); const int Rb = Epi::BMAP ? (64 * (Rr[i] >> 5) + r5) : ((Rr[i] & ~31) + r5); voffB[i] = (unsigned)(Rb * K + Cc[i]) * 2u; }
    const size_t kstep = (size_t)(BK * 2);
    const size_t hstep = (size_t)(Epi::BMAP ? 32 : HALF) * K * 2;
    const unsigned ldsw = (unsigned)wid * 1024u;
    const int aoff = lds_byte(wr * 64 + fr, fq * 8), boff = lds_byte(wc * 32 + fr, fq * 8);
#define PG8_SA(b, h) (((b) * 2 + (h)) * HTB)
#define PG8_SB(b, h) ((4 + (b) * 2 + (h)) * HTB)
#define PG8_STAGE_B(bufoff, gbase) do { _Pragma("unroll") for (int _i = 0; _i < 2; ++_i) \
        __builtin_amdgcn_global_load_lds((const unsigned*)((const char*)(gbase) + voffB[_i]), (LAS unsigned*)(lds + (bufoff) + ldsw + _i * 8192), 16, 0, 0); } while (0)
#define PG8_STAGE_A(bufoff, gbase, o0, o1) do { \
        __builtin_amdgcn_global_load_lds((const unsigned*)((const char*)(gbase) + (o0)), (LAS unsigned*)(lds + (bufoff) + ldsw), 16, 0, 0); \
        __builtin_amdgcn_global_load_lds((const unsigned*)((const char*)(gbase) + (o1)), (LAS unsigned*)(lds + (bufoff) + ldsw + 8192), 16, 0, 0); } while (0)
#define PG8_LDA(dst, b, h) do { if constexpr (FP8) { _Pragma("unroll") for (int m = 0; m < 4; ++m) { const i32x4 lo_ = *(const LAS i32x4*)(lds + PG8_SA(b, h) + aoff + m * 2048), hi_ = *(const LAS i32x4*)(lds + PG8_SA(b, h) + aoff + m * 2048 + 1024); \
            dst##8[m] = __builtin_shufflevector(lo_, hi_, 0, 1, 2, 3, 4, 5, 6, 7); } } \
        else { _Pragma("unroll") for (int m = 0; m < 4; ++m) _Pragma("unroll") for (int k = 0; k < 2; ++k) dst[m][k] = *(const LAS bf16x8*)(lds + PG8_SA(b, h) + aoff + m * 2048 + k * 1024); } } while (0)
#define PG8_LDB(dst, b, h) do { if constexpr (FP8) { _Pragma("unroll") for (int n = 0; n < 2; ++n) { const i32x4 lo_ = *(const LAS i32x4*)(lds + PG8_SB(b, h) + boff + n * 2048), hi_ = *(const LAS i32x4*)(lds + PG8_SB(b, h) + boff + n * 2048 + 1024); \
            dst##8[n] = __builtin_shufflevector(lo_, hi_, 0, 1, 2, 3, 4, 5, 6, 7); } } \
        else { _Pragma("unroll") for (int n = 0; n < 2; ++n) _Pragma("unroll") for (int k = 0; k < 2; ++k) dst[n][k] = *(const LAS bf16x8*)(lds + PG8_SB(b, h) + boff + n * 2048 + k * 1024); } } while (0)
#define PG8_MMA(ai, bj, At, Bt) do { __builtin_amdgcn_s_setprio(1); \
        if constexpr (FP8) { _Pragma("unroll") for (int m = 0; m < 4; ++m) _Pragma("unroll") for (int n = 0; n < 2; ++n) \
            asm volatile("s_nop 1\n\tv_mfma_f32_16x16x128_f8f6f4 %0, %1, %2, %0" : "+v"(acc[ai][bj][m][n]) : "v"(Bt##8[n]), "v"(At##8[m])); } \
        else { _Pragma("unroll") for (int m = 0; m < 4; ++m) _Pragma("unroll") for (int n = 0; n < 2; ++n) _Pragma("unroll") for (int k = 0; k < 2; ++k) \
            acc[ai][bj][m][n] = __builtin_amdgcn_mfma_f32_16x16x32_bf16(Bt[n][k], At[m][k], acc[ai][bj][m][n], 0, 0, 0); } \
        __builtin_amdgcn_s_setprio(0); } while (0)
#define PG8_WAIT_V(n) asm volatile("s_waitcnt vmcnt(" #n ")" ::: "memory")
#define PG8_WAIT_L(n) asm volatile("s_waitcnt lgkmcnt(" #n ")" ::: "memory")
#define PG8_BAR __builtin_amdgcn_s_barrier()
#define PG8_SCHED __builtin_amdgcn_sched_barrier(0)
    Unit cur, nxt; int ui = 0;
    if (!S.next(0, cur)) return;
    f32x4 acc[2][2][4][2];
#pragma unroll
    for (int a = 0; a < 2; ++a)
#pragma unroll
        for (int b = 0; b < 2; ++b)
#pragma unroll
            for (int m = 0; m < 4; ++m)
#pragma unroll
                for (int n = 0; n < 2; ++n) acc[a][b][m][n] = (f32x4){0.f, 0.f, 0.f, 0.f};
    bf16x8 At[4][2], B0[2][2], B1[2][2]; i32x8 At8[4], B08[2], B18[2];
    unsigned offC[2][2], offN[2][2];
    const char* uA = A0; const char* nA = A0;
    if constexpr (Sched::AFFINE) {
#pragma unroll
        for (int h = 0; h < 2; ++h)
#pragma unroll
            for (int i = 0; i < 2; ++i) offC[h][i] = (unsigned)(((h * HALF + Rr[i]) * K + Cc[i]) * 2);
        uA = A0 + (size_t)cur.pm * BM * K * 2;
    } else S.a_off(cur, Rr, Cc, offC);
    const char* cB = S.b_ptr(cur);
    if (Sched::DRAIN) PG8_WAIT_V(0);
    PG8_STAGE_B(PG8_SB(0, 0), cB); PG8_STAGE_B(PG8_SB(0, 1), cB + hstep); PG8_STAGE_A(PG8_SA(0, 0), uA, offC[0][0], offC[0][1]); PG8_STAGE_A(PG8_SA(0, 1), uA, offC[1][0], offC[1][1]);
    if (wr == 1) PG8_BAR;
    PG8_WAIT_V(2); PG8_BAR;
    PG8_STAGE_B(PG8_SB(1, 0), cB + kstep); PG8_STAGE_A(PG8_SA(1, 0), uA + kstep, offC[0][0], offC[0][1]); PG8_STAGE_B(PG8_SB(1, 1), cB + hstep + kstep);
    PG8_WAIT_V(6); PG8_BAR;
    for (;;) {
        const bool has_next = S.next(ui + 1, nxt);
        const char* nB = cB;
        if constexpr (Sched::AFFINE) { nA = uA; if (has_next) { nA = A0 + (size_t)nxt.pm * BM * K * 2; nB = S.b_ptr(nxt); } }
        else {
            if (has_next) { S.a_off(nxt, Rr, Cc, offN); nB = S.b_ptr(nxt); }
            else {
#pragma unroll
                for (int h = 0; h < 2; ++h)
#pragma unroll
                    for (int i = 0; i < 2; ++i) offN[h][i] = offC[h][i];
            }
        }
        if (Sched::DRAIN) PG8_WAIT_V(0);
        for (int t = 0; t < nt; t += 2) {
            const bool last = (t == nt - 2);
            const char* a1 = uA + (size_t)(t + 1) * kstep;
            const char* a2 = last ? nA : uA + (size_t)(t + 2) * kstep; const char* b2 = last ? nB : cB + (size_t)(t + 2) * kstep;
            const char* a3 = a2 + kstep; const char* b3 = b2 + kstep;
            unsigned o00 = offC[0][0], o01 = offC[0][1], o10 = offC[1][0], o11 = offC[1][1];
            if constexpr (!Sched::AFFINE) { if (last) { o00 = offN[0][0]; o01 = offN[0][1]; o10 = offN[1][0]; o11 = offN[1][1]; } }
            PG8_LDB(B0, 0, 0); PG8_LDB(B1, 0, 1); PG8_SCHED; PG8_LDA(At, 0, 0); PG8_STAGE_A(PG8_SA(1, 1), a1, offC[1][0], offC[1][1]);
            PG8_WAIT_V(8); PG8_WAIT_L(0); PG8_BAR; PG8_MMA(0, 0, At, B0); PG8_MMA(0, 1, At, B1); PG8_BAR; PG8_SCHED;
            PG8_LDA(At, 0, 1); PG8_STAGE_B(PG8_SB(0, 0), b2); PG8_STAGE_B(PG8_SB(0, 1), b2 + hstep); PG8_STAGE_A(PG8_SA(0, 0), a2, o00, o01);
            PG8_WAIT_V(8); PG8_WAIT_L(0); PG8_BAR; PG8_MMA(1, 0, At, B0); PG8_MMA(1, 1, At, B1); PG8_BAR; PG8_SCHED;
            PG8_LDB(B0, 1, 0); PG8_LDB(B1, 1, 1); PG8_SCHED; PG8_LDA(At, 1, 0); PG8_STAGE_A(PG8_SA(0, 1), a2, o10, o11);
            PG8_WAIT_V(8); PG8_WAIT_L(0); PG8_BAR; PG8_MMA(0, 0, At, B0); PG8_MMA(0, 1, At, B1); PG8_BAR; PG8_SCHED;
            PG8_LDA(At, 1, 1); PG8_STAGE_B(PG8_SB(1, 0), b3); PG8_STAGE_B(PG8_SB(1, 1), b3 + hstep); PG8_STAGE_A(PG8_SA(1, 0), a3, o00, o01);
            PG8_WAIT_V(8); PG8_WAIT_L(0); PG8_BAR; PG8_MMA(1, 0, At, B0); PG8_MMA(1, 1, At, B1); PG8_BAR; PG8_SCHED;
        }
        if (wr == 0) PG8_BAR;
        if constexpr (FP8) {
            asm volatile("s_nop 15\n\ts_nop 15" : "+v"(acc[0][0][0][0]), "+v"(acc[0][0][0][1]), "+v"(acc[0][0][1][0]), "+v"(acc[0][0][1][1]), "+v"(acc[0][0][2][0]), "+v"(acc[0][0][2][1]), "+v"(acc[0][0][3][0]), "+v"(acc[0][0][3][1]),
                                                    "+v"(acc[0][1][0][0]), "+v"(acc[0][1][0][1]), "+v"(acc[0][1][1][0]), "+v"(acc[0][1][1][1]), "+v"(acc[0][1][2][0]), "+v"(acc[0][1][2][1]), "+v"(acc[0][1][3][0]), "+v"(acc[0][1][3][1]));
            asm volatile("s_nop 0" : "+v"(acc[1][0][0][0]), "+v"(acc[1][0][0][1]), "+v"(acc[1][0][1][0]), "+v"(acc[1][0][1][1]), "+v"(acc[1][0][2][0]), "+v"(acc[1][0][2][1]), "+v"(acc[1][0][3][0]), "+v"(acc[1][0][3][1]),
                                   "+v"(acc[1][1][0][0]), "+v"(acc[1][1][0][1]), "+v"(acc[1][1][1][0]), "+v"(acc[1][1][1][1]), "+v"(acc[1][1][2][0]), "+v"(acc[1][1][2][1]), "+v"(acc[1][1][3][0]), "+v"(acc[1][1][3][1]));
        }
        E(acc, cur, wr, wc, fr, fq);
        if (!has_next) break;
#pragma unroll
        for (int a = 0; a < 2; ++a)
#pragma unroll
            for (int b = 0; b < 2; ++b)
#pragma unroll
                for (int m = 0; m < 4; ++m)
#pragma unroll
                    for (int n = 0; n < 2; ++n) acc[a][b][m][n] = (f32x4){0.f, 0.f, 0.f, 0.f};
        cur = nxt; cB = nB; ++ui;
        if constexpr (Sched::AFFINE) uA = nA;
        else {
#pragma unroll
            for (int h = 0; h < 2; ++h)
#pragma unroll
                for (int i = 0; i < 2; ++i) offC[h][i] = offN[h][i];
        }
        if (wr == 1) PG8_BAR;
    }
    PG8_WAIT_V(0);
    PG8_BAR;
#undef PG8_SA
#undef PG8_SB
#undef PG8_STAGE_A
#undef PG8_STAGE_B
#undef PG8_LDA
#undef PG8_LDB
#undef PG8_MMA
#undef PG8_WAIT_V
#undef PG8_WAIT_L
#undef PG8_BAR
#undef PG8_SCHED
}
}

namespace {
struct Params { const float* in[20]; float* out; unsigned char* ws; };

struct Frame {
    LAS unsigned char* lds;
    int tid, lane, wave, G, vcu, gw, ngw;
};

struct ConvItem { const float* src; unsigned char* dst; int ldw, ldt, kind; float scale; };
__device__ __forceinline__ void conv_load(const ConvItem& I, f32x4 (&v)[8], int lane) {
    const int r8 = lane >> 3, c4 = (lane & 7) * 4;
#pragma unroll
    for (int i = 0; i < 8; ++i) v[i] = __builtin_nontemporal_load((const f32x4*)(I.src + (size_t)(8 * i + r8) * I.ldw + c4));
}
__device__ __forceinline__ void conv_store(const ConvItem& I, const f32x4 (&v)[8], LAS float* scr, int lane) {
    const int r8 = lane >> 3, c4 = (lane & 7) * 4;
#pragma unroll
    for (int i = 0; i < 8; ++i) { LAS float* d = scr + (8 * i + r8) * 33 + c4; d[0] = v[i][0]; d[1] = v[i][1]; d[2] = v[i][2]; d[3] = v[i][3]; }
    asm volatile("s_waitcnt lgkmcnt(0)" ::: "memory");
    const float scale = I.scale;
    if (I.kind == 0) {
        const int c = lane & 7;
#pragma unroll
        for (int j = 0; j < 4; ++j) { const int n = (lane >> 3) + 8 * j; const LAS float* s = scr + (8 * c) * 33 + n;
            u32x4 o; o.x = pk2(s[0 * 33] * scale, s[1 * 33] * scale); o.y = pk2(s[2 * 33] * scale, s[3 * 33] * scale); o.z = pk2(s[4 * 33] * scale, s[5 * 33] * scale); o.w = pk2(s[6 * 33] * scale, s[7 * 33] * scale);
            *(u32x4*)(I.dst + ((size_t)n * I.ldt + 8 * c) * 2) = o; }
    } else {
        const int n = lane >> 1, kh = lane & 1; const LAS float* s = scr + (32 * kh) * 33 + n;
        unsigned w[8];
#pragma unroll
        for (int q = 0; q < 8; ++q) w[q] = pk4_fp8(s[(4 * q) * 33] * scale, s[(4 * q + 1) * 33] * scale, s[(4 * q + 2) * 33] * scale, s[(4 * q + 3) * 33] * scale);
        unsigned char* d = I.dst + (size_t)n * I.ldt + 32 * kh;
        *(u32x4*)d = (u32x4){w[0], w[1], w[2], w[3]}; *(u32x4*)(d + 16) = (u32x4){w[4], w[5], w[6], w[7]};
    }
    asm volatile("s_waitcnt lgkmcnt(0)" ::: "memory");
}
template <class GetItem>
__device__ __forceinline__ void conv_run(GetItem get, int first, int n, int stride, LAS float* scr, int lane) {
    if (first >= n) return;
    ConvItem A, B, C; f32x4 va[8], vb[8], vc[8];
    get(first, A); conv_load(A, va, lane);
    const bool hb = first + stride < n, hc = first + 2 * stride < n;
    B = A; C = A;
    if (hb) { get(first + stride, B); conv_load(B, vb, lane); }
    if (hc) { get(first + 2 * stride, C); conv_load(C, vc, lane); }
    for (int it = first; it < n; it += stride) {
        conv_store(A, va, scr, lane);
        A = B; B = C;
#pragma unroll
        for (int i = 0; i < 8; ++i) { va[i] = vb[i]; vb[i] = vc[i]; }
        const int nx = it + 3 * stride;
        if (nx < n) { get(nx, C); conv_load(C, vc, lane); }
    }
}
constexpr int I_GU = NE * 16 * 64, I_D = NE * 16 * 32;
__device__ __forceinline__ void moe_item(const Params& P, int r, ConvItem& I) {
    I.kind = 1; I.scale = SC_W; I.ldt = DM;
    if (r < I_GU) { const int e = r >> 10, kb = (r >> 6) & 15, nb = r & 63, n0 = 32 * nb, f = n0 & 1023, up = n0 >> 10;
        const int drow = (f >> 7) * 256 + up * 128 + (f & 127);
        I.src = P.in[16] + (size_t)e * DM * 2 * DFF + (size_t)(64 * kb) * 2 * DFF + n0; I.ldw = 2 * DFF;
        I.dst = P.ws + WS_WGU + (size_t)e * 2 * DFF * DM + (size_t)drow * DM + 64 * kb;
    } else { r -= I_GU; const int e = r >> 9, kb = (r >> 5) & 15, nb = r & 31;
        I.src = P.in[18] + (size_t)e * DFF * DM + (size_t)(64 * kb) * DM + 32 * nb; I.ldw = DM;
        I.dst = P.ws + WS_WD + (size_t)e * DM * DFF + (size_t)(32 * nb) * DFF + 64 * kb; }
}
__device__ __forceinline__ void moe_convert(const Params& P, Frame& F, int cw, int ncw) {
    LAS float* scr = (LAS float*)(F.lds + F.wave * 8448);
    conv_run([&](int r, ConvItem& I) { moe_item(P, r, I); }, cw, I_GU + I_D, ncw, scr, F.lane);
}

__device__ __forceinline__ void p0_prologue(const Params& P, Frame& F) {
    unsigned char* ws = P.ws;
    const float* w_in = P.in[2];
    LAS float* scr = (LAS float*)(F.lds + F.wave * 8448);
    LAS float* gwl = (LAS float*)(F.lds + 73728);
    for (int i = F.tid; i < 1024 * 8; i += NTHR) gwl[i] = w_in[(size_t)(i >> 3) * DIN + NZ + (i & 7)];
    __syncthreads();
    constexpr int I_IN = 16 * 96, I_OUT = 16 * 32, I_QK = 8 * 2 * 4, I_ZERO = 8 * 3;
    bf16_t* WqkT = (bf16_t*)(ws + WS_WQK);
    conv_run([&](int r, ConvItem& I) {
        I.kind = 0; I.scale = 1.f;
        if (r < I_IN) { const int kb = r / 96, nb = r % 96; I.src = w_in + (size_t)(64 * kb) * DIN + 32 * nb; I.ldw = DIN; I.dst = ws + WS_WIN + ((size_t)(32 * nb) * DM + 64 * kb) * 2; I.ldt = DM; return; }
        r -= I_IN;
        if (r < I_OUT) { const int kb = r / 32, nb = r % 32; I.src = P.in[12] + (size_t)(64 * kb) * DM + 32 * nb; I.ldw = DM; I.dst = ws + WS_WOUT + ((size_t)(32 * nb) * DM + 64 * kb) * 2; I.ldt = DM; return; }
        r -= I_OUT;
        { const int isk = r >> 5, h = (r >> 3) & 3, kb = (r >> 2) & 1, nb = r & 3;
            I.src = P.in[isk ? 8 : 7] + (size_t)h * 16384 + (size_t)(64 * kb) * 128 + 32 * nb; I.ldw = 128;
            I.dst = ws + WS_WQK + ((size_t)(isk * 512 + h * 128 + 32 * nb) * 512 + h * 128 + 64 * kb) * 2; I.ldt = 512; I.scale = isk ? 0.08838834764831845f : 1.f; }
    }, F.gw, I_IN + I_OUT + I_QK, F.ngw, scr, F.lane);
    moe_convert(P, F, F.gw, F.ngw);
    for (int r = F.gw; r < I_ZERO; r += F.ngw) {
        const int rb = r / 3, j = r % 3, cb = j + (j >= (rb & 3) ? 1 : 0);
        for (int q = F.lane; q < 128 * 16; q += 64) { const int rr = q >> 4, cc = q & 15; *(u32x4*)(WqkT + (size_t)(rb * 128 + rr) * 512 + cb * 128 + cc * 8) = (u32x4){0u, 0u, 0u, 0u}; }
    }
    {
        const float* wr = P.in[14]; float* wrt = (float*)(ws + WS_WRT);
        for (int idx = F.vcu * NTHR + F.tid; idx < DM * NE; idx += F.G * NTHR) wrt[(idx & 31) * DM + (idx >> 5)] = wr[idx];
    }
    const float* x = P.in[0]; const float* g1 = P.in[1];
    bf16_t* XN = (bf16_t*)(ws + WS_XN); float* GATE = (float*)(ws + WS_GATE);
    for (int row = F.gw; row < T; row += F.ngw) {
        const f32x4* xr = (const f32x4*)(x + (size_t)row * DM);
        f32x4 v[4]; float s = 0.f;
#pragma unroll
        for (int j = 0; j < 4; ++j) { v[j] = xr[F.lane + 64 * j]; s += v[j][0] * v[j][0] + v[j][1] * v[j][1] + v[j][2] * v[j][2] + v[j][3] * v[j][3]; }
        s = wave_sum(s);
        const float rs = 1.0f / sqrtf(s * (1.0f / DM) + EPS);
        float ga[8];
#pragma unroll
        for (int c = 0; c < 8; ++c) ga[c] = 0.f;
#pragma unroll
        for (int j = 0; j < 4; ++j) { const f32x4 gg = ((const f32x4*)g1)[F.lane + 64 * j]; v[j] = v[j] * rs * gg;
            u32x2 w; w.x = pk2(v[j][0], v[j][1]); w.y = pk2(v[j][2], v[j][3]);
            *(u32x2*)(XN + (size_t)row * DM + 4 * (F.lane + 64 * j)) = w;
#pragma unroll
            for (int q = 0; q < 4; ++q) { const int k = 4 * (F.lane + 64 * j) + q; const f32x4 w0 = *(const LAS f32x4*)(gwl + k * 8), w1 = *(const LAS f32x4*)(gwl + k * 8 + 4);
                ga[0] += v[j][q] * w0[0]; ga[1] += v[j][q] * w0[1]; ga[2] += v[j][q] * w0[2]; ga[3] += v[j][q] * w0[3];
                ga[4] += v[j][q] * w1[0]; ga[5] += v[j][q] * w1[1]; ga[6] += v[j][q] * w1[2]; ga[7] += v[j][q] * w1[3]; } }
#pragma unroll
        for (int c = 0; c < 8; ++c) ga[c] = wave_sum(ga[c]);
        if (F.lane == 0) { *(f32x4*)(GATE + (size_t)row * 8) = (f32x4){ga[0], ga[1], ga[2], ga[3]}; *(f32x4*)(GATE + (size_t)row * 8 + 4) = (f32x4){ga[4], ga[5], ga[6], ga[7]}; }
    }
}

#define MFMA16(a, b, c) __builtin_amdgcn_mfma_f32_16x16x32_bf16((a), (b), (c), 0, 0, 0)
struct AttBlk { int tlb, off, d, qb, m, b, h, pass, tt; };
__device__ __forceinline__ void att_decode(int fb, int w, int vcu, int G, AttBlk& k) {
    const int ul = fb / 30, r = fb - 30 * ul, t6 = r / 5; k.m = r - 5 * t6; k.pass = t6 >> 1; k.tt = t6 & 1;
    const int unit = vcu + ul * G; k.tlb = (unit & 31) * 256; k.h = (unit >> 5) & 7; k.b = unit >> 8;
    const int tau = 2 * w + k.tt; k.d = 1 << (2 * k.pass);
    k.off = k.pass == 0 ? 0 : (k.pass == 1 ? (tau & 3) : tau); k.qb = k.pass == 0 ? 16 * tau : (k.pass == 1 ? 16 * (tau >> 2) : 0);
}
__device__ __forceinline__ void attn_phase(const Params& P, Frame& F) {
    const bf16_t* Z = (const bf16_t*)(P.ws + WS_Z); bf16_t* MIX = (bf16_t*)(P.ws + WS_MIX);
    const int tid = F.tid;
    const int lane = tid & 63, i = lane & 15, g = lane >> 4, w = F.wave;
    float gm = fabsf(P.in[4][lane]);
#pragma unroll
    for (int o = 1; o < 64; o <<= 1) gm = fmaxf(gm, __shfl_xor(gm, o));
    const float kmax = 8.0f * gm * 1.01f;
    constexpr int OP = 272;
    LAS unsigned char* OL = F.lds;
    LAS float* LL = (LAS float*)(F.lds + 256 * OP);
    LAS unsigned char* vb = F.lds + 256 * OP + 1024 + w * 4608;
    const int vwr = (lane >> 3) * 144 + (lane & 7) * 16;
    const int vrd = (4 * g + (i >> 2)) * 144 + (i & 3) * 8;
    const int nunits = (512 - F.vcu + F.G - 1) / F.G, NFB = 30 * nunits;
    if (NFB <= 0) return;
#define ATT_WGBAR() do { asm volatile("s_waitcnt lgkmcnt(0)" ::: "memory"); __builtin_amdgcn_s_barrier(); asm volatile("" ::: "memory"); } while (0)
#define ATT_LOAD(kd, kfn, vrn) do { const bf16_t* Kh_ = Z + (size_t)(kd).b * SEQ * NZ + ZK + (kd).h * 64 + 8 * g; const bf16_t* Vh_ = Z + (size_t)(kd).b * SEQ * NZ + ZV + (kd).h * 64 + 8 * (lane & 7); \
        const int nb_ = (kd).qb - 144 + 32 * (kd).m, p0_ = (kd).tlb + (kd).off; \
        _Pragma("unroll") for (int sb = 0; sb < 2; ++sb) { int kp = p0_ + (nb_ + 16 * sb + i) * (kd).d; kp = kp < 0 ? 0 : (kp > SEQ - 1 ? SEQ - 1 : kp); const bf16_t* kr = Kh_ + (size_t)kp * NZ; kfn[sb][0] = *(const bf16x8*)kr; kfn[sb][1] = *(const bf16x8*)(kr + 32); } \
        _Pragma("unroll") for (int c = 0; c < 4; ++c) { int kp = p0_ + (nb_ + 8 * c + (lane >> 3)) * (kd).d; kp = kp < 0 ? 0 : (kp > SEQ - 1 ? SEQ - 1 : kp); vrn[c] = *(const u32x4*)(Vh_ + (size_t)kp * NZ); } } while (0)
#define ATT_LOADQ(kd, q0_, q1_) do { const bf16_t* qr_ = Z + (size_t)((kd).b * SEQ + (kd).tlb + (kd).off + (kd).d * ((kd).qb + i)) * NZ + ZQ + (kd).h * 64 + 8 * g; q0_ = *(const bf16x8*)qr_; q1_ = *(const bf16x8*)(qr_ + 32); } while (0)
    bf16x8 kfa[2][2], kfb[2][2]; u32x4 vra[4], vrb[4]; bf16x8 qn0, qn1, qf0, qf1;
    AttBlk cur, nx;
    att_decode(0, w, F.vcu, F.G, cur);
    ATT_LOADQ(cur, qn0, qn1);
    ATT_LOAD(cur, kfa, vra);
    att_decode(1, w, F.vcu, F.G, nx); ATT_LOAD(nx, kfb, vrb);
    f32x4 o[4]; float lsum = 0.f, ref = 0.f, slope2 = 0.f;
    __syncthreads();
#pragma unroll 1
    for (int fb = 0; fb < NFB; ++fb) {
        att_decode(fb, w, F.vcu, F.G, cur);
        if (cur.m == 0) {
            qf0 = qn0; qf1 = qn1;
            if (fb + 5 < NFB) { att_decode(fb + 5, w, F.vcu, F.G, nx); ATT_LOADQ(nx, qn0, qn1); }
            float ss = 0.f;
#pragma unroll
            for (int j = 0; j < 8; ++j) { const float a = bf2f((unsigned short)qf0[j]), c = bf2f((unsigned short)qf1[j]); ss += a * a + c * c; }
            ss += __shfl_xor(ss, 16); ss += __shfl_xor(ss, 32);
            ref = sqrtf(ss) * kmax; slope2 = exp2f(-(float)(cur.h + 1)) * LOG2E;
#pragma unroll
            for (int dt = 0; dt < 4; ++dt) o[dt] = (f32x4){0.f, 0.f, 0.f, 0.f};
            lsum = 0.f;
        }
        bf16x8 kf[2][2]; u32x4 vr[4];
#pragma unroll
        for (int sb = 0; sb < 2; ++sb) { kf[sb][0] = kfa[sb][0]; kf[sb][1] = kfa[sb][1]; kfa[sb][0] = kfb[sb][0]; kfa[sb][1] = kfb[sb][1]; }
#pragma unroll
        for (int c = 0; c < 4; ++c) { vr[c] = vra[c]; vra[c] = vrb[c]; }
        if (fb + 2 < NFB) { att_decode(fb + 2, w, F.vcu, F.G, nx); ATT_LOAD(nx, kfb, vrb); }
        const int d = cur.d, qb = cur.qb, nb = qb - 144 + 32 * cur.m, p0 = cur.tlb + cur.off;
#pragma unroll
        for (int c = 0; c < 4; ++c) *(LAS u32x4*)(vb + vwr + c * 8 * 144) = vr[c];
        f32x4 s[2];
#pragma unroll
        for (int sb = 0; sb < 2; ++sb) { s[sb] = MFMA16(kf[sb][0], qf0, ((f32x4){0.f, 0.f, 0.f, 0.f})); s[sb] = MFMA16(kf[sb][1], qf1, s[sb]); }
        float p[8];
#pragma unroll
        for (int sb = 0; sb < 2; ++sb)
#pragma unroll
            for (int j = 0; j < 4; ++j) { const int n = nb + 16 * sb + 4 * g + j, a = qb + i - n;
                const bool valid = (a >= 0) && (a <= 128) && (p0 + n * d >= 0);
                const float e = s[sb][j] - slope2 * (float)(a * d) - ref;
                const float pv = valid ? __builtin_amdgcn_exp2f(e) : 0.f;
                p[4 * sb + j] = pv; lsum += pv; }
        u32x4 pw; pw.x = pk2(p[0], p[1]); pw.y = pk2(p[2], p[3]); pw.z = pk2(p[4], p[5]); pw.w = pk2(p[6], p[7]);
        const bf16x8 pf = __builtin_bit_cast(bf16x8, pw);
#pragma unroll
        for (int dt = 0; dt < 4; ++dt) {
            const s16x4 v0 = __builtin_amdgcn_ds_read_tr16_b64_v4i16((LAS s16x4*)(vb + vrd + dt * 32));
            const s16x4 v1 = __builtin_amdgcn_ds_read_tr16_b64_v4i16((LAS s16x4*)(vb + vrd + 16 * 144 + dt * 32));
            const bf16x8 vf = (bf16x8){v0[0], v0[1], v0[2], v0[3], v1[0], v1[1], v1[2], v1[3]};
            o[dt] = MFMA16(vf, pf, o[dt]);
        }
        if (cur.m == 4) {
            float ls = lsum; ls += __shfl_xor(ls, 16); ls += __shfl_xor(ls, 32);
            const int row = cur.off + d * (qb + i);
            LAS f32x4* orow = (LAS f32x4*)(OL + row * OP + 16 * g);
            if (cur.pass == 0) {
#pragma unroll
                for (int dt = 0; dt < 4; ++dt) orow[4 * dt] = o[dt];
                if (g == 0) LL[row] = ls;
            } else {
#pragma unroll
                for (int dt = 0; dt < 4; ++dt) orow[4 * dt] = orow[4 * dt] + o[dt];
                if (g == 0) LL[row] += ls;
            }
            if (cur.tt == 1) {
                ATT_WGBAR();
                if (cur.pass == 2) {
                    const int rw = tid >> 1, hf = tid & 1;
                    const float inv = 1.0f / LL[rw];
                    const LAS f32x4* orw = (const LAS f32x4*)(OL + rw * OP + hf * 128);
                    bf16_t* mrow = MIX + (size_t)(cur.b * SEQ + cur.tlb + rw) * DM + cur.h * 64 + hf * 32;
#pragma unroll
                    for (int q = 0; q < 4; ++q) { const f32x4 a0 = orw[2 * q] * inv, a1 = orw[2 * q + 1] * inv;
                        u32x4 wv_; wv_.x = pk2(a0[0], a0[1]); wv_.y = pk2(a0[2], a0[3]); wv_.z = pk2(a1[0], a1[1]); wv_.w = pk2(a1[2], a1[3]);
                        *(u32x4*)(mrow + 8 * q) = wv_; }
                    ATT_WGBAR();
                }
            }
        }
    }
#undef ATT_LOAD
#undef ATT_LOADQ
#undef ATT_WGBAR
    __syncthreads();
}

__device__ __forceinline__ bf16x8 tr2(LAS unsigned char* p0, LAS unsigned char* p1) {
    const s16x4 a = __builtin_amdgcn_ds_read_tr16_b64_v4i16((LAS s16x4*)p0);
    const s16x4 b = __builtin_amdgcn_ds_read_tr16_b64_v4i16((LAS s16x4*)p1);
    return (bf16x8){a[0], a[1], a[2], a[3], b[0], b[1], b[2], b[3]};
}

__device__ __forceinline__ void ml1_phase(const Params& P, Frame& F) {
    const bf16_t* Z = (const bf16_t*)(P.ws + WS_Z); bf16_t* QK = (bf16_t*)(P.ws + WS_QK); const float* GATE = (const float*)(P.ws + WS_GATE);
    const bf16_t* WqkT = (const bf16_t*)(P.ws + WS_WQK);
    float* BC = (float*)(P.ws + WS_BC); float* IG = (float*)(P.ws + WS_IG); float* BT = (float*)(P.ws + WS_BT); float* U = (float*)(P.ws + WS_U); float* NV = (float*)(P.ws + WS_NV);
    const float* bi = P.in[9]; const float* bf = P.in[10]; const float* cw = P.in[5]; const float* cb = P.in[6];
    constexpr int PIT = 272;
    LAS unsigned char* KIM = F.lds; LAS unsigned char* VIM = F.lds + 128 * PIT; LAS unsigned char* XIM = F.lds + 2 * 128 * PIT;
    LAS float* bc = (LAS float*)(F.lds + 3 * 128 * PIT); LAS float* wv = bc + 256;
    const int tid = F.tid;
    const int lane = tid & 63, i = lane & 15, g = lane >> 4, w = F.wave;
    bf16x8 ones;
#pragma unroll
    for (int j = 0; j < 8; ++j) ones[j] = (i == 0) ? (short)0x3F80 : (short)0;
    for (int unit = F.vcu; unit < 256; unit += F.G) {
        const int bh = unit / NCH, c = unit % NCH, b = bh / NHM, h = bh % NHM, t0 = b * SEQ + c * CH;
        float ig = 0.f;
        __syncthreads();
        if (tid < 256) { const float f = GATE[(size_t)(t0 + tid) * 8 + 4 + h] + bf[h];
            bc[tid] = fminf(f, 0.f) - log1pf(__expf(-fabsf(f)));
            ig = GATE[(size_t)(t0 + tid) * 8 + h] + bi[h]; }
        __syncthreads();
        if (w == 0) {
            const f32x4 a = *(const LAS f32x4*)(bc + 4 * lane);
            const float s1 = a[0], s2 = s1 + a[1], s3 = s2 + a[2], s4 = s3 + a[3];
            float x = s4;
#pragma unroll
            for (int off = 1; off < 64; off <<= 1) { const float v = __shfl_up(x, off); if (lane >= off) x += v; }
            const float ex = x - s4;
            *(LAS f32x4*)(bc + 4 * lane) = (f32x4){ex + s1, ex + s2, ex + s3, ex + s4};
        }
        __syncthreads();
        if (tid < 256) { BC[(size_t)(t0 + tid) * 4 + h] = bc[tid]; IG[(size_t)(t0 + tid) * 4 + h] = ig; wv[tid] = __expf(bc[255] - bc[tid] + ig); }
        if (tid == 0) BT[unit] = bc[255];
        bf16x8 wf[2][4];
#pragma unroll
        for (int e2 = 0; e2 < 2; ++e2) { const bf16_t* wp = WqkT + (size_t)((w >> 2) * 512 + h * 128 + 32 * (w & 3) + 16 * e2 + i) * 512 + h * 128 + 8 * g;
#pragma unroll
            for (int ks = 0; ks < 4; ++ks) wf[e2][ks] = *(const bf16x8*)(wp + 32 * ks); }
        f32x4 acc[9];
#pragma unroll
        for (int q = 0; q < 9; ++q) acc[q] = (f32x4){0.f, 0.f, 0.f, 0.f};
        for (int half = 0; half < 2; ++half) {
            __syncthreads();
#pragma unroll
            for (int q = 0; q < 4; ++q) { const int id = tid + 512 * q, row = id >> 4, c8 = (id & 15) * 8, sidx = half * 128 + row, tok = t0 + sidx, tl = c * CH + sidx;
                const int ch = h * 128 + c8;
                float a[8];
                { const f32x4 b0 = *(const f32x4*)(cb + ch), b1 = *(const f32x4*)(cb + ch + 4); a[0] = b0[0]; a[1] = b0[1]; a[2] = b0[2]; a[3] = b0[3]; a[4] = b1[0]; a[5] = b1[1]; a[6] = b1[2]; a[7] = b1[3]; }
#pragma unroll
                for (int j = 0; j < 4; ++j) { const int dt = 3 - j; if (tl - dt >= 0) {
                        const u32x4 xw = *(const u32x4*)(Z + (size_t)(tok - dt) * NZ + ZXM + ch);
                        const f32x4 w0 = *(const f32x4*)(cw + j * 512 + ch), w1 = *(const f32x4*)(cw + j * 512 + ch + 4);
                        a[0] += w0[0] * bflo(xw.x); a[1] += w0[1] * bfhi(xw.x); a[2] += w0[2] * bflo(xw.y); a[3] += w0[3] * bfhi(xw.y);
                        a[4] += w1[0] * bflo(xw.z); a[5] += w1[1] * bfhi(xw.z); a[6] += w1[2] * bflo(xw.w); a[7] += w1[3] * bfhi(xw.w); } }
#pragma unroll
                for (int j = 0; j < 8; ++j) a[j] = a[j] * sigmoidf_(a[j]);
                u32x4 o; o.x = pk2(a[0], a[1]); o.y = pk2(a[2], a[3]); o.z = pk2(a[4], a[5]); o.w = pk2(a[6], a[7]);
                *(LAS u32x4*)(XIM + row * PIT + c8 * 2) = o;
                *(LAS u32x4*)(VIM + row * PIT + c8 * 2) = *(const u32x4*)(Z + (size_t)tok * NZ + ZVM + ch); }
            __syncthreads();
#pragma unroll 2
            for (int tt = 0; tt < 8; ++tt) {
                bf16x8 xf[4];
#pragma unroll
                for (int ks = 0; ks < 4; ++ks) xf[ks] = *(const LAS bf16x8*)(XIM + (16 * tt + i) * PIT + (32 * ks + 8 * g) * 2);
                const int trow = 16 * tt + i, sidx = half * 128 + trow; const float ws_ = wv[sidx];
                bf16_t* qkrow = QK + (size_t)(t0 + sidx) * 1024 + (w >> 2) * 512 + h * 128 + 32 * (w & 3) + 4 * g;
#pragma unroll
                for (int e2 = 0; e2 < 2; ++e2) {
                    f32x4 d = (f32x4){0.f, 0.f, 0.f, 0.f};
#pragma unroll
                    for (int ks = 0; ks < 4; ++ks) d = MFMA16(wf[e2][ks], xf[ks], d);
                    u32x2 o; o.x = pk2(d[0], d[1]); o.y = pk2(d[2], d[3]);
                    *(u32x2*)(qkrow + 16 * e2) = o;
                    if (w >= 4) { u32x2 ok; ok.x = pk2(d[0] * ws_, d[1] * ws_); ok.y = pk2(d[2] * ws_, d[3] * ws_); *(LAS u32x2*)(KIM + trow * PIT + (32 * (w & 3) + 16 * e2 + 4 * g) * 2) = ok; }
                }
            }
            __syncthreads();
#pragma unroll
            for (int kk = 0; kk < 4; ++kk) {
                const int ro = (32 * kk + 8 * g + (i >> 2)) * PIT + (i & 3) * 8;
                const bf16x8 af = tr2(KIM + ro + 32 * w, KIM + ro + 4 * PIT + 32 * w);
#pragma unroll
                for (int et = 0; et < 8; ++et) { const bf16x8 bfr = tr2(VIM + ro + 32 * et, VIM + ro + 4 * PIT + 32 * et); acc[et] = MFMA16(af, bfr, acc[et]); }
                acc[8] = MFMA16(af, ones, acc[8]);
            }
        }
        float* up = U + (size_t)unit * 16384 + (size_t)(16 * w + 4 * g) * 128 + i;
#pragma unroll
        for (int et = 0; et < 8; ++et)
#pragma unroll
            for (int j = 0; j < 4; ++j) up[j * 128 + 16 * et] = acc[et][j];
        if (i == 0) {
#pragma unroll
            for (int j = 0; j < 4; ++j) NV[unit * 128 + 16 * w + 4 * g + j] = acc[8][j];
        }
    }
}

__device__ __forceinline__ void ml3_phase(const Params& P, Frame& F) {
    const bf16_t* Z = (const bf16_t*)(P.ws + WS_Z); const bf16_t* QK = (const bf16_t*)(P.ws + WS_QK);
    const float* BC = (const float*)(P.ws + WS_BC); const float* IG = (const float*)(P.ws + WS_IG); const float* BT = (const float*)(P.ws + WS_BT);
    const float* U = (const float*)(P.ws + WS_U); const float* NV = (const float*)(P.ws + WS_NV); const float* gn = P.in[11];
    bf16_t* MIX = (bf16_t*)(P.ws + WS_MIX);
    constexpr int CP = 288, VP = 272;
    LAS unsigned char* CIM = F.lds;
    LAS unsigned char* VIM = F.lds + 128 * CP;
    LAS float* cs = (LAS float*)(F.lds + 128 * CP + 256 * VP);
    LAS float* bq = cs + 256;
    const int tid = F.tid;
    const int lane = tid & 63, i = lane & 15, g = lane >> 4, w = F.wave;
    for (int unit = F.vcu; unit < 256; unit += F.G) {
        const int bh = unit / NCH, c = unit % NCH, b = bh / NHM, h = bh % NHM, t0 = b * SEQ + c * CH;
        __syncthreads();
#pragma unroll
        for (int q = 0; q < 8; ++q) { const int id = tid + 512 * q, row = id >> 4, c8 = (id & 15) * 8;
            *(LAS u32x4*)(VIM + row * VP + c8 * 2) = *(const u32x4*)(Z + (size_t)(t0 + row) * NZ + ZVM + h * 128 + c8); }
        if (tid < 256) { const float bb = BC[(size_t)(t0 + tid) * 4 + h]; bq[tid] = bb; cs[tid] = IG[(size_t)(t0 + tid) * 4 + h] - bb; }
        {   f32x4 cc[4][2]; float n = 0.f;
#pragma unroll
            for (int q = 0; q < 4; ++q) { cc[q][0] = (f32x4){0.f, 0.f, 0.f, 0.f}; cc[q][1] = (f32x4){0.f, 0.f, 0.f, 0.f}; }
            for (int j = 0; j < c; ++j) {
                const float dec = __expf(BT[bh * NCH + j]);
                const float* up = U + (size_t)(bh * NCH + j) * 16384;
#pragma unroll
                for (int q = 0; q < 4; ++q) { const int id = tid + 512 * q; const f32x4 u0 = *(const f32x4*)(up + id * 8), u1 = *(const f32x4*)(up + id * 8 + 4);
                    cc[q][0] = cc[q][0] * dec + u0; cc[q][1] = cc[q][1] * dec + u1; }
                if (tid < 128) n = dec * n + NV[(bh * NCH + j) * 128 + tid];
            }
#pragma unroll
            for (int q = 0; q < 4; ++q) { const int id = tid + 512 * q, d = id >> 4, e8 = (id & 15) * 8;
                u32x4 o; o.x = pk2(cc[q][0][0], cc[q][0][1]); o.y = pk2(cc[q][0][2], cc[q][0][3]); o.z = pk2(cc[q][1][0], cc[q][1][1]); o.w = pk2(cc[q][1][2], cc[q][1][3]);
                *(LAS u32x4*)(CIM + d * CP + e8 * 2) = o; }
            if (tid < 128) { *(LAS u32x4*)(CIM + tid * CP + 256) = (u32x4){f2bf(n), 0u, 0u, 0u}; *(LAS u32x4*)(CIM + tid * CP + 272) = (u32x4){0u, 0u, 0u, 0u}; }
        }
        __syncthreads();
#pragma unroll 1
        for (int a = 0; a < 2; ++a) {
            const int qt = a ? 15 - w : w;
            bf16x8 qf[4];
            { const bf16_t* qp = QK + (size_t)(t0 + 16 * qt + i) * 1024 + h * 128 + 8 * g;
#pragma unroll
                for (int ks = 0; ks < 4; ++ks) qf[ks] = *(const bf16x8*)(qp + 32 * ks); }
            const float bt = bq[16 * qt + i];
            f32x4 acc[8]; float den;
            {
                f32x4 a8 = (f32x4){0.f, 0.f, 0.f, 0.f};
#pragma unroll
                for (int et = 0; et < 8; ++et) acc[et] = (f32x4){0.f, 0.f, 0.f, 0.f};
#pragma unroll
                for (int ks = 0; ks < 4; ++ks) {
                    const int ro = (32 * ks + 8 * g + (i >> 2)) * CP + (i & 3) * 8;
#pragma unroll
                    for (int et = 0; et < 8; ++et) { const bf16x8 cf = tr2(CIM + ro + 32 * et, CIM + ro + 4 * CP + 32 * et); acc[et] = MFMA16(cf, qf[ks], acc[et]); }
                    const bf16x8 cf = tr2(CIM + ro + 256, CIM + ro + 4 * CP + 256);
                    a8 = MFMA16(cf, qf[ks], a8);
                }
                const float eb = __expf(bt);
#pragma unroll
                for (int et = 0; et < 8; ++et) acc[et] = acc[et] * eb;
                den = (g == 0) ? a8[0] * eb : 0.f;
            }
            const int kbhi = qt >> 1;
#pragma unroll 1
            for (int kb = 0; kb <= kbhi; ++kb) {
                float p[8];
#pragma unroll
                for (int sb = 0; sb < 2; ++sb) {
                    const bf16_t* kp = QK + (size_t)(t0 + 32 * kb + 16 * sb + i) * 1024 + 512 + h * 128 + 8 * g;
                    f32x4 sacc = (f32x4){0.f, 0.f, 0.f, 0.f};
#pragma unroll
                    for (int ks = 0; ks < 4; ++ks) { const bf16x8 kf = *(const bf16x8*)(kp + 32 * ks); sacc = MFMA16(kf, qf[ks], sacc); }
                    const f32x4 cv = *(const LAS f32x4*)(cs + 32 * kb + 16 * sb + 4 * g);
#pragma unroll
                    for (int j = 0; j < 4; ++j) { const int srow = 32 * kb + 16 * sb + 4 * g + j, tcol = 16 * qt + i;
                        const float pv = (srow <= tcol) ? sacc[j] * __expf(bt + cv[j]) : 0.f;
                        p[4 * sb + j] = pv; den += pv; } }
                u32x4 pw; pw.x = pk2(p[0], p[1]); pw.y = pk2(p[2], p[3]); pw.z = pk2(p[4], p[5]); pw.w = pk2(p[6], p[7]);
                const bf16x8 pf = __builtin_bit_cast(bf16x8, pw);
                const int ro = (32 * kb + 4 * g + (i >> 2)) * VP + (i & 3) * 8;
#pragma unroll
                for (int et = 0; et < 8; ++et) { const bf16x8 vf = tr2(VIM + ro + 32 * et, VIM + ro + 16 * VP + 32 * et); acc[et] = MFMA16(vf, pf, acc[et]); }
            }
            float dn = den; dn += __shfl_xor(dn, 16); dn += __shfl_xor(dn, 32);
            const float dd = 1.0f / fmaxf(fabsf(dn), 1.0f);
            float ss = 0.f;
#pragma unroll
            for (int et = 0; et < 8; ++et) { acc[et] = acc[et] * dd; ss += acc[et][0] * acc[et][0] + acc[et][1] * acc[et][1] + acc[et][2] * acc[et][2] + acc[et][3] * acc[et][3]; }
            ss += __shfl_xor(ss, 16); ss += __shfl_xor(ss, 32);
            const float rstd = 1.0f / sqrtf(ss * (1.0f / HDM) + EPS);
            const int tok = t0 + 16 * qt + i;
#pragma unroll
            for (int et = 0; et < 8; ++et) { const int e0 = 16 * et + 4 * g;
                const u32x2 ow = *(const u32x2*)(Z + (size_t)tok * NZ + ZOM + h * 128 + e0);
                const f32x4 gv = *(const f32x4*)(gn + h * 128 + e0);
                const float r0 = sigmoidf_(bflo(ow.x)) * acc[et][0] * rstd * gv[0], r1 = sigmoidf_(bfhi(ow.x)) * acc[et][1] * rstd * gv[1];
                const float r2 = sigmoidf_(bflo(ow.y)) * acc[et][2] * rstd * gv[2], r3 = sigmoidf_(bfhi(ow.y)) * acc[et][3] * rstd * gv[3];
                u32x2 o; o.x = pk2(r0, r1); o.y = pk2(r2, r3);
                *(u32x2*)(MIX + (size_t)tok * DM + 512 + h * 128 + e0) = o; }
        }
    }
}

__device__ __forceinline__ void router_phase(const Params& P, Frame& F, const bool commit) {
    const float* X1 = P.out; const float* g2 = P.in[13]; const float* wrt = (const float*)(P.ws + WS_WRT); const float* br = P.in[15];
    unsigned char* H8 = P.ws + WS_H8; int* cnt = (int*)(P.ws + WS_CTL); int* ltok = (int*)(P.ws + WS_LTOK); float* lgate = (float*)(P.ws + WS_LGATE); int* tke = (int*)(P.ws + WS_TKE);
    LAS int* lcnt = (LAS int*)(F.lds);
    LAS int* pe = lcnt + 64;
    LAS float* pg = (LAS float*)(pe + 256);
    const int lane = F.lane, tid = F.tid;
    for (int chunk = F.vcu; chunk < T / 64; chunk += F.G) {
        __syncthreads();
        if (tid < 64) lcnt[tid] = 0;
        __syncthreads();
#pragma unroll 1
        for (int hp = 0; hp < 2; ++hp) {
            f32x4 v[4][4];
#pragma unroll
            for (int tt = 0; tt < 4; ++tt) {
                const int tok = chunk * 64 + F.wave * 8 + hp * 4 + tt;
                const f32x4* xr = (const f32x4*)(X1 + (size_t)tok * DM);
                float s = 0.f;
#pragma unroll
                for (int j = 0; j < 4; ++j) { v[tt][j] = xr[lane + 64 * j]; s += v[tt][j][0] * v[tt][j][0] + v[tt][j][1] * v[tt][j][1] + v[tt][j][2] * v[tt][j][2] + v[tt][j][3] * v[tt][j][3]; }
                s = wave_sum(s);
                const float r = 1.0f / sqrtf(s * (1.0f / DM) + EPS);
#pragma unroll
                for (int j = 0; j < 4; ++j) { const f32x4 gg = ((const f32x4*)g2)[lane + 64 * j]; v[tt][j] = v[tt][j] * r * gg;
                    *(unsigned*)(H8 + (size_t)tok * DM + 4 * (lane + 64 * j)) = pk4_fp8(v[tt][j][0] * SC_H, v[tt][j][1] * SC_H, v[tt][j][2] * SC_H, v[tt][j][3] * SC_H); }
            }
            const bool b0 = lane & 1, b1 = lane & 2;
            float tv0 = -INFINITY, tv1 = -INFINITY, tv2 = -INFINITY, tv3 = -INFINITY; int te0 = 0, te1 = 0, te2 = 0, te3 = 0;
#pragma unroll 2
            for (int e = 0; e < NE; ++e) {
                const f32x4* wrow = (const f32x4*)(wrt + (size_t)e * DM);
                f32x4 w4[4];
#pragma unroll
                for (int j = 0; j < 4; ++j) w4[j] = wrow[lane + 64 * j];
                float a[4];
#pragma unroll
                for (int tt = 0; tt < 4; ++tt) { float pa = 0.f;
#pragma unroll
                    for (int j = 0; j < 4; ++j) pa += v[tt][j][0] * w4[j][0] + v[tt][j][1] * w4[j][1] + v[tt][j][2] * w4[j][2] + v[tt][j][3] * w4[j][3];
                    a[tt] = pa; }
                float m0 = b0 ? a[2] : a[0], m1 = b0 ? a[3] : a[1];
                m0 += __shfl_xor(b0 ? a[0] : a[2], 1); m1 += __shfl_xor(b0 ? a[1] : a[3], 1);
                float d = b1 ? m1 : m0;
                d += __shfl_xor(b1 ? m0 : m1, 2);
                d += __shfl_xor(d, 4); d += __shfl_xor(d, 8); d += __shfl_xor(d, 16); d += __shfl_xor(d, 32);
                const float x = d + br[e];
                const bool g0 = x > tv0, g1 = x > tv1, g2_ = x > tv2, g3 = x > tv3;
                tv3 = g2_ ? tv2 : (g3 ? x : tv3); te3 = g2_ ? te2 : (g3 ? e : te3);
                tv2 = g1 ? tv1 : (g2_ ? x : tv2); te2 = g1 ? te1 : (g2_ ? e : te2);
                tv1 = g0 ? tv0 : (g1 ? x : tv1); te1 = g0 ? te0 : (g1 ? e : te1);
                tv0 = g0 ? x : tv0; te0 = g0 ? e : te0;
            }
            const float e1 = __expf(tv1 - tv0), e2 = __expf(tv2 - tv0), e3 = __expf(tv3 - tv0);
            const float inv = 1.0f / (1.0f + e1 + e2 + e3);
            if (lane < 4) {
                const int tl = F.wave * 8 + hp * 4 + (b0 ? 2 : 0) + (b1 ? 1 : 0);
                const int rk0 = __hip_atomic_fetch_add((int*)(lcnt + te0), 1, __ATOMIC_RELAXED, __HIP_MEMORY_SCOPE_WORKGROUP);
                const int rk1 = __hip_atomic_fetch_add((int*)(lcnt + te1), 1, __ATOMIC_RELAXED, __HIP_MEMORY_SCOPE_WORKGROUP);
                const int rk2 = __hip_atomic_fetch_add((int*)(lcnt + te2), 1, __ATOMIC_RELAXED, __HIP_MEMORY_SCOPE_WORKGROUP);
                const int rk3 = __hip_atomic_fetch_add((int*)(lcnt + te3), 1, __ATOMIC_RELAXED, __HIP_MEMORY_SCOPE_WORKGROUP);
                pe[tl * 4 + 0] = te0 | (rk0 << 8); pe[tl * 4 + 1] = te1 | (rk1 << 8); pe[tl * 4 + 2] = te2 | (rk2 << 8); pe[tl * 4 + 3] = te3 | (rk3 << 8);
                pg[tl * 4 + 0] = inv; pg[tl * 4 + 1] = e1 * inv; pg[tl * 4 + 2] = e2 * inv; pg[tl * 4 + 3] = e3 * inv;
            }
        }
        __syncthreads();
        if (tid < NE && commit) { const int n = lcnt[tid]; lcnt[32 + tid] = n ? atomicAdd(&cnt[64 * tid], n) : 0; }
        __syncthreads();
        if (tid < 256 && commit) { const int w = pe[tid], ee = w & 255, p = lcnt[32 + ee] + (w >> 8), tok = chunk * 64 + (tid >> 2);
            ltok[ee * T + p] = tok; lgate[ee * T + p] = pg[tid]; tke[tok * 4 + (tid & 3)] = ee | (p << 8); }
    }
}

__device__ __forceinline__ void build_tables(const Params& P, Frame& F) {
    LAS int* trs = (LAS int*)(F.lds + LDS_TAB); LAS int* cnts = trs + 64;
    const int* cnt = (const int*)(P.ws + WS_CTL);
    if (F.tid == 0) { int a = 0; for (int e = 0; e < NE; ++e) { const int n = cnt[64 * e]; trs[e] = a; cnts[e] = n; a += (n + 255) >> 8; } trs[NE] = a; }
    __syncthreads();
}

__device__ __forceinline__ void combine_phase(const Params& P, Frame& F, const bool commit) {
    const LAS int* trs = (const LAS int*)(F.lds + LDS_TAB);
    const bf16_t* Y = (const bf16_t*)(P.ws + WS_Y); const int* tke = (const int*)(P.ws + WS_TKE);
    float* out = P.out; const int lane = F.lane;
    for (int tok = F.gw; tok < T; tok += F.ngw) {
        f32x4 a[4];
#pragma unroll
        for (int j = 0; j < 4; ++j) a[j] = *(const f32x4*)(out + (size_t)tok * DM + 4 * (lane + 64 * j));
#pragma unroll
        for (int k = 0; k < 4; ++k) { const int w = tke[tok * 4 + k], e = w & 255, p = w >> 8; const size_t slot = (size_t)trs[e] * 256 + p;
#pragma unroll
            for (int j = 0; j < 4; ++j) { const u32x2 y = *(const u32x2*)(Y + slot * DM + 4 * (lane + 64 * j)); a[j][0] += bflo(y.x); a[j][1] += bfhi(y.x); a[j][2] += bflo(y.y); a[j][3] += bfhi(y.y); } }
#pragma unroll
        for (int j = 0; j < 4; ++j) if (commit || a[j][0] == 123456.789f) *(f32x4*)(out + (size_t)tok * DM + 4 * (lane + 64 * j)) = a[j];
    }
}


#define XB_TMO      128
#define XB_XCNT(j)  (256  + 64 * (j))
#define XB_XSUB(j)  (1280 + 64 * (j))
#define XB_XGEN(j)  (2304 + 64 * (j))
#define XB_TOP      3328
#define XB_TOPGEN   3392
#define XCD_BAR_WORDS 3456
#define XB_SPIN_CAP (1u << 18)
__device__ __forceinline__ unsigned xb_ld(unsigned* p)              { return __hip_atomic_load(p, __ATOMIC_RELAXED, __HIP_MEMORY_SCOPE_AGENT); }
__device__ __forceinline__ unsigned xb_add(unsigned* p, unsigned v) { return __hip_atomic_fetch_add(p, v, __ATOMIC_RELAXED, __HIP_MEMORY_SCOPE_AGENT); }
__device__ __forceinline__ unsigned xb_xcc_id() { return (unsigned)__builtin_amdgcn_s_getreg((3 << 11) | 20) & 0xFu; }
#define XB_SPIN(cond, bar) do { unsigned _sp = 0; while (cond) { __builtin_amdgcn_s_sleep(1); \
    if ((++_sp & 255u) == 0u) { if (xb_ld(&(bar)[XB_TMO])) break; if (_sp > XB_SPIN_CAP) { atomicAdd(&(bar)[XB_TMO], 1u); break; } } } } while (0)
struct XcdBarrier { unsigned* bar; unsigned x; volatile LAS unsigned* st; };
__device__ __forceinline__ XcdBarrier xcd_barrier_post(unsigned* bar, volatile LAS unsigned* st) {
    XcdBarrier b; b.bar = bar; b.x = xb_xcc_id(); b.st = st;
    if (threadIdx.x == 0) (void)xb_add(&bar[XB_XCNT(b.x)], 1u);
    return b;
}
__device__ __forceinline__ void xcd_barrier_complete(unsigned* bar, unsigned x, unsigned& nloc, unsigned& nx) {
    const unsigned G = gridDim.x * gridDim.y * gridDim.z;
    unsigned sum, cnt, mine, sp = 0u;
    for (;;) {
        sum = 0u; cnt = 0u; mine = 0u;
#pragma unroll
        for (unsigned j = 0; j < 16; ++j) { const unsigned c = xb_ld(&bar[XB_XCNT(j)]); sum += c; cnt += (c > 0u) ? 1u : 0u; mine = (j == x) ? c : mine; }
        if (sum == G) break;
        __builtin_amdgcn_s_sleep(1);
        if ((++sp & 255u) == 0u) { if (xb_ld(&bar[XB_TMO])) break; if (sp > XB_SPIN_CAP) { atomicAdd(&bar[XB_TMO], 1u); break; } }
    }
    nloc = mine > 0u ? mine : 1u; nx = cnt > 0u ? cnt : 1u;
}
__device__ __forceinline__ void xcd_barrier(const XcdBarrier& b) {
    asm volatile("s_waitcnt vmcnt(0)" ::: "memory");
    __syncthreads();
    if (threadIdx.x == 0) {
        unsigned* bar = b.bar;
        __builtin_amdgcn_s_waitcnt(0);
        unsigned nloc = b.st[0], nx = b.st[1];
        if (nloc == 0u) { xcd_barrier_complete(bar, b.x, nloc, nx); b.st[0] = nloc; b.st[1] = nx; }
        const unsigned old = xb_add(&bar[XB_XSUB(b.x)], 1u);
        const unsigned gen = old / nloc;
        if (old + 1u == (gen + 1u) * nloc) {
            __builtin_amdgcn_fence(__ATOMIC_RELEASE, "agent");
            asm volatile("s_waitcnt vmcnt(0)" ::: "memory");
            const unsigned og = xb_add(&bar[XB_TOP], 1u);
            const unsigned tg = og / nx;
            if (og + 1u == (tg + 1u) * nx) xb_add(&bar[XB_TOPGEN], 1u);
            else XB_SPIN(xb_ld(&bar[XB_TOPGEN]) == tg, bar);
            __builtin_amdgcn_fence(__ATOMIC_ACQUIRE, "agent");
            xb_add(&bar[XB_XGEN(b.x)], 1u);
            asm volatile("s_waitcnt vmcnt(0)" ::: "memory");
        } else {
            XB_SPIN(xb_ld(&bar[XB_XGEN(b.x)]) == gen, bar);
            __builtin_amdgcn_fence(__ATOMIC_ACQUIRE, "agent");
            asm volatile("s_waitcnt vmcnt(0)" ::: "memory");
        }
    }
    __syncthreads();
}

__global__ void __launch_bounds__(NTHR) fwd_megakernel(Params P) {
    extern __shared__ __attribute__((aligned(16))) unsigned char lds_raw[];
    Frame F;
    F.lds = (LAS unsigned char*)lds_raw;
    F.tid = threadIdx.x; F.lane = F.tid & 63; F.wave = __builtin_amdgcn_readfirstlane(F.tid >> 6);
    F.G = gridDim.x; { const int bx = blockIdx.x; F.vcu = (F.G % 8 == 0) ? (bx % 8) * (F.G / 8) + bx / 8 : bx; }
    F.gw = F.vcu * NWAVES + F.wave; F.ngw = F.G * NWAVES;
    unsigned char* ws = P.ws;
    LAS unsigned char* stage = F.lds + LDS_STAGE;
    volatile LAS unsigned* bst = (volatile LAS unsigned*)(F.lds + LDS_TAB + 512);
    if (F.tid < 2) bst[F.tid] = 0u;
    __syncthreads();
    const XcdBarrier bar = xcd_barrier_post((unsigned*)(ws + WS_CTL) + 4096, bst);
    LAS unsigned long long* tstamp = (LAS unsigned long long*)(F.lds + LDS_TAB + 640); int nstamp = 0;
    if (TPROBE >= 0 && blockIdx.x == 0 && F.tid == 0) tstamp[nstamp] = __builtin_amdgcn_s_memrealtime();
    ++nstamp;
#define GRID_SYNC() do { xcd_barrier(bar); if (TPROBE >= 0 && blockIdx.x == 0 && F.tid == 0) tstamp[nstamp] = __builtin_amdgcn_s_memrealtime(); ++nstamp; } while (0)

    p0_prologue(P, F);
    if (DUP & 1) p0_prologue(P, F);
    GRID_SYNC();
    {
        pg8::DenseSched S{T / 256, NZ / 256, F.G, (int)blockIdx.x, DM, (const char*)(ws + WS_WIN), (DUP & 2) ? 2 : 1};
        pg8::EpiQKNorm E{(bf16_t*)(ws + WS_Z), P.in[3], P.in[4]};
        pg8::gemm_phase<false>(stage, (const char*)(ws + WS_XN), DM, S, E);
    }
    GRID_SYNC();
    if (DUP & 4096) { for (int q = 0; q < 10; ++q) GRID_SYNC(); }
    attn_phase(P, F);
    if (DUP & 8) attn_phase(P, F);
    ml1_phase(P, F);
    if (DUP & 16) ml1_phase(P, F);
    GRID_SYNC();
    ml3_phase(P, F);
    if (DUP & 32) ml3_phase(P, F);
    GRID_SYNC();
    {
        pg8::DenseSched S{T / 256, DM / 256, F.G, (int)blockIdx.x, DM, (const char*)(ws + WS_WOUT), (DUP & 64) ? 2 : 1};
        pg8::EpiResF32 E{P.out, P.in[0], DM};
        pg8::gemm_phase<false>(stage, (const char*)(ws + WS_MIX), DM, S, E);
    }
    GRID_SYNC();
    if (DUP & 512) router_phase(P, F, false);
    router_phase(P, F, true);
    GRID_SYNC();
    build_tables(P, F);
    const LAS int* trs = (const LAS int*)(F.lds + LDS_TAB); const LAS int* cnts = trs + 64;
    {
        pg8::MoeSched<true> S{trs, cnts, 8, F.G, (int)blockIdx.x, DM / 2, (const char*)(ws + WS_WGU), (size_t)2 * DFF * DM, (const int*)(ws + WS_LTOK)};
        pg8::EpiSwiglu E{(unsigned char*)(ws + WS_ACT), P.in[17]};
        pg8::gemm_phase<true>(stage, (const char*)(ws + WS_H8), DM / 2, S, E);
    }
    GRID_SYNC();
    {
        pg8::MoeSched<false> S{trs, cnts, 4, F.G, (int)blockIdx.x, DFF / 2, (const char*)(ws + WS_WD), (size_t)DM * DFF, nullptr};
        pg8::EpiDown E{(bf16_t*)(ws + WS_Y), P.in[19], (const float*)(ws + WS_LGATE), cnts};
        pg8::gemm_phase<true>(stage, (const char*)(ws + WS_ACT), DFF / 2, S, E);
    }
    GRID_SYNC();
    if (DUP & 1024) combine_phase(P, F, false);
    combine_phase(P, F, true);
    if (TPROBE >= 0 && blockIdx.x == 0 && F.tid == 0) {
        tstamp[nstamp] = __builtin_amdgcn_s_memrealtime();
        const unsigned long long span = tstamp[TPROBE + 1] - tstamp[TPROBE], t0_ = __builtin_amdgcn_s_memrealtime();
        while (__builtin_amdgcn_s_memrealtime() - t0_ < 4ull * span) __builtin_amdgcn_s_sleep(8);
    }
}
}

extern "C" void kernel_launch(void* const* d_in, const int* in_sizes, int n_in, void* d_out, int out_size, void* d_ws, size_t ws_size, hipStream_t stream) {
    static int grid = 0;
    if (grid == 0) {
        if (n_in != 20 || out_size != T * DM || ws_size < WS_END) { fprintf(stderr, "kernel_launch: unexpected problem (n_in %d out %d ws %zu)\n", n_in, out_size, ws_size); grid = -1; return; }
        int dev = 0, cus = 0, per_cu = 0;
        (void)hipGetDevice(&dev);
        (void)hipDeviceGetAttribute(&cus, hipDeviceAttributeMultiprocessorCount, dev);
        (void)hipFuncSetAttribute((const void*)fwd_megakernel, hipFuncAttributeMaxDynamicSharedMemorySize, LDS_BYTES);
        (void)hipOccupancyMaxActiveBlocksPerMultiprocessor(&per_cu, (const void*)fwd_megakernel, NTHR, LDS_BYTES);
        if (per_cu < 1) { fprintf(stderr, "kernel_launch: occupancy query says %d blocks per CU\n", per_cu); per_cu = 1; }
        grid = cus;
    }
    if (grid < 0) return;
    (void)hipMemsetAsync((char*)d_ws + WS_CTL, 0, 65536, stream);
    Params p{};
    for (int i = 0; i < 20; ++i) p.in[i] = (const float*)d_in[i];
    p.out = (float*)d_out; p.ws = (unsigned char*)d_ws;
    hipLaunchKernelGGL(fwd_megakernel, dim3(grid), dim3(NTHR), LDS_BYTES, stream, p);
    const hipError_t e = hipPeekAtLastError();
    if (e != hipSuccess) fprintf(stderr, "launch failed: %s (grid %d)\n", hipGetErrorString(e), grid);
}
```

```cpp
#include <hip/hip_runtime.h>
#include <cstdio>
#include <cstdint>

#define LAS __attribute__((address_space(3)))
typedef unsigned short bf16_t;
typedef short bf16x8 __attribute__((ext_vector_type(8)));
typedef short s16x4 __attribute__((ext_vector_type(4)));
typedef float f32x4 __attribute__((ext_vector_type(4)));
typedef unsigned u32x4 __attribute__((ext_vector_type(4)));
typedef unsigned u32x2 __attribute__((ext_vector_type(2)));
typedef int i32x4 __attribute__((ext_vector_type(4)));
typedef int i32x8 __attribute__((ext_vector_type(8)));

namespace {
constexpr int BATCH = 2, SEQ = 8192, T = BATCH * SEQ, DM = 1024, DIN = 3080, NZ = 3072;
constexpr int NHA = 8, NHM = 4, HDM = 128;
constexpr int NE = 32, DFF = 1024;
constexpr int CH = 256, NCH = SEQ / CH;
constexpr float EPS = 1e-6f;
constexpr float LOG2E = 1.4426950408889634f;
constexpr float SC_W = 32.f, SC_H = 8.f, SC_A = 4.f;
constexpr int ZQ = 0, ZK = 512, ZV = 1024, ZXM = 1536, ZVM = 2048, ZOM = 2560;
constexpr int NWAVES = 8, NTHR = 512;
constexpr int MAXTR = 288;
constexpr int TPROBE = -1;
constexpr int DUP = 0;
constexpr size_t MiB = 1u << 20;
constexpr size_t WS_CTL = 0;
constexpr size_t WS_WIN = 1 * MiB;
constexpr size_t WS_WOUT = 7 * MiB;
constexpr size_t WS_WQK = 9 * MiB;
constexpr size_t WS_WGU = 16 * MiB;
constexpr size_t WS_WD = 144 * MiB;
constexpr size_t WS_XN = 208 * MiB;
constexpr size_t WS_Z = 240 * MiB;
constexpr size_t WS_GATE = 336 * MiB;
constexpr size_t WS_XC = 337 * MiB;
constexpr size_t WS_QK = 353 * MiB;
constexpr size_t WS_BC = 385 * MiB;
constexpr size_t WS_IG = 385 * MiB + 512 * 1024;
constexpr size_t WS_BT = 386 * MiB;
constexpr size_t WS_NV = 386 * MiB + 4096;
constexpr size_t WS_U = 387 * MiB;
constexpr size_t WS_MIX = 403 * MiB;
constexpr size_t WS_LTOK = 435 * MiB;
constexpr size_t WS_LGATE = 437 * MiB;
constexpr size_t WS_TKE = 439 * MiB;
constexpr size_t WS_WRT = 439 * MiB + 512 * 1024;
constexpr size_t WS_H8 = 728 * MiB;
constexpr size_t WS_CS = 337 * MiB;
constexpr size_t WS_ACT = 440 * MiB;
constexpr size_t WS_Y = 584 * MiB;
constexpr size_t WS_END = 744 * MiB;
constexpr int LDS_STAGE = 0;
constexpr int LDS_TAB = 135168;
constexpr int LDS_BYTES = 135168 + 1024;

__device__ __forceinline__ unsigned f2bf(float f) { unsigned u = __builtin_bit_cast(unsigned, f); return (u + 0x7fffu + ((u >> 16) & 1u)) >> 16; }
__device__ __forceinline__ unsigned pk2(float lo, float hi) { return f2bf(lo) | (f2bf(hi) << 16); }
__device__ __forceinline__ unsigned pk4_fp8(float a, float b, float c, float d) { int w = 0; w = __builtin_amdgcn_cvt_pk_fp8_f32(a, b, w, false); w = __builtin_amdgcn_cvt_pk_fp8_f32(c, d, w, true); return (unsigned)w; }
__device__ __forceinline__ float bf2f(unsigned b) { return __builtin_bit_cast(float, b << 16); }
__device__ __forceinline__ float bflo(unsigned w) { return __builtin_bit_cast(float, w << 16); }
__device__ __forceinline__ float bfhi(unsigned w) { return __builtin_bit_cast(float, w & 0xffff0000u); }
__device__ __forceinline__ float wave_sum(float v) {
#pragma unroll
    for (int o = 1; o < 64; o <<= 1) v += __shfl_xor(v, o);
    return v;
}
__device__ __forceinline__ float sigmoidf_(float x) { return 1.0f / (1.0f + __expf(-x)); }
}

namespace pg8 {
constexpr int BM = 256, BK = 64, HALF = 128, HTB = HALF * BK * 2, STAGE_BYTES = 8 * HTB, NXCD = 8, WGM = 8;
__host__ __device__ __forceinline__ int lds_byte(int r, int c) { const int st = (r >> 4) * 2 + (c >> 5), rr = r & 15, cc = c & 31, ob = rr * 64 + cc * 2; return st * 1024 + (ob ^ (((ob >> 9) & 1) << 5)); }
__host__ __device__ __forceinline__ void stage_rc(int b, int& R, int& C) { const int st = b / 1024, sb = b % 1024, swz = sb ^ (((sb >> 9) & 1) << 5); R = (st >> 1) * 16 + swz / 64; C = (st & 1) * 32 + (swz % 64) / 2; }
__host__ __device__ __forceinline__ int perm32(int rho) { const int n = rho >> 4, i = rho & 15; return 8 * (i >> 2) + 4 * n + (i & 3); }

__device__ __forceinline__ bool tile_order(int i, int G, int c, int nM, int nN, int& pm, int& pn) {
    const int nwg = nM * nN; const long L = (long)i * G + c; if (L >= nwg) return false;
    int wgid = (int)L; { const int q = nwg / NXCD, r = nwg % NXCD, xcd = wgid % NXCD, off = wgid / NXCD; wgid = (xcd < r ? xcd * (q + 1) : r * (q + 1) + (xcd - r) * q) + off; }
    const int nig = WGM * nN, gid = wgid / nig, fm = gid * WGM, gsz = (nM - fm) < WGM ? (nM - fm) : WGM;
    pm = fm + ((wgid % nig) % gsz); pn = (wgid % nig) / gsz; return true;
}

struct Unit { int pm, pn, e, mt; };

struct DenseSched {
    int nM, nN, G, c, K; const char* Bt; int reps;
    static constexpr bool DRAIN = false, AFFINE = true;
    __device__ __forceinline__ bool next(int i, Unit& u) const { u.e = 0; u.mt = 0; const int per = (nM * nN + G - 1) / G; if (i >= per * reps) return false; if (!tile_order(i % per, G, c, nM, nN, u.pm, u.pn)) return tile_order(0, G, c, nM, nN, u.pm, u.pn); return true; }
    __device__ __forceinline__ void a_off(const Unit& u, const int (&R)[2], const int (&C)[2], unsigned (&off)[2][2]) const {
#pragma unroll
        for (int h = 0; h < 2; ++h)
#pragma unroll
            for (int i = 0; i < 2; ++i) off[h][i] = (unsigned)(((u.pm * BM + h * HALF + R[i]) * K + C[i]) * 2);
    }
    __device__ __forceinline__ const char* b_ptr(const Unit& u) const { return Bt + (size_t)u.pn * BM * K * 2; }
};
template <bool GATHER> struct MoeSched {
    const LAS int* trs; const LAS int* cnts; int nN, G, c, K; const char* Bt; size_t bstride; const int* ltok;
    static constexpr bool DRAIN = GATHER, AFFINE = !GATHER;
    __device__ __forceinline__ bool next(int i, Unit& u) const {
        const int nM = __builtin_amdgcn_readfirstlane(trs[NE]);
        if (!tile_order(i, G, c, nM, nN, u.pm, u.pn)) return false;
        const int ln = (int)(threadIdx.x & 63u); const int tv = trs[ln < NE ? ln : NE - 1];
        const int e = __popcll(__ballot(ln >= 1 && ln < NE && tv <= u.pm));
        u.e = e; u.mt = u.pm - __builtin_amdgcn_readfirstlane(trs[e]); return true;
    }
    __device__ __forceinline__ void a_off(const Unit& u, const int (&R)[2], const int (&C)[2], unsigned (&off)[2][2]) const {
        const int n = __builtin_amdgcn_readfirstlane(cnts[u.e]);
#pragma unroll
        for (int h = 0; h < 2; ++h)
#pragma unroll
            for (int i = 0; i < 2; ++i) {
                int row;
                if (GATHER) { const int p = u.mt * BM + h * HALF + R[i]; row = (p < n) ? ltok[u.e * T + p] : 0; }
                else row = u.pm * BM + h * HALF + R[i];
                off[h][i] = (unsigned)((row * K + C[i]) * 2);
            }
    }
    __device__ __forceinline__ const char* b_ptr(const Unit& u) const { return Bt + (size_t)u.e * bstride + (size_t)u.pn * BM * K * 2; }
};

struct EpiBf16 {
    static constexpr bool PERM = true; static constexpr int BMAP = 0;
    bf16_t* O; int ldc;
    __device__ __forceinline__ void operator()(const f32x4 (&acc)[2][2][4][2], const Unit& u, int wr, int wc, int fr, int fq) const {
        const int row0 = u.pm * BM + wr * 64 + fr, col0 = u.pn * BM + wc * 32 + 8 * fq;
#pragma unroll
        for (int ai = 0; ai < 2; ++ai)
#pragma unroll
            for (int m = 0; m < 4; ++m) { bf16_t* rowp = O + (size_t)(row0 + ai * HALF + m * 16) * ldc + col0;
#pragma unroll
                for (int bj = 0; bj < 2; ++bj) { const f32x4 v0 = acc[ai][bj][m][0], v1 = acc[ai][bj][m][1];
                    u32x4 w; w.x = pk2(v0[0], v0[1]); w.y = pk2(v0[2], v0[3]); w.z = pk2(v1[0], v1[1]); w.w = pk2(v1[2], v1[3]);
                    *(u32x4*)(rowp + bj * HALF) = w; } }
    }
};
struct EpiQKNorm {
    static constexpr bool PERM = true; static constexpr int BMAP = 1;
    bf16_t* O; const float* gq; const float* gk;
    __device__ __forceinline__ void operator()(const f32x4 (&acc)[2][2][4][2], const Unit& u, int wr, int wc, int fr, int fq) const {
        const int row0 = u.pm * BM + wr * 64 + fr, col0 = u.pn * BM + wc * 64 + 8 * fq;
        const bool nrm = u.pn < 4; const float* g = (u.pn < 2) ? gq : gk; const float qs = (u.pn < 2) ? 0.125f * LOG2E : 1.0f;
        f32x4 gv[2][2];
#pragma unroll
        for (int bj = 0; bj < 2; ++bj)
#pragma unroll
            for (int n = 0; n < 2; ++n) gv[bj][n] = nrm ? *(const f32x4*)(g + 32 * bj + 8 * fq + 4 * n) : (f32x4){1.f, 1.f, 1.f, 1.f};
#pragma unroll
        for (int ai = 0; ai < 2; ++ai)
#pragma unroll
            for (int m = 0; m < 4; ++m) { bf16_t* rowp = O + (size_t)(row0 + ai * HALF + m * 16) * NZ + col0;
                float sc = 1.0f;
                if (nrm) { float ss = 0.f;
#pragma unroll
                    for (int bj = 0; bj < 2; ++bj)
#pragma unroll
                        for (int n = 0; n < 2; ++n) { const f32x4 v = acc[ai][bj][m][n]; ss += v[0] * v[0] + v[1] * v[1] + v[2] * v[2] + v[3] * v[3]; }
                    ss += __shfl_xor(ss, 16); ss += __shfl_xor(ss, 32);
                    sc = qs / sqrtf(ss * (1.0f / 64.f) + EPS); }
#pragma unroll
                for (int bj = 0; bj < 2; ++bj) { const f32x4 v0 = acc[ai][bj][m][0] * gv[bj][0] * sc, v1 = acc[ai][bj][m][1] * gv[bj][1] * sc;
                    u32x4 w; w.x = pk2(v0[0], v0[1]); w.y = pk2(v0[2], v0[3]); w.z = pk2(v1[0], v1[1]); w.w = pk2(v1[2], v1[3]);
                    *(u32x4*)(rowp + bj * 32) = w; } }
    }
};
struct EpiResF32 {
    static constexpr bool PERM = false; static constexpr int BMAP = 0;
    float* C; const float* Rs; int ldc;
    __device__ __forceinline__ void operator()(const f32x4 (&acc)[2][2][4][2], const Unit& u, int wr, int wc, int fr, int fq) const {
        const int row0 = u.pm * BM + wr * 64 + fr, col0 = u.pn * BM + wc * 32 + 4 * fq;
#pragma unroll
        for (int ai = 0; ai < 2; ++ai)
#pragma unroll
            for (int m = 0; m < 4; ++m) { const size_t ro = (size_t)(row0 + ai * HALF + m * 16) * ldc + col0;
#pragma unroll
                for (int bj = 0; bj < 2; ++bj)
#pragma unroll
                    for (int n = 0; n < 2; ++n) { const f32x4 r = *(const f32x4*)(Rs + ro + bj * HALF + n * 16); *(f32x4*)(C + ro + bj * HALF + n * 16) = acc[ai][bj][m][n] + r; } }
    }
};
struct EpiSwiglu {
    static constexpr bool PERM = true; static constexpr int BMAP = 0;
    unsigned char* O; const float* bgu;
    __device__ __forceinline__ void operator()(const f32x4 (&acc)[2][2][4][2], const Unit& u, int wr, int wc, int fr, int fq) const {
        const int row0 = u.pm * BM + wr * 64 + fr, f0 = u.pn * HALF + wc * 32 + 8 * fq;
        const float* bg = bgu + (size_t)u.e * 2 * DFF + f0;
        constexpr float inv = 1.0f / (SC_H * SC_W);
        f32x4 bgv[2], buv[2];
#pragma unroll
        for (int n = 0; n < 2; ++n) { bgv[n] = *(const f32x4*)(bg + 4 * n); buv[n] = *(const f32x4*)(bg + DFF + 4 * n); }
#pragma unroll
        for (int ai = 0; ai < 2; ++ai)
#pragma unroll
            for (int m = 0; m < 4; ++m) { unsigned char* rowp = O + (size_t)(row0 + ai * HALF + m * 16) * DFF + f0;
                float r[8];
#pragma unroll
                for (int n = 0; n < 2; ++n) { const f32x4 gv = acc[ai][0][m][n] * inv + bgv[n], uv = acc[ai][1][m][n] * inv + buv[n];
#pragma unroll
                    for (int j = 0; j < 4; ++j) { const float gg = fminf(gv[j], 7.0f), uu = fminf(fmaxf(uv[j], -7.0f), 7.0f);
                        r[4 * n + j] = SC_A * gg * (uu + 1.0f) * __builtin_amdgcn_rcpf(1.0f + __builtin_amdgcn_exp2f(-1.702f * LOG2E * gg)); } }
                u32x2 w; w.x = pk4_fp8(r[0], r[1], r[2], r[3]); w.y = pk4_fp8(r[4], r[5], r[6], r[7]);
                *(u32x2*)rowp = w; }
    }
};
struct EpiDown {
    static constexpr bool PERM = true; static constexpr int BMAP = 0;
    bf16_t* O; const float* bd; const float* lgate; const LAS int* cnts;
    __device__ __forceinline__ void operator()(const f32x4 (&acc)[2][2][4][2], const Unit& u, int wr, int wc, int fr, int fq) const {
        const int row0 = u.pm * BM + wr * 64 + fr, col0 = u.pn * BM + wc * 32 + 8 * fq;
        const int n_e = cnts[u.e];
        f32x4 bv[2][2];
#pragma unroll
        for (int bj = 0; bj < 2; ++bj)
#pragma unroll
            for (int n = 0; n < 2; ++n) bv[bj][n] = *(const f32x4*)(bd + (size_t)u.e * DM + col0 + bj * HALF + 4 * n);
#pragma unroll
        for (int ai = 0; ai < 2; ++ai)
#pragma unroll
            for (int m = 0; m < 4; ++m) { const int rt = wr * 64 + fr + ai * HALF + m * 16, p = u.mt * BM + rt;
                const float gt = (p < n_e) ? lgate[(size_t)u.e * T + p] : 0.f;
                bf16_t* rowp = O + (size_t)(row0 + ai * HALF + m * 16) * DM + col0;
#pragma unroll
                for (int bj = 0; bj < 2; ++bj) { const f32x4 v0 = (acc[ai][bj][m][0] * (1.0f / (SC_A * SC_W)) + bv[bj][0]) * gt, v1 = (acc[ai][bj][m][1] * (1.0f / (SC_A * SC_W)) + bv[bj][1]) * gt;
                    u32x4 w; w.x = pk2(v0[0], v0[1]); w.y = pk2(v0[2], v0[3]); w.z = pk2(v1[0], v1[1]); w.w = pk2(v1[2], v1[3]);
                    *(u32x4*)(rowp + bj * HALF) = w; } }
    }
};

template <bool FP8, class Epi, class Sched>
__device__ __forceinline__ void gemm_phase(LAS unsigned char* lds, const char* A0, const int K, const Sched& S, const Epi& E) {
    int tid = threadIdx.x; asm volatile("" : "+v"(tid));
    const int wid = __builtin_amdgcn_readfirstlane(tid >> 6), lane = tid & 63, wr = wid >> 2, wc = wid & 3, fr = lane & 15, fq = lane >> 4;
    const int nt = K / BK;
    int Rr[2], Cc[2]; unsigned voffB[2];
#pragma unroll
    for (int i = 0; i < 2; ++i) { stage_rc(tid * 16 + i * 8192, Rr[i], Cc[i]); const int r5 = Epi::PERM ? perm32(Rr[i] & 31) : (Rr[i] & 31); const int Rb = Epi::BMAP ? (64 * (Rr[i] >> 5) + r5) : ((Rr[i] & ~31) + r5); voffB[i] = (unsigned)(Rb * K + Cc[i]) * 2u; }
    const size_t kstep = (size_t)(BK * 2);
    const size_t hstep = (size_t)(Epi::BMAP ? 32 : HALF) * K * 2;
    const unsigned ldsw = (unsigned)wid * 1024u;
    const int aoff = lds_byte(wr * 64 + fr, fq * 8), boff = lds_byte(wc * 32 + fr, fq * 8);
#define PG8_SA(b, h) (((b) * 2 + (h)) * HTB)
#define PG8_SB(b, h) ((4 + (b) * 2 + (h)) * HTB)
#define PG8_STAGE_B(bufoff, gbase) do { _Pragma("unroll") for (int _i = 0; _i < 2; ++_i) \
        __builtin_amdgcn_global_load_lds((const unsigned*)((const char*)(gbase) + voffB[_i]), (LAS unsigned*)(lds + (bufoff) + ldsw + _i * 8192), 16, 0, 0); } while (0)
#define PG8_STAGE_A(bufoff, gbase, o0, o1) do { \
        __builtin_amdgcn_global_load_lds((const unsigned*)((const char*)(gbase) + (o0)), (LAS unsigned*)(lds + (bufoff) + ldsw), 16, 0, 0); \
        __builtin_amdgcn_global_load_lds((const unsigned*)((const char*)(gbase) + (o1)), (LAS unsigned*)(lds + (bufoff) + ldsw + 8192), 16, 0, 0); } while (0)
#define PG8_LDA(dst, b, h) do { if constexpr (FP8) { _Pragma("unroll") for (int m = 0; m < 4; ++m) { const i32x4 lo_ = *(const LAS i32x4*)(lds + PG8_SA(b, h) + aoff + m * 2048), hi_ = *(const LAS i32x4*)(lds + PG8_SA(b, h) + aoff + m * 2048 + 1024); \
            dst##8[m] = __builtin_shufflevector(lo_, hi_, 0, 1, 2, 3, 4, 5, 6, 7); } } \
        else { _Pragma("unroll") for (int m = 0; m < 4; ++m) _Pragma("unroll") for (int k = 0; k < 2; ++k) dst[m][k] = *(const LAS bf16x8*)(lds + PG8_SA(b, h) + aoff + m * 2048 + k * 1024); } } while (0)
#define PG8_LDB(dst, b, h) do { if constexpr (FP8) { _Pragma("unroll") for (int n = 0; n < 2; ++n) { const i32x4 lo_ = *(const LAS i32x4*)(lds + PG8_SB(b, h) + boff + n * 2048), hi_ = *(const LAS i32x4*)(lds + PG8_SB(b, h) + boff + n * 2048 + 1024); \
            dst##8[n] = __builtin_shufflevector(lo_, hi_, 0, 1, 2, 3, 4, 5, 6, 7); } } \
        else { _Pragma("unroll") for (int n = 0; n < 2; ++n) _Pragma("unroll") for (int k = 0; k < 2; ++k) dst[n][k] = *(const LAS bf16x8*)(lds + PG8_SB(b, h) + boff + n * 2048 + k * 1024); } } while (0)
#define PG8_MMA(ai, bj, At, Bt) do { __builtin_amdgcn_s_setprio(1); \
        if constexpr (FP8) { _Pragma("unroll") for (int m = 0; m < 4; ++m) _Pragma("unroll") for (int n = 0; n < 2; ++n) \
            asm volatile("s_nop 1\n\tv_mfma_f32_16x16x128_f8f6f4 %0, %1, %2, %0" : "+v"(acc[ai][bj][m][n]) : "v"(Bt##8[n]), "v"(At##8[m])); } \
        else { _Pragma("unroll") for (int m = 0; m < 4; ++m) _Pragma("unroll") for (int n = 0; n < 2; ++n) _Pragma("unroll") for (int k = 0; k < 2; ++k) \
            acc[ai][bj][m][n] = __builtin_amdgcn_mfma_f32_16x16x32_bf16(Bt[n][k], At[m][k], acc[ai][bj][m][n], 0, 0, 0); } \
        __builtin_amdgcn_s_setprio(0); } while (0)
#define PG8_WAIT_V(n) asm volatile("s_waitcnt vmcnt(" #n ")" ::: "memory")
#define PG8_WAIT_L(n) asm volatile("s_waitcnt lgkmcnt(" #n ")" ::: "memory")
#define PG8_BAR __builtin_amdgcn_s_barrier()
#define PG8_SCHED __builtin_amdgcn_sched_barrier(0)
    Unit cur, nxt; int ui = 0;
    if (!S.next(0, cur)) return;
    f32x4 acc[2][2][4][2];
#pragma unroll
    for (int a = 0; a < 2; ++a)
#pragma unroll
        for (int b = 0; b < 2; ++b)
#pragma unroll
            for (int m = 0; m < 4; ++m)
#pragma unroll
                for (int n = 0; n < 2; ++n) acc[a][b][m][n] = (f32x4){0.f, 0.f, 0.f, 0.f};
    bf16x8 At[4][2], B0[2][2], B1[2][2]; i32x8 At8[4], B08[2], B18[2];
    unsigned offC[2][2], offN[2][2];
    const char* uA = A0; const char* nA = A0;
    if constexpr (Sched::AFFINE) {
#pragma unroll
        for (int h = 0; h < 2; ++h)
#pragma unroll
            for (int i = 0; i < 2; ++i) offC[h][i] = (unsigned)(((h * HALF + Rr[i]) * K + Cc[i]) * 2);
        uA = A0 + (size_t)cur.pm * BM * K * 2;
    } else S.a_off(cur, Rr, Cc, offC);
    const char* cB = S.b_ptr(cur);
    if (Sched::DRAIN) PG8_WAIT_V(0);
    PG8_STAGE_B(PG8_SB(0, 0), cB); PG8_STAGE_B(PG8_SB(0, 1), cB + hstep); PG8_STAGE_A(PG8_SA(0, 0), uA, offC[0][0], offC[0][1]); PG8_STAGE_A(PG8_SA(0, 1), uA, offC[1][0], offC[1][1]);
    if (wr == 1) PG8_BAR;
    PG8_WAIT_V(2); PG8_BAR;
    PG8_STAGE_B(PG8_SB(1, 0), cB + kstep); PG8_STAGE_A(PG8_SA(1, 0), uA + kstep, offC[0][0], offC[0][1]); PG8_STAGE_B(PG8_SB(1, 1), cB + hstep + kstep);
    PG8_WAIT_V(6); PG8_BAR;
    for (;;) {
        const bool has_next = S.next(ui + 1, nxt);
        const char* nB = cB;
        if constexpr (Sched::AFFINE) { nA = uA; if (has_next) { nA = A0 + (size_t)nxt.pm * BM * K * 2; nB = S.b_ptr(nxt); } }
        else {
            if (has_next) { S.a_off(nxt, Rr, Cc, offN); nB = S.b_ptr(nxt); }
            else {
#pragma unroll
                for (int h = 0; h < 2; ++h)
#pragma unroll
                    for (int i = 0; i < 2; ++i) offN[h][i] = offC[h][i];
            }
        }
        if (Sched::DRAIN) PG8_WAIT_V(0);
        for (int t = 0; t < nt; t += 2) {
            const bool last = (t == nt - 2);
            const char* a1 = uA + (size_t)(t + 1) * kstep;
            const char* a2 = last ? nA : uA + (size_t)(t + 2) * kstep; const char* b2 = last ? nB : cB + (size_t)(t + 2) * kstep;
            const char* a3 = a2 + kstep; const char* b3 = b2 + kstep;
            unsigned o00 = offC[0][0], o01 = offC[0][1], o10 = offC[1][0], o11 = offC[1][1];
            if constexpr (!Sched::AFFINE) { if (last) { o00 = offN[0][0]; o01 = offN[0][1]; o10 = offN[1][0]; o11 = offN[1][1]; } }
            PG8_LDB(B0, 0, 0); PG8_LDB(B1, 0, 1); PG8_SCHED; PG8_LDA(At, 0, 0); PG8_STAGE_A(PG8_SA(1, 1), a1, offC[1][0], offC[1][1]);
            PG8_WAIT_V(8); PG8_WAIT_L(0); PG8_BAR; PG8_MMA(0, 0, At, B0); PG8_MMA(0, 1, At, B1); PG8_BAR; PG8_SCHED;
            PG8_LDA(At, 0, 1); PG8_STAGE_B(PG8_SB(0, 0), b2); PG8_STAGE_B(PG8_SB(0, 1), b2 + hstep); PG8_STAGE_A(PG8_SA(0, 0), a2, o00, o01);
            PG8_WAIT_V(8); PG8_WAIT_L(0); PG8_BAR; PG8_MMA(1, 0, At, B0); PG8_MMA(1, 1, At, B1); PG8_BAR; PG8_SCHED;
            PG8_LDB(B0, 1, 0); PG8_LDB(B1, 1, 1); PG8_SCHED; PG8_LDA(At, 1, 0); PG8_STAGE_A(PG8_SA(0, 1), a2, o10, o11);
            PG8_WAIT_V(8); PG8_WAIT_L(0); PG8_BAR; PG8_MMA(0, 0, At, B0); PG8_MMA(0, 1, At, B1); PG8_BAR; PG8_SCHED;
            PG8_LDA(At, 1, 1); PG8_STAGE_B(PG8_SB(1, 0), b3); PG8_STAGE_B(PG8_SB(1, 1), b3 + hstep); PG8_STAGE_A(PG8_SA(1, 0), a3, o00, o01);
            PG8_WAIT_V(8); PG8_WAIT_L(0); PG8_BAR; PG8_MMA(1, 0, At, B0); PG8_MMA(1, 1, At, B1); PG8_BAR; PG8_SCHED;
        }
        if (wr == 0) PG8_BAR;
        if constexpr (FP8) {
            asm volatile("s_nop 15\n\ts_nop 15" : "+v"(acc[0][0][0][0]), "+v"(acc[0][0][0][1]), "+v"(acc[0][0][1][0]), "+v"(acc[0][0][1][1]), "+v"(acc[0][0][2][0]), "+v"(acc[0][0][2][1]), "+v"(acc[0][0][3][0]), "+v"(acc[0][0][3][1]),
                                                    "+v"(acc[0][1][0][0]), "+v"(acc[0][1][0][1]), "+v"(acc[0][1][1][0]), "+v"(acc[0][1][1][1]), "+v"(acc[0][1][2][0]), "+v"(acc[0][1][2][1]), "+v"(acc[0][1][3][0]), "+v"(acc[0][1][3][1]));
            asm volatile("s_nop 0" : "+v"(acc[1][0][0][0]), "+v"(acc[1][0][0][1]), "+v"(acc[1][0][1][0]), "+v"(acc[1][0][1][1]), "+v"(acc[1][0][2][0]), "+v"(acc[1][0][2][1]), "+v"(acc[1][0][3][0]), "+v"(acc[1][0][3][1]),
                                   "+v"(acc[1][1][0][0]), "+v"(acc[1][1][0][1]), "+v"(acc[1][1][1][0]), "+v"(acc[1][1][1][1]), "+v"(acc[1][1][2][0]), "+v"(acc[1][1][2][1]), "+v"(acc[1][1][3][0]), "+v"(acc[1][1][3][1]));
        }
        E(acc, cur, wr, wc, fr, fq);
        if (!has_next) break;
#pragma unroll
        for (int a = 0; a < 2; ++a)
#pragma unroll
            for (int b = 0; b < 2; ++b)
#pragma unroll
                for (int m = 0; m < 4; ++m)
#pragma unroll
                    for (int n = 0; n < 2; ++n) acc[a][b][m][n] = (f32x4){0.f, 0.f, 0.f, 0.f};
        cur = nxt; cB = nB; ++ui;
        if constexpr (Sched::AFFINE) uA = nA;
        else {
#pragma unroll
            for (int h = 0; h < 2; ++h)
#pragma unroll
                for (int i = 0; i < 2; ++i) offC[h][i] = offN[h][i];
        }
        if (wr == 1) PG8_BAR;
    }
    PG8_WAIT_V(0);
    PG8_BAR;
#undef PG8_SA
#undef PG8_SB
#undef PG8_STAGE_A
#undef PG8_STAGE_B
#undef PG8_LDA
#undef PG8_LDB
#undef PG8_MMA
#undef PG8_WAIT_V
#undef PG8_WAIT_L
#undef PG8_BAR
#undef PG8_SCHED
}
}

namespace {
struct Params { const float* in[20]; float* out; unsigned char* ws; };

struct Frame {
    LAS unsigned char* lds;
    int tid, lane, wave, G, vcu, gw, ngw;
};

struct ConvItem { const float* src; unsigned char* dst; int ldw, ldt, kind; float scale; };
__device__ __forceinline__ void conv_load(const ConvItem& I, f32x4 (&v)[8], int lane) {
    const int r8 = lane >> 3, c4 = (lane & 7) * 4;
#pragma unroll
    for (int i = 0; i < 8; ++i) v[i] = __builtin_nontemporal_load((const f32x4*)(I.src + (size_t)(8 * i + r8) * I.ldw + c4));
}
__device__ __forceinline__ void conv_store(const ConvItem& I, const f32x4 (&v)[8], LAS float* scr, int lane) {
    const int r8 = lane >> 3, c4 = (lane & 7) * 4;
#pragma unroll
    for (int i = 0; i < 8; ++i) { LAS float* d = scr + (8 * i + r8) * 33 + c4; d[0] = v[i][0]; d[1] = v[i][1]; d[2] = v[i][2]; d[3] = v[i][3]; }
    asm volatile("s_waitcnt lgkmcnt(0)" ::: "memory");
    const float scale = I.scale;
    if (I.kind == 0) {
        const int c = lane & 7;
#pragma unroll
        for (int j = 0; j < 4; ++j) { const int n = (lane >> 3) + 8 * j; const LAS float* s = scr + (8 * c) * 33 + n;
            u32x4 o; o.x = pk2(s[0 * 33] * scale, s[1 * 33] * scale); o.y = pk2(s[2 * 33] * scale, s[3 * 33] * scale); o.z = pk2(s[4 * 33] * scale, s[5 * 33] * scale); o.w = pk2(s[6 * 33] * scale, s[7 * 33] * scale);
            *(u32x4*)(I.dst + ((size_t)n * I.ldt + 8 * c) * 2) = o; }
    } else {
        const int n = lane >> 1, kh = lane & 1; const LAS float* s = scr + (32 * kh) * 33 + n;
        unsigned w[8];
#pragma unroll
        for (int q = 0; q < 8; ++q) w[q] = pk4_fp8(s[(4 * q) * 33] * scale, s[(4 * q + 1) * 33] * scale, s[(4 * q + 2) * 33] * scale, s[(4 * q + 3) * 33] * scale);
        unsigned char* d = I.dst + (size_t)n * I.ldt + 32 * kh;
        *(u32x4*)d = (u32x4){w[0], w[1], w[2], w[3]}; *(u32x4*)(d + 16) = (u32x4){w[4], w[5], w[6], w[7]};
    }
    asm volatile("s_waitcnt lgkmcnt(0)" ::: "memory");
}
template <class GetItem>
__device__ __forceinline__ void conv_run(GetItem get, int first, int n, int stride, LAS float* scr, int lane) {
    if (first >= n) return;
    ConvItem A, B, C; f32x4 va[8], vb[8], vc[8];
    get(first, A); conv_load(A, va, lane);
    const bool hb = first + stride < n, hc = first + 2 * stride < n;
    B = A; C = A;
    if (hb) { get(first + stride, B); conv_load(B, vb, lane); }
    if (hc) { get(first + 2 * stride, C); conv_load(C, vc, lane); }
    for (int it = first; it < n; it += stride) {
        conv_store(A, va, scr, lane);
        A = B; B = C;
#pragma unroll
        for (int i = 0; i < 8; ++i) { va[i] = vb[i]; vb[i] = vc[i]; }
        const int nx = it + 3 * stride;
        if (nx < n) { get(nx, C); conv_load(C, vc, lane); }
    }
}
constexpr int I_GU = NE * 16 * 64, I_D = NE * 16 * 32;
__device__ __forceinline__ void moe_item(const Params& P, int r, ConvItem& I) {
    I.kind = 1; I.scale = SC_W; I.ldt = DM;
    if (r < I_GU) { const int e = r >> 10, kb = (r >> 6) & 15, nb = r & 63, n0 = 32 * nb, f = n0 & 1023, up = n0 >> 10;
        const int drow = (f >> 7) * 256 + up * 128 + (f & 127);
        I.src = P.in[16] + (size_t)e * DM * 2 * DFF + (size_t)(64 * kb) * 2 * DFF + n0; I.ldw = 2 * DFF;
        I.dst = P.ws + WS_WGU + (size_t)e * 2 * DFF * DM + (size_t)drow * DM + 64 * kb;
    } else { r -= I_GU; const int e = r >> 9, kb = (r >> 5) & 15, nb = r & 31;
        I.src = P.in[18] + (size_t)e * DFF * DM + (size_t)(64 * kb) * DM + 32 * nb; I.ldw = DM;
        I.dst = P.ws + WS_WD + (size_t)e * DM * DFF + (size_t)(32 * nb) * DFF + 64 * kb; }
}
__device__ __forceinline__ void moe_convert(const Params& P, Frame& F, int cw, int ncw) {
    LAS float* scr = (LAS float*)(F.lds + F.wave * 8448);
    conv_run([&](int r, ConvItem& I) { moe_item(P, r, I); }, cw, I_GU + I_D, ncw, scr, F.lane);
}

__device__ __forceinline__ void p0_prologue(const Params& P, Frame& F) {
    unsigned char* ws = P.ws;
    const float* w_in = P.in[2];
    LAS float* scr = (LAS float*)(F.lds + F.wave * 8448);
    LAS float* gwl = (LAS float*)(F.lds + 73728);
    for (int i = F.tid; i < 1024 * 8; i += NTHR) gwl[i] = w_in[(size_t)(i >> 3) * DIN + NZ + (i & 7)];
    __syncthreads();
    constexpr int I_IN = 16 * 96, I_OUT = 16 * 32, I_QK = 8 * 2 * 4, I_ZERO = 8 * 3;
    bf16_t* WqkT = (bf16_t*)(ws + WS_WQK);
    conv_run([&](int r, ConvItem& I) {
        I.kind = 0; I.scale = 1.f;
        if (r < I_IN) { const int kb = r / 96, nb = r % 96; I.src = w_in + (size_t)(64 * kb) * DIN + 32 * nb; I.ldw = DIN; I.dst = ws + WS_WIN + ((size_t)(32 * nb) * DM + 64 * kb) * 2; I.ldt = DM; return; }
        r -= I_IN;
        if (r < I_OUT) { const int kb = r / 32, nb = r % 32; I.src = P.in[12] + (size_t)(64 * kb) * DM + 32 * nb; I.ldw = DM; I.dst = ws + WS_WOUT + ((size_t)(32 * nb) * DM + 64 * kb) * 2; I.ldt = DM; return; }
        r -= I_OUT;
        { const int isk = r >> 5, h = (r >> 3) & 3, kb = (r >> 2) & 1, nb = r & 3;
            I.src = P.in[isk ? 8 : 7] + (size_t)h * 16384 + (size_t)(64 * kb) * 128 + 32 * nb; I.ldw = 128;
            I.dst = ws + WS_WQK + ((size_t)(isk * 512 + h * 128 + 32 * nb) * 512 + h * 128 + 64 * kb) * 2; I.ldt = 512; I.scale = isk ? 0.08838834764831845f : 1.f; }
    }, F.gw, I_IN + I_OUT + I_QK, F.ngw, scr, F.lane);
    moe_convert(P, F, F.gw, F.ngw);
    for (int r = F.gw; r < I_ZERO; r += F.ngw) {
        const int rb = r / 3, j = r % 3, cb = j + (j >= (rb & 3) ? 1 : 0);
        for (int q = F.lane; q < 128 * 16; q += 64) { const int rr = q >> 4, cc = q & 15; *(u32x4*)(WqkT + (size_t)(rb * 128 + rr) * 512 + cb * 128 + cc * 8) = (u32x4){0u, 0u, 0u, 0u}; }
    }
    {
        const float* wr = P.in[14]; float* wrt = (float*)(ws + WS_WRT);
        for (int idx = F.vcu * NTHR + F.tid; idx < DM * NE; idx += F.G * NTHR) wrt[(idx & 31) * DM + (idx >> 5)] = wr[idx];
    }
    const float* x = P.in[0]; const float* g1 = P.in[1];
    bf16_t* XN = (bf16_t*)(ws + WS_XN); float* GATE = (float*)(ws + WS_GATE);
    for (int row = F.gw; row < T; row += F.ngw) {
        const f32x4* xr = (const f32x4*)(x + (size_t)row * DM);
        f32x4 v[4]; float s = 0.f;
#pragma unroll
        for (int j = 0; j < 4; ++j) { v[j] = xr[F.lane + 64 * j]; s += v[j][0] * v[j][0] + v[j][1] * v[j][1] + v[j][2] * v[j][2] + v[j][3] * v[j][3]; }
        s = wave_sum(s);
        const float rs = 1.0f / sqrtf(s * (1.0f / DM) + EPS);
        float ga[8];
#pragma unroll
        for (int c = 0; c < 8; ++c) ga[c] = 0.f;
#pragma unroll
        for (int j = 0; j < 4; ++j) { const f32x4 gg = ((const f32x4*)g1)[F.lane + 64 * j]; v[j] = v[j] * rs * gg;
            u32x2 w; w.x = pk2(v[j][0], v[j][1]); w.y = pk2(v[j][2], v[j][3]);
            *(u32x2*)(XN + (size_t)row * DM + 4 * (F.lane + 64 * j)) = w;
#pragma unroll
            for (int q = 0; q < 4; ++q) { const int k = 4 * (F.lane + 64 * j) + q; const f32x4 w0 = *(const LAS f32x4*)(gwl + k * 8), w1 = *(const LAS f32x4*)(gwl + k * 8 + 4);
                ga[0] += v[j][q] * w0[0]; ga[1] += v[j][q] * w0[1]; ga[2] += v[j][q] * w0[2]; ga[3] += v[j][q] * w0[3];
                ga[4] += v[j][q] * w1[0]; ga[5] += v[j][q] * w1[1]; ga[6] += v[j][q] * w1[2]; ga[7] += v[j][q] * w1[3]; } }
#pragma unroll
        for (int c = 0; c < 8; ++c) ga[c] = wave_sum(ga[c]);
        if (F.lane == 0) { *(f32x4*)(GATE + (size_t)row * 8) = (f32x4){ga[0], ga[1], ga[2], ga[3]}; *(f32x4*)(GATE + (size_t)row * 8 + 4) = (f32x4){ga[4], ga[5], ga[6], ga[7]}; }
    }
}

#define MFMA16(a, b, c) __builtin_amdgcn_mfma_f32_16x16x32_bf16((a), (b), (c), 0, 0, 0)
struct AttBlk { int tlb, off, d, qb, m, b, h, pass, tt; };
__device__ __forceinline__ void att_decode(int fb, int w, int vcu, int G, AttBlk& k) {
    const int ul = fb / 30, r = fb - 30 * ul, t6 = r / 5; k.m = r - 5 * t6; k.pass = t6 >> 1; k.tt = t6 & 1;
    const int unit = vcu + ul * G; k.tlb = (unit & 31) * 256; k.h = (unit >> 5) & 7; k.b = unit >> 8;
    const int tau = 2 * w + k.tt; k.d = 1 << (2 * k.pass);
    k.off = k.pass == 0 ? 0 : (k.pass == 1 ? (tau & 3) : tau); k.qb = k.pass == 0 ? 16 * tau : (k.pass == 1 ? 16 * (tau >> 2) : 0);
}
__device__ __forceinline__ void attn_phase(const Params& P, Frame& F) {
    const bf16_t* Z = (const bf16_t*)(P.ws + WS_Z); bf16_t* MIX = (bf16_t*)(P.ws + WS_MIX);
    const int tid = F.tid;
    const int lane = tid & 63, i = lane & 15, g = lane >> 4, w = F.wave;
    float gm = fabsf(P.in[4][lane]);
#pragma unroll
    for (int o = 1; o < 64; o <<= 1) gm = fmaxf(gm, __shfl_xor(gm, o));
    const float kmax = 8.0f * gm * 1.01f;
    constexpr int OP = 272;
    LAS unsigned char* OL = F.lds;
    LAS float* LL = (LAS float*)(F.lds + 256 * OP);
    LAS unsigned char* vb = F.lds + 256 * OP + 1024 + w * 4608;
    const int vwr = (lane >> 3) * 144 + (lane & 7) * 16;
    const int vrd = (4 * g + (i >> 2)) * 144 + (i & 3) * 8;
    const int nunits = (512 - F.vcu + F.G - 1) / F.G, NFB = 30 * nunits;
    if (NFB <= 0) return;
#define ATT_WGBAR() do { asm volatile("s_waitcnt lgkmcnt(0)" ::: "memory"); __builtin_amdgcn_s_barrier(); asm volatile("" ::: "memory"); } while (0)
#define ATT_LOAD(kd, kfn, vrn) do { const bf16_t* Kh_ = Z + (size_t)(kd).b * SEQ * NZ + ZK + (kd).h * 64 + 8 * g; const bf16_t* Vh_ = Z + (size_t)(kd).b * SEQ * NZ + ZV + (kd).h * 64 + 8 * (lane & 7); \
        const int nb_ = (kd).qb - 144 + 32 * (kd).m, p0_ = (kd).tlb + (kd).off; \
        _Pragma("unroll") for (int sb = 0; sb < 2; ++sb) { int kp = p0_ + (nb_ + 16 * sb + i) * (kd).d; kp = kp < 0 ? 0 : (kp > SEQ - 1 ? SEQ - 1 : kp); const bf16_t* kr = Kh_ + (size_t)kp * NZ; kfn[sb][0] = *(const bf16x8*)kr; kfn[sb][1] = *(const bf16x8*)(kr + 32); } \
        _Pragma("unroll") for (int c = 0; c < 4; ++c) { int kp = p0_ + (nb_ + 8 * c + (lane >> 3)) * (kd).d; kp = kp < 0 ? 0 : (kp > SEQ - 1 ? SEQ - 1 : kp); vrn[c] = *(const u32x4*)(Vh_ + (size_t)kp * NZ); } } while (0)
#define ATT_LOADQ(kd, q0_, q1_) do { const bf16_t* qr_ = Z + (size_t)((kd).b * SEQ + (kd).tlb + (kd).off + (kd).d * ((kd).qb + i)) * NZ + ZQ + (kd).h * 64 + 8 * g; q0_ = *(const bf16x8*)qr_; q1_ = *(const bf16x8*)(qr_ + 32); } while (0)
    bf16x8 kfa[2][2], kfb[2][2]; u32x4 vra[4], vrb[4]; bf16x8 qn0, qn1, qf0, qf1;
    AttBlk cur, nx;
    att_decode(0, w, F.vcu, F.G, cur);
    ATT_LOADQ(cur, qn0, qn1);
    ATT_LOAD(cur, kfa, vra);
    att_decode(1, w, F.vcu, F.G, nx); ATT_LOAD(nx, kfb, vrb);
    f32x4 o[4]; float lsum = 0.f, ref = 0.f, slope2 = 0.f;
    __syncthreads();
#pragma unroll 1
    for (int fb = 0; fb < NFB; ++fb) {
        att_decode(fb, w, F.vcu, F.G, cur);
        if (cur.m == 0) {
            qf0 = qn0; qf1 = qn1;
            if (fb + 5 < NFB) { att_decode(fb + 5, w, F.vcu, F.G, nx); ATT_LOADQ(nx, qn0, qn1); }
            float ss = 0.f;
#pragma unroll
            for (int j = 0; j < 8; ++j) { const float a = bf2f((unsigned short)qf0[j]), c = bf2f((unsigned short)qf1[j]); ss += a * a + c * c; }
            ss += __shfl_xor(ss, 16); ss += __shfl_xor(ss, 32);
            ref = sqrtf(ss) * kmax; slope2 = exp2f(-(float)(cur.h + 1)) * LOG2E;
#pragma unroll
            for (int dt = 0; dt < 4; ++dt) o[dt] = (f32x4){0.f, 0.f, 0.f, 0.f};
            lsum = 0.f;
        }
        bf16x8 kf[2][2]; u32x4 vr[4];
#pragma unroll
        for (int sb = 0; sb < 2; ++sb) { kf[sb][0] = kfa[sb][0]; kf[sb][1] = kfa[sb][1]; kfa[sb][0] = kfb[sb][0]; kfa[sb][1] = kfb[sb][1]; }
#pragma unroll
        for (int c = 0; c < 4; ++c) { vr[c] = vra[c]; vra[c] = vrb[c]; }
        if (fb + 2 < NFB) { att_decode(fb + 2, w, F.vcu, F.G, nx); ATT_LOAD(nx, kfb, vrb); }
        const int d = cur.d, qb = cur.qb, nb = qb - 144 + 32 * cur.m, p0 = cur.tlb + cur.off;
#pragma unroll
        for (int c = 0; c < 4; ++c) *(LAS u32x4*)(vb + vwr + c * 8 * 144) = vr[c];
        f32x4 s[2];
#pragma unroll
        for (int sb = 0; sb < 2; ++sb) { s[sb] = MFMA16(kf[sb][0], qf0, ((f32x4){0.f, 0.f, 0.f, 0.f})); s[sb] = MFMA16(kf[sb][1], qf1, s[sb]); }
        float p[8];
#pragma unroll
        for (int sb = 0; sb < 2; ++sb)
#pragma unroll
            for (int j = 0; j < 4; ++j) { const int n = nb + 16 * sb + 4 * g + j, a = qb + i - n;
                const bool valid = (a >= 0) && (a <= 128) && (p0 + n * d >= 0);
                const float e = s[sb][j] - slope2 * (float)(a * d) - ref;
                const float pv = valid ? __builtin_amdgcn_exp2f(e) : 0.f;
                p[4 * sb + j] = pv; lsum += pv; }
        u32x4 pw; pw.x = pk2(p[0], p[1]); pw.y = pk2(p[2], p[3]); pw.z = pk2(p[4], p[5]); pw.w = pk2(p[6], p[7]);
        const bf16x8 pf = __builtin_bit_cast(bf16x8, pw);
#pragma unroll
        for (int dt = 0; dt < 4; ++dt) {
            const s16x4 v0 = __builtin_amdgcn_ds_read_tr16_b64_v4i16((LAS s16x4*)(vb + vrd + dt * 32));
            const s16x4 v1 = __builtin_amdgcn_ds_read_tr16_b64_v4i16((LAS s16x4*)(vb + vrd + 16 * 144 + dt * 32));
            const bf16x8 vf = (bf16x8){v0[0], v0[1], v0[2], v0[3], v1[0], v1[1], v1[2], v1[3]};
            o[dt] = MFMA16(vf, pf, o[dt]);
        }
        if (cur.m == 4) {
            float ls = lsum; ls += __shfl_xor(ls, 16); ls += __shfl_xor(ls, 32);
            const int row = cur.off + d * (qb + i);
            LAS f32x4* orow = (LAS f32x4*)(OL + row * OP + 16 * g);
            if (cur.pass == 0) {
#pragma unroll
                for (int dt = 0; dt < 4; ++dt) orow[4 * dt] = o[dt];
                if (g == 0) LL[row] = ls;
            } else {
#pragma unroll
                for (int dt = 0; dt < 4; ++dt) orow[4 * dt] = orow[4 * dt] + o[dt];
                if (g == 0) LL[row] += ls;
            }
            if (cur.tt == 1) {
                ATT_WGBAR();
                if (cur.pass == 2) {
                    const int rw = tid >> 1, hf = tid & 1;
                    const float inv = 1.0f / LL[rw];
                    const LAS f32x4* orw = (const LAS f32x4*)(OL + rw * OP + hf * 128);
                    bf16_t* mrow = MIX + (size_t)(cur.b * SEQ + cur.tlb + rw) * DM + cur.h * 64 + hf * 32;
#pragma unroll
                    for (int q = 0; q < 4; ++q) { const f32x4 a0 = orw[2 * q] * inv, a1 = orw[2 * q + 1] * inv;
                        u32x4 wv_; wv_.x = pk2(a0[0], a0[1]); wv_.y = pk2(a0[2], a0[3]); wv_.z = pk2(a1[0], a1[1]); wv_.w = pk2(a1[2], a1[3]);
                        *(u32x4*)(mrow + 8 * q) = wv_; }
                    ATT_WGBAR();
                }
            }
        }
    }
#undef ATT_LOAD
#undef ATT_LOADQ
#undef ATT_WGBAR
    __syncthreads();
}

__device__ __forceinline__ bf16x8 tr2(LAS unsigned char* p0, LAS unsigned char* p1) {
    const s16x4 a = __builtin_amdgcn_ds_read_tr16_b64_v4i16((LAS s16x4*)p0);
    const s16x4 b = __builtin_amdgcn_ds_read_tr16_b64_v4i16((LAS s16x4*)p1);
    return (bf16x8){a[0], a[1], a[2], a[3], b[0], b[1], b[2], b[3]};
}

__device__ __forceinline__ void ml1_phase(const Params& P, Frame& F) {
    const bf16_t* Z = (const bf16_t*)(P.ws + WS_Z); bf16_t* QK = (bf16_t*)(P.ws + WS_QK); const float* GATE = (const float*)(P.ws + WS_GATE);
    const bf16_t* WqkT = (const bf16_t*)(P.ws + WS_WQK);
    float* BC = (float*)(P.ws + WS_BC); float* IG = (float*)(P.ws + WS_IG); float* BT = (float*)(P.ws + WS_BT); float* U = (float*)(P.ws + WS_U); float* NV = (float*)(P.ws + WS_NV);
    const float* bi = P.in[9]; const float* bf = P.in[10]; const float* cw = P.in[5]; const float* cb = P.in[6];
    constexpr int PIT = 272;
    LAS unsigned char* KIM = F.lds; LAS unsigned char* VIM = F.lds + 128 * PIT; LAS unsigned char* XIM = F.lds + 2 * 128 * PIT;
    LAS float* bc = (LAS float*)(F.lds + 3 * 128 * PIT); LAS float* wv = bc + 256;
    const int tid = F.tid;
    const int lane = tid & 63, i = lane & 15, g = lane >> 4, w = F.wave;
    bf16x8 ones;
#pragma unroll
    for (int j = 0; j < 8; ++j) ones[j] = (i == 0) ? (short)0x3F80 : (short)0;
    for (int unit = F.vcu; unit < 256; unit += F.G) {
        const int bh = unit / NCH, c = unit % NCH, b = bh / NHM, h = bh % NHM, t0 = b * SEQ + c * CH;
        float ig = 0.f;
        __syncthreads();
        if (tid < 256) { const float f = GATE[(size_t)(t0 + tid) * 8 + 4 + h] + bf[h];
            bc[tid] = fminf(f, 0.f) - log1pf(__expf(-fabsf(f)));
            ig = GATE[(size_t)(t0 + tid) * 8 + h] + bi[h]; }
        __syncthreads();
        if (w == 0) {
            const f32x4 a = *(const LAS f32x4*)(bc + 4 * lane);
            const float s1 = a[0], s2 = s1 + a[1], s3 = s2 + a[2], s4 = s3 + a[3];
            float x = s4;
#pragma unroll
            for (int off = 1; off < 64; off <<= 1) { const float v = __shfl_up(x, off); if (lane >= off) x += v; }
            const float ex = x - s4;
            *(LAS f32x4*)(bc + 4 * lane) = (f32x4){ex + s1, ex + s2, ex + s3, ex + s4};
        }
        __syncthreads();
        if (tid < 256) { BC[(size_t)(t0 + tid) * 4 + h] = bc[tid]; IG[(size_t)(t0 + tid) * 4 + h] = ig; wv[tid] = __expf(bc[255] - bc[tid] + ig); }
        if (tid == 0) BT[unit] = bc[255];
        bf16x8 wf[2][4];
#pragma unroll
        for (int e2 = 0; e2 < 2; ++e2) { const bf16_t* wp = WqkT + (size_t)((w >> 2) * 512 + h * 128 + 32 * (w & 3) + 16 * e2 + i) * 512 + h * 128 + 8 * g;
#pragma unroll
            for (int ks = 0; ks < 4; ++ks) wf[e2][ks] = *(const bf16x8*)(wp + 32 * ks); }
        f32x4 acc[9];
#pragma unroll
        for (int q = 0; q < 9; ++q) acc[q] = (f32x4){0.f, 0.f, 0.f, 0.f};
        for (int half = 0; half < 2; ++half) {
            __syncthreads();
#pragma unroll
            for (int q = 0; q < 4; ++q) { const int id = tid + 512 * q, row = id >> 4, c8 = (id & 15) * 8, sidx = half * 128 + row, tok = t0 + sidx, tl = c * CH + sidx;
                const int ch = h * 128 + c8;
                float a[8];
                { const f32x4 b0 = *(const f32x4*)(cb + ch), b1 = *(const f32x4*)(cb + ch + 4); a[0] = b0[0]; a[1] = b0[1]; a[2] = b0[2]; a[3] = b0[3]; a[4] = b1[0]; a[5] = b1[1]; a[6] = b1[2]; a[7] = b1[3]; }
#pragma unroll
                for (int j = 0; j < 4; ++j) { const int dt = 3 - j; if (tl - dt >= 0) {
                        const u32x4 xw = *(const u32x4*)(Z + (size_t)(tok - dt) * NZ + ZXM + ch);
                        const f32x4 w0 = *(const f32x4*)(cw + j * 512 + ch), w1 = *(const f32x4*)(cw + j * 512 + ch + 4);
                        a[0] += w0[0] * bflo(xw.x); a[1] += w0[1] * bfhi(xw.x); a[2] += w0[2] * bflo(xw.y); a[3] += w0[3] * bfhi(xw.y);
                        a[4] += w1[0] * bflo(xw.z); a[5] += w1[1] * bfhi(xw.z); a[6] += w1[2] * bflo(xw.w); a[7] += w1[3] * bfhi(xw.w); } }
#pragma unroll
                for (int j = 0; j < 8; ++j) a[j] = a[j] * sigmoidf_(a[j]);
                u32x4 o; o.x = pk2(a[0], a[1]); o.y = pk2(a[2], a[3]); o.z = pk2(a[4], a[5]); o.w = pk2(a[6], a[7]);
                *(LAS u32x4*)(XIM + row * PIT + c8 * 2) = o;
                *(LAS u32x4*)(VIM + row * PIT + c8 * 2) = *(const u32x4*)(Z + (size_t)tok * NZ + ZVM + ch); }
            __syncthreads();
#pragma unroll 2
            for (int tt = 0; tt < 8; ++tt) {
                bf16x8 xf[4];
#pragma unroll
                for (int ks = 0; ks < 4; ++ks) xf[ks] = *(const LAS bf16x8*)(XIM + (16 * tt + i) * PIT + (32 * ks + 8 * g) * 2);
                const int trow = 16 * tt + i, sidx = half * 128 + trow; const float ws_ = wv[sidx];
                bf16_t* qkrow = QK + (size_t)(t0 + sidx) * 1024 + (w >> 2) * 512 + h * 128 + 32 * (w & 3) + 4 * g;
#pragma unroll
                for (int e2 = 0; e2 < 2; ++e2) {
                    f32x4 d = (f32x4){0.f, 0.f, 0.f, 0.f};
#pragma unroll
                    for (int ks = 0; ks < 4; ++ks) d = MFMA16(wf[e2][ks], xf[ks], d);
                    u32x2 o; o.x = pk2(d[0], d[1]); o.y = pk2(d[2], d[3]);
                    *(u32x2*)(qkrow + 16 * e2) = o;
                    if (w >= 4) { u32x2 ok; ok.x = pk2(d[0] * ws_, d[1] * ws_); ok.y = pk2(d[2] * ws_, d[3] * ws_); *(LAS u32x2*)(KIM + trow * PIT + (32 * (w & 3) + 16 * e2 + 4 * g) * 2) = ok; }
                }
            }
            __syncthreads();
#pragma unroll
            for (int kk = 0; kk < 4; ++kk) {
                const int ro = (32 * kk + 8 * g + (i >> 2)) * PIT + (i & 3) * 8;
                const bf16x8 af = tr2(KIM + ro + 32 * w, KIM + ro + 4 * PIT + 32 * w);
#pragma unroll
                for (int et = 0; et < 8; ++et) { const bf16x8 bfr = tr2(VIM + ro + 32 * et, VIM + ro + 4 * PIT + 32 * et); acc[et] = MFMA16(af, bfr, acc[et]); }
                acc[8] = MFMA16(af, ones, acc[8]);
            }
        }
        float* up = U + (size_t)unit * 16384 + (size_t)(16 * w + 4 * g) * 128 + i;
#pragma unroll
        for (int et = 0; et < 8; ++et)
#pragma unroll
            for (int j = 0; j < 4; ++j) up[j * 128 + 16 * et] = acc[et][j];
        if (i == 0) {
#pragma unroll
            for (int j = 0; j < 4; ++j) NV[unit * 128 + 16 * w + 4 * g + j] = acc[8][j];
        }
    }
}

__device__ __forceinline__ void ml2_phase(const Params& P, Frame& F) {
    const float* BT = (const float*)(P.ws + WS_BT); const float* U = (const float*)(P.ws + WS_U); const float* NV = (const float*)(P.ws + WS_NV);
    bf16_t* CS = (bf16_t*)(P.ws + WS_CS); float* NS = (float*)(P.ws + WS_CS + 8 * MiB);
    for (int item = F.vcu; item < 256; item += F.G) {
        const int bh = item >> 5, sl = item & 31, el = sl * 512 + F.tid;
        float u[NCH];
#pragma unroll
        for (int c = 0; c < NCH; ++c) u[c] = U[(size_t)(bh * NCH + c) * 16384 + el];
        float st = 0.f;
#pragma unroll
        for (int c = 0; c < NCH; ++c) { CS[(size_t)(bh * NCH + c) * 16384 + el] = (bf16_t)f2bf(st); st = __expf(BT[bh * NCH + c]) * st + u[c]; }
        if (sl == 0 && F.tid < 128) { float n = 0.f;
            for (int c = 0; c < NCH; ++c) { NS[(bh * NCH + c) * 128 + F.tid] = n; n = __expf(BT[bh * NCH + c]) * n + NV[(bh * NCH + c) * 128 + F.tid]; } }
    }
}

__device__ __forceinline__ void ml3_phase(const Params& P, Frame& F) {
    const bf16_t* Z = (const bf16_t*)(P.ws + WS_Z); const bf16_t* QK = (const bf16_t*)(P.ws + WS_QK);
    const float* BC = (const float*)(P.ws + WS_BC); const float* IG = (const float*)(P.ws + WS_IG); const float* BT = (const float*)(P.ws + WS_BT);
    const float* U = (const float*)(P.ws + WS_U); const float* NV = (const float*)(P.ws + WS_NV); const float* gn = P.in[11];
    bf16_t* MIX = (bf16_t*)(P.ws + WS_MIX);
    constexpr int CP = 288, VP = 272;
    LAS unsigned char* CIM = F.lds;
    LAS unsigned char* VIM = F.lds + 128 * CP;
    LAS float* cs = (LAS float*)(F.lds + 128 * CP + 256 * VP);
    LAS float* bq = cs + 256;
    const int tid = F.tid;
    const int lane = tid & 63, i = lane & 15, g = lane >> 4, w = F.wave;
    for (int unit = F.vcu; unit < 256; unit += F.G) {
        const int bh = unit / NCH, c = unit % NCH, b = bh / NHM, h = bh % NHM, t0 = b * SEQ + c * CH;
        __syncthreads();
#pragma unroll
        for (int q = 0; q < 8; ++q) { const int id = tid + 512 * q, row = id >> 4, c8 = (id & 15) * 8;
            *(LAS u32x4*)(VIM + row * VP + c8 * 2) = *(const u32x4*)(Z + (size_t)(t0 + row) * NZ + ZVM + h * 128 + c8); }
        if (tid < 256) { const float bb = BC[(size_t)(t0 + tid) * 4 + h]; bq[tid] = bb; cs[tid] = IG[(size_t)(t0 + tid) * 4 + h] - bb; }
        {   const bf16_t* cs = (const bf16_t*)(P.ws + WS_CS) + (size_t)unit * 16384; const float* ns = (const float*)(P.ws + WS_CS + 8 * MiB) + unit * 128;
#pragma unroll
            for (int q = 0; q < 4; ++q) { const int id = tid + 512 * q, d = id >> 4, e8 = (id & 15) * 8; *(LAS u32x4*)(CIM + d * CP + e8 * 2) = *(const u32x4*)(cs + d * 128 + e8); }
            if (tid < 128) { *(LAS u32x4*)(CIM + tid * CP + 256) = (u32x4){f2bf(ns[tid]), 0u, 0u, 0u}; *(LAS u32x4*)(CIM + tid * CP + 272) = (u32x4){0u, 0u, 0u, 0u}; }
        }
        __syncthreads();
#pragma unroll 1
        for (int a = 0; a < 2; ++a) {
            const int qt = a ? 15 - w : w;
            bf16x8 qf[4];
            { const bf16_t* qp = QK + (size_t)(t0 + 16 * qt + i) * 1024 + h * 128 + 8 * g;
#pragma unroll
                for (int ks = 0; ks < 4; ++ks) qf[ks] = *(const bf16x8*)(qp + 32 * ks); }
            const float bt = bq[16 * qt + i];
            f32x4 acc[8]; float den;
            {
                f32x4 a8 = (f32x4){0.f, 0.f, 0.f, 0.f};
#pragma unroll
                for (int et = 0; et < 8; ++et) acc[et] = (f32x4){0.f, 0.f, 0.f, 0.f};
#pragma unroll
                for (int ks = 0; ks < 4; ++ks) {
                    const int ro = (32 * ks + 8 * g + (i >> 2)) * CP + (i & 3) * 8;
#pragma unroll
                    for (int et = 0; et < 8; ++et) { const bf16x8 cf = tr2(CIM + ro + 32 * et, CIM + ro + 4 * CP + 32 * et); acc[et] = MFMA16(cf, qf[ks], acc[et]); }
                    const bf16x8 cf = tr2(CIM + ro + 256, CIM + ro + 4 * CP + 256);
                    a8 = MFMA16(cf, qf[ks], a8);
                }
                const float eb = __expf(bt);
#pragma unroll
                for (int et = 0; et < 8; ++et) acc[et] = acc[et] * eb;
                den = (g == 0) ? a8[0] * eb : 0.f;
            }
            const int kbhi = qt >> 1;
#pragma unroll 1
            for (int kb = 0; kb <= kbhi; ++kb) {
                float p[8];
#pragma unroll
                for (int sb = 0; sb < 2; ++sb) {
                    const bf16_t* kp = QK + (size_t)(t0 + 32 * kb + 16 * sb + i) * 1024 + 512 + h * 128 + 8 * g;
                    f32x4 sacc = (f32x4){0.f, 0.f, 0.f, 0.f};
#pragma unroll
                    for (int ks = 0; ks < 4; ++ks) { const bf16x8 kf = *(const bf16x8*)(kp + 32 * ks); sacc = MFMA16(kf, qf[ks], sacc); }
                    const f32x4 cv = *(const LAS f32x4*)(cs + 32 * kb + 16 * sb + 4 * g);
#pragma unroll
                    for (int j = 0; j < 4; ++j) { const int srow = 32 * kb + 16 * sb + 4 * g + j, tcol = 16 * qt + i;
                        const float pv = (srow <= tcol) ? sacc[j] * __expf(bt + cv[j]) : 0.f;
                        p[4 * sb + j] = pv; den += pv; } }
                u32x4 pw; pw.x = pk2(p[0], p[1]); pw.y = pk2(p[2], p[3]); pw.z = pk2(p[4], p[5]); pw.w = pk2(p[6], p[7]);
                const bf16x8 pf = __builtin_bit_cast(bf16x8, pw);
                const int ro = (32 * kb + 4 * g + (i >> 2)) * VP + (i & 3) * 8;
#pragma unroll
                for (int et = 0; et < 8; ++et) { const bf16x8 vf = tr2(VIM + ro + 32 * et, VIM + ro + 16 * VP + 32 * et); acc[et] = MFMA16(vf, pf, acc[et]); }
            }
            float dn = den; dn += __shfl_xor(dn, 16); dn += __shfl_xor(dn, 32);
            const float dd = 1.0f / fmaxf(fabsf(dn), 1.0f);
            float ss = 0.f;
#pragma unroll
            for (int et = 0; et < 8; ++et) { acc[et] = acc[et] * dd; ss += acc[et][0] * acc[et][0] + acc[et][1] * acc[et][1] + acc[et][2] * acc[et][2] + acc[et][3] * acc[et][3]; }
            ss += __shfl_xor(ss, 16); ss += __shfl_xor(ss, 32);
            const float rstd = 1.0f / sqrtf(ss * (1.0f / HDM) + EPS);
            const int tok = t0 + 16 * qt + i;
#pragma unroll
            for (int et = 0; et < 8; ++et) { const int e0 = 16 * et + 4 * g;
                const u32x2 ow = *(const u32x2*)(Z + (size_t)tok * NZ + ZOM + h * 128 + e0);
                const f32x4 gv = *(const f32x4*)(gn + h * 128 + e0);
                const float r0 = sigmoidf_(bflo(ow.x)) * acc[et][0] * rstd * gv[0], r1 = sigmoidf_(bfhi(ow.x)) * acc[et][1] * rstd * gv[1];
                const float r2 = sigmoidf_(bflo(ow.y)) * acc[et][2] * rstd * gv[2], r3 = sigmoidf_(bfhi(ow.y)) * acc[et][3] * rstd * gv[3];
                u32x2 o; o.x = pk2(r0, r1); o.y = pk2(r2, r3);
                *(u32x2*)(MIX + (size_t)tok * DM + 512 + h * 128 + e0) = o; }
        }
    }
}

__device__ __forceinline__ void router_phase(const Params& P, Frame& F, const bool commit) {
    const float* X1 = P.out; const float* g2 = P.in[13]; const float* wrt = (const float*)(P.ws + WS_WRT); const float* br = P.in[15];
    unsigned char* H8 = P.ws + WS_H8; int* cnt = (int*)(P.ws + WS_CTL); int* ltok = (int*)(P.ws + WS_LTOK); float* lgate = (float*)(P.ws + WS_LGATE); int* tke = (int*)(P.ws + WS_TKE);
    LAS float* wl = (LAS float*)(F.lds + 4096);
    for (int q = F.tid; q < NE * DM / 4; q += NTHR) *(LAS f32x4*)(wl + 4 * q) = *(const f32x4*)(wrt + 4 * q);
    LAS int* lcnt = (LAS int*)(F.lds);
    LAS int* pe = lcnt + 64;
    LAS float* pg = (LAS float*)(pe + 256);
    const int lane = F.lane, tid = F.tid;
    for (int chunk = F.vcu; chunk < T / 64; chunk += F.G) {
        __syncthreads();
        if (tid < 64) lcnt[tid] = 0;
        __syncthreads();
#pragma unroll 1
        for (int hp = 0; hp < 2; ++hp) {
            f32x4 v[4][4];
#pragma unroll
            for (int tt = 0; tt < 4; ++tt) {
                const int tok = chunk * 64 + F.wave * 8 + hp * 4 + tt;
                const f32x4* xr = (const f32x4*)(X1 + (size_t)tok * DM);
                float s = 0.f;
#pragma unroll
                for (int j = 0; j < 4; ++j) { v[tt][j] = xr[lane + 64 * j]; s += v[tt][j][0] * v[tt][j][0] + v[tt][j][1] * v[tt][j][1] + v[tt][j][2] * v[tt][j][2] + v[tt][j][3] * v[tt][j][3]; }
                s = wave_sum(s);
                const float r = 1.0f / sqrtf(s * (1.0f / DM) + EPS);
#pragma unroll
                for (int j = 0; j < 4; ++j) { const f32x4 gg = ((const f32x4*)g2)[lane + 64 * j]; v[tt][j] = v[tt][j] * r * gg;
                    *(unsigned*)(H8 + (size_t)tok * DM + 4 * (lane + 64 * j)) = pk4_fp8(v[tt][j][0] * SC_H, v[tt][j][1] * SC_H, v[tt][j][2] * SC_H, v[tt][j][3] * SC_H); }
            }
            const bool b0 = lane & 1, b1 = lane & 2;
            float tv0 = -INFINITY, tv1 = -INFINITY, tv2 = -INFINITY, tv3 = -INFINITY; int te0 = 0, te1 = 0, te2 = 0, te3 = 0;
#pragma unroll 2
            for (int e = 0; e < NE; ++e) {
                const LAS f32x4* wrow = (const LAS f32x4*)(wl + e * DM);
                f32x4 w4[4];
#pragma unroll
                for (int j = 0; j < 4; ++j) w4[j] = wrow[lane + 64 * j];
                float a[4];
#pragma unroll
                for (int tt = 0; tt < 4; ++tt) { float pa = 0.f;
#pragma unroll
                    for (int j = 0; j < 4; ++j) pa += v[tt][j][0] * w4[j][0] + v[tt][j][1] * w4[j][1] + v[tt][j][2] * w4[j][2] + v[tt][j][3] * w4[j][3];
                    a[tt] = pa; }
                float m0 = b0 ? a[2] : a[0], m1 = b0 ? a[3] : a[1];
                m0 += __shfl_xor(b0 ? a[0] : a[2], 1); m1 += __shfl_xor(b0 ? a[1] : a[3], 1);
                float d = b1 ? m1 : m0;
                d += __shfl_xor(b1 ? m0 : m1, 2);
                d += __shfl_xor(d, 4); d += __shfl_xor(d, 8); d += __shfl_xor(d, 16); d += __shfl_xor(d, 32);
                const float x = d + br[e];
                const bool g0 = x > tv0, g1 = x > tv1, g2_ = x > tv2, g3 = x > tv3;
                tv3 = g2_ ? tv2 : (g3 ? x : tv3); te3 = g2_ ? te2 : (g3 ? e : te3);
                tv2 = g1 ? tv1 : (g2_ ? x : tv2); te2 = g1 ? te1 : (g2_ ? e : te2);
                tv1 = g0 ? tv0 : (g1 ? x : tv1); te1 = g0 ? te0 : (g1 ? e : te1);
                tv0 = g0 ? x : tv0; te0 = g0 ? e : te0;
            }
            const float e1 = __expf(tv1 - tv0), e2 = __expf(tv2 - tv0), e3 = __expf(tv3 - tv0);
            const float inv = 1.0f / (1.0f + e1 + e2 + e3);
            if (lane < 4) {
                const int tl = F.wave * 8 + hp * 4 + (b0 ? 2 : 0) + (b1 ? 1 : 0);
                const int rk0 = __hip_atomic_fetch_add((int*)(lcnt + te0), 1, __ATOMIC_RELAXED, __HIP_MEMORY_SCOPE_WORKGROUP);
                const int rk1 = __hip_atomic_fetch_add((int*)(lcnt + te1), 1, __ATOMIC_RELAXED, __HIP_MEMORY_SCOPE_WORKGROUP);
                const int rk2 = __hip_atomic_fetch_add((int*)(lcnt + te2), 1, __ATOMIC_RELAXED, __HIP_MEMORY_SCOPE_WORKGROUP);
                const int rk3 = __hip_atomic_fetch_add((int*)(lcnt + te3), 1, __ATOMIC_RELAXED, __HIP_MEMORY_SCOPE_WORKGROUP);
                pe[tl * 4 + 0] = te0 | (rk0 << 8); pe[tl * 4 + 1] = te1 | (rk1 << 8); pe[tl * 4 + 2] = te2 | (rk2 << 8); pe[tl * 4 + 3] = te3 | (rk3 << 8);
                pg[tl * 4 + 0] = inv; pg[tl * 4 + 1] = e1 * inv; pg[tl * 4 + 2] = e2 * inv; pg[tl * 4 + 3] = e3 * inv;
            }
        }
        __syncthreads();
        if (tid < NE && commit) { const int n = lcnt[tid]; lcnt[32 + tid] = n ? atomicAdd(&cnt[64 * tid], n) : 0; }
        __syncthreads();
        if (tid < 256 && commit) { const int w = pe[tid], ee = w & 255, p = lcnt[32 + ee] + (w >> 8), tok = chunk * 64 + (tid >> 2);
            ltok[ee * T + p] = tok; lgate[ee * T + p] = pg[tid]; tke[tok * 4 + (tid & 3)] = ee | (p << 8); }
    }
}

__device__ __forceinline__ void build_tables(const Params& P, Frame& F) {
    LAS int* trs = (LAS int*)(F.lds + LDS_TAB); LAS int* cnts = trs + 64;
    const int* cnt = (const int*)(P.ws + WS_CTL);
    if (F.tid == 0) { int a = 0; for (int e = 0; e < NE; ++e) { const int n = cnt[64 * e]; trs[e] = a; cnts[e] = n; a += (n + 255) >> 8; } trs[NE] = a; }
    __syncthreads();
}

__device__ __forceinline__ void combine_phase(const Params& P, Frame& F, const bool commit) {
    const LAS int* trs = (const LAS int*)(F.lds + LDS_TAB);
    const bf16_t* Y = (const bf16_t*)(P.ws + WS_Y); const int* tke = (const int*)(P.ws + WS_TKE);
    float* out = P.out; const int lane = F.lane;
    for (int tok = F.gw; tok < T; tok += F.ngw) {
        f32x4 a[4];
#pragma unroll
        for (int j = 0; j < 4; ++j) a[j] = *(const f32x4*)(out + (size_t)tok * DM + 4 * (lane + 64 * j));
#pragma unroll
        for (int k = 0; k < 4; ++k) { const int w = tke[tok * 4 + k], e = w & 255, p = w >> 8; const size_t slot = (size_t)trs[e] * 256 + p;
#pragma unroll
            for (int j = 0; j < 4; ++j) { const u32x2 y = *(const u32x2*)(Y + slot * DM + 4 * (lane + 64 * j)); a[j][0] += bflo(y.x); a[j][1] += bfhi(y.x); a[j][2] += bflo(y.y); a[j][3] += bfhi(y.y); } }
#pragma unroll
        for (int j = 0; j < 4; ++j) if (commit || a[j][0] == 123456.789f) *(f32x4*)(out + (size_t)tok * DM + 4 * (lane + 64 * j)) = a[j];
    }
}


#define XB_TMO      128
#define XB_XCNT(j)  (256  + 64 * (j))
#define XB_XSUB(j)  (1280 + 64 * (j))
#define XB_XGEN(j)  (2304 + 64 * (j))
#define XB_TOP      3328
#define XB_TOPGEN   3392
#define XCD_BAR_WORDS 3456
#define XB_SPIN_CAP (1u << 18)
__device__ __forceinline__ unsigned xb_ld(unsigned* p)              { return __hip_atomic_load(p, __ATOMIC_RELAXED, __HIP_MEMORY_SCOPE_AGENT); }
__device__ __forceinline__ unsigned xb_add(unsigned* p, unsigned v) { return __hip_atomic_fetch_add(p, v, __ATOMIC_RELAXED, __HIP_MEMORY_SCOPE_AGENT); }
__device__ __forceinline__ unsigned xb_xcc_id() { return (unsigned)__builtin_amdgcn_s_getreg((3 << 11) | 20) & 0xFu; }
#define XB_SPIN(cond, bar) do { unsigned _sp = 0; while (cond) { __builtin_amdgcn_s_sleep(1); \
    if ((++_sp & 255u) == 0u) { if (xb_ld(&(bar)[XB_TMO])) break; if (_sp > XB_SPIN_CAP) { atomicAdd(&(bar)[XB_TMO], 1u); break; } } } } while (0)
struct XcdBarrier { unsigned* bar; unsigned x; volatile LAS unsigned* st; };
__device__ __forceinline__ XcdBarrier xcd_barrier_post(unsigned* bar, volatile LAS unsigned* st) {
    XcdBarrier b; b.bar = bar; b.x = xb_xcc_id(); b.st = st;
    if (threadIdx.x == 0) (void)xb_add(&bar[XB_XCNT(b.x)], 1u);
    return b;
}
__device__ __forceinline__ void xcd_barrier_complete(unsigned* bar, unsigned x, unsigned& nloc, unsigned& nx) {
    const unsigned G = gridDim.x * gridDim.y * gridDim.z;
    unsigned sum, cnt, mine, sp = 0u;
    for (;;) {
        sum = 0u; cnt = 0u; mine = 0u;
#pragma unroll
        for (unsigned j = 0; j < 16; ++j) { const unsigned c = xb_ld(&bar[XB_XCNT(j)]); sum += c; cnt += (c > 0u) ? 1u : 0u; mine = (j == x) ? c : mine; }
        if (sum == G) break;
        __builtin_amdgcn_s_sleep(1);
        if ((++sp & 255u) == 0u) { if (xb_ld(&bar[XB_TMO])) break; if (sp > XB_SPIN_CAP) { atomicAdd(&bar[XB_TMO], 1u); break; } }
    }
    nloc = mine > 0u ? mine : 1u; nx = cnt > 0u ? cnt : 1u;
}
__device__ __forceinline__ void xcd_barrier(const XcdBarrier& b) {
    asm volatile("s_waitcnt vmcnt(0)" ::: "memory");
    __syncthreads();
    if (threadIdx.x == 0) {
        unsigned* bar = b.bar;
        __builtin_amdgcn_s_waitcnt(0);
        unsigned nloc = b.st[0], nx = b.st[1];
        if (nloc == 0u) { xcd_barrier_complete(bar, b.x, nloc, nx); b.st[0] = nloc; b.st[1] = nx; }
        const unsigned old = xb_add(&bar[XB_XSUB(b.x)], 1u);
        const unsigned gen = old / nloc;
        if (old + 1u == (gen + 1u) * nloc) {
            __builtin_amdgcn_fence(__ATOMIC_RELEASE, "agent");
            asm volatile("s_waitcnt vmcnt(0)" ::: "memory");
            const unsigned og = xb_add(&bar[XB_TOP], 1u);
            const unsigned tg = og / nx;
            if (og + 1u == (tg + 1u) * nx) xb_add(&bar[XB_TOPGEN], 1u);
            else XB_SPIN(xb_ld(&bar[XB_TOPGEN]) == tg, bar);
            __builtin_amdgcn_fence(__ATOMIC_ACQUIRE, "agent");
            xb_add(&bar[XB_XGEN(b.x)], 1u);
            asm volatile("s_waitcnt vmcnt(0)" ::: "memory");
        } else {
            XB_SPIN(xb_ld(&bar[XB_XGEN(b.x)]) == gen, bar);
            __builtin_amdgcn_fence(__ATOMIC_ACQUIRE, "agent");
            asm volatile("s_waitcnt vmcnt(0)" ::: "memory");
        }
    }
    __syncthreads();
}

__device__ __forceinline__ void xcd_barrier2(const XcdBarrier& b, unsigned& epoch) {
    asm volatile("s_waitcnt vmcnt(0)" ::: "memory");
    __syncthreads();
    const unsigned ep = ++epoch;
    if (threadIdx.x < 64) {
        unsigned* bar = b.bar; const unsigned lane = threadIdx.x;
        unsigned mask = 0u;
        if (lane == 0) {
            __builtin_amdgcn_s_waitcnt(0);
            unsigned nloc = b.st[0], nx = b.st[1];
            if (nloc == 0u) { xcd_barrier_complete(bar, b.x, nloc, nx); unsigned m = 0u;
#pragma unroll
                for (unsigned j = 0; j < 16; ++j) m |= (xb_ld(&bar[XB_XCNT(j)]) > 0u) ? (1u << j) : 0u;
                b.st[0] = nloc; b.st[1] = nx; b.st[2] = m; }
            mask = b.st[2];
            const unsigned old = xb_add(&bar[XB_XSUB(b.x)], 1u);
            if (old + 1u == ep * nloc) {
                __builtin_amdgcn_fence(__ATOMIC_RELEASE, "agent");
                asm volatile("s_waitcnt vmcnt(0)" ::: "memory");
                __hip_atomic_store(&bar[XB_XGEN(b.x)], ep, __ATOMIC_RELAXED, __HIP_MEMORY_SCOPE_AGENT);
            }
        }
        mask = __builtin_amdgcn_readfirstlane(mask);
        unsigned sp = 0;
        for (;;) {
            const bool need = lane < 16u && ((mask >> lane) & 1u);
            const unsigned v = need ? xb_ld(&bar[XB_XGEN(lane)]) : ep;
            if (__all(v >= ep)) break;
            __builtin_amdgcn_s_sleep(1);
            if ((++sp & 255u) == 0u) { if (xb_ld(&bar[XB_TMO])) break; if (sp > XB_SPIN_CAP) { atomicAdd(&bar[XB_TMO], 1u); break; } }
        }
        __builtin_amdgcn_fence(__ATOMIC_ACQUIRE, "agent");
        asm volatile("s_waitcnt vmcnt(0)" ::: "memory");
    }
    __syncthreads();
}

__global__ void __launch_bounds__(NTHR) fwd_megakernel(Params P) {
    extern __shared__ __attribute__((aligned(16))) unsigned char lds_raw[];
    Frame F;
    F.lds = (LAS unsigned char*)lds_raw;
    F.tid = threadIdx.x; F.lane = F.tid & 63; F.wave = __builtin_amdgcn_readfirstlane(F.tid >> 6);
    F.G = gridDim.x; { const int bx = blockIdx.x; F.vcu = (F.G % 8 == 0) ? (bx % 8) * (F.G / 8) + bx / 8 : bx; }
    F.gw = F.vcu * NWAVES + F.wave; F.ngw = F.G * NWAVES;
    unsigned char* ws = P.ws;
    LAS unsigned char* stage = F.lds + LDS_STAGE;
    volatile LAS unsigned* bst = (volatile LAS unsigned*)(F.lds + LDS_TAB + 512);
    if (F.tid < 4) bst[F.tid] = 0u;
    __syncthreads();
    const XcdBarrier bar = xcd_barrier_post((unsigned*)(ws + WS_CTL) + 4096, bst);
    LAS unsigned long long* tstamp = (LAS unsigned long long*)(F.lds + LDS_TAB + 640); int nstamp = 0;
    if (TPROBE >= 0 && blockIdx.x == 0 && F.tid == 0) tstamp[nstamp] = __builtin_amdgcn_s_memrealtime();
    ++nstamp;
    unsigned bar_epoch = 0u;
#define GRID_SYNC() do { xcd_barrier2(bar, bar_epoch); if (TPROBE >= 0 && blockIdx.x == 0 && F.tid == 0) tstamp[nstamp] = __builtin_amdgcn_s_memrealtime(); ++nstamp; } while (0)

    p0_prologue(P, F);
    if (DUP & 1) p0_prologue(P, F);
    GRID_SYNC();
    {
        pg8::DenseSched S{T / 256, NZ / 256, F.G, (int)blockIdx.x, DM, (const char*)(ws + WS_WIN), (DUP & 2) ? 2 : 1};
        pg8::EpiQKNorm E{(bf16_t*)(ws + WS_Z), P.in[3], P.in[4]};
        pg8::gemm_phase<false>(stage, (const char*)(ws + WS_XN), DM, S, E);
    }
    GRID_SYNC();
    if (DUP & 4096) { for (int q = 0; q < 10; ++q) GRID_SYNC(); }
    attn_phase(P, F);
    if (DUP & 8) attn_phase(P, F);
    ml1_phase(P, F);
    if (DUP & 16) ml1_phase(P, F);
    GRID_SYNC();
    ml2_phase(P, F);
    GRID_SYNC();
    ml3_phase(P, F);
    if (DUP & 32) ml3_phase(P, F);
    GRID_SYNC();
    {
        pg8::DenseSched S{T / 256, DM / 256, F.G, (int)blockIdx.x, DM, (const char*)(ws + WS_WOUT), (DUP & 64) ? 2 : 1};
        pg8::EpiResF32 E{P.out, P.in[0], DM};
        pg8::gemm_phase<false>(stage, (const char*)(ws + WS_MIX), DM, S, E);
    }
    GRID_SYNC();
    if (DUP & 512) router_phase(P, F, false);
    router_phase(P, F, true);
    GRID_SYNC();
    build_tables(P, F);
    const LAS int* trs = (const LAS int*)(F.lds + LDS_TAB); const LAS int* cnts = trs + 64;
    {
        pg8::MoeSched<true> S{trs, cnts, 8, F.G, (int)blockIdx.x, DM / 2, (const char*)(ws + WS_WGU), (size_t)2 * DFF * DM, (const int*)(ws + WS_LTOK)};
        pg8::EpiSwiglu E{(unsigned char*)(ws + WS_ACT), P.in[17]};
        pg8::gemm_phase<true>(stage, (const char*)(ws + WS_H8), DM / 2, S, E);
    }
    GRID_SYNC();
    {
        pg8::MoeSched<false> S{trs, cnts, 4, F.G, (int)blockIdx.x, DFF / 2, (const char*)(ws + WS_WD), (size_t)DM * DFF, nullptr};
        pg8::EpiDown E{(bf16_t*)(ws + WS_Y), P.in[19], (const float*)(ws + WS_LGATE), cnts};
        pg8::gemm_phase<true>(stage, (const char*)(ws + WS_ACT), DFF / 2, S, E);
    }
    GRID_SYNC();
    if (DUP & 1024) combine_phase(P, F, false);
    combine_phase(P, F, true);
    if (TPROBE >= 0 && blockIdx.x == 0 && F.tid == 0) {
        tstamp[nstamp] = __builtin_amdgcn_s_memrealtime();
        const unsigned long long span = tstamp[TPROBE + 1] - tstamp[TPROBE], t0_ = __builtin_amdgcn_s_memrealtime();
        while (__builtin_amdgcn_s_memrealtime() - t0_ < 4ull * span) __builtin_amdgcn_s_sleep(8);
    }
}
}

extern "C" void kernel_launch(void* const* d_in, const int* in_sizes, int n_in, void* d_out, int out_size, void* d_ws, size_t ws_size, hipStream_t stream) {
    static int grid = 0;
    if (grid == 0) {
        if (n_in != 20 || out_size != T * DM || ws_size < WS_END) { fprintf(stderr, "kernel_launch: unexpected problem (n_in %d out %d ws %zu)\n", n_in, out_size, ws_size); grid = -1; return; }
        int dev = 0, cus = 0, per_cu = 0;
        (void)hipGetDevice(&dev);
        (void)hipDeviceGetAttribute(&cus, hipDeviceAttributeMultiprocessorCount, dev);
        (void)hipFuncSetAttribute((const void*)fwd_megakernel, hipFuncAttributeMaxDynamicSharedMemorySize, LDS_BYTES);
        (void)hipOccupancyMaxActiveBlocksPerMultiprocessor(&per_cu, (const void*)fwd_megakernel, NTHR, LDS_BYTES);
        if (per_cu < 1) { fprintf(stderr, "kernel_launch: occupancy query says %d blocks per CU\n", per_cu); per_cu = 1; }
        grid = cus;
    }
    if (grid < 0) return;
    (void)hipMemsetAsync((char*)d_ws + WS_CTL, 0, 65536, stream);
    Params p{};
    for (int i = 0; i < 20; ++i) p.in[i] = (const float*)d_in[i];
    p.out = (float*)d_out; p.ws = (unsigned char*)d_ws;
    hipLaunchKernelGGL(fwd_megakernel, dim3(grid), dim3(NTHR), LDS_BYTES, stream, p);
    const hipError_t e = hipPeekAtLastError();
    if (e != hipSuccess) fprintf(stderr, "launch failed: %s (grid %d)\n", hipGetErrorString(e), grid);
}
```

```cpp
#include <hip/hip_runtime.h>
#include <cstdio>
#include <cstdint>

#define LAS __attribute__((address_space(3)))
typedef unsigned short bf16_t;
typedef short bf16x8 __attribute__((ext_vector_type(8)));
typedef short s16x4 __attribute__((ext_vector_type(4)));
typedef float f32x4 __attribute__((ext_vector_type(4)));
typedef unsigned u32x4 __attribute__((ext_vector_type(4)));
typedef unsigned u32x2 __attribute__((ext_vector_type(2)));
typedef int i32x4 __attribute__((ext_vector_type(4)));
typedef int i32x8 __attribute__((ext_vector_type(8)));

namespace {
constexpr int BATCH = 2, SEQ = 8192, T = BATCH * SEQ, DM = 1024, DIN = 3080, NZ = 3072;
constexpr int NHA = 8, NHM = 4, HDM = 128;
constexpr int NE = 32, DFF = 1024;
constexpr int CH = 256, NCH = SEQ / CH;
constexpr float EPS = 1e-6f;
constexpr float LOG2E = 1.4426950408889634f;
constexpr float SC_W = 32.f, SC_H = 8.f, SC_A = 4.f;
constexpr int ZQ = 0, ZK = 512, ZV = 1024, ZXM = 1536, ZVM = 2048, ZOM = 2560;
constexpr int NWAVES = 8, NTHR = 512;
constexpr int MAXTR = 288;
constexpr int TPROBE = -1;
constexpr int DUP = 0;
constexpr size_t MiB = 1u << 20;
constexpr size_t WS_CTL = 0;
constexpr size_t WS_WIN = 1 * MiB;
constexpr size_t WS_WOUT = 7 * MiB;
constexpr size_t WS_WQK = 9 * MiB;
constexpr size_t WS_WGU = 16 * MiB;
constexpr size_t WS_WD = 144 * MiB;
constexpr size_t WS_XN = 208 * MiB;
constexpr size_t WS_Z = 240 * MiB;
constexpr size_t WS_GATE = 336 * MiB;
constexpr size_t WS_XC = 337 * MiB;
constexpr size_t WS_QK = 353 * MiB;
constexpr size_t WS_BC = 385 * MiB;
constexpr size_t WS_IG = 385 * MiB + 512 * 1024;
constexpr size_t WS_BT = 386 * MiB;
constexpr size_t WS_NV = 386 * MiB + 4096;
constexpr size_t WS_U = 387 * MiB;
constexpr size_t WS_MIX = 403 * MiB;
constexpr size_t WS_LTOK = 435 * MiB;
constexpr size_t WS_LGATE = 437 * MiB;
constexpr size_t WS_TKE = 439 * MiB;
constexpr size_t WS_WRT = 439 * MiB + 512 * 1024;
constexpr size_t WS_H8 = 728 * MiB;
constexpr size_t WS_CS = 337 * MiB;
constexpr size_t WS_ACT = 440 * MiB;
constexpr size_t WS_Y = 584 * MiB;
constexpr size_t WS_END = 744 * MiB;
constexpr int LDS_STAGE = 0;
constexpr int LDS_TAB = 144384;
constexpr int LDS_BYTES = 144384 + 1024;

__device__ __forceinline__ unsigned f2bf(float f) { unsigned u = __builtin_bit_cast(unsigned, f); return (u + 0x7fffu + ((u >> 16) & 1u)) >> 16; }
__device__ __forceinline__ unsigned pk2(float lo, float hi) { return f2bf(lo) | (f2bf(hi) << 16); }
__device__ __forceinline__ unsigned pk4_fp8(float a, float b, float c, float d) { int w = 0; w = __builtin_amdgcn_cvt_pk_fp8_f32(a, b, w, false); w = __builtin_amdgcn_cvt_pk_fp8_f32(c, d, w, true); return (unsigned)w; }
__device__ __forceinline__ float bf2f(unsigned b) { return __builtin_bit_cast(float, b << 16); }
__device__ __forceinline__ float bflo(unsigned w) { return __builtin_bit_cast(float, w << 16); }
__device__ __forceinline__ float bfhi(unsigned w) { return __builtin_bit_cast(float, w & 0xffff0000u); }
__device__ __forceinline__ float wave_sum(float v) {
#pragma unroll
    for (int o = 1; o < 64; o <<= 1) v += __shfl_xor(v, o);
    return v;
}
__device__ __forceinline__ float sigmoidf_(float x) { return 1.0f / (1.0f + __expf(-x)); }
}

namespace pg8 {
constexpr int BM = 256, BK = 64, HALF = 128, HTB = HALF * BK * 2, STAGE_BYTES = 8 * HTB, NXCD = 8, WGM = 8;
__host__ __device__ __forceinline__ int lds_byte(int r, int c) { const int st = (r >> 4) * 2 + (c >> 5), rr = r & 15, cc = c & 31, ob = rr * 64 + cc * 2; return st * 1024 + (ob ^ (((ob >> 9) & 1) << 5)); }
__host__ __device__ __forceinline__ void stage_rc(int b, int& R, int& C) { const int st = b / 1024, sb = b % 1024, swz = sb ^ (((sb >> 9) & 1) << 5); R = (st >> 1) * 16 + swz / 64; C = (st & 1) * 32 + (swz % 64) / 2; }
__host__ __device__ __forceinline__ int perm32(int rho) { const int n = rho >> 4, i = rho & 15; return 8 * (i >> 2) + 4 * n + (i & 3); }

__device__ __forceinline__ bool tile_order(int i, int G, int c, int nM, int nN, int& pm, int& pn) {
    const int nwg = nM * nN; const long L = (long)i * G + c; if (L >= nwg) return false;
    int wgid = (int)L; { const int q = nwg / NXCD, r = nwg % NXCD, xcd = wgid % NXCD, off = wgid / NXCD; wgid = (xcd < r ? xcd * (q + 1) : r * (q + 1) + (xcd - r) * q) + off; }
    const int nig = WGM * nN, gid = wgid / nig, fm = gid * WGM, gsz = (nM - fm) < WGM ? (nM - fm) : WGM;
    pm = fm + ((wgid % nig) % gsz); pn = (wgid % nig) / gsz; return true;
}

struct Unit { int pm, pn, e, mt; };

struct DenseSched {
    int nM, nN, G, c, K; const char* Bt; int reps;
    static constexpr bool DRAIN = false, AFFINE = true;
    __device__ __forceinline__ bool next(int i, Unit& u) const { u.e = 0; u.mt = 0; const int per = (nM * nN + G - 1) / G; if (i >= per * reps) return false; if (!tile_order(i % per, G, c, nM, nN, u.pm, u.pn)) return tile_order(0, G, c, nM, nN, u.pm, u.pn); return true; }
    __device__ __forceinline__ void a_off(const Unit& u, const int (&R)[2], const int (&C)[2], unsigned (&off)[2][2]) const {
#pragma unroll
        for (int h = 0; h < 2; ++h)
#pragma unroll
            for (int i = 0; i < 2; ++i) off[h][i] = (unsigned)(((u.pm * BM + h * HALF + R[i]) * K + C[i]) * 2);
    }
    __device__ __forceinline__ const char* b_ptr(const Unit& u) const { return Bt + (size_t)u.pn * BM * K * 2; }
};
template <bool GATHER> struct MoeSched {
    const LAS int* trs; const LAS int* cnts; int nN, G, c, K; const char* Bt; size_t bstride; const int* ltok;
    static constexpr bool DRAIN = GATHER, AFFINE = !GATHER;
    __device__ __forceinline__ bool next(int i, Unit& u) const {
        const int nM = __builtin_amdgcn_readfirstlane(trs[NE]);
        if (!tile_order(i, G, c, nM, nN, u.pm, u.pn)) return false;
        const int ln = (int)(threadIdx.x & 63u); const int tv = trs[ln < NE ? ln : NE - 1];
        const int e = __popcll(__ballot(ln >= 1 && ln < NE && tv <= u.pm));
        u.e = e; u.mt = u.pm - __builtin_amdgcn_readfirstlane(trs[e]); return true;
    }
    __device__ __forceinline__ void a_rows(const Unit& u, const int (&R)[2], int (&row)[2][2]) const {
        const int n = __builtin_amdgcn_readfirstlane(cnts[u.e]);
#pragma unroll
        for (int h = 0; h < 2; ++h)
#pragma unroll
            for (int i = 0; i < 2; ++i) {
                if (GATHER) { const int p = u.mt * BM + h * HALF + R[i]; row[h][i] = (p < n) ? ltok[u.e * T + p] : 0; }
                else row[h][i] = u.pm * BM + h * HALF + R[i];
            }
    }
    __device__ __forceinline__ void a_off(const Unit& u, const int (&R)[2], const int (&C)[2], unsigned (&off)[2][2]) const {
        int row[2][2]; a_rows(u, R, row);
#pragma unroll
        for (int h = 0; h < 2; ++h)
#pragma unroll
            for (int i = 0; i < 2; ++i) off[h][i] = (unsigned)((row[h][i] * K + C[i]) * 2);
    }
    __device__ __forceinline__ const char* b_ptr(const Unit& u) const { return Bt + (size_t)u.e * bstride + (size_t)u.pn * BM * K * 2; }
};

struct EpiBf16 {
    static constexpr bool PERM = true; static constexpr int BMAP = 0;
    bf16_t* O; int ldc;
    __device__ __forceinline__ void operator()(const f32x4 (&acc)[2][2][4][2], const Unit& u, int wr, int wc, int fr, int fq) const {
        const int row0 = u.pm * BM + wr * 64 + fr, col0 = u.pn * BM + wc * 32 + 8 * fq;
#pragma unroll
        for (int ai = 0; ai < 2; ++ai)
#pragma unroll
            for (int m = 0; m < 4; ++m) { bf16_t* rowp = O + (size_t)(row0 + ai * HALF + m * 16) * ldc + col0;
#pragma unroll
                for (int bj = 0; bj < 2; ++bj) { const f32x4 v0 = acc[ai][bj][m][0], v1 = acc[ai][bj][m][1];
                    u32x4 w; w.x = pk2(v0[0], v0[1]); w.y = pk2(v0[2], v0[3]); w.z = pk2(v1[0], v1[1]); w.w = pk2(v1[2], v1[3]);
                    *(u32x4*)(rowp + bj * HALF) = w; } }
    }
};
struct EpiQKNorm {
    static constexpr bool PERM = true; static constexpr int BMAP = 1;
    bf16_t* O; const float* gq; const float* gk;
    __device__ __forceinline__ void operator()(const f32x4 (&acc)[2][2][4][2], const Unit& u, int wr, int wc, int fr, int fq) const {
        const int row0 = u.pm * BM + wr * 64 + fr, col0 = u.pn * BM + wc * 64 + 8 * fq;
        const bool nrm = u.pn < 4; const float* g = (u.pn < 2) ? gq : gk; const float qs = (u.pn < 2) ? 0.125f * LOG2E : 1.0f;
        f32x4 gv[2][2];
#pragma unroll
        for (int bj = 0; bj < 2; ++bj)
#pragma unroll
            for (int n = 0; n < 2; ++n) gv[bj][n] = nrm ? *(const f32x4*)(g + 32 * bj + 8 * fq + 4 * n) : (f32x4){1.f, 1.f, 1.f, 1.f};
#pragma unroll
        for (int ai = 0; ai < 2; ++ai)
#pragma unroll
            for (int m = 0; m < 4; ++m) { bf16_t* rowp = O + (size_t)(row0 + ai * HALF + m * 16) * NZ + col0;
                float sc = 1.0f;
                if (nrm) { float ss = 0.f;
#pragma unroll
                    for (int bj = 0; bj < 2; ++bj)
#pragma unroll
                        for (int n = 0; n < 2; ++n) { const f32x4 v = acc[ai][bj][m][n]; ss += v[0] * v[0] + v[1] * v[1] + v[2] * v[2] + v[3] * v[3]; }
                    ss += __shfl_xor(ss, 16); ss += __shfl_xor(ss, 32);
                    sc = qs / sqrtf(ss * (1.0f / 64.f) + EPS); }
#pragma unroll
                for (int bj = 0; bj < 2; ++bj) { const f32x4 v0 = acc[ai][bj][m][0] * gv[bj][0] * sc, v1 = acc[ai][bj][m][1] * gv[bj][1] * sc;
                    u32x4 w; w.x = pk2(v0[0], v0[1]); w.y = pk2(v0[2], v0[3]); w.z = pk2(v1[0], v1[1]); w.w = pk2(v1[2], v1[3]);
                    *(u32x4*)(rowp + bj * 32) = w; } }
    }
};
struct EpiResF32 {
    static constexpr bool PERM = false; static constexpr int BMAP = 0;
    float* C; const float* Rs; int ldc;
    __device__ __forceinline__ void operator()(const f32x4 (&acc)[2][2][4][2], const Unit& u, int wr, int wc, int fr, int fq) const {
        const int row0 = u.pm * BM + wr * 64 + fr, col0 = u.pn * BM + wc * 32 + 4 * fq;
#pragma unroll
        for (int ai = 0; ai < 2; ++ai)
#pragma unroll
            for (int m = 0; m < 4; ++m) { const size_t ro = (size_t)(row0 + ai * HALF + m * 16) * ldc + col0;
#pragma unroll
                for (int bj = 0; bj < 2; ++bj)
#pragma unroll
                    for (int n = 0; n < 2; ++n) { const f32x4 r = *(const f32x4*)(Rs + ro + bj * HALF + n * 16); *(f32x4*)(C + ro + bj * HALF + n * 16) = acc[ai][bj][m][n] + r; } }
    }
};
struct EpiSwiglu {
    static constexpr bool PERM = true; static constexpr int BMAP = 0;
    unsigned char* O; const float* bgu;
    __device__ __forceinline__ void operator()(const f32x4 (&acc)[2][2][4][2], const Unit& u, int wr, int wc, int fr, int fq) const {
        const int row0 = u.pm * BM + wr * 64 + fr, f0 = u.pn * HALF + wc * 32 + 8 * fq;
        const float* bg = bgu + (size_t)u.e * 2 * DFF + f0;
        constexpr float inv = 1.0f / (SC_H * SC_W);
        f32x4 bgv[2], buv[2];
#pragma unroll
        for (int n = 0; n < 2; ++n) { bgv[n] = *(const f32x4*)(bg + 4 * n); buv[n] = *(const f32x4*)(bg + DFF + 4 * n); }
#pragma unroll
        for (int ai = 0; ai < 2; ++ai)
#pragma unroll
            for (int m = 0; m < 4; ++m) { unsigned char* rowp = O + (size_t)(row0 + ai * HALF + m * 16) * DFF + f0;
                float r[8];
#pragma unroll
                for (int n = 0; n < 2; ++n) { const f32x4 gv = acc[ai][0][m][n] * inv + bgv[n], uv = acc[ai][1][m][n] * inv + buv[n];
#pragma unroll
                    for (int j = 0; j < 4; ++j) { const float gg = fminf(gv[j], 7.0f), uu = fminf(fmaxf(uv[j], -7.0f), 7.0f);
                        r[4 * n + j] = SC_A * gg * (uu + 1.0f) * __builtin_amdgcn_rcpf(1.0f + __builtin_amdgcn_exp2f(-1.702f * LOG2E * gg)); } }
                u32x2 w; w.x = pk4_fp8(r[0], r[1], r[2], r[3]); w.y = pk4_fp8(r[4], r[5], r[6], r[7]);
                *(u32x2*)rowp = w; }
    }
};
struct EpiDown {
    static constexpr bool PERM = true; static constexpr int BMAP = 0;
    bf16_t* O; const float* bd; const float* lgate; const LAS int* cnts;
    __device__ __forceinline__ void operator()(const f32x4 (&acc)[2][2][4][2], const Unit& u, int wr, int wc, int fr, int fq) const {
        const int row0 = u.pm * BM + wr * 64 + fr, col0 = u.pn * BM + wc * 32 + 8 * fq;
        const int n_e = cnts[u.e];
        f32x4 bv[2][2];
#pragma unroll
        for (int bj = 0; bj < 2; ++bj)
#pragma unroll
            for (int n = 0; n < 2; ++n) bv[bj][n] = *(const f32x4*)(bd + (size_t)u.e * DM + col0 + bj * HALF + 4 * n);
#pragma unroll
        for (int ai = 0; ai < 2; ++ai)
#pragma unroll
            for (int m = 0; m < 4; ++m) { const int rt = wr * 64 + fr + ai * HALF + m * 16, p = u.mt * BM + rt;
                const float gt = (p < n_e) ? lgate[(size_t)u.e * T + p] : 0.f;
                bf16_t* rowp = O + (size_t)(row0 + ai * HALF + m * 16) * DM + col0;
#pragma unroll
                for (int bj = 0; bj < 2; ++bj) { const f32x4 v0 = (acc[ai][bj][m][0] * (1.0f / (SC_A * SC_W)) + bv[bj][0]) * gt, v1 = (acc[ai][bj][m][1] * (1.0f / (SC_A * SC_W)) + bv[bj][1]) * gt;
                    u32x4 w; w.x = pk2(v0[0], v0[1]); w.y = pk2(v0[2], v0[3]); w.z = pk2(v1[0], v1[1]); w.w = pk2(v1[2], v1[3]);
                    *(u32x4*)(rowp + bj * HALF) = w; } }
    }
};

template <bool FP8, class Epi, class Sched>
__device__ __forceinline__ void gemm_phase(LAS unsigned char* lds, const char* A0, const int K, const Sched& S, const Epi& E) {
    int tid = threadIdx.x; asm volatile("" : "+v"(tid));
    const int wid = __builtin_amdgcn_readfirstlane(tid >> 6), lane = tid & 63, wr = wid >> 2, wc = wid & 3, fr = lane & 15, fq = lane >> 4;
    const int nt = K / BK;
    int Rr[2], Cc[2]; unsigned voffB[2];
#pragma unroll
    for (int i = 0; i < 2; ++i) { stage_rc(tid * 16 + i * 8192, Rr[i], Cc[i]); const int r5 = Epi::PERM ? perm32(Rr[i] & 31) : (Rr[i] & 31); const int Rb = Epi::BMAP ? (64 * (Rr[i] >> 5) + r5) : ((Rr[i] & ~31) + r5); voffB[i] = (unsigned)(Rb * K + Cc[i]) * 2u; }
    const size_t kstep = (size_t)(BK * 2);
    const size_t hstep = (size_t)(Epi::BMAP ? 32 : HALF) * K * 2;
    const unsigned ldsw = (unsigned)wid * 1024u;
    const int aoff = lds_byte(wr * 64 + fr, fq * 8), boff = lds_byte(wc * 32 + fr, fq * 8);
#define PG8_SA(b, h) (((b) * 2 + (h)) * HTB)
#define PG8_SB(b, h) ((4 + (b) * 2 + (h)) * HTB)
#define PG8_STAGE_B(bufoff, gbase) do { _Pragma("unroll") for (int _i = 0; _i < 2; ++_i) \
        __builtin_amdgcn_global_load_lds((const unsigned*)((const char*)(gbase) + voffB[_i]), (LAS unsigned*)(lds + (bufoff) + ldsw + _i * 8192), 16, 0, 0); } while (0)
#define PG8_STAGE_A(bufoff, gbase, o0, o1) do { \
        __builtin_amdgcn_global_load_lds((const unsigned*)((const char*)(gbase) + (o0)), (LAS unsigned*)(lds + (bufoff) + ldsw), 16, 0, 0); \
        __builtin_amdgcn_global_load_lds((const unsigned*)((const char*)(gbase) + (o1)), (LAS unsigned*)(lds + (bufoff) + ldsw + 8192), 16, 0, 0); } while (0)
#define PG8_LDA(dst, b, h) do { if constexpr (FP8) { _Pragma("unroll") for (int m = 0; m < 4; ++m) { const i32x4 lo_ = *(const LAS i32x4*)(lds + PG8_SA(b, h) + aoff + m * 2048), hi_ = *(const LAS i32x4*)(lds + PG8_SA(b, h) + aoff + m * 2048 + 1024); \
            dst##8[m] = __builtin_shufflevector(lo_, hi_, 0, 1, 2, 3, 4, 5, 6, 7); } } \
        else { _Pragma("unroll") for (int m = 0; m < 4; ++m) _Pragma("unroll") for (int k = 0; k < 2; ++k) dst[m][k] = *(const LAS bf16x8*)(lds + PG8_SA(b, h) + aoff + m * 2048 + k * 1024); } } while (0)
#define PG8_LDB(dst, b, h) do { if constexpr (FP8) { _Pragma("unroll") for (int n = 0; n < 2; ++n) { const i32x4 lo_ = *(const LAS i32x4*)(lds + PG8_SB(b, h) + boff + n * 2048), hi_ = *(const LAS i32x4*)(lds + PG8_SB(b, h) + boff + n * 2048 + 1024); \
            dst##8[n] = __builtin_shufflevector(lo_, hi_, 0, 1, 2, 3, 4, 5, 6, 7); } } \
        else { _Pragma("unroll") for (int n = 0; n < 2; ++n) _Pragma("unroll") for (int k = 0; k < 2; ++k) dst[n][k] = *(const LAS bf16x8*)(lds + PG8_SB(b, h) + boff + n * 2048 + k * 1024); } } while (0)
#define PG8_MMA(ai, bj, At, Bt) do { __builtin_amdgcn_s_setprio(1); \
        if constexpr (FP8) { _Pragma("unroll") for (int m = 0; m < 4; ++m) _Pragma("unroll") for (int n = 0; n < 2; ++n) \
            asm volatile("s_nop 1\n\tv_mfma_f32_16x16x128_f8f6f4 %0, %1, %2, %0" : "+v"(acc[ai][bj][m][n]) : "v"(Bt##8[n]), "v"(At##8[m])); } \
        else { _Pragma("unroll") for (int m = 0; m < 4; ++m) _Pragma("unroll") for (int n = 0; n < 2; ++n) _Pragma("unroll") for (int k = 0; k < 2; ++k) \
            acc[ai][bj][m][n] = __builtin_amdgcn_mfma_f32_16x16x32_bf16(Bt[n][k], At[m][k], acc[ai][bj][m][n], 0, 0, 0); } \
        __builtin_amdgcn_s_setprio(0); } while (0)
#define PG8_WAIT_V(n) asm volatile("s_waitcnt vmcnt(" #n ")" ::: "memory")
#define PG8_WAIT_L(n) asm volatile("s_waitcnt lgkmcnt(" #n ")" ::: "memory")
#define PG8_BAR __builtin_amdgcn_s_barrier()
#define PG8_SCHED __builtin_amdgcn_sched_barrier(0)
    Unit cur, nxt; int ui = 0;
    if (!S.next(0, cur)) return;
    f32x4 acc[2][2][4][2];
#pragma unroll
    for (int a = 0; a < 2; ++a)
#pragma unroll
        for (int b = 0; b < 2; ++b)
#pragma unroll
            for (int m = 0; m < 4; ++m)
#pragma unroll
                for (int n = 0; n < 2; ++n) acc[a][b][m][n] = (f32x4){0.f, 0.f, 0.f, 0.f};
    bf16x8 At[4][2], B0[2][2], B1[2][2]; i32x8 At8[4], B08[2], B18[2];
    unsigned offC[2][2], offN[2][2];
    const char* uA = A0; const char* nA = A0;
    if constexpr (Sched::AFFINE) {
#pragma unroll
        for (int h = 0; h < 2; ++h)
#pragma unroll
            for (int i = 0; i < 2; ++i) offC[h][i] = (unsigned)(((h * HALF + Rr[i]) * K + Cc[i]) * 2);
        uA = A0 + (size_t)cur.pm * BM * K * 2;
    } else S.a_off(cur, Rr, Cc, offC);
    const char* cB = S.b_ptr(cur);
    int rowP[2][2] = {{0, 0}, {0, 0}}; Unit nx2;
    if constexpr (!Sched::AFFINE) { if (S.next(1, nx2)) S.a_rows(nx2, Rr, rowP); }
    if (Sched::DRAIN) PG8_WAIT_V(0);
    PG8_STAGE_B(PG8_SB(0, 0), cB); PG8_STAGE_B(PG8_SB(0, 1), cB + hstep); PG8_STAGE_A(PG8_SA(0, 0), uA, offC[0][0], offC[0][1]); PG8_STAGE_A(PG8_SA(0, 1), uA, offC[1][0], offC[1][1]);
    if (wr == 1) PG8_BAR;
    PG8_WAIT_V(2); PG8_BAR;
    PG8_STAGE_B(PG8_SB(1, 0), cB + kstep); PG8_STAGE_A(PG8_SA(1, 0), uA + kstep, offC[0][0], offC[0][1]); PG8_STAGE_B(PG8_SB(1, 1), cB + hstep + kstep);
    PG8_WAIT_V(6); PG8_BAR;
    for (;;) {
        const bool has_next = S.next(ui + 1, nxt);
        const char* nB = cB;
        if constexpr (Sched::AFFINE) { nA = uA; if (has_next) { nA = A0 + (size_t)nxt.pm * BM * K * 2; nB = S.b_ptr(nxt); } }
        else {
            if (has_next) { nB = S.b_ptr(nxt);
#pragma unroll
                for (int h = 0; h < 2; ++h)
#pragma unroll
                    for (int i = 0; i < 2; ++i) offN[h][i] = (unsigned)((rowP[h][i] * K + Cc[i]) * 2);
                if (S.next(ui + 2, nx2)) S.a_rows(nx2, Rr, rowP);
            } else {
#pragma unroll
                for (int h = 0; h < 2; ++h)
#pragma unroll
                    for (int i = 0; i < 2; ++i) offN[h][i] = offC[h][i];
            }
        }
        for (int t = 0; t < nt; t += 2) {
            const bool last = (t == nt - 2);
            const char* a1 = uA + (size_t)(t + 1) * kstep;
            const char* a2 = last ? nA : uA + (size_t)(t + 2) * kstep; const char* b2 = last ? nB : cB + (size_t)(t + 2) * kstep;
            const char* a3 = a2 + kstep; const char* b3 = b2 + kstep;
            unsigned o00 = offC[0][0], o01 = offC[0][1], o10 = offC[1][0], o11 = offC[1][1];
            if constexpr (!Sched::AFFINE) { if (last) { o00 = offN[0][0]; o01 = offN[0][1]; o10 = offN[1][0]; o11 = offN[1][1]; } }
            PG8_LDB(B0, 0, 0); PG8_LDB(B1, 0, 1); PG8_SCHED; PG8_LDA(At, 0, 0); PG8_STAGE_A(PG8_SA(1, 1), a1, offC[1][0], offC[1][1]);
            PG8_WAIT_V(8); PG8_WAIT_L(0); PG8_BAR; PG8_MMA(0, 0, At, B0); PG8_MMA(0, 1, At, B1); PG8_BAR; PG8_SCHED;
            PG8_LDA(At, 0, 1); PG8_STAGE_B(PG8_SB(0, 0), b2); PG8_STAGE_B(PG8_SB(0, 1), b2 + hstep); PG8_STAGE_A(PG8_SA(0, 0), a2, o00, o01);
            PG8_WAIT_V(8); PG8_WAIT_L(0); PG8_BAR; PG8_MMA(1, 0, At, B0); PG8_MMA(1, 1, At, B1); PG8_BAR; PG8_SCHED;
            PG8_LDB(B0, 1, 0); PG8_LDB(B1, 1, 1); PG8_SCHED; PG8_LDA(At, 1, 0); PG8_STAGE_A(PG8_SA(0, 1), a2, o10, o11);
            PG8_WAIT_V(8); PG8_WAIT_L(0); PG8_BAR; PG8_MMA(0, 0, At, B0); PG8_MMA(0, 1, At, B1); PG8_BAR; PG8_SCHED;
            PG8_LDA(At, 1, 1); PG8_STAGE_B(PG8_SB(1, 0), b3); PG8_STAGE_B(PG8_SB(1, 1), b3 + hstep); PG8_STAGE_A(PG8_SA(1, 0), a3, o00, o01);
            PG8_WAIT_V(8); PG8_WAIT_L(0); PG8_BAR; PG8_MMA(1, 0, At, B0); PG8_MMA(1, 1, At, B1); PG8_BAR; PG8_SCHED;
        }
        if (wr == 0) PG8_BAR;
        if constexpr (FP8) {
            asm volatile("s_nop 15\n\ts_nop 15" : "+v"(acc[0][0][0][0]), "+v"(acc[0][0][0][1]), "+v"(acc[0][0][1][0]), "+v"(acc[0][0][1][1]), "+v"(acc[0][0][2][0]), "+v"(acc[0][0][2][1]), "+v"(acc[0][0][3][0]), "+v"(acc[0][0][3][1]),
                                                    "+v"(acc[0][1][0][0]), "+v"(acc[0][1][0][1]), "+v"(acc[0][1][1][0]), "+v"(acc[0][1][1][1]), "+v"(acc[0][1][2][0]), "+v"(acc[0][1][2][1]), "+v"(acc[0][1][3][0]), "+v"(acc[0][1][3][1]));
            asm volatile("s_nop 0" : "+v"(acc[1][0][0][0]), "+v"(acc[1][0][0][1]), "+v"(acc[1][0][1][0]), "+v"(acc[1][0][1][1]), "+v"(acc[1][0][2][0]), "+v"(acc[1][0][2][1]), "+v"(acc[1][0][3][0]), "+v"(acc[1][0][3][1]),
                                   "+v"(acc[1][1][0][0]), "+v"(acc[1][1][0][1]), "+v"(acc[1][1][1][0]), "+v"(acc[1][1][1][1]), "+v"(acc[1][1][2][0]), "+v"(acc[1][1][2][1]), "+v"(acc[1][1][3][0]), "+v"(acc[1][1][3][1]));
        }
        E(acc, cur, wr, wc, fr, fq);
        if (!has_next) break;
#pragma unroll
        for (int a = 0; a < 2; ++a)
#pragma unroll
            for (int b = 0; b < 2; ++b)
#pragma unroll
                for (int m = 0; m < 4; ++m)
#pragma unroll
                    for (int n = 0; n < 2; ++n) acc[a][b][m][n] = (f32x4){0.f, 0.f, 0.f, 0.f};
        cur = nxt; cB = nB; ++ui;
        if constexpr (Sched::AFFINE) uA = nA;
        else {
#pragma unroll
            for (int h = 0; h < 2; ++h)
#pragma unroll
                for (int i = 0; i < 2; ++i) offC[h][i] = offN[h][i];
        }
        if (wr == 1) PG8_BAR;
    }
    PG8_WAIT_V(0);
    PG8_BAR;
#undef PG8_SA
#undef PG8_SB
#undef PG8_STAGE_A
#undef PG8_STAGE_B
#undef PG8_LDA
#undef PG8_LDB
#undef PG8_MMA
#undef PG8_WAIT_V
#undef PG8_WAIT_L
#undef PG8_BAR
#undef PG8_SCHED
}
}

namespace {
struct Params { const float* in[20]; float* out; unsigned char* ws; };

struct Frame {
    LAS unsigned char* lds;
    int tid, lane, wave, G, vcu, gw, ngw;
};

struct ConvItem { const float* src; unsigned char* dst; int ldw, ldt, kind; float scale; };
__device__ __forceinline__ void conv_load(const ConvItem& I, f32x4 (&v)[8], int lane) {
    const int r8 = lane >> 3, c4 = (lane & 7) * 4;
#pragma unroll
    for (int i = 0; i < 8; ++i) v[i] = __builtin_nontemporal_load((const f32x4*)(I.src + (size_t)(8 * i + r8) * I.ldw + c4));
}
__device__ __forceinline__ void conv_store(const ConvItem& I, const f32x4 (&v)[8], LAS float* scr, int lane) {
    const int r8 = lane >> 3, c4 = (lane & 7) * 4;
#pragma unroll
    for (int i = 0; i < 8; ++i) { LAS float* d = scr + (8 * i + r8) * 33 + c4; d[0] = v[i][0]; d[1] = v[i][1]; d[2] = v[i][2]; d[3] = v[i][3]; }
    asm volatile("s_waitcnt lgkmcnt(0)" ::: "memory");
    const float scale = I.scale;
    if (I.kind == 0) {
        const int c = lane & 7;
#pragma unroll
        for (int j = 0; j < 4; ++j) { const int n = (lane >> 3) + 8 * j; const LAS float* s = scr + (8 * c) * 33 + n;
            u32x4 o; o.x = pk2(s[0 * 33] * scale, s[1 * 33] * scale); o.y = pk2(s[2 * 33] * scale, s[3 * 33] * scale); o.z = pk2(s[4 * 33] * scale, s[5 * 33] * scale); o.w = pk2(s[6 * 33] * scale, s[7 * 33] * scale);
            *(u32x4*)(I.dst + ((size_t)n * I.ldt + 8 * c) * 2) = o; }
    } else {
        const int n = lane >> 1, kh = lane & 1; const LAS float* s = scr + (32 * kh) * 33 + n;
        unsigned w[8];
#pragma unroll
        for (int q = 0; q < 8; ++q) w[q] = pk4_fp8(s[(4 * q) * 33] * scale, s[(4 * q + 1) * 33] * scale, s[(4 * q + 2) * 33] * scale, s[(4 * q + 3) * 33] * scale);
        unsigned char* d = I.dst + (size_t)n * I.ldt + 32 * kh;
        *(u32x4*)d = (u32x4){w[0], w[1], w[2], w[3]}; *(u32x4*)(d + 16) = (u32x4){w[4], w[5], w[6], w[7]};
    }
    asm volatile("s_waitcnt lgkmcnt(0)" ::: "memory");
}
template <class GetItem>
__device__ __forceinline__ void conv_run(GetItem get, int first, int n, int stride, LAS float* scr, int lane) {
    if (first >= n) return;
    ConvItem A, B, C; f32x4 va[8], vb[8], vc[8];
    get(first, A); conv_load(A, va, lane);
    const bool hb = first + stride < n, hc = first + 2 * stride < n;
    B = A; C = A;
    if (hb) { get(first + stride, B); conv_load(B, vb, lane); }
    if (hc) { get(first + 2 * stride, C); conv_load(C, vc, lane); }
    for (int it = first; it < n; it += stride) {
        conv_store(A, va, scr, lane);
        A = B; B = C;
#pragma unroll
        for (int i = 0; i < 8; ++i) { va[i] = vb[i]; vb[i] = vc[i]; }
        const int nx = it + 3 * stride;
        if (nx < n) { get(nx, C); conv_load(C, vc, lane); }
    }
}
constexpr int I_GU = NE * 16 * 64, I_D = NE * 16 * 32;
__device__ __forceinline__ void moe_item(const Params& P, int r, ConvItem& I) {
    I.kind = 1; I.scale = SC_W; I.ldt = DM;
    if (r < I_GU) { const int e = r >> 10, kb = (r >> 6) & 15, nb = r & 63, n0 = 32 * nb, f = n0 & 1023, up = n0 >> 10;
        const int drow = (f >> 7) * 256 + up * 128 + (f & 127);
        I.src = P.in[16] + (size_t)e * DM * 2 * DFF + (size_t)(64 * kb) * 2 * DFF + n0; I.ldw = 2 * DFF;
        I.dst = P.ws + WS_WGU + (size_t)e * 2 * DFF * DM + (size_t)drow * DM + 64 * kb;
    } else { r -= I_GU; const int e = r >> 9, kb = (r >> 5) & 15, nb = r & 31;
        I.src = P.in[18] + (size_t)e * DFF * DM + (size_t)(64 * kb) * DM + 32 * nb; I.ldw = DM;
        I.dst = P.ws + WS_WD + (size_t)e * DM * DFF + (size_t)(32 * nb) * DFF + 64 * kb; }
}
__device__ __forceinline__ void moe_convert(const Params& P, Frame& F, int cw, int ncw) {
    LAS float* scr = (LAS float*)(F.lds + F.wave * 8448);
    conv_run([&](int r, ConvItem& I) { moe_item(P, r, I); }, cw, I_GU + I_D, ncw, scr, F.lane);
}

__device__ __forceinline__ void p0_prologue(const Params& P, Frame& F) {
    unsigned char* ws = P.ws;
    const float* w_in = P.in[2];
    LAS float* scr = (LAS float*)(F.lds + F.wave * 8448);
    LAS float* gwl = (LAS float*)(F.lds + 73728);
    for (int i = F.tid; i < 1024 * 8; i += NTHR) gwl[(i & 7) * 1024 + (i >> 3)] = w_in[(size_t)(i >> 3) * DIN + NZ + (i & 7)];
    __syncthreads();
    constexpr int I_IN = 16 * 96, I_OUT = 16 * 32, I_QK = 8 * 2 * 4, I_ZERO = 8 * 3;
    bf16_t* WqkT = (bf16_t*)(ws + WS_WQK);
    conv_run([&](int r, ConvItem& I) {
        I.kind = 0; I.scale = 1.f;
        if (r < I_IN) { const int kb = r / 96, nb = r % 96; I.src = w_in + (size_t)(64 * kb) * DIN + 32 * nb; I.ldw = DIN; I.dst = ws + WS_WIN + ((size_t)(32 * nb) * DM + 64 * kb) * 2; I.ldt = DM; return; }
        r -= I_IN;
        if (r < I_OUT) { const int kb = r / 32, nb = r % 32; I.src = P.in[12] + (size_t)(64 * kb) * DM + 32 * nb; I.ldw = DM; I.dst = ws + WS_WOUT + ((size_t)(32 * nb) * DM + 64 * kb) * 2; I.ldt = DM; return; }
        r -= I_OUT;
        { const int isk = r >> 5, h = (r >> 3) & 3, kb = (r >> 2) & 1, nb = r & 3;
            I.src = P.in[isk ? 8 : 7] + (size_t)h * 16384 + (size_t)(64 * kb) * 128 + 32 * nb; I.ldw = 128;
            I.dst = ws + WS_WQK + ((size_t)(isk * 512 + h * 128 + 32 * nb) * 512 + h * 128 + 64 * kb) * 2; I.ldt = 512; I.scale = isk ? 0.08838834764831845f : 1.f; }
    }, F.gw, I_IN + I_OUT + I_QK, F.ngw, scr, F.lane);
    moe_convert(P, F, F.gw, F.ngw);
    for (int r = F.gw; r < I_ZERO; r += F.ngw) {
        const int rb = r / 3, j = r % 3, cb = j + (j >= (rb & 3) ? 1 : 0);
        for (int q = F.lane; q < 128 * 16; q += 64) { const int rr = q >> 4, cc = q & 15; *(u32x4*)(WqkT + (size_t)(rb * 128 + rr) * 512 + cb * 128 + cc * 8) = (u32x4){0u, 0u, 0u, 0u}; }
    }
    {
        const float* wr = P.in[14]; float* wrt = (float*)(ws + WS_WRT);
        for (int idx = F.vcu * NTHR + F.tid; idx < DM * NE; idx += F.G * NTHR) wrt[(idx & 31) * DM + (idx >> 5)] = wr[idx];
    }
    const float* x = P.in[0]; const float* g1 = P.in[1];
    bf16_t* XN = (bf16_t*)(ws + WS_XN); float* GATE = (float*)(ws + WS_GATE);
    for (int row0 = F.gw; row0 < T; row0 += 2 * F.ngw) {
        f32x4 vv[2][4];
#pragma unroll
        for (int q = 0; q < 2; ++q) { const int row = row0 + q * F.ngw; const f32x4* xr = (const f32x4*)(x + (size_t)(row < T ? row : row0) * DM);
#pragma unroll
            for (int j = 0; j < 4; ++j) vv[q][j] = __builtin_nontemporal_load(xr + F.lane + 64 * j); }
#pragma unroll
        for (int q = 0; q < 2; ++q) {
            const int row = row0 + q * F.ngw; if (row >= T) break;
            float s = 0.f;
#pragma unroll
            for (int j = 0; j < 4; ++j) s += vv[q][j][0] * vv[q][j][0] + vv[q][j][1] * vv[q][j][1] + vv[q][j][2] * vv[q][j][2] + vv[q][j][3] * vv[q][j][3];
            s = wave_sum(s);
            const float rs = 1.0f / sqrtf(s * (1.0f / DM) + EPS);
            float ga[8];
#pragma unroll
            for (int c = 0; c < 8; ++c) ga[c] = 0.f;
#pragma unroll
            for (int j = 0; j < 4; ++j) { const f32x4 gg = ((const f32x4*)g1)[F.lane + 64 * j]; const f32x4 v = vv[q][j] * rs * gg;
                u32x2 w; w.x = pk2(v[0], v[1]); w.y = pk2(v[2], v[3]);
                *(u32x2*)(XN + (size_t)row * DM + 4 * (F.lane + 64 * j)) = w;
#pragma unroll
                for (int c = 0; c < 8; ++c) { const f32x4 wc = *(const LAS f32x4*)(gwl + c * 1024 + 4 * (F.lane + 64 * j)); ga[c] += v[0] * wc[0] + v[1] * wc[1] + v[2] * wc[2] + v[3] * wc[3]; } }
#pragma unroll
            for (int c = 0; c < 8; ++c) ga[c] = wave_sum(ga[c]);
            if (F.lane == 0) { *(f32x4*)(GATE + (size_t)row * 8) = (f32x4){ga[0], ga[1], ga[2], ga[3]}; *(f32x4*)(GATE + (size_t)row * 8 + 4) = (f32x4){ga[4], ga[5], ga[6], ga[7]}; }
        }
    }
}

#define MFMA16(a, b, c) __builtin_amdgcn_mfma_f32_16x16x32_bf16((a), (b), (c), 0, 0, 0)
struct AttBlk { int tlb, off, d, qb, m, b, h, pass, tt, edge; };
__device__ __forceinline__ void att_decode(int fb, int w, int vcu, int G, AttBlk& k) {
    const int ul = fb / 30, r = fb - 30 * ul, t6 = r / 5; k.m = r - 5 * t6; k.pass = t6 >> 1; k.tt = t6 & 1;
    const int unit = vcu + ul * G; k.tlb = (unit & 31) * 256; k.h = (unit >> 5) & 7; k.b = unit >> 8;
    const int tau = 2 * w + k.tt; k.d = 1 << (2 * k.pass);
    k.off = k.pass == 0 ? 0 : (k.pass == 1 ? (tau & 3) : tau); k.qb = k.pass == 0 ? 16 * tau : (k.pass == 1 ? 16 * (tau >> 2) : 0);
    const int p0 = k.tlb + k.off; k.edge = (p0 + (k.qb - 144) * k.d < 0) || (p0 + (k.qb + 15) * k.d > SEQ - 1);
}
__device__ __forceinline__ void attn_phase(const Params& P, Frame& F) {
    const bf16_t* Z = (const bf16_t*)(P.ws + WS_Z); bf16_t* MIX = (bf16_t*)(P.ws + WS_MIX);
    const int tid = F.tid;
    const int lane = tid & 63, i = lane & 15, g = lane >> 4, w = F.wave;
    float gm = fabsf(P.in[4][lane]);
#pragma unroll
    for (int o = 1; o < 64; o <<= 1) gm = fmaxf(gm, __shfl_xor(gm, o));
    const float kmax = 8.0f * gm * 1.01f;
    constexpr int OP = 272;
    LAS unsigned char* OL = F.lds;
    LAS float* LL = (LAS float*)(F.lds + 256 * OP);
    LAS unsigned char* vb = F.lds + 256 * OP + 1024 + w * 4608;
    const int vwr = (lane >> 3) * 144 + (lane & 7) * 16;
    const int vrd = (4 * g + (i >> 2)) * 144 + (i & 3) * 8;
    const int nunits = (512 - F.vcu + F.G - 1) / F.G, NFB = 30 * nunits;
    if (NFB <= 0) return;
#define ATT_WGBAR() do { asm volatile("s_waitcnt lgkmcnt(0)" ::: "memory"); __builtin_amdgcn_s_barrier(); asm volatile("" ::: "memory"); } while (0)
#define ATT_LOAD(kd, kfn, vrn) do { const bf16_t* Kh_ = Z + (size_t)(kd).b * SEQ * NZ + ZK + (kd).h * 64 + 8 * g; const bf16_t* Vh_ = Z + (size_t)(kd).b * SEQ * NZ + ZV + (kd).h * 64 + 8 * (lane & 7); \
        const int nb_ = (kd).qb - 144 + 32 * (kd).m, p0_ = (kd).tlb + (kd).off; \
        if ((kd).edge) { \
        _Pragma("unroll") for (int sb = 0; sb < 2; ++sb) { int kp = p0_ + (nb_ + 16 * sb + i) * (kd).d; kp = kp < 0 ? 0 : (kp > SEQ - 1 ? SEQ - 1 : kp); const bf16_t* kr = Kh_ + (size_t)kp * NZ; kfn[sb][0] = *(const bf16x8*)kr; kfn[sb][1] = *(const bf16x8*)(kr + 32); } \
        _Pragma("unroll") for (int c = 0; c < 4; ++c) { int kp = p0_ + (nb_ + 8 * c + (lane >> 3)) * (kd).d; kp = kp < 0 ? 0 : (kp > SEQ - 1 ? SEQ - 1 : kp); vrn[c] = *(const u32x4*)(Vh_ + (size_t)kp * NZ); } \
        } else { const size_t dz_ = (size_t)(kd).d * NZ; const bf16_t* kr0 = Kh_ + (size_t)(p0_ + (nb_ + i) * (kd).d) * NZ; const bf16_t* vr0 = Vh_ + (size_t)(p0_ + (nb_ + (lane >> 3)) * (kd).d) * NZ; \
        _Pragma("unroll") for (int sb = 0; sb < 2; ++sb) { const bf16_t* kr = kr0 + 16 * sb * dz_; kfn[sb][0] = *(const bf16x8*)kr; kfn[sb][1] = *(const bf16x8*)(kr + 32); } \
        _Pragma("unroll") for (int c = 0; c < 4; ++c) vrn[c] = *(const u32x4*)(vr0 + 8 * c * dz_); } } while (0)
#define ATT_LOADQ(kd, q0_, q1_) do { const bf16_t* qr_ = Z + (size_t)((kd).b * SEQ + (kd).tlb + (kd).off + (kd).d * ((kd).qb + i)) * NZ + ZQ + (kd).h * 64 + 8 * g; q0_ = *(const bf16x8*)qr_; q1_ = *(const bf16x8*)(qr_ + 32); } while (0)
    bf16x8 kfa[2][2], kfb[2][2]; u32x4 vra[4], vrb[4]; bf16x8 qn0, qn1, qf0, qf1;
    AttBlk cur, nx;
    att_decode(0, w, F.vcu, F.G, cur);
    ATT_LOADQ(cur, qn0, qn1);
    ATT_LOAD(cur, kfa, vra);
    att_decode(1, w, F.vcu, F.G, nx); ATT_LOAD(nx, kfb, vrb);
    f32x4 o[4]; float lsum = 0.f, ref = 0.f, slope2 = 0.f;
    __syncthreads();
#pragma unroll 1
    for (int fb = 0; fb < NFB; ++fb) {
        att_decode(fb, w, F.vcu, F.G, cur);
        if (cur.m == 0) {
            qf0 = qn0; qf1 = qn1;
            if (fb + 5 < NFB) { att_decode(fb + 5, w, F.vcu, F.G, nx); ATT_LOADQ(nx, qn0, qn1); }
            float ss = 0.f;
#pragma unroll
            for (int j = 0; j < 8; ++j) { const float a = bf2f((unsigned short)qf0[j]), c = bf2f((unsigned short)qf1[j]); ss += a * a + c * c; }
            ss += __shfl_xor(ss, 16); ss += __shfl_xor(ss, 32);
            ref = sqrtf(ss) * kmax; slope2 = exp2f(-(float)(cur.h + 1)) * LOG2E;
#pragma unroll
            for (int dt = 0; dt < 4; ++dt) o[dt] = (f32x4){0.f, 0.f, 0.f, 0.f};
            lsum = 0.f;
        }
        bf16x8 kf[2][2]; u32x4 vr[4];
#pragma unroll
        for (int sb = 0; sb < 2; ++sb) { kf[sb][0] = kfa[sb][0]; kf[sb][1] = kfa[sb][1]; kfa[sb][0] = kfb[sb][0]; kfa[sb][1] = kfb[sb][1]; }
#pragma unroll
        for (int c = 0; c < 4; ++c) { vr[c] = vra[c]; vra[c] = vrb[c]; }
        if (fb + 2 < NFB) { att_decode(fb + 2, w, F.vcu, F.G, nx); ATT_LOAD(nx, kfb, vrb); }
        const int d = cur.d, qb = cur.qb, nb = qb - 144 + 32 * cur.m, p0 = cur.tlb + cur.off;
#pragma unroll
        for (int c = 0; c < 4; ++c) *(LAS u32x4*)(vb + vwr + c * 8 * 144) = vr[c];
        f32x4 s[2];
#pragma unroll
        for (int sb = 0; sb < 2; ++sb) { s[sb] = MFMA16(kf[sb][0], qf0, ((f32x4){0.f, 0.f, 0.f, 0.f})); s[sb] = MFMA16(kf[sb][1], qf1, s[sb]); }
        float p[8];
        if (!cur.edge && cur.m >= 1 && cur.m <= 3) {
            const float a0 = (float)((qb + i - nb - 4 * g) * d);
            const float base = -slope2 * a0 - ref, st = slope2 * (float)d;
#pragma unroll
            for (int sb = 0; sb < 2; ++sb)
#pragma unroll
                for (int j = 0; j < 4; ++j) { const float pv = __builtin_amdgcn_exp2f(s[sb][j] + (base + st * (float)(16 * sb + j))); p[4 * sb + j] = pv; lsum += pv; }
        } else {
#pragma unroll
        for (int sb = 0; sb < 2; ++sb)
#pragma unroll
            for (int j = 0; j < 4; ++j) { const int n = nb + 16 * sb + 4 * g + j, a = qb + i - n;
                const bool valid = (a >= 0) && (a <= 128) && (p0 + n * d >= 0);
                const float e = s[sb][j] - slope2 * (float)(a * d) - ref;
                const float pv = valid ? __builtin_amdgcn_exp2f(e) : 0.f;
                p[4 * sb + j] = pv; lsum += pv; }
        }
        u32x4 pw; pw.x = pk2(p[0], p[1]); pw.y = pk2(p[2], p[3]); pw.z = pk2(p[4], p[5]); pw.w = pk2(p[6], p[7]);
        const bf16x8 pf = __builtin_bit_cast(bf16x8, pw);
#pragma unroll
        for (int dt = 0; dt < 4; ++dt) {
            const s16x4 v0 = __builtin_amdgcn_ds_read_tr16_b64_v4i16((LAS s16x4*)(vb + vrd + dt * 32));
            const s16x4 v1 = __builtin_amdgcn_ds_read_tr16_b64_v4i16((LAS s16x4*)(vb + vrd + 16 * 144 + dt * 32));
            const bf16x8 vf = (bf16x8){v0[0], v0[1], v0[2], v0[3], v1[0], v1[1], v1[2], v1[3]};
            o[dt] = MFMA16(vf, pf, o[dt]);
        }
        if (cur.m == 4) {
            float ls = lsum; ls += __shfl_xor(ls, 16); ls += __shfl_xor(ls, 32);
            const int row = cur.off + d * (qb + i);
            LAS f32x4* orow = (LAS f32x4*)(OL + row * OP + 16 * g);
            if (cur.pass == 0) {
#pragma unroll
                for (int dt = 0; dt < 4; ++dt) orow[4 * dt] = o[dt];
                if (g == 0) LL[row] = ls;
            } else {
#pragma unroll
                for (int dt = 0; dt < 4; ++dt) orow[4 * dt] = orow[4 * dt] + o[dt];
                if (g == 0) LL[row] += ls;
            }
            if (cur.tt == 1) {
                ATT_WGBAR();
                if (cur.pass == 2) {
                    const int rw = tid >> 1, hf = tid & 1;
                    const float inv = 1.0f / LL[rw];
                    const LAS f32x4* orw = (const LAS f32x4*)(OL + rw * OP + hf * 128);
                    bf16_t* mrow = MIX + (size_t)(cur.b * SEQ + cur.tlb + rw) * DM + cur.h * 64 + hf * 32;
#pragma unroll
                    for (int q = 0; q < 4; ++q) { const f32x4 a0 = orw[2 * q] * inv, a1 = orw[2 * q + 1] * inv;
                        u32x4 wv_; wv_.x = pk2(a0[0], a0[1]); wv_.y = pk2(a0[2], a0[3]); wv_.z = pk2(a1[0], a1[1]); wv_.w = pk2(a1[2], a1[3]);
                        *(u32x4*)(mrow + 8 * q) = wv_; }
                    ATT_WGBAR();
                }
            }
        }
    }
#undef ATT_LOAD
#undef ATT_LOADQ
#undef ATT_WGBAR
    __syncthreads();
}

__device__ __forceinline__ bf16x8 tr2(LAS unsigned char* p0, LAS unsigned char* p1) {
    const s16x4 a = __builtin_amdgcn_ds_read_tr16_b64_v4i16((LAS s16x4*)p0);
    const s16x4 b = __builtin_amdgcn_ds_read_tr16_b64_v4i16((LAS s16x4*)p1);
    return (bf16x8){a[0], a[1], a[2], a[3], b[0], b[1], b[2], b[3]};
}

__device__ __forceinline__ void ml1_phase(const Params& P, Frame& F) {
    const bf16_t* Z = (const bf16_t*)(P.ws + WS_Z); bf16_t* QK = (bf16_t*)(P.ws + WS_QK); const float* GATE = (const float*)(P.ws + WS_GATE);
    const bf16_t* WqkT = (const bf16_t*)(P.ws + WS_WQK);
    float* BC = (float*)(P.ws + WS_BC); float* IG = (float*)(P.ws + WS_IG); float* BT = (float*)(P.ws + WS_BT); float* U = (float*)(P.ws + WS_U); float* NV = (float*)(P.ws + WS_NV);
    const float* bi = P.in[9]; const float* bf = P.in[10]; const float* cw = P.in[5]; const float* cb = P.in[6];
    constexpr int PIT = 272;
    LAS unsigned char* KIM = F.lds; LAS unsigned char* VIM = F.lds + 128 * PIT; LAS unsigned char* XIM = F.lds + 2 * 128 * PIT;
    LAS float* bc = (LAS float*)(F.lds + 3 * 128 * PIT); LAS float* wv = bc + 256;
    const int tid = F.tid;
    const int lane = tid & 63, i = lane & 15, g = lane >> 4, w = F.wave;
    bf16x8 ones;
#pragma unroll
    for (int j = 0; j < 8; ++j) ones[j] = (i == 0) ? (short)0x3F80 : (short)0;
    for (int unit = F.vcu; unit < 256; unit += F.G) {
        const int bh = unit / NCH, c = unit % NCH, b = bh / NHM, h = bh % NHM, t0 = b * SEQ + c * CH;
        float ig = 0.f;
        __syncthreads();
        if (tid < 256) { const float f = GATE[(size_t)(t0 + tid) * 8 + 4 + h] + bf[h];
            bc[tid] = fminf(f, 0.f) - log1pf(__expf(-fabsf(f)));
            ig = GATE[(size_t)(t0 + tid) * 8 + h] + bi[h]; }
        __syncthreads();
        if (w == 0) {
            const f32x4 a = *(const LAS f32x4*)(bc + 4 * lane);
            const float s1 = a[0], s2 = s1 + a[1], s3 = s2 + a[2], s4 = s3 + a[3];
            float x = s4;
#pragma unroll
            for (int off = 1; off < 64; off <<= 1) { const float v = __shfl_up(x, off); if (lane >= off) x += v; }
            const float ex = x - s4;
            *(LAS f32x4*)(bc + 4 * lane) = (f32x4){ex + s1, ex + s2, ex + s3, ex + s4};
        }
        __syncthreads();
        if (tid < 256) { BC[(size_t)(t0 + tid) * 4 + h] = bc[tid]; IG[(size_t)(t0 + tid) * 4 + h] = ig; wv[tid] = __expf(bc[255] - bc[tid] + ig); }
        if (tid == 0) BT[unit] = bc[255];
        bf16x8 wf[2][4];
#pragma unroll
        for (int e2 = 0; e2 < 2; ++e2) { const bf16_t* wp = WqkT + (size_t)((w >> 2) * 512 + h * 128 + 32 * (w & 3) + 16 * e2 + i) * 512 + h * 128 + 8 * g;
#pragma unroll
            for (int ks = 0; ks < 4; ++ks) wf[e2][ks] = *(const bf16x8*)(wp + 32 * ks); }
        f32x4 acc[9];
#pragma unroll
        for (int q = 0; q < 9; ++q) acc[q] = (f32x4){0.f, 0.f, 0.f, 0.f};
        for (int half = 0; half < 2; ++half) {
            __syncthreads();
#pragma unroll
            for (int q = 0; q < 4; ++q) { const int id = tid + 512 * q, row = id >> 4, c8 = (id & 15) * 8, sidx = half * 128 + row, tok = t0 + sidx, tl = c * CH + sidx;
                const int ch = h * 128 + c8;
                float a[8];
                { const f32x4 b0 = *(const f32x4*)(cb + ch), b1 = *(const f32x4*)(cb + ch + 4); a[0] = b0[0]; a[1] = b0[1]; a[2] = b0[2]; a[3] = b0[3]; a[4] = b1[0]; a[5] = b1[1]; a[6] = b1[2]; a[7] = b1[3]; }
#pragma unroll
                for (int j = 0; j < 4; ++j) { const int dt = 3 - j; if (tl - dt >= 0) {
                        const u32x4 xw = *(const u32x4*)(Z + (size_t)(tok - dt) * NZ + ZXM + ch);
                        const f32x4 w0 = *(const f32x4*)(cw + j * 512 + ch), w1 = *(const f32x4*)(cw + j * 512 + ch + 4);
                        a[0] += w0[0] * bflo(xw.x); a[1] += w0[1] * bfhi(xw.x); a[2] += w0[2] * bflo(xw.y); a[3] += w0[3] * bfhi(xw.y);
                        a[4] += w1[0] * bflo(xw.z); a[5] += w1[1] * bfhi(xw.z); a[6] += w1[2] * bflo(xw.w); a[7] += w1[3] * bfhi(xw.w); } }
#pragma unroll
                for (int j = 0; j < 8; ++j) a[j] = a[j] * sigmoidf_(a[j]);
                u32x4 o; o.x = pk2(a[0], a[1]); o.y = pk2(a[2], a[3]); o.z = pk2(a[4], a[5]); o.w = pk2(a[6], a[7]);
                *(LAS u32x4*)(XIM + row * PIT + c8 * 2) = o;
                *(LAS u32x4*)(VIM + row * PIT + c8 * 2) = *(const u32x4*)(Z + (size_t)tok * NZ + ZVM + ch); }
            __syncthreads();
#pragma unroll 2
            for (int tt = 0; tt < 8; ++tt) {
                bf16x8 xf[4];
#pragma unroll
                for (int ks = 0; ks < 4; ++ks) xf[ks] = *(const LAS bf16x8*)(XIM + (16 * tt + i) * PIT + (32 * ks + 8 * g) * 2);
                const int trow = 16 * tt + i, sidx = half * 128 + trow; const float ws_ = wv[sidx];
                bf16_t* qkrow = QK + (size_t)(t0 + sidx) * 1024 + (w >> 2) * 512 + h * 128 + 32 * (w & 3) + 4 * g;
#pragma unroll
                for (int e2 = 0; e2 < 2; ++e2) {
                    f32x4 d = (f32x4){0.f, 0.f, 0.f, 0.f};
#pragma unroll
                    for (int ks = 0; ks < 4; ++ks) d = MFMA16(wf[e2][ks], xf[ks], d);
                    u32x2 o; o.x = pk2(d[0], d[1]); o.y = pk2(d[2], d[3]);
                    *(u32x2*)(qkrow + 16 * e2) = o;
                    if (w >= 4) { u32x2 ok; ok.x = pk2(d[0] * ws_, d[1] * ws_); ok.y = pk2(d[2] * ws_, d[3] * ws_); *(LAS u32x2*)(KIM + trow * PIT + (32 * (w & 3) + 16 * e2 + 4 * g) * 2) = ok; }
                }
            }
            __syncthreads();
#pragma unroll
            for (int kk = 0; kk < 4; ++kk) {
                const int ro = (32 * kk + 8 * g + (i >> 2)) * PIT + (i & 3) * 8;
                const bf16x8 af = tr2(KIM + ro + 32 * w, KIM + ro + 4 * PIT + 32 * w);
#pragma unroll
                for (int et = 0; et < 8; ++et) { const bf16x8 bfr = tr2(VIM + ro + 32 * et, VIM + ro + 4 * PIT + 32 * et); acc[et] = MFMA16(af, bfr, acc[et]); }
                acc[8] = MFMA16(af, ones, acc[8]);
            }
        }
        float* up = U + (size_t)unit * 16384 + (size_t)(16 * w + 4 * g) * 128 + i;
#pragma unroll
        for (int et = 0; et < 8; ++et)
#pragma unroll
            for (int j = 0; j < 4; ++j) up[j * 128 + 16 * et] = acc[et][j];
        if (i == 0) {
#pragma unroll
            for (int j = 0; j < 4; ++j) NV[unit * 128 + 16 * w + 4 * g + j] = acc[8][j];
        }
    }
}

__device__ __forceinline__ void ml2_phase(const Params& P, Frame& F) {
    const float* BT = (const float*)(P.ws + WS_BT); const float* U = (const float*)(P.ws + WS_U); const float* NV = (const float*)(P.ws + WS_NV);
    bf16_t* CS = (bf16_t*)(P.ws + WS_CS); float* NS = (float*)(P.ws + WS_CS + 8 * MiB);
    for (int item = F.vcu; item < 256; item += F.G) {
        const int bh = item >> 5, sl = item & 31, el = sl * 512 + F.tid;
        float u[NCH];
#pragma unroll
        for (int c = 0; c < NCH; ++c) u[c] = U[(size_t)(bh * NCH + c) * 16384 + el];
        float st = 0.f;
#pragma unroll
        for (int c = 0; c < NCH; ++c) { CS[(size_t)(bh * NCH + c) * 16384 + el] = (bf16_t)f2bf(st); st = __expf(BT[bh * NCH + c]) * st + u[c]; }
        if (sl == 0 && F.tid < 128) { float n = 0.f;
            for (int c = 0; c < NCH; ++c) { NS[(bh * NCH + c) * 128 + F.tid] = n; n = __expf(BT[bh * NCH + c]) * n + NV[(bh * NCH + c) * 128 + F.tid]; } }
    }
}

__device__ __forceinline__ void ml3_phase(const Params& P, Frame& F) {
    const bf16_t* Z = (const bf16_t*)(P.ws + WS_Z); const bf16_t* QK = (const bf16_t*)(P.ws + WS_QK);
    const float* BC = (const float*)(P.ws + WS_BC); const float* IG = (const float*)(P.ws + WS_IG); const float* BT = (const float*)(P.ws + WS_BT);
    const float* U = (const float*)(P.ws + WS_U); const float* NV = (const float*)(P.ws + WS_NV); const float* gn = P.in[11];
    bf16_t* MIX = (bf16_t*)(P.ws + WS_MIX);
    constexpr int CP = 288, VP = 272;
    LAS unsigned char* CIM = F.lds;
    LAS unsigned char* VIM = F.lds + 128 * CP;
    LAS float* cs = (LAS float*)(F.lds + 128 * CP + 256 * VP);
    LAS float* bq = cs + 256;
    const int tid = F.tid;
    const int lane = tid & 63, i = lane & 15, g = lane >> 4, w = F.wave;
    for (int unit = F.vcu; unit < 256; unit += F.G) {
        const int bh = unit / NCH, c = unit % NCH, b = bh / NHM, h = bh % NHM, t0 = b * SEQ + c * CH;
        __syncthreads();
#pragma unroll
        for (int q = 0; q < 8; ++q) { const int id = tid + 512 * q, row = id >> 4, c8 = (id & 15) * 8;
            *(LAS u32x4*)(VIM + row * VP + c8 * 2) = *(const u32x4*)(Z + (size_t)(t0 + row) * NZ + ZVM + h * 128 + c8); }
        if (tid < 256) { const float bb = BC[(size_t)(t0 + tid) * 4 + h]; bq[tid] = bb; cs[tid] = IG[(size_t)(t0 + tid) * 4 + h] - bb; }
        {   const bf16_t* cs = (const bf16_t*)(P.ws + WS_CS) + (size_t)unit * 16384; const float* ns = (const float*)(P.ws + WS_CS + 8 * MiB) + unit * 128;
#pragma unroll
            for (int q = 0; q < 4; ++q) { const int id = tid + 512 * q, d = id >> 4, e8 = (id & 15) * 8; *(LAS u32x4*)(CIM + d * CP + e8 * 2) = *(const u32x4*)(cs + d * 128 + e8); }
            if (tid < 128) { *(LAS u32x4*)(CIM + tid * CP + 256) = (u32x4){f2bf(ns[tid]), 0u, 0u, 0u}; *(LAS u32x4*)(CIM + tid * CP + 272) = (u32x4){0u, 0u, 0u, 0u}; }
        }
        __syncthreads();
#pragma unroll 1
        for (int a = 0; a < 2; ++a) {
            const int qt = a ? 15 - w : w;
            bf16x8 qf[4];
            { const bf16_t* qp = QK + (size_t)(t0 + 16 * qt + i) * 1024 + h * 128 + 8 * g;
#pragma unroll
                for (int ks = 0; ks < 4; ++ks) qf[ks] = *(const bf16x8*)(qp + 32 * ks); }
            const float bt = bq[16 * qt + i];
            f32x4 acc[8]; float den;
            {
                f32x4 a8 = (f32x4){0.f, 0.f, 0.f, 0.f};
#pragma unroll
                for (int et = 0; et < 8; ++et) acc[et] = (f32x4){0.f, 0.f, 0.f, 0.f};
#pragma unroll
                for (int ks = 0; ks < 4; ++ks) {
                    const int ro = (32 * ks + 8 * g + (i >> 2)) * CP + (i & 3) * 8;
#pragma unroll
                    for (int et = 0; et < 8; ++et) { const bf16x8 cf = tr2(CIM + ro + 32 * et, CIM + ro + 4 * CP + 32 * et); acc[et] = MFMA16(cf, qf[ks], acc[et]); }
                    const bf16x8 cf = tr2(CIM + ro + 256, CIM + ro + 4 * CP + 256);
                    a8 = MFMA16(cf, qf[ks], a8);
                }
                const float eb = __expf(bt);
#pragma unroll
                for (int et = 0; et < 8; ++et) acc[et] = acc[et] * eb;
                den = (g == 0) ? a8[0] * eb : 0.f;
            }
            const int kbhi = qt >> 1;
#pragma unroll 1
            for (int kb = 0; kb <= kbhi; ++kb) {
                float p[8];
#pragma unroll
                for (int sb = 0; sb < 2; ++sb) {
                    const bf16_t* kp = QK + (size_t)(t0 + 32 * kb + 16 * sb + i) * 1024 + 512 + h * 128 + 8 * g;
                    f32x4 sacc = (f32x4){0.f, 0.f, 0.f, 0.f};
#pragma unroll
                    for (int ks = 0; ks < 4; ++ks) { const bf16x8 kf = *(const bf16x8*)(kp + 32 * ks); sacc = MFMA16(kf, qf[ks], sacc); }
                    const f32x4 cv = *(const LAS f32x4*)(cs + 32 * kb + 16 * sb + 4 * g);
#pragma unroll
                    for (int j = 0; j < 4; ++j) { const int srow = 32 * kb + 16 * sb + 4 * g + j, tcol = 16 * qt + i;
                        const float pv = (srow <= tcol) ? sacc[j] * __expf(bt + cv[j]) : 0.f;
                        p[4 * sb + j] = pv; den += pv; } }
                u32x4 pw; pw.x = pk2(p[0], p[1]); pw.y = pk2(p[2], p[3]); pw.z = pk2(p[4], p[5]); pw.w = pk2(p[6], p[7]);
                const bf16x8 pf = __builtin_bit_cast(bf16x8, pw);
                const int ro = (32 * kb + 4 * g + (i >> 2)) * VP + (i & 3) * 8;
#pragma unroll
                for (int et = 0; et < 8; ++et) { const bf16x8 vf = tr2(VIM + ro + 32 * et, VIM + ro + 16 * VP + 32 * et); acc[et] = MFMA16(vf, pf, acc[et]); }
            }
            float dn = den; dn += __shfl_xor(dn, 16); dn += __shfl_xor(dn, 32);
            const float dd = 1.0f / fmaxf(fabsf(dn), 1.0f);
            float ss = 0.f;
#pragma unroll
            for (int et = 0; et < 8; ++et) { acc[et] = acc[et] * dd; ss += acc[et][0] * acc[et][0] + acc[et][1] * acc[et][1] + acc[et][2] * acc[et][2] + acc[et][3] * acc[et][3]; }
            ss += __shfl_xor(ss, 16); ss += __shfl_xor(ss, 32);
            const float rstd = 1.0f / sqrtf(ss * (1.0f / HDM) + EPS);
            const int tok = t0 + 16 * qt + i;
#pragma unroll
            for (int et = 0; et < 8; ++et) { const int e0 = 16 * et + 4 * g;
                const u32x2 ow = *(const u32x2*)(Z + (size_t)tok * NZ + ZOM + h * 128 + e0);
                const f32x4 gv = *(const f32x4*)(gn + h * 128 + e0);
                const float r0 = sigmoidf_(bflo(ow.x)) * acc[et][0] * rstd * gv[0], r1 = sigmoidf_(bfhi(ow.x)) * acc[et][1] * rstd * gv[1];
                const float r2 = sigmoidf_(bflo(ow.y)) * acc[et][2] * rstd * gv[2], r3 = sigmoidf_(bfhi(ow.y)) * acc[et][3] * rstd * gv[3];
                u32x2 o; o.x = pk2(r0, r1); o.y = pk2(r2, r3);
                *(u32x2*)(MIX + (size_t)tok * DM + 512 + h * 128 + e0) = o; }
        }
    }
}

__device__ __forceinline__ void router_phase(const Params& P, Frame& F, const bool commit) {
    const float* X1 = P.out; const float* g2 = P.in[13]; const float* wrt = (const float*)(P.ws + WS_WRT); const float* br = P.in[15];
    unsigned char* H8 = P.ws + WS_H8; int* cnt = (int*)(P.ws + WS_CTL); int* ltok = (int*)(P.ws + WS_LTOK); float* lgate = (float*)(P.ws + WS_LGATE); int* tke = (int*)(P.ws + WS_TKE);
    constexpr int HP = 4112;
    LAS int* lcnt = (LAS int*)(F.lds);
    LAS int* pe = lcnt + 64;
    LAS float* pg = (LAS float*)(pe + 256);
    LAS float* lp = pg + 256;
    LAS unsigned char* him = F.lds + 12288;
    const int lane = F.lane, tid = F.tid, w = F.wave, i = lane & 15, g = lane >> 4;
    for (int chunk = F.vcu; chunk < T / 64; chunk += F.G) {
        __syncthreads();
        if (tid < 64) lcnt[tid] = 0;
        for (int hp = 0; hp < 2; ++hp) {
            __syncthreads();
#pragma unroll
            for (int tt = 0; tt < 4; ++tt) {
                const int tl = w * 4 + tt, tok = chunk * 64 + hp * 32 + tl;
                const f32x4* xr = (const f32x4*)(X1 + (size_t)tok * DM);
                f32x4 v[4]; float s = 0.f;
#pragma unroll
                for (int j = 0; j < 4; ++j) { v[j] = xr[lane + 64 * j]; s += v[j][0] * v[j][0] + v[j][1] * v[j][1] + v[j][2] * v[j][2] + v[j][3] * v[j][3]; }
                s = wave_sum(s);
                const float r = 1.0f / sqrtf(s * (1.0f / DM) + EPS);
#pragma unroll
                for (int j = 0; j < 4; ++j) { const f32x4 gg = ((const f32x4*)g2)[lane + 64 * j]; v[j] = v[j] * r * gg;
                    *(LAS f32x4*)(him + tl * HP + 16 * (lane + 64 * j)) = v[j];
                    *(unsigned*)(H8 + (size_t)tok * DM + 4 * (lane + 64 * j)) = pk4_fp8(v[j][0] * SC_H, v[j][1] * SC_H, v[j][2] * SC_H, v[j][3] * SC_H); }
            }
            __syncthreads();
            {   const int tt2 = w & 1, et = (w >> 1) & 1, kh = w >> 2;
                const float* ap = wrt + (size_t)(16 * et + i) * DM + 512 * kh + 4 * g;
                const LAS unsigned char* bp = him + (16 * tt2 + i) * HP + (512 * kh + 4 * g) * 4;
                f32x4 acc = (f32x4){0.f, 0.f, 0.f, 0.f}, acc1 = (f32x4){0.f, 0.f, 0.f, 0.f};
#pragma unroll 8
                for (int c = 0; c < 32; ++c) {
                    const f32x4 av = *(const f32x4*)(ap + 16 * c); const f32x4 bv = *(const LAS f32x4*)(bp + 64 * c);
                    acc = __builtin_amdgcn_mfma_f32_16x16x4f32(av[0], bv[0], acc, 0, 0, 0); acc1 = __builtin_amdgcn_mfma_f32_16x16x4f32(av[1], bv[1], acc1, 0, 0, 0);
                    acc = __builtin_amdgcn_mfma_f32_16x16x4f32(av[2], bv[2], acc, 0, 0, 0); acc1 = __builtin_amdgcn_mfma_f32_16x16x4f32(av[3], bv[3], acc1, 0, 0, 0);
                }
                acc = acc + acc1;
                *(LAS f32x4*)(lp + (kh * 32 + 16 * tt2 + i) * 32 + 16 * et + 4 * g) = acc;
            }
            __syncthreads();
            if (tid < 32) {
                const LAS float* l0 = lp + tid * 32; const LAS float* l1 = lp + (32 + tid) * 32;
                float tv0 = -INFINITY, tv1 = -INFINITY, tv2 = -INFINITY, tv3 = -INFINITY; int te0 = 0, te1 = 0, te2 = 0, te3 = 0;
#pragma unroll
                for (int e = 0; e < NE; ++e) {
                    const float x = (l0[e] + l1[e]) + br[e];
                    const bool g0 = x > tv0, g1 = x > tv1, g2_ = x > tv2, g3 = x > tv3;
                    tv3 = g2_ ? tv2 : (g3 ? x : tv3); te3 = g2_ ? te2 : (g3 ? e : te3);
                    tv2 = g1 ? tv1 : (g2_ ? x : tv2); te2 = g1 ? te1 : (g2_ ? e : te2);
                    tv1 = g0 ? tv0 : (g1 ? x : tv1); te1 = g0 ? te0 : (g1 ? e : te1);
                    tv0 = g0 ? x : tv0; te0 = g0 ? e : te0;
                }
                const float e1 = __expf(tv1 - tv0), e2 = __expf(tv2 - tv0), e3 = __expf(tv3 - tv0);
                const float inv = 1.0f / (1.0f + e1 + e2 + e3);
                const int tl = hp * 32 + tid;
                const int rk0 = __hip_atomic_fetch_add((int*)(lcnt + te0), 1, __ATOMIC_RELAXED, __HIP_MEMORY_SCOPE_WORKGROUP);
                const int rk1 = __hip_atomic_fetch_add((int*)(lcnt + te1), 1, __ATOMIC_RELAXED, __HIP_MEMORY_SCOPE_WORKGROUP);
                const int rk2 = __hip_atomic_fetch_add((int*)(lcnt + te2), 1, __ATOMIC_RELAXED, __HIP_MEMORY_SCOPE_WORKGROUP);
                const int rk3 = __hip_atomic_fetch_add((int*)(lcnt + te3), 1, __ATOMIC_RELAXED, __HIP_MEMORY_SCOPE_WORKGROUP);
                pe[tl * 4 + 0] = te0 | (rk0 << 8); pe[tl * 4 + 1] = te1 | (rk1 << 8); pe[tl * 4 + 2] = te2 | (rk2 << 8); pe[tl * 4 + 3] = te3 | (rk3 << 8);
                pg[tl * 4 + 0] = inv; pg[tl * 4 + 1] = e1 * inv; pg[tl * 4 + 2] = e2 * inv; pg[tl * 4 + 3] = e3 * inv;
            }
        }
        __syncthreads();
        if (tid < NE && commit) { const int n = lcnt[tid]; lcnt[32 + tid] = n ? atomicAdd(&cnt[64 * tid], n) : 0; }
        __syncthreads();
        if (tid < 256 && commit) { const int wq = pe[tid], ee = wq & 255, p = lcnt[32 + ee] + (wq >> 8), tok = chunk * 64 + (tid >> 2);
            ltok[ee * T + p] = tok; lgate[ee * T + p] = pg[tid]; tke[tok * 4 + (tid & 3)] = ee | (p << 8); }
    }
}

__device__ __forceinline__ void build_tables(const Params& P, Frame& F) {
    LAS int* trs = (LAS int*)(F.lds + LDS_TAB); LAS int* cnts = trs + 64;
    const int* cnt = (const int*)(P.ws + WS_CTL);
    if (F.tid == 0) { int a = 0; for (int e = 0; e < NE; ++e) { const int n = cnt[64 * e]; trs[e] = a; cnts[e] = n; a += (n + 255) >> 8; } trs[NE] = a; }
    __syncthreads();
}

__device__ __forceinline__ void combine_phase(const Params& P, Frame& F, const bool commit) {
    const LAS int* trs = (const LAS int*)(F.lds + LDS_TAB);
    const bf16_t* Y = (const bf16_t*)(P.ws + WS_Y); const int* tke = (const int*)(P.ws + WS_TKE);
    float* out = P.out; const int lane = F.lane;
    for (int tok = F.gw; tok < T; tok += F.ngw) {
        f32x4 a[4];
#pragma unroll
        for (int j = 0; j < 4; ++j) a[j] = *(const f32x4*)(out + (size_t)tok * DM + 4 * (lane + 64 * j));
#pragma unroll
        for (int k = 0; k < 4; ++k) { const int w = tke[tok * 4 + k], e = w & 255, p = w >> 8; const size_t slot = (size_t)trs[e] * 256 + p;
#pragma unroll
            for (int j = 0; j < 4; ++j) { const u32x2 y = *(const u32x2*)(Y + slot * DM + 4 * (lane + 64 * j)); a[j][0] += bflo(y.x); a[j][1] += bfhi(y.x); a[j][2] += bflo(y.y); a[j][3] += bfhi(y.y); } }
#pragma unroll
        for (int j = 0; j < 4; ++j) if (commit || a[j][0] == 123456.789f) *(f32x4*)(out + (size_t)tok * DM + 4 * (lane + 64 * j)) = a[j];
    }
}


#define XB_TMO      128
#define XB_XCNT(j)  (256  + 64 * (j))
#define XB_XSUB(j)  (1280 + 64 * (j))
#define XB_XGEN(j)  (2304 + 64 * (j))
#define XB_TOP      3328
#define XB_TOPGEN   3392
#define XCD_BAR_WORDS 3456
#define XB_SPIN_CAP (1u << 18)
__device__ __forceinline__ unsigned xb_ld(unsigned* p)              { return __hip_atomic_load(p, __ATOMIC_RELAXED, __HIP_MEMORY_SCOPE_AGENT); }
__device__ __forceinline__ unsigned xb_add(unsigned* p, unsigned v) { return __hip_atomic_fetch_add(p, v, __ATOMIC_RELAXED, __HIP_MEMORY_SCOPE_AGENT); }
__device__ __forceinline__ unsigned xb_xcc_id() { return (unsigned)__builtin_amdgcn_s_getreg((3 << 11) | 20) & 0xFu; }
#define XB_SPIN(cond, bar) do { unsigned _sp = 0; while (cond) { __builtin_amdgcn_s_sleep(1); \
    if ((++_sp & 255u) == 0u) { if (xb_ld(&(bar)[XB_TMO])) break; if (_sp > XB_SPIN_CAP) { atomicAdd(&(bar)[XB_TMO], 1u); break; } } } } while (0)
struct XcdBarrier { unsigned* bar; unsigned x; volatile LAS unsigned* st; };
__device__ __forceinline__ XcdBarrier xcd_barrier_post(unsigned* bar, volatile LAS unsigned* st) {
    XcdBarrier b; b.bar = bar; b.x = xb_xcc_id(); b.st = st;
    if (threadIdx.x == 0) (void)xb_add(&bar[XB_XCNT(b.x)], 1u);
    return b;
}
__device__ __forceinline__ void xcd_barrier_complete(unsigned* bar, unsigned x, unsigned& nloc, unsigned& nx) {
    const unsigned G = gridDim.x * gridDim.y * gridDim.z;
    unsigned sum, cnt, mine, sp = 0u;
    for (;;) {
        sum = 0u; cnt = 0u; mine = 0u;
#pragma unroll
        for (unsigned j = 0; j < 16; ++j) { const unsigned c = xb_ld(&bar[XB_XCNT(j)]); sum += c; cnt += (c > 0u) ? 1u : 0u; mine = (j == x) ? c : mine; }
        if (sum == G) break;
        __builtin_amdgcn_s_sleep(1);
        if ((++sp & 255u) == 0u) { if (xb_ld(&bar[XB_TMO])) break; if (sp > XB_SPIN_CAP) { atomicAdd(&bar[XB_TMO], 1u); break; } }
    }
    nloc = mine > 0u ? mine : 1u; nx = cnt > 0u ? cnt : 1u;
}
__device__ __forceinline__ void xcd_barrier(const XcdBarrier& b) {
    asm volatile("s_waitcnt vmcnt(0)" ::: "memory");
    __syncthreads();
    if (threadIdx.x == 0) {
        unsigned* bar = b.bar;
        __builtin_amdgcn_s_waitcnt(0);
        unsigned nloc = b.st[0], nx = b.st[1];
        if (nloc == 0u) { xcd_barrier_complete(bar, b.x, nloc, nx); b.st[0] = nloc; b.st[1] = nx; }
        const unsigned old = xb_add(&bar[XB_XSUB(b.x)], 1u);
        const unsigned gen = old / nloc;
        if (old + 1u == (gen + 1u) * nloc) {
            __builtin_amdgcn_fence(__ATOMIC_RELEASE, "agent");
            asm volatile("s_waitcnt vmcnt(0)" ::: "memory");
            const unsigned og = xb_add(&bar[XB_TOP], 1u);
            const unsigned tg = og / nx;
            if (og + 1u == (tg + 1u) * nx) xb_add(&bar[XB_TOPGEN], 1u);
            else XB_SPIN(xb_ld(&bar[XB_TOPGEN]) == tg, bar);
            __builtin_amdgcn_fence(__ATOMIC_ACQUIRE, "agent");
            xb_add(&bar[XB_XGEN(b.x)], 1u);
            asm volatile("s_waitcnt vmcnt(0)" ::: "memory");
        } else {
            XB_SPIN(xb_ld(&bar[XB_XGEN(b.x)]) == gen, bar);
            __builtin_amdgcn_fence(__ATOMIC_ACQUIRE, "agent");
            asm volatile("s_waitcnt vmcnt(0)" ::: "memory");
        }
    }
    __syncthreads();
}

__device__ __forceinline__ void xcd_barrier2(const XcdBarrier& b, unsigned& epoch) {
    asm volatile("s_waitcnt vmcnt(0)" ::: "memory");
    __syncthreads();
    const unsigned ep = ++epoch;
    if (threadIdx.x < 64) {
        unsigned* bar = b.bar; const unsigned lane = threadIdx.x;
        unsigned mask = 0u;
        if (lane == 0) {
            __builtin_amdgcn_s_waitcnt(0);
            unsigned nloc = b.st[0], nx = b.st[1];
            if (nloc == 0u) { xcd_barrier_complete(bar, b.x, nloc, nx); unsigned m = 0u;
#pragma unroll
                for (unsigned j = 0; j < 16; ++j) m |= (xb_ld(&bar[XB_XCNT(j)]) > 0u) ? (1u << j) : 0u;
                b.st[0] = nloc; b.st[1] = nx; b.st[2] = m; }
            mask = b.st[2];
            const unsigned old = xb_add(&bar[XB_XSUB(b.x)], 1u);
            if (old + 1u == ep * nloc) {
                __builtin_amdgcn_fence(__ATOMIC_RELEASE, "agent");
                asm volatile("s_waitcnt vmcnt(0)" ::: "memory");
                __hip_atomic_store(&bar[XB_XGEN(b.x)], ep, __ATOMIC_RELAXED, __HIP_MEMORY_SCOPE_AGENT);
            }
        }
        mask = __builtin_amdgcn_readfirstlane(mask);
        unsigned sp = 0;
        for (;;) {
            const bool need = lane < 16u && ((mask >> lane) & 1u);
            const unsigned v = need ? xb_ld(&bar[XB_XGEN(lane)]) : ep;
            if (__all(v >= ep)) break;
            __builtin_amdgcn_s_sleep(1);
            if ((++sp & 255u) == 0u) { if (xb_ld(&bar[XB_TMO])) break; if (sp > XB_SPIN_CAP) { atomicAdd(&bar[XB_TMO], 1u); break; } }
        }
        __builtin_amdgcn_fence(__ATOMIC_ACQUIRE, "agent");
        asm volatile("s_waitcnt vmcnt(0)" ::: "memory");
    }
    __syncthreads();
}

__global__ void __launch_bounds__(NTHR) fwd_megakernel(Params P) {
    extern __shared__ __attribute__((aligned(16))) unsigned char lds_raw[];
    Frame F;
    F.lds = (LAS unsigned char*)lds_raw;
    F.tid = threadIdx.x; F.lane = F.tid & 63; F.wave = __builtin_amdgcn_readfirstlane(F.tid >> 6);
    F.G = gridDim.x; { const int bx = blockIdx.x; F.vcu = (F.G % 8 == 0) ? (bx % 8) * (F.G / 8) + bx / 8 : bx; }
    F.gw = F.vcu * NWAVES + F.wave; F.ngw = F.G * NWAVES;
    unsigned char* ws = P.ws;
    LAS unsigned char* stage = F.lds + LDS_STAGE;
    volatile LAS unsigned* bst = (volatile LAS unsigned*)(F.lds + LDS_TAB + 512);
    if (F.tid < 4) bst[F.tid] = 0u;
    __syncthreads();
    const XcdBarrier bar = xcd_barrier_post((unsigned*)(ws + WS_CTL) + 4096, bst);
    LAS unsigned long long* tstamp = (LAS unsigned long long*)(F.lds + LDS_TAB + 640); int nstamp = 0;
    if (TPROBE >= 0 && blockIdx.x == 0 && F.tid == 0) tstamp[nstamp] = __builtin_amdgcn_s_memrealtime();
    ++nstamp;
    unsigned bar_epoch = 0u;
#define GRID_SYNC() do { xcd_barrier2(bar, bar_epoch); if (TPROBE >= 0 && blockIdx.x == 0 && F.tid == 0) tstamp[nstamp] = __builtin_amdgcn_s_memrealtime(); ++nstamp; } while (0)

    p0_prologue(P, F);
    if (DUP & 1) p0_prologue(P, F);
    GRID_SYNC();
    {
        pg8::DenseSched S{T / 256, NZ / 256, F.G, (int)blockIdx.x, DM, (const char*)(ws + WS_WIN), (DUP & 2) ? 2 : 1};
        pg8::EpiQKNorm E{(bf16_t*)(ws + WS_Z), P.in[3], P.in[4]};
        pg8::gemm_phase<false>(stage, (const char*)(ws + WS_XN), DM, S, E);
    }
    GRID_SYNC();
    if (DUP & 4096) { for (int q = 0; q < 10; ++q) GRID_SYNC(); }
    attn_phase(P, F);
    if (DUP & 8) attn_phase(P, F);
    ml1_phase(P, F);
    if (DUP & 16) ml1_phase(P, F);
    GRID_SYNC();
    ml2_phase(P, F);
    GRID_SYNC();
    ml3_phase(P, F);
    if (DUP & 32) ml3_phase(P, F);
    GRID_SYNC();
    {
        pg8::DenseSched S{T / 256, DM / 256, F.G, (int)blockIdx.x, DM, (const char*)(ws + WS_WOUT), (DUP & 64) ? 2 : 1};
        pg8::EpiResF32 E{P.out, P.in[0], DM};
        pg8::gemm_phase<false>(stage, (const char*)(ws + WS_MIX), DM, S, E);
    }
    GRID_SYNC();
    if (DUP & 512) router_phase(P, F, false);
    router_phase(P, F, true);
    GRID_SYNC();
    build_tables(P, F);
    const LAS int* trs = (const LAS int*)(F.lds + LDS_TAB); const LAS int* cnts = trs + 64;
    {
        pg8::MoeSched<true> S{trs, cnts, 8, F.G, (int)blockIdx.x, DM / 2, (const char*)(ws + WS_WGU), (size_t)2 * DFF * DM, (const int*)(ws + WS_LTOK)};
        pg8::EpiSwiglu E{(unsigned char*)(ws + WS_ACT), P.in[17]};
        pg8::gemm_phase<true>(stage, (const char*)(ws + WS_H8), DM / 2, S, E);
    }
    GRID_SYNC();
    {
        pg8::MoeSched<false> S{trs, cnts, 4, F.G, (int)blockIdx.x, DFF / 2, (const char*)(ws + WS_WD), (size_t)DM * DFF, nullptr};
        pg8::EpiDown E{(bf16_t*)(ws + WS_Y), P.in[19], (const float*)(ws + WS_LGATE), cnts};
        pg8::gemm_phase<true>(stage, (const char*)(ws + WS_ACT), DFF / 2, S, E);
    }
    GRID_SYNC();
    if (DUP & 1024) combine_phase(P, F, false);
    combine_phase(P, F, true);
    if (TPROBE >= 0 && blockIdx.x == 0 && F.tid == 0) {
        tstamp[nstamp] = __builtin_amdgcn_s_memrealtime();
        const unsigned long long span = tstamp[TPROBE + 1] - tstamp[TPROBE], t0_ = __builtin_amdgcn_s_memrealtime();
        while (__builtin_amdgcn_s_memrealtime() - t0_ < 4ull * span) __builtin_amdgcn_s_sleep(8);
    }
}
}

extern "C" void kernel_launch(void* const* d_in, const int* in_sizes, int n_in, void* d_out, int out_size, void* d_ws, size_t ws_size, hipStream_t stream) {
    static int grid = 0;
    if (grid == 0) {
        if (n_in != 20 || out_size != T * DM || ws_size < WS_END) { fprintf(stderr, "kernel_launch: unexpected problem (n_in %d out %d ws %zu)\n", n_in, out_size, ws_size); grid = -1; return; }
        int dev = 0, cus = 0, per_cu = 0;
        (void)hipGetDevice(&dev);
        (void)hipDeviceGetAttribute(&cus, hipDeviceAttributeMultiprocessorCount, dev);
        (void)hipFuncSetAttribute((const void*)fwd_megakernel, hipFuncAttributeMaxDynamicSharedMemorySize, LDS_BYTES);
        (void)hipOccupancyMaxActiveBlocksPerMultiprocessor(&per_cu, (const void*)fwd_megakernel, NTHR, LDS_BYTES);
        if (per_cu < 1) { fprintf(stderr, "kernel_launch: occupancy query says %d blocks per CU\n", per_cu); per_cu = 1; }
        grid = cus;
    }
    if (grid < 0) return;
    (void)hipMemsetAsync((char*)d_ws + WS_CTL, 0, 65536, stream);
    Params p{};
    for (int i = 0; i < 20; ++i) p.in[i] = (const float*)d_in[i];
    p.out = (float*)d_out; p.ws = (unsigned char*)d_ws;
    hipLaunchKernelGGL(fwd_megakernel, dim3(grid), dim3(NTHR), LDS_BYTES, stream, p);
    const hipError_t e = hipPeekAtLastError();
    if (e != hipSuccess) fprintf(stderr, "launch failed: %s (grid %d)\n", hipGetErrorString(e), grid);
}
```

```cpp
#include <hip/hip_runtime.h>
#include <cstdio>
#include <cstdint>

#define LAS __attribute__((address_space(3)))
typedef unsigned short bf16_t;
typedef short bf16x8 __attribute__((ext_vector_type(8)));
typedef short s16x4 __attribute__((ext_vector_type(4)));
typedef float f32x4 __attribute__((ext_vector_type(4)));
typedef unsigned u32x4 __attribute__((ext_vector_type(4)));
typedef unsigned u32x2 __attribute__((ext_vector_type(2)));
typedef int i32x4 __attribute__((ext_vector_type(4)));
typedef int i32x8 __attribute__((ext_vector_type(8)));

namespace {
constexpr int BATCH = 2, SEQ = 8192, T = BATCH * SEQ, DM = 1024, DIN = 3080, NZ = 3072;
constexpr int NHA = 8, NHM = 4, HDM = 128;
constexpr int NE = 32, DFF = 1024;
constexpr int CH = 256, NCH = SEQ / CH;
constexpr float EPS = 1e-6f;
constexpr float LOG2E = 1.4426950408889634f;
constexpr float SC_W = 32.f, SC_H = 8.f, SC_A = 4.f;
constexpr int ZQ = 0, ZK = 512, ZV = 1024, ZXM = 1536, ZVM = 2048, ZOM = 2560;
constexpr int NWAVES = 8, NTHR = 512;
constexpr int TPROBE = -1;
constexpr int DUP = 0;
constexpr size_t MiB = 1u << 20;
constexpr size_t WS_CTL = 0;
constexpr size_t WS_WIN = 1 * MiB;
constexpr size_t WS_WOUT = 7 * MiB;
constexpr size_t WS_WQK = 9 * MiB;
constexpr size_t WS_WGU = 16 * MiB;
constexpr size_t WS_WD = 144 * MiB;
constexpr size_t WS_XN = 208 * MiB;
constexpr size_t WS_Z = 240 * MiB;
constexpr size_t WS_GATE = 336 * MiB;
constexpr size_t WS_QK = 353 * MiB;
constexpr size_t WS_BC = 385 * MiB;
constexpr size_t WS_IG = 385 * MiB + 512 * 1024;
constexpr size_t WS_BT = 386 * MiB;
constexpr size_t WS_NV = 386 * MiB + 4096;
constexpr size_t WS_U = 387 * MiB;
constexpr size_t WS_MIX = 403 * MiB;
constexpr size_t WS_LTOK = 435 * MiB;
constexpr size_t WS_LGATE = 437 * MiB;
constexpr size_t WS_TKE = 439 * MiB;
constexpr size_t WS_WRT = 439 * MiB + 512 * 1024;
constexpr size_t WS_H8 = 728 * MiB;
constexpr size_t WS_CS = 337 * MiB;
constexpr size_t WS_ACT = 440 * MiB;
constexpr size_t WS_Y = 584 * MiB;
constexpr size_t WS_END = 744 * MiB;
constexpr int LDS_STAGE = 0;
constexpr int LDS_TAB = 144384;
constexpr int LDS_BYTES = 144384 + 1024;

__device__ __forceinline__ unsigned f2bf(float f) { unsigned u = __builtin_bit_cast(unsigned, f); return (u + 0x7fffu + ((u >> 16) & 1u)) >> 16; }
__device__ __forceinline__ unsigned pk2(float lo, float hi) { return f2bf(lo) | (f2bf(hi) << 16); }
__device__ __forceinline__ unsigned pk4_fp8(float a, float b, float c, float d) { int w = 0; w = __builtin_amdgcn_cvt_pk_fp8_f32(a, b, w, false); w = __builtin_amdgcn_cvt_pk_fp8_f32(c, d, w, true); return (unsigned)w; }
__device__ __forceinline__ float bf2f(unsigned b) { return __builtin_bit_cast(float, b << 16); }
__device__ __forceinline__ float bflo(unsigned w) { return __builtin_bit_cast(float, w << 16); }
__device__ __forceinline__ float bfhi(unsigned w) { return __builtin_bit_cast(float, w & 0xffff0000u); }
__device__ __forceinline__ float wave_sum(float v) {
#pragma unroll
    for (int o = 1; o < 64; o <<= 1) v += __shfl_xor(v, o);
    return v;
}
__device__ __forceinline__ float sigmoidf_(float x) { return 1.0f / (1.0f + __expf(-x)); }
}

namespace pg8 {
constexpr int BM = 256, BK = 64, HALF = 128, HTB = HALF * BK * 2, STAGE_BYTES = 8 * HTB, NXCD = 8, WGM = 8;
__host__ __device__ __forceinline__ int lds_byte(int r, int c) { const int st = (r >> 4) * 2 + (c >> 5), rr = r & 15, cc = c & 31, ob = rr * 64 + cc * 2; return st * 1024 + (ob ^ (((ob >> 9) & 1) << 5)); }
__host__ __device__ __forceinline__ void stage_rc(int b, int& R, int& C) { const int st = b / 1024, sb = b % 1024, swz = sb ^ (((sb >> 9) & 1) << 5); R = (st >> 1) * 16 + swz / 64; C = (st & 1) * 32 + (swz % 64) / 2; }
__host__ __device__ __forceinline__ int perm32(int rho) { const int n = rho >> 4, i = rho & 15; return 8 * (i >> 2) + 4 * n + (i & 3); }

__device__ __forceinline__ bool tile_order(int i, int G, int c, int nM, int nN, int& pm, int& pn) {
    const int nwg = nM * nN; const long L = (long)i * G + c; if (L >= nwg) return false;
    int wgid = (int)L; { const int q = nwg / NXCD, r = nwg % NXCD, xcd = wgid % NXCD, off = wgid / NXCD; wgid = (xcd < r ? xcd * (q + 1) : r * (q + 1) + (xcd - r) * q) + off; }
    const int nig = WGM * nN, gid = wgid / nig, fm = gid * WGM, gsz = (nM - fm) < WGM ? (nM - fm) : WGM;
    pm = fm + ((wgid % nig) % gsz); pn = (wgid % nig) / gsz; return true;
}

struct Unit { int pm, pn, e, mt; };

struct DenseSched {
    int nM, nN, G, c, K; const char* Bt; int reps;
    static constexpr bool DRAIN = false, AFFINE = true;
    __device__ __forceinline__ bool next(int i, Unit& u) const { u.e = 0; u.mt = 0; const int per = (nM * nN + G - 1) / G; if (i >= per * reps) return false; if (!tile_order(i % per, G, c, nM, nN, u.pm, u.pn)) return tile_order(0, G, c, nM, nN, u.pm, u.pn); return true; }
    __device__ __forceinline__ void a_off(const Unit& u, const int (&R)[2], const int (&C)[2], unsigned (&off)[2][2]) const {
#pragma unroll
        for (int h = 0; h < 2; ++h)
#pragma unroll
            for (int i = 0; i < 2; ++i) off[h][i] = (unsigned)(((u.pm * BM + h * HALF + R[i]) * K + C[i]) * 2);
    }
    __device__ __forceinline__ const char* b_ptr(const Unit& u) const { return Bt + (size_t)u.pn * BM * K * 2; }
};
template <bool GATHER> struct MoeSched {
    const LAS int* trs; const LAS int* cnts; int nN, G, c, K; const char* Bt; size_t bstride; const int* ltok;
    static constexpr bool DRAIN = GATHER, AFFINE = !GATHER;
    __device__ __forceinline__ bool next(int i, Unit& u) const {
        const int nM = __builtin_amdgcn_readfirstlane(trs[NE]);
        if (!tile_order(i, G, c, nM, nN, u.pm, u.pn)) return false;
        const int ln = (int)(threadIdx.x & 63u); const int tv = trs[ln < NE ? ln : NE - 1];
        const int e = __popcll(__ballot(ln >= 1 && ln < NE && tv <= u.pm));
        u.e = e; u.mt = u.pm - __builtin_amdgcn_readfirstlane(trs[e]); return true;
    }
    __device__ __forceinline__ void a_rows(const Unit& u, const int (&R)[2], int (&row)[2][2]) const {
        const int n = __builtin_amdgcn_readfirstlane(cnts[u.e]);
#pragma unroll
        for (int h = 0; h < 2; ++h)
#pragma unroll
            for (int i = 0; i < 2; ++i) {
                if (GATHER) { const int p = u.mt * BM + h * HALF + R[i]; row[h][i] = (p < n) ? ltok[u.e * T + p] : 0; }
                else row[h][i] = u.pm * BM + h * HALF + R[i];
            }
    }
    __device__ __forceinline__ void a_off(const Unit& u, const int (&R)[2], const int (&C)[2], unsigned (&off)[2][2]) const {
        int row[2][2]; a_rows(u, R, row);
#pragma unroll
        for (int h = 0; h < 2; ++h)
#pragma unroll
            for (int i = 0; i < 2; ++i) off[h][i] = (unsigned)((row[h][i] * K + C[i]) * 2);
    }
    __device__ __forceinline__ const char* b_ptr(const Unit& u) const { return Bt + (size_t)u.e * bstride + (size_t)u.pn * BM * K * 2; }
};

struct EpiQKNorm {
    static constexpr bool PERM = true; static constexpr int BMAP = 1;
    bf16_t* O; const float* gq; const float* gk;
    __device__ __forceinline__ void operator()(const f32x4 (&acc)[2][2][4][2], const Unit& u, int wr, int wc, int fr, int fq) const {
        const int row0 = u.pm * BM + wr * 64 + fr, col0 = u.pn * BM + wc * 64 + 8 * fq;
        const bool nrm = u.pn < 4; const float* g = (u.pn < 2) ? gq : gk; const float qs = (u.pn < 2) ? 0.125f * LOG2E : 1.0f;
        f32x4 gv[2][2];
#pragma unroll
        for (int bj = 0; bj < 2; ++bj)
#pragma unroll
            for (int n = 0; n < 2; ++n) gv[bj][n] = nrm ? *(const f32x4*)(g + 32 * bj + 8 * fq + 4 * n) : (f32x4){1.f, 1.f, 1.f, 1.f};
#pragma unroll
        for (int ai = 0; ai < 2; ++ai)
#pragma unroll
            for (int m = 0; m < 4; ++m) { bf16_t* rowp = O + (size_t)(row0 + ai * HALF + m * 16) * NZ + col0;
                float sc = 1.0f;
                if (nrm) { float ss = 0.f;
#pragma unroll
                    for (int bj = 0; bj < 2; ++bj)
#pragma unroll
                        for (int n = 0; n < 2; ++n) { const f32x4 v = acc[ai][bj][m][n]; ss += v[0] * v[0] + v[1] * v[1] + v[2] * v[2] + v[3] * v[3]; }
                    ss += __shfl_xor(ss, 16); ss += __shfl_xor(ss, 32);
                    sc = qs / sqrtf(ss * (1.0f / 64.f) + EPS); }
#pragma unroll
                for (int bj = 0; bj < 2; ++bj) { const f32x4 v0 = acc[ai][bj][m][0] * gv[bj][0] * sc, v1 = acc[ai][bj][m][1] * gv[bj][1] * sc;
                    u32x4 w; w.x = pk2(v0[0], v0[1]); w.y = pk2(v0[2], v0[3]); w.z = pk2(v1[0], v1[1]); w.w = pk2(v1[2], v1[3]);
                    *(u32x4*)(rowp + bj * 32) = w; } }
    }
};
struct EpiF16 {
    static constexpr bool PERM = true; static constexpr int BMAP = 0;
    _Float16* O; int ldc;
    __device__ __forceinline__ void operator()(const f32x4 (&acc)[2][2][4][2], const Unit& u, int wr, int wc, int fr, int fq) const {
        typedef _Float16 h8 __attribute__((ext_vector_type(8)));
        const int row0 = u.pm * BM + wr * 64 + fr, col0 = u.pn * BM + wc * 32 + 8 * fq;
#pragma unroll
        for (int ai = 0; ai < 2; ++ai)
#pragma unroll
            for (int m = 0; m < 4; ++m) { _Float16* rowp = O + (size_t)(row0 + ai * HALF + m * 16) * ldc + col0;
#pragma unroll
                for (int bj = 0; bj < 2; ++bj) { const f32x4 v0 = acc[ai][bj][m][0], v1 = acc[ai][bj][m][1];
                    h8 w; w[0] = (_Float16)v0[0]; w[1] = (_Float16)v0[1]; w[2] = (_Float16)v0[2]; w[3] = (_Float16)v0[3]; w[4] = (_Float16)v1[0]; w[5] = (_Float16)v1[1]; w[6] = (_Float16)v1[2]; w[7] = (_Float16)v1[3];
                    *(h8*)(rowp + bj * HALF) = w; } }
    }
};
struct EpiResF32 {
    static constexpr bool PERM = false; static constexpr int BMAP = 0;
    float* C; const float* Rs; int ldc;
    __device__ __forceinline__ void operator()(const f32x4 (&acc)[2][2][4][2], const Unit& u, int wr, int wc, int fr, int fq) const {
        const int row0 = u.pm * BM + wr * 64 + fr, col0 = u.pn * BM + wc * 32 + 4 * fq;
#pragma unroll
        for (int ai = 0; ai < 2; ++ai)
#pragma unroll
            for (int mp = 0; mp < 2; ++mp) {
                f32x4 r[2][2][2];
#pragma unroll
                for (int mm = 0; mm < 2; ++mm) { const size_t ro = (size_t)(row0 + ai * HALF + (2 * mp + mm) * 16) * ldc + col0;
#pragma unroll
                    for (int bj = 0; bj < 2; ++bj)
#pragma unroll
                        for (int n = 0; n < 2; ++n) r[mm][bj][n] = __builtin_nontemporal_load((const f32x4*)(Rs + ro + bj * HALF + n * 16)); }
#pragma unroll
                for (int mm = 0; mm < 2; ++mm) { const size_t ro = (size_t)(row0 + ai * HALF + (2 * mp + mm) * 16) * ldc + col0;
#pragma unroll
                    for (int bj = 0; bj < 2; ++bj)
#pragma unroll
                        for (int n = 0; n < 2; ++n) *(f32x4*)(C + ro + bj * HALF + n * 16) = acc[ai][bj][2 * mp + mm][n] + r[mm][bj][n]; }
            }
    }
};
struct EpiSwiglu {
    static constexpr bool PERM = true; static constexpr int BMAP = 0;
    unsigned char* O; const float* bgu;
    __device__ __forceinline__ void operator()(const f32x4 (&acc)[2][2][4][2], const Unit& u, int wr, int wc, int fr, int fq) const {
        const int row0 = u.pm * BM + wr * 64 + fr, f0 = u.pn * HALF + wc * 32 + 8 * fq;
        const float* bg = bgu + (size_t)u.e * 2 * DFF + f0;
        constexpr float inv = 1.0f / (SC_H * SC_W);
        f32x4 bgv[2], buv[2];
#pragma unroll
        for (int n = 0; n < 2; ++n) { bgv[n] = *(const f32x4*)(bg + 4 * n); buv[n] = *(const f32x4*)(bg + DFF + 4 * n); }
#pragma unroll
        for (int ai = 0; ai < 2; ++ai)
#pragma unroll
            for (int m = 0; m < 4; ++m) { unsigned char* rowp = O + (size_t)(row0 + ai * HALF + m * 16) * DFF + f0;
                float r[8];
#pragma unroll
                for (int n = 0; n < 2; ++n) { const f32x4 gv = acc[ai][0][m][n] * inv + bgv[n], uv = acc[ai][1][m][n] * inv + buv[n];
#pragma unroll
                    for (int j = 0; j < 4; ++j) { const float gg = fminf(gv[j], 7.0f), uu = fminf(fmaxf(uv[j], -7.0f), 7.0f);
                        r[4 * n + j] = SC_A * gg * (uu + 1.0f) * __builtin_amdgcn_rcpf(1.0f + __builtin_amdgcn_exp2f(-1.702f * LOG2E * gg)); } }
                u32x2 w; w.x = pk4_fp8(r[0], r[1], r[2], r[3]); w.y = pk4_fp8(r[4], r[5], r[6], r[7]);
                *(u32x2*)rowp = w; }
    }
};
struct EpiDown {
    static constexpr bool PERM = true; static constexpr int BMAP = 0;
    bf16_t* O; const float* bd; const float* lgate; const LAS int* cnts;
    __device__ __forceinline__ void operator()(const f32x4 (&acc)[2][2][4][2], const Unit& u, int wr, int wc, int fr, int fq) const {
        const int row0 = u.pm * BM + wr * 64 + fr, col0 = u.pn * BM + wc * 32 + 8 * fq;
        const int n_e = cnts[u.e];
        f32x4 bv[2][2];
#pragma unroll
        for (int bj = 0; bj < 2; ++bj)
#pragma unroll
            for (int n = 0; n < 2; ++n) bv[bj][n] = *(const f32x4*)(bd + (size_t)u.e * DM + col0 + bj * HALF + 4 * n);
        float gts[2][4];
#pragma unroll
        for (int ai = 0; ai < 2; ++ai)
#pragma unroll
            for (int m = 0; m < 4; ++m) { const int p = u.mt * BM + wr * 64 + fr + ai * HALF + m * 16; gts[ai][m] = lgate[(size_t)u.e * T + (p < T ? p : T - 1)]; }
#pragma unroll
        for (int ai = 0; ai < 2; ++ai)
#pragma unroll
            for (int m = 0; m < 4; ++m) { const int rt = wr * 64 + fr + ai * HALF + m * 16, p = u.mt * BM + rt;
                const float gt = (p < n_e) ? gts[ai][m] : 0.f;
                bf16_t* rowp = O + (size_t)(row0 + ai * HALF + m * 16) * DM + col0;
#pragma unroll
                for (int bj = 0; bj < 2; ++bj) { const f32x4 v0 = (acc[ai][bj][m][0] * (1.0f / (SC_A * SC_W)) + bv[bj][0]) * gt, v1 = (acc[ai][bj][m][1] * (1.0f / (SC_A * SC_W)) + bv[bj][1]) * gt;
                    u32x4 w; w.x = pk2(v0[0], v0[1]); w.y = pk2(v0[2], v0[3]); w.z = pk2(v1[0], v1[1]); w.w = pk2(v1[2], v1[3]);
                    *(u32x4*)(rowp + bj * HALF) = w; } }
    }
};

template <bool FP8, class Epi, class Sched>
__device__ __forceinline__ void gemm_phase(LAS unsigned char* lds, const char* A0, const int K, const Sched& S, const Epi& E) {
    int tid = threadIdx.x; asm volatile("" : "+v"(tid));
    const int wid = __builtin_amdgcn_readfirstlane(tid >> 6), lane = tid & 63, wr = wid >> 2, wc = wid & 3, fr = lane & 15, fq = lane >> 4;
    const int nt = K / BK;
    int Rr[2], Cc[2]; unsigned voffB[2];
#pragma unroll
    for (int i = 0; i < 2; ++i) { stage_rc(tid * 16 + i * 8192, Rr[i], Cc[i]); const int r5 = Epi::PERM ? perm32(Rr[i] & 31) : (Rr[i] & 31); const int Rb = Epi::BMAP ? (64 * (Rr[i] >> 5) + r5) : ((Rr[i] & ~31) + r5); voffB[i] = (unsigned)(Rb * K + Cc[i]) * 2u; }
    const size_t kstep = (size_t)(BK * 2);
    const size_t hstep = (size_t)(Epi::BMAP ? 32 : HALF) * K * 2;
    const unsigned ldsw = (unsigned)wid * 1024u;
    const int aoff = lds_byte(wr * 64 + fr, fq * 8), boff = lds_byte(wc * 32 + fr, fq * 8);
#define PG8_SA(b, h) (((b) * 2 + (h)) * HTB)
#define PG8_SB(b, h) ((4 + (b) * 2 + (h)) * HTB)
#define PG8_STAGE_B(bufoff, gbase) do { _Pragma("unroll") for (int _i = 0; _i < 2; ++_i) \
        __builtin_amdgcn_global_load_lds((const unsigned*)((const char*)(gbase) + voffB[_i]), (LAS unsigned*)(lds + (bufoff) + ldsw + _i * 8192), 16, 0, 0); } while (0)
#define PG8_STAGE_A(bufoff, gbase, o0, o1) do { \
        __builtin_amdgcn_global_load_lds((const unsigned*)((const char*)(gbase) + (o0)), (LAS unsigned*)(lds + (bufoff) + ldsw), 16, 0, 0); \
        __builtin_amdgcn_global_load_lds((const unsigned*)((const char*)(gbase) + (o1)), (LAS unsigned*)(lds + (bufoff) + ldsw + 8192), 16, 0, 0); } while (0)
#define PG8_LDA(dst, b, h) do { if constexpr (FP8) { _Pragma("unroll") for (int m = 0; m < 4; ++m) { const i32x4 lo_ = *(const LAS i32x4*)(lds + PG8_SA(b, h) + aoff + m * 2048), hi_ = *(const LAS i32x4*)(lds + PG8_SA(b, h) + aoff + m * 2048 + 1024); \
            dst##8[m] = __builtin_shufflevector(lo_, hi_, 0, 1, 2, 3, 4, 5, 6, 7); } } \
        else { _Pragma("unroll") for (int m = 0; m < 4; ++m) _Pragma("unroll") for (int k = 0; k < 2; ++k) dst[m][k] = *(const LAS bf16x8*)(lds + PG8_SA(b, h) + aoff + m * 2048 + k * 1024); } } while (0)
#define PG8_LDB(dst, b, h) do { if constexpr (FP8) { _Pragma("unroll") for (int n = 0; n < 2; ++n) { const i32x4 lo_ = *(const LAS i32x4*)(lds + PG8_SB(b, h) + boff + n * 2048), hi_ = *(const LAS i32x4*)(lds + PG8_SB(b, h) + boff + n * 2048 + 1024); \
            dst##8[n] = __builtin_shufflevector(lo_, hi_, 0, 1, 2, 3, 4, 5, 6, 7); } } \
        else { _Pragma("unroll") for (int n = 0; n < 2; ++n) _Pragma("unroll") for (int k = 0; k < 2; ++k) dst[n][k] = *(const LAS bf16x8*)(lds + PG8_SB(b, h) + boff + n * 2048 + k * 1024); } } while (0)
#define PG8_MMA(ai, bj, At, Bt) do { __builtin_amdgcn_s_setprio(1); \
        if constexpr (FP8) { _Pragma("unroll") for (int m = 0; m < 4; ++m) _Pragma("unroll") for (int n = 0; n < 2; ++n) \
            asm volatile("s_nop 1\n\tv_mfma_f32_16x16x128_f8f6f4 %0, %1, %2, %0" : "+v"(acc[ai][bj][m][n]) : "v"(Bt##8[n]), "v"(At##8[m])); } \
        else { _Pragma("unroll") for (int m = 0; m < 4; ++m) _Pragma("unroll") for (int n = 0; n < 2; ++n) _Pragma("unroll") for (int k = 0; k < 2; ++k) \
            acc[ai][bj][m][n] = __builtin_amdgcn_mfma_f32_16x16x32_bf16(Bt[n][k], At[m][k], acc[ai][bj][m][n], 0, 0, 0); } \
        __builtin_amdgcn_s_setprio(0); } while (0)
#define PG8_WAIT_V(n) asm volatile("s_waitcnt vmcnt(" #n ")" ::: "memory")
#define PG8_WAIT_L(n) asm volatile("s_waitcnt lgkmcnt(" #n ")" ::: "memory")
#define PG8_BAR __builtin_amdgcn_s_barrier()
#define PG8_SCHED __builtin_amdgcn_sched_barrier(0)
    Unit cur, nxt; int ui = 0;
    if (!S.next(0, cur)) return;
    f32x4 acc[2][2][4][2];
#pragma unroll
    for (int a = 0; a < 2; ++a)
#pragma unroll
        for (int b = 0; b < 2; ++b)
#pragma unroll
            for (int m = 0; m < 4; ++m)
#pragma unroll
                for (int n = 0; n < 2; ++n) acc[a][b][m][n] = (f32x4){0.f, 0.f, 0.f, 0.f};
    bf16x8 At[4][2], B0[2][2], B1[2][2]; i32x8 At8[4], B08[2], B18[2];
    unsigned offC[2][2], offN[2][2];
    const char* uA = A0; const char* nA = A0;
    if constexpr (Sched::AFFINE) {
#pragma unroll
        for (int h = 0; h < 2; ++h)
#pragma unroll
            for (int i = 0; i < 2; ++i) offC[h][i] = (unsigned)(((h * HALF + Rr[i]) * K + Cc[i]) * 2);
        uA = A0 + (size_t)cur.pm * BM * K * 2;
    } else S.a_off(cur, Rr, Cc, offC);
    const char* cB = S.b_ptr(cur);
    int rowP[2][2] = {{0, 0}, {0, 0}}; Unit nx2;
    if constexpr (!Sched::AFFINE) { if (S.next(1, nx2)) S.a_rows(nx2, Rr, rowP); }
    if (Sched::DRAIN) PG8_WAIT_V(0);
    PG8_STAGE_B(PG8_SB(0, 0), cB); PG8_STAGE_B(PG8_SB(0, 1), cB + hstep); PG8_STAGE_A(PG8_SA(0, 0), uA, offC[0][0], offC[0][1]); PG8_STAGE_A(PG8_SA(0, 1), uA, offC[1][0], offC[1][1]);
    if (wr == 1) PG8_BAR;
    PG8_WAIT_V(2); PG8_BAR;
    PG8_STAGE_B(PG8_SB(1, 0), cB + kstep); PG8_STAGE_A(PG8_SA(1, 0), uA + kstep, offC[0][0], offC[0][1]); PG8_STAGE_B(PG8_SB(1, 1), cB + hstep + kstep);
    PG8_WAIT_V(6); PG8_BAR;
    for (;;) {
        const bool has_next = S.next(ui + 1, nxt);
        const char* nB = cB;
        if constexpr (Sched::AFFINE) { nA = uA; if (has_next) { nA = A0 + (size_t)nxt.pm * BM * K * 2; nB = S.b_ptr(nxt); } }
        else {
            if (has_next) { nB = S.b_ptr(nxt);
#pragma unroll
                for (int h = 0; h < 2; ++h)
#pragma unroll
                    for (int i = 0; i < 2; ++i) offN[h][i] = (unsigned)((rowP[h][i] * K + Cc[i]) * 2);
                if (S.next(ui + 2, nx2)) S.a_rows(nx2, Rr, rowP);
            } else {
#pragma unroll
                for (int h = 0; h < 2; ++h)
#pragma unroll
                    for (int i = 0; i < 2; ++i) offN[h][i] = offC[h][i];
            }
        }
        for (int t = 0; t < nt; t += 2) {
            const bool last = (t == nt - 2);
            const char* a1 = uA + (size_t)(t + 1) * kstep;
            const char* a2 = last ? nA : uA + (size_t)(t + 2) * kstep; const char* b2 = last ? nB : cB + (size_t)(t + 2) * kstep;
            const char* a3 = a2 + kstep; const char* b3 = b2 + kstep;
            unsigned o00 = offC[0][0], o01 = offC[0][1], o10 = offC[1][0], o11 = offC[1][1];
            if constexpr (!Sched::AFFINE) { if (last) { o00 = offN[0][0]; o01 = offN[0][1]; o10 = offN[1][0]; o11 = offN[1][1]; } }
            PG8_LDB(B0, 0, 0); PG8_LDB(B1, 0, 1); PG8_SCHED; PG8_LDA(At, 0, 0); PG8_STAGE_A(PG8_SA(1, 1), a1, offC[1][0], offC[1][1]);
            PG8_WAIT_V(8); PG8_WAIT_L(0); PG8_BAR; PG8_MMA(0, 0, At, B0); PG8_MMA(0, 1, At, B1); PG8_BAR; PG8_SCHED;
            PG8_LDA(At, 0, 1); PG8_STAGE_B(PG8_SB(0, 0), b2); PG8_STAGE_B(PG8_SB(0, 1), b2 + hstep); PG8_STAGE_A(PG8_SA(0, 0), a2, o00, o01);
            PG8_WAIT_V(8); PG8_WAIT_L(0); PG8_BAR; PG8_MMA(1, 0, At, B0); PG8_MMA(1, 1, At, B1); PG8_BAR; PG8_SCHED;
            PG8_LDB(B0, 1, 0); PG8_LDB(B1, 1, 1); PG8_SCHED; PG8_LDA(At, 1, 0); PG8_STAGE_A(PG8_SA(0, 1), a2, o10, o11);
            PG8_WAIT_V(8); PG8_WAIT_L(0); PG8_BAR; PG8_MMA(0, 0, At, B0); PG8_MMA(0, 1, At, B1); PG8_BAR; PG8_SCHED;
            PG8_LDA(At, 1, 1); PG8_STAGE_B(PG8_SB(1, 0), b3); PG8_STAGE_B(PG8_SB(1, 1), b3 + hstep); PG8_STAGE_A(PG8_SA(1, 0), a3, o00, o01);
            PG8_WAIT_V(8); PG8_WAIT_L(0); PG8_BAR; PG8_MMA(1, 0, At, B0); PG8_MMA(1, 1, At, B1); PG8_BAR; PG8_SCHED;
        }
        if (wr == 0) PG8_BAR;
        if constexpr (FP8) {
            asm volatile("s_nop 15\n\ts_nop 15" : "+v"(acc[0][0][0][0]), "+v"(acc[0][0][0][1]), "+v"(acc[0][0][1][0]), "+v"(acc[0][0][1][1]), "+v"(acc[0][0][2][0]), "+v"(acc[0][0][2][1]), "+v"(acc[0][0][3][0]), "+v"(acc[0][0][3][1]),
                                                    "+v"(acc[0][1][0][0]), "+v"(acc[0][1][0][1]), "+v"(acc[0][1][1][0]), "+v"(acc[0][1][1][1]), "+v"(acc[0][1][2][0]), "+v"(acc[0][1][2][1]), "+v"(acc[0][1][3][0]), "+v"(acc[0][1][3][1]));
            asm volatile("s_nop 0" : "+v"(acc[1][0][0][0]), "+v"(acc[1][0][0][1]), "+v"(acc[1][0][1][0]), "+v"(acc[1][0][1][1]), "+v"(acc[1][0][2][0]), "+v"(acc[1][0][2][1]), "+v"(acc[1][0][3][0]), "+v"(acc[1][0][3][1]),
                                   "+v"(acc[1][1][0][0]), "+v"(acc[1][1][0][1]), "+v"(acc[1][1][1][0]), "+v"(acc[1][1][1][1]), "+v"(acc[1][1][2][0]), "+v"(acc[1][1][2][1]), "+v"(acc[1][1][3][0]), "+v"(acc[1][1][3][1]));
        }
        E(acc, cur, wr, wc, fr, fq);
        if (!has_next) break;
#pragma unroll
        for (int a = 0; a < 2; ++a)
#pragma unroll
            for (int b = 0; b < 2; ++b)
#pragma unroll
                for (int m = 0; m < 4; ++m)
#pragma unroll
                    for (int n = 0; n < 2; ++n) acc[a][b][m][n] = (f32x4){0.f, 0.f, 0.f, 0.f};
        cur = nxt; cB = nB; ++ui;
        if constexpr (Sched::AFFINE) uA = nA;
        else {
#pragma unroll
            for (int h = 0; h < 2; ++h)
#pragma unroll
                for (int i = 0; i < 2; ++i) offC[h][i] = offN[h][i];
        }
        if (wr == 1) PG8_BAR;
    }
    PG8_WAIT_V(0);
    PG8_BAR;
#undef PG8_SA
#undef PG8_SB
#undef PG8_STAGE_A
#undef PG8_STAGE_B
#undef PG8_LDA
#undef PG8_LDB
#undef PG8_MMA
#undef PG8_WAIT_V
#undef PG8_WAIT_L
#undef PG8_BAR
#undef PG8_SCHED
}
}

namespace {
struct Params { const float* in[20]; float* out; unsigned char* ws; };

struct Frame {
    LAS unsigned char* lds;
    int tid, lane, wave, G, vcu, gw, ngw;
};

struct ConvItem { const float* src; unsigned char* dst; int ldw, ldt, kind; float scale; };
__device__ __forceinline__ void conv_load(const ConvItem& I, f32x4 (&v)[8], int lane) {
    const int r8 = lane >> 3, c4 = (lane & 7) * 4;
#pragma unroll
    for (int i = 0; i < 8; ++i) v[i] = __builtin_nontemporal_load((const f32x4*)(I.src + (size_t)(8 * i + r8) * I.ldw + c4));
}
__device__ __forceinline__ void conv_store(const ConvItem& I, const f32x4 (&v)[8], LAS float* scr, int lane) {
    const int r8 = lane >> 3, c4 = (lane & 7) * 4;
#pragma unroll
    for (int i = 0; i < 8; ++i) { LAS float* d = scr + (8 * i + r8) * 33 + c4; d[0] = v[i][0]; d[1] = v[i][1]; d[2] = v[i][2]; d[3] = v[i][3]; }
    asm volatile("s_waitcnt lgkmcnt(0)" ::: "memory");
    const float scale = I.scale;
    if (I.kind == 0) {
        const int c = lane & 7;
#pragma unroll
        for (int j = 0; j < 4; ++j) { const int n = (lane >> 3) + 8 * j; const LAS float* s = scr + (8 * c) * 33 + n;
            u32x4 o; o.x = pk2(s[0 * 33] * scale, s[1 * 33] * scale); o.y = pk2(s[2 * 33] * scale, s[3 * 33] * scale); o.z = pk2(s[4 * 33] * scale, s[5 * 33] * scale); o.w = pk2(s[6 * 33] * scale, s[7 * 33] * scale);
            *(u32x4*)(I.dst + ((size_t)n * I.ldt + 8 * c) * 2) = o; }
    } else {
        const int n = lane >> 1, kh = lane & 1; const LAS float* s = scr + (32 * kh) * 33 + n;
        unsigned w[8];
#pragma unroll
        for (int q = 0; q < 8; ++q) w[q] = pk4_fp8(s[(4 * q) * 33] * scale, s[(4 * q + 1) * 33] * scale, s[(4 * q + 2) * 33] * scale, s[(4 * q + 3) * 33] * scale);
        unsigned char* d = I.dst + (size_t)n * I.ldt + 32 * kh;
        *(u32x4*)d = (u32x4){w[0], w[1], w[2], w[3]}; *(u32x4*)(d + 16) = (u32x4){w[4], w[5], w[6], w[7]};
    }
    asm volatile("s_waitcnt lgkmcnt(0)" ::: "memory");
}
template <class GetItem>
__device__ __forceinline__ void conv_run(GetItem get, int first, int n, int stride, LAS float* scr, int lane) {
    if (first >= n) return;
    ConvItem A, B, C; f32x4 va[8], vb[8], vc[8];
    get(first, A); conv_load(A, va, lane);
    const bool hb = first + stride < n, hc = first + 2 * stride < n;
    B = A; C = A;
    if (hb) { get(first + stride, B); conv_load(B, vb, lane); }
    if (hc) { get(first + 2 * stride, C); conv_load(C, vc, lane); }
    for (int it = first; it < n; it += stride) {
        conv_store(A, va, scr, lane);
        A = B; B = C;
#pragma unroll
        for (int i = 0; i < 8; ++i) { va[i] = vb[i]; vb[i] = vc[i]; }
        const int nx = it + 3 * stride;
        if (nx < n) { get(nx, C); conv_load(C, vc, lane); }
    }
}
constexpr int I_GU = NE * 16 * 64, I_D = NE * 16 * 32;
__device__ __forceinline__ void moe_item(const Params& P, int r, ConvItem& I) {
    I.kind = 1; I.scale = SC_W; I.ldt = DM;
    if (r < I_GU) { const int e = r >> 10, kb = (r >> 6) & 15, nb = r & 63, n0 = 32 * nb, f = n0 & 1023, up = n0 >> 10;
        const int drow = (f >> 7) * 256 + up * 128 + (f & 127);
        I.src = P.in[16] + (size_t)e * DM * 2 * DFF + (size_t)(64 * kb) * 2 * DFF + n0; I.ldw = 2 * DFF;
        I.dst = P.ws + WS_WGU + (size_t)e * 2 * DFF * DM + (size_t)drow * DM + 64 * kb;
    } else { r -= I_GU; const int e = r >> 9, kb = (r >> 5) & 15, nb = r & 31;
        I.src = P.in[18] + (size_t)e * DFF * DM + (size_t)(64 * kb) * DM + 32 * nb; I.ldw = DM;
        I.dst = P.ws + WS_WD + (size_t)e * DM * DFF + (size_t)(32 * nb) * DFF + 64 * kb; }
}
__device__ __forceinline__ void moe_convert(const Params& P, Frame& F, int cw, int ncw) {
    LAS float* scr = (LAS float*)(F.lds + F.wave * 8448);
    conv_run([&](int r, ConvItem& I) { moe_item(P, r, I); }, cw, I_GU + I_D, ncw, scr, F.lane);
}

__device__ __forceinline__ void p0_prologue(const Params& P, Frame& F) {
    unsigned char* ws = P.ws;
    const float* w_in = P.in[2];
    LAS float* scr = (LAS float*)(F.lds + F.wave * 8448);
    LAS float* gwl = (LAS float*)(F.lds + 73728);
    for (int i = F.tid; i < 1024 * 8; i += NTHR) gwl[(i & 7) * 1024 + (i >> 3)] = w_in[(size_t)(i >> 3) * DIN + NZ + (i & 7)];
    __syncthreads();
    constexpr int I_IN = 16 * 96, I_OUT = 16 * 32, I_QK = 8 * 2 * 4, I_ZERO = 8 * 3;
    bf16_t* WqkT = (bf16_t*)(ws + WS_WQK);
    conv_run([&](int r, ConvItem& I) {
        I.kind = 0; I.scale = 1.f;
        if (r < I_IN) { const int kb = r / 96, nb = r % 96; I.src = w_in + (size_t)(64 * kb) * DIN + 32 * nb; I.ldw = DIN; I.dst = ws + WS_WIN + ((size_t)(32 * nb) * DM + 64 * kb) * 2; I.ldt = DM; return; }
        r -= I_IN;
        if (r < I_OUT) { const int kb = r / 32, nb = r % 32; I.src = P.in[12] + (size_t)(64 * kb) * DM + 32 * nb; I.ldw = DM; I.dst = ws + WS_WOUT + ((size_t)(32 * nb) * DM + 64 * kb) * 2; I.ldt = DM; return; }
        r -= I_OUT;
        { const int isk = r >> 5, h = (r >> 3) & 3, kb = (r >> 2) & 1, nb = r & 3;
            I.src = P.in[isk ? 8 : 7] + (size_t)h * 16384 + (size_t)(64 * kb) * 128 + 32 * nb; I.ldw = 128;
            I.dst = ws + WS_WQK + ((size_t)(isk * 512 + h * 128 + 32 * nb) * 512 + h * 128 + 64 * kb) * 2; I.ldt = 512; I.scale = isk ? 0.08838834764831845f : 1.f; }
    }, F.gw, I_IN + I_OUT + I_QK, F.ngw, scr, F.lane);
    moe_convert(P, F, F.gw, F.ngw);
    for (int r = F.gw; r < I_ZERO; r += F.ngw) {
        const int rb = r / 3, j = r % 3, cb = j + (j >= (rb & 3) ? 1 : 0);
        for (int q = F.lane; q < 128 * 16; q += 64) { const int rr = q >> 4, cc = q & 15; *(u32x4*)(WqkT + (size_t)(rb * 128 + rr) * 512 + cb * 128 + cc * 8) = (u32x4){0u, 0u, 0u, 0u}; }
    }
    {
        const float* wr = P.in[14]; float* wrt = (float*)(ws + WS_WRT);
        for (int idx = F.vcu * NTHR + F.tid; idx < DM * NE; idx += F.G * NTHR) wrt[(idx & 31) * DM + (idx >> 5)] = wr[idx];
    }
    const float* x = P.in[0]; const float* g1 = P.in[1];
    bf16_t* XN = (bf16_t*)(ws + WS_XN); float* GATE = (float*)(ws + WS_GATE);
    for (int row0 = F.gw; row0 < T; row0 += 2 * F.ngw) {
        f32x4 vv[2][4];
#pragma unroll
        for (int q = 0; q < 2; ++q) { const int row = row0 + q * F.ngw; const f32x4* xr = (const f32x4*)(x + (size_t)(row < T ? row : row0) * DM);
#pragma unroll
            for (int j = 0; j < 4; ++j) vv[q][j] = __builtin_nontemporal_load(xr + F.lane + 64 * j); }
#pragma unroll
        for (int q = 0; q < 2; ++q) {
            const int row = row0 + q * F.ngw; if (row >= T) break;
            float s = 0.f;
#pragma unroll
            for (int j = 0; j < 4; ++j) s += vv[q][j][0] * vv[q][j][0] + vv[q][j][1] * vv[q][j][1] + vv[q][j][2] * vv[q][j][2] + vv[q][j][3] * vv[q][j][3];
            s = wave_sum(s);
            const float rs = 1.0f / sqrtf(s * (1.0f / DM) + EPS);
            float ga[8];
#pragma unroll
            for (int c = 0; c < 8; ++c) ga[c] = 0.f;
#pragma unroll
            for (int j = 0; j < 4; ++j) { const f32x4 gg = ((const f32x4*)g1)[F.lane + 64 * j]; const f32x4 v = vv[q][j] * rs * gg;
                u32x2 w; w.x = pk2(v[0], v[1]); w.y = pk2(v[2], v[3]);
                *(u32x2*)(XN + (size_t)row * DM + 4 * (F.lane + 64 * j)) = w;
#pragma unroll
                for (int c = 0; c < 8; ++c) { const f32x4 wc = *(const LAS f32x4*)(gwl + c * 1024 + 4 * (F.lane + 64 * j)); ga[c] += v[0] * wc[0] + v[1] * wc[1] + v[2] * wc[2] + v[3] * wc[3]; } }
#pragma unroll
            for (int c = 0; c < 8; ++c) ga[c] = wave_sum(ga[c]);
            if (F.lane == 0) { *(f32x4*)(GATE + (size_t)row * 8) = (f32x4){ga[0], ga[1], ga[2], ga[3]}; *(f32x4*)(GATE + (size_t)row * 8 + 4) = (f32x4){ga[4], ga[5], ga[6], ga[7]}; }
        }
    }
}

#define MFMA16(a, b, c) __builtin_amdgcn_mfma_f32_16x16x32_bf16((a), (b), (c), 0, 0, 0)
struct AttBlk { int tlb, off, d, qb, m, b, h, pass, tt, edge; };
__device__ __forceinline__ void att_decode(int fb, int w, int vcu, int G, AttBlk& k) {
    const int ul = fb / 30, r = fb - 30 * ul, t6 = r / 5; k.m = r - 5 * t6; k.pass = t6 >> 1; k.tt = t6 & 1;
    const int unit = vcu + ul * G; k.tlb = (unit & 31) * 256; k.h = (unit >> 5) & 7; k.b = unit >> 8;
    const int tau = 2 * w + k.tt; k.d = 1 << (2 * k.pass);
    k.off = k.pass == 0 ? 0 : (k.pass == 1 ? (tau & 3) : tau); k.qb = k.pass == 0 ? 16 * tau : (k.pass == 1 ? 16 * (tau >> 2) : 0);
    const int p0 = k.tlb + k.off; k.edge = (p0 + (k.qb - 144) * k.d < 0) || (p0 + (k.qb + 15) * k.d > SEQ - 1);
}
__device__ __forceinline__ void attn_phase(const Params& P, Frame& F) {
    const bf16_t* Z = (const bf16_t*)(P.ws + WS_Z); bf16_t* MIX = (bf16_t*)(P.ws + WS_MIX);
    const int tid = F.tid;
    const int lane = tid & 63, i = lane & 15, g = lane >> 4, w = F.wave;
    float gm = fabsf(P.in[4][lane]);
#pragma unroll
    for (int o = 1; o < 64; o <<= 1) gm = fmaxf(gm, __shfl_xor(gm, o));
    const float kmax = 8.0f * gm * 1.01f;
    constexpr int OP = 272;
    LAS unsigned char* OL = F.lds;
    LAS float* LL = (LAS float*)(F.lds + 256 * OP);
    LAS unsigned char* vb = F.lds + 256 * OP + 1024 + w * 4608;
    const int vwr = (lane >> 3) * 144 + (lane & 7) * 16;
    const int vrd = (4 * g + (i >> 2)) * 144 + (i & 3) * 8;
    const int nunits = (512 - F.vcu + F.G - 1) / F.G, NFB = 30 * nunits;
    if (NFB <= 0) return;
#define ATT_WGBAR() do { asm volatile("s_waitcnt lgkmcnt(0)" ::: "memory"); __builtin_amdgcn_s_barrier(); asm volatile("" ::: "memory"); } while (0)
#define ATT_LOAD(kd, kfn, vrn) do { const bf16_t* Kh_ = Z + (size_t)(kd).b * SEQ * NZ + ZK + (kd).h * 64 + 8 * g; const bf16_t* Vh_ = Z + (size_t)(kd).b * SEQ * NZ + ZV + (kd).h * 64 + 8 * (lane & 7); \
        const int nb_ = (kd).qb - 144 + 32 * (kd).m, p0_ = (kd).tlb + (kd).off; \
        if ((kd).edge) { \
        _Pragma("unroll") for (int sb = 0; sb < 2; ++sb) { int kp = p0_ + (nb_ + 16 * sb + i) * (kd).d; kp = kp < 0 ? 0 : (kp > SEQ - 1 ? SEQ - 1 : kp); const bf16_t* kr = Kh_ + (size_t)kp * NZ; kfn[sb][0] = *(const bf16x8*)kr; kfn[sb][1] = *(const bf16x8*)(kr + 32); } \
        _Pragma("unroll") for (int c = 0; c < 4; ++c) { int kp = p0_ + (nb_ + 8 * c + (lane >> 3)) * (kd).d; kp = kp < 0 ? 0 : (kp > SEQ - 1 ? SEQ - 1 : kp); vrn[c] = *(const u32x4*)(Vh_ + (size_t)kp * NZ); } \
        } else { const size_t dz_ = (size_t)(kd).d * NZ; const bf16_t* kr0 = Kh_ + (size_t)(p0_ + (nb_ + i) * (kd).d) * NZ; const bf16_t* vr0 = Vh_ + (size_t)(p0_ + (nb_ + (lane >> 3)) * (kd).d) * NZ; \
        _Pragma("unroll") for (int sb = 0; sb < 2; ++sb) { const bf16_t* kr = kr0 + 16 * sb * dz_; kfn[sb][0] = *(const bf16x8*)kr; kfn[sb][1] = *(const bf16x8*)(kr + 32); } \
        _Pragma("unroll") for (int c = 0; c < 4; ++c) vrn[c] = *(const u32x4*)(vr0 + 8 * c * dz_); } } while (0)
#define ATT_LOADQ(kd, q0_, q1_) do { const bf16_t* qr_ = Z + (size_t)((kd).b * SEQ + (kd).tlb + (kd).off + (kd).d * ((kd).qb + i)) * NZ + ZQ + (kd).h * 64 + 8 * g; q0_ = *(const bf16x8*)qr_; q1_ = *(const bf16x8*)(qr_ + 32); } while (0)
    bf16x8 kfa[2][2], kfb[2][2]; u32x4 vra[4], vrb[4]; bf16x8 qn0, qn1, qf0, qf1;
    AttBlk cur, nx;
    att_decode(0, w, F.vcu, F.G, cur);
    ATT_LOADQ(cur, qn0, qn1);
    ATT_LOAD(cur, kfa, vra);
    att_decode(1, w, F.vcu, F.G, nx); ATT_LOAD(nx, kfb, vrb);
    f32x4 o[4]; float lsum = 0.f, ref = 0.f, slope2 = 0.f;
    __syncthreads();
#pragma unroll 1
    for (int fb = 0; fb < NFB; ++fb) {
        att_decode(fb, w, F.vcu, F.G, cur);
        if (cur.m == 0) {
            qf0 = qn0; qf1 = qn1;
            if (fb + 5 < NFB) { att_decode(fb + 5, w, F.vcu, F.G, nx); ATT_LOADQ(nx, qn0, qn1); }
            float ss = 0.f;
#pragma unroll
            for (int j = 0; j < 8; ++j) { const float a = bf2f((unsigned short)qf0[j]), c = bf2f((unsigned short)qf1[j]); ss += a * a + c * c; }
            ss += __shfl_xor(ss, 16); ss += __shfl_xor(ss, 32);
            ref = sqrtf(ss) * kmax; slope2 = exp2f(-(float)(cur.h + 1)) * LOG2E;
#pragma unroll
            for (int dt = 0; dt < 4; ++dt) o[dt] = (f32x4){0.f, 0.f, 0.f, 0.f};
            lsum = 0.f;
        }
        bf16x8 kf[2][2]; u32x4 vr[4];
#pragma unroll
        for (int sb = 0; sb < 2; ++sb) { kf[sb][0] = kfa[sb][0]; kf[sb][1] = kfa[sb][1]; kfa[sb][0] = kfb[sb][0]; kfa[sb][1] = kfb[sb][1]; }
#pragma unroll
        for (int c = 0; c < 4; ++c) { vr[c] = vra[c]; vra[c] = vrb[c]; }
        if (fb + 2 < NFB) { att_decode(fb + 2, w, F.vcu, F.G, nx); ATT_LOAD(nx, kfb, vrb); }
        const int d = cur.d, qb = cur.qb, nb = qb - 144 + 32 * cur.m, p0 = cur.tlb + cur.off;
#pragma unroll
        for (int c = 0; c < 4; ++c) *(LAS u32x4*)(vb + vwr + c * 8 * 144) = vr[c];
        f32x4 s[2];
#pragma unroll
        for (int sb = 0; sb < 2; ++sb) { s[sb] = MFMA16(kf[sb][0], qf0, ((f32x4){0.f, 0.f, 0.f, 0.f})); s[sb] = MFMA16(kf[sb][1], qf1, s[sb]); }
        float p[8];
        if (!cur.edge && cur.m >= 1 && cur.m <= 3) {
            const float a0 = (float)((qb + i - nb - 4 * g) * d);
            const float base = -slope2 * a0 - ref, st = slope2 * (float)d;
#pragma unroll
            for (int sb = 0; sb < 2; ++sb)
#pragma unroll
                for (int j = 0; j < 4; ++j) { const float pv = __builtin_amdgcn_exp2f(s[sb][j] + (base + st * (float)(16 * sb + j))); p[4 * sb + j] = pv; lsum += pv; }
        } else {
#pragma unroll
        for (int sb = 0; sb < 2; ++sb)
#pragma unroll
            for (int j = 0; j < 4; ++j) { const int n = nb + 16 * sb + 4 * g + j, a = qb + i - n;
                const bool valid = (a >= 0) && (a <= 128) && (p0 + n * d >= 0);
                const float e = s[sb][j] - slope2 * (float)(a * d) - ref;
                const float pv = valid ? __builtin_amdgcn_exp2f(e) : 0.f;
                p[4 * sb + j] = pv; lsum += pv; }
        }
        u32x4 pw; pw.x = pk2(p[0], p[1]); pw.y = pk2(p[2], p[3]); pw.z = pk2(p[4], p[5]); pw.w = pk2(p[6], p[7]);
        const bf16x8 pf = __builtin_bit_cast(bf16x8, pw);
#pragma unroll
        for (int dt = 0; dt < 4; ++dt) {
            const s16x4 v0 = __builtin_amdgcn_ds_read_tr16_b64_v4i16((LAS s16x4*)(vb + vrd + dt * 32));
            const s16x4 v1 = __builtin_amdgcn_ds_read_tr16_b64_v4i16((LAS s16x4*)(vb + vrd + 16 * 144 + dt * 32));
            const bf16x8 vf = (bf16x8){v0[0], v0[1], v0[2], v0[3], v1[0], v1[1], v1[2], v1[3]};
            o[dt] = MFMA16(vf, pf, o[dt]);
        }
        if (cur.m == 4) {
            float ls = lsum; ls += __shfl_xor(ls, 16); ls += __shfl_xor(ls, 32);
            const int row = cur.off + d * (qb + i);
            LAS f32x4* orow = (LAS f32x4*)(OL + row * OP + 16 * g);
            if (cur.pass == 0) {
#pragma unroll
                for (int dt = 0; dt < 4; ++dt) orow[4 * dt] = o[dt];
                if (g == 0) LL[row] = ls;
            } else {
#pragma unroll
                for (int dt = 0; dt < 4; ++dt) orow[4 * dt] = orow[4 * dt] + o[dt];
                if (g == 0) LL[row] += ls;
            }
            if (cur.tt == 1) {
                ATT_WGBAR();
                if (cur.pass == 2) {
                    const int rw = tid >> 1, hf = tid & 1;
                    const float inv = 1.0f / LL[rw];
                    const LAS f32x4* orw = (const LAS f32x4*)(OL + rw * OP + hf * 128);
                    bf16_t* mrow = MIX + (size_t)(cur.b * SEQ + cur.tlb + rw) * DM + cur.h * 64 + hf * 32;
#pragma unroll
                    for (int q = 0; q < 4; ++q) { const f32x4 a0 = orw[2 * q] * inv, a1 = orw[2 * q + 1] * inv;
                        u32x4 wv_; wv_.x = pk2(a0[0], a0[1]); wv_.y = pk2(a0[2], a0[3]); wv_.z = pk2(a1[0], a1[1]); wv_.w = pk2(a1[2], a1[3]);
                        *(u32x4*)(mrow + 8 * q) = wv_; }
                    ATT_WGBAR();
                }
            }
        }
    }
#undef ATT_LOAD
#undef ATT_LOADQ
#undef ATT_WGBAR
    __syncthreads();
}

__device__ __forceinline__ bf16x8 tr2(LAS unsigned char* p0, LAS unsigned char* p1) {
    const s16x4 a = __builtin_amdgcn_ds_read_tr16_b64_v4i16((LAS s16x4*)p0);
    const s16x4 b = __builtin_amdgcn_ds_read_tr16_b64_v4i16((LAS s16x4*)p1);
    return (bf16x8){a[0], a[1], a[2], a[3], b[0], b[1], b[2], b[3]};
}

__device__ __forceinline__ void ml1_phase(const Params& P, Frame& F) {
    const bf16_t* Z = (const bf16_t*)(P.ws + WS_Z); bf16_t* QK = (bf16_t*)(P.ws + WS_QK); const float* GATE = (const float*)(P.ws + WS_GATE);
    const bf16_t* WqkT = (const bf16_t*)(P.ws + WS_WQK);
    float* BC = (float*)(P.ws + WS_BC); float* IG = (float*)(P.ws + WS_IG); float* BT = (float*)(P.ws + WS_BT); float* U = (float*)(P.ws + WS_U); float* NV = (float*)(P.ws + WS_NV);
    const float* bi = P.in[9]; const float* bf = P.in[10]; const float* cw = P.in[5]; const float* cb = P.in[6];
    constexpr int PIT = 272;
    LAS unsigned char* KIM = F.lds; LAS unsigned char* VIM = F.lds + 128 * PIT; LAS unsigned char* XIM = F.lds + 2 * 128 * PIT;
    LAS float* bc = (LAS float*)(F.lds + 3 * 128 * PIT); LAS float* wv = bc + 256;
    const int tid = F.tid;
    const int lane = tid & 63, i = lane & 15, g = lane >> 4, w = F.wave;
    bf16x8 ones;
#pragma unroll
    for (int j = 0; j < 8; ++j) ones[j] = (i == 0) ? (short)0x3F80 : (short)0;
    for (int unit = F.vcu; unit < 256; unit += F.G) {
        const int bh = unit / NCH, c = unit % NCH, b = bh / NHM, h = bh % NHM, t0 = b * SEQ + c * CH;
        float ig = 0.f;
        __syncthreads();
        if (tid < 256) { const float f = GATE[(size_t)(t0 + tid) * 8 + 4 + h] + bf[h];
            bc[tid] = fminf(f, 0.f) - log1pf(__expf(-fabsf(f)));
            ig = GATE[(size_t)(t0 + tid) * 8 + h] + bi[h]; }
        __syncthreads();
        if (w == 0) {
            const f32x4 a = *(const LAS f32x4*)(bc + 4 * lane);
            const float s1 = a[0], s2 = s1 + a[1], s3 = s2 + a[2], s4 = s3 + a[3];
            float x = s4;
#pragma unroll
            for (int off = 1; off < 64; off <<= 1) { const float v = __shfl_up(x, off); if (lane >= off) x += v; }
            const float ex = x - s4;
            *(LAS f32x4*)(bc + 4 * lane) = (f32x4){ex + s1, ex + s2, ex + s3, ex + s4};
        }
        __syncthreads();
        if (tid < 256) { BC[(size_t)(t0 + tid) * 4 + h] = bc[tid]; IG[(size_t)(t0 + tid) * 4 + h] = ig; wv[tid] = __expf(bc[255] - bc[tid] + ig); }
        if (tid == 0) BT[unit] = bc[255];
        bf16x8 wf[2][4];
#pragma unroll
        for (int e2 = 0; e2 < 2; ++e2) { const bf16_t* wp = WqkT + (size_t)((w >> 2) * 512 + h * 128 + 32 * (w & 3) + 16 * e2 + i) * 512 + h * 128 + 8 * g;
#pragma unroll
            for (int ks = 0; ks < 4; ++ks) wf[e2][ks] = *(const bf16x8*)(wp + 32 * ks); }
        f32x4 acc[9];
#pragma unroll
        for (int q = 0; q < 9; ++q) acc[q] = (f32x4){0.f, 0.f, 0.f, 0.f};
        for (int half = 0; half < 2; ++half) {
            __syncthreads();
#pragma unroll
            for (int q = 0; q < 4; ++q) { const int id = tid + 512 * q, row = id >> 4, c8 = (id & 15) * 8, sidx = half * 128 + row, tok = t0 + sidx, tl = c * CH + sidx;
                const int ch = h * 128 + c8;
                float a[8];
                { const f32x4 b0 = *(const f32x4*)(cb + ch), b1 = *(const f32x4*)(cb + ch + 4); a[0] = b0[0]; a[1] = b0[1]; a[2] = b0[2]; a[3] = b0[3]; a[4] = b1[0]; a[5] = b1[1]; a[6] = b1[2]; a[7] = b1[3]; }
#pragma unroll
                for (int j = 0; j < 4; ++j) { const int dt = 3 - j; if (tl - dt >= 0) {
                        const u32x4 xw = *(const u32x4*)(Z + (size_t)(tok - dt) * NZ + ZXM + ch);
                        const f32x4 w0 = *(const f32x4*)(cw + j * 512 + ch), w1 = *(const f32x4*)(cw + j * 512 + ch + 4);
                        a[0] += w0[0] * bflo(xw.x); a[1] += w0[1] * bfhi(xw.x); a[2] += w0[2] * bflo(xw.y); a[3] += w0[3] * bfhi(xw.y);
                        a[4] += w1[0] * bflo(xw.z); a[5] += w1[1] * bfhi(xw.z); a[6] += w1[2] * bflo(xw.w); a[7] += w1[3] * bfhi(xw.w); } }
#pragma unroll
                for (int j = 0; j < 8; ++j) a[j] = a[j] * sigmoidf_(a[j]);
                u32x4 o; o.x = pk2(a[0], a[1]); o.y = pk2(a[2], a[3]); o.z = pk2(a[4], a[5]); o.w = pk2(a[6], a[7]);
                *(LAS u32x4*)(XIM + row * PIT + c8 * 2) = o;
                *(LAS u32x4*)(VIM + row * PIT + c8 * 2) = *(const u32x4*)(Z + (size_t)tok * NZ + ZVM + ch); }
            __syncthreads();
#pragma unroll 2
            for (int tt = 0; tt < 8; ++tt) {
                bf16x8 xf[4];
#pragma unroll
                for (int ks = 0; ks < 4; ++ks) xf[ks] = *(const LAS bf16x8*)(XIM + (16 * tt + i) * PIT + (32 * ks + 8 * g) * 2);
                const int trow = 16 * tt + i, sidx = half * 128 + trow; const float ws_ = wv[sidx];
                bf16_t* qkrow = QK + (size_t)(t0 + sidx) * 1024 + (w >> 2) * 512 + h * 128 + 32 * (w & 3) + 4 * g;
#pragma unroll
                for (int e2 = 0; e2 < 2; ++e2) {
                    f32x4 d = (f32x4){0.f, 0.f, 0.f, 0.f};
#pragma unroll
                    for (int ks = 0; ks < 4; ++ks) d = MFMA16(wf[e2][ks], xf[ks], d);
                    u32x2 o; o.x = pk2(d[0], d[1]); o.y = pk2(d[2], d[3]);
                    *(u32x2*)(qkrow + 16 * e2) = o;
                    if (w >= 4) { u32x2 ok; ok.x = pk2(d[0] * ws_, d[1] * ws_); ok.y = pk2(d[2] * ws_, d[3] * ws_); *(LAS u32x2*)(KIM + trow * PIT + (32 * (w & 3) + 16 * e2 + 4 * g) * 2) = ok; }
                }
            }
            __syncthreads();
#pragma unroll
            for (int kk = 0; kk < 4; ++kk) {
                const int ro = (32 * kk + 8 * g + (i >> 2)) * PIT + (i & 3) * 8;
                const bf16x8 af = tr2(KIM + ro + 32 * w, KIM + ro + 4 * PIT + 32 * w);
#pragma unroll
                for (int et = 0; et < 8; ++et) { const bf16x8 bfr = tr2(VIM + ro + 32 * et, VIM + ro + 4 * PIT + 32 * et); acc[et] = MFMA16(af, bfr, acc[et]); }
                acc[8] = MFMA16(af, ones, acc[8]);
            }
        }
        float* up = U + (size_t)unit * 16384 + (size_t)(16 * w + 4 * g) * 128 + i;
#pragma unroll
        for (int et = 0; et < 8; ++et)
#pragma unroll
            for (int j = 0; j < 4; ++j) up[j * 128 + 16 * et] = acc[et][j];
        if (i == 0) {
#pragma unroll
            for (int j = 0; j < 4; ++j) NV[unit * 128 + 16 * w + 4 * g + j] = acc[8][j];
        }
    }
}

__device__ __forceinline__ void ml2_phase(const Params& P, Frame& F) {
    const float* BT = (const float*)(P.ws + WS_BT); const float* U = (const float*)(P.ws + WS_U); const float* NV = (const float*)(P.ws + WS_NV);
    bf16_t* CS = (bf16_t*)(P.ws + WS_CS); float* NS = (float*)(P.ws + WS_CS + 8 * MiB);
    for (int item = F.vcu; item < 256; item += F.G) {
        const int bh = item >> 5, sl = item & 31, el = sl * 512 + F.tid;
        float u[NCH];
#pragma unroll
        for (int c = 0; c < NCH; ++c) u[c] = U[(size_t)(bh * NCH + c) * 16384 + el];
        float st = 0.f;
#pragma unroll
        for (int c = 0; c < NCH; ++c) { CS[(size_t)(bh * NCH + c) * 16384 + el] = (bf16_t)f2bf(st); st = __expf(BT[bh * NCH + c]) * st + u[c]; }
        if (sl == 0 && F.tid < 128) { float n = 0.f;
            for (int c = 0; c < NCH; ++c) { NS[(bh * NCH + c) * 128 + F.tid] = n; n = __expf(BT[bh * NCH + c]) * n + NV[(bh * NCH + c) * 128 + F.tid]; } }
    }
}

__device__ __forceinline__ void ml3_phase(const Params& P, Frame& F) {
    const bf16_t* Z = (const bf16_t*)(P.ws + WS_Z); const bf16_t* QK = (const bf16_t*)(P.ws + WS_QK);
    const float* BC = (const float*)(P.ws + WS_BC); const float* IG = (const float*)(P.ws + WS_IG); const float* BT = (const float*)(P.ws + WS_BT);
    const float* U = (const float*)(P.ws + WS_U); const float* NV = (const float*)(P.ws + WS_NV); const float* gn = P.in[11];
    bf16_t* MIX = (bf16_t*)(P.ws + WS_MIX);
    constexpr int CP = 288, VP = 272;
    LAS unsigned char* CIM = F.lds;
    LAS unsigned char* VIM = F.lds + 128 * CP;
    LAS float* cs = (LAS float*)(F.lds + 128 * CP + 256 * VP);
    LAS float* bq = cs + 256;
    const int tid = F.tid;
    const int lane = tid & 63, i = lane & 15, g = lane >> 4, w = F.wave;
    for (int unit = F.vcu; unit < 256; unit += F.G) {
        const int bh = unit / NCH, c = unit % NCH, b = bh / NHM, h = bh % NHM, t0 = b * SEQ + c * CH;
        __syncthreads();
#pragma unroll
        for (int q = 0; q < 8; ++q) { const int id = tid + 512 * q, row = id >> 4, c8 = (id & 15) * 8;
            *(LAS u32x4*)(VIM + row * VP + c8 * 2) = *(const u32x4*)(Z + (size_t)(t0 + row) * NZ + ZVM + h * 128 + c8); }
        if (tid < 256) { const float bb = BC[(size_t)(t0 + tid) * 4 + h]; bq[tid] = bb; cs[tid] = IG[(size_t)(t0 + tid) * 4 + h] - bb; }
        {   const bf16_t* cs = (const bf16_t*)(P.ws + WS_CS) + (size_t)unit * 16384; const float* ns = (const float*)(P.ws + WS_CS + 8 * MiB) + unit * 128;
#pragma unroll
            for (int q = 0; q < 4; ++q) { const int id = tid + 512 * q, d = id >> 4, e8 = (id & 15) * 8; *(LAS u32x4*)(CIM + d * CP + e8 * 2) = *(const u32x4*)(cs + d * 128 + e8); }
            if (tid < 128) { *(LAS u32x4*)(CIM + tid * CP + 256) = (u32x4){f2bf(ns[tid]), 0u, 0u, 0u}; *(LAS u32x4*)(CIM + tid * CP + 272) = (u32x4){0u, 0u, 0u, 0u}; }
        }
        __syncthreads();
#pragma unroll 1
        for (int a = 0; a < 2; ++a) {
            const int qt = a ? 15 - w : w;
            bf16x8 qf[4];
            { const bf16_t* qp = QK + (size_t)(t0 + 16 * qt + i) * 1024 + h * 128 + 8 * g;
#pragma unroll
                for (int ks = 0; ks < 4; ++ks) qf[ks] = *(const bf16x8*)(qp + 32 * ks); }
            const float bt = bq[16 * qt + i];
            f32x4 acc[8]; float den;
            {
                f32x4 a8 = (f32x4){0.f, 0.f, 0.f, 0.f};
#pragma unroll
                for (int et = 0; et < 8; ++et) acc[et] = (f32x4){0.f, 0.f, 0.f, 0.f};
#pragma unroll
                for (int ks = 0; ks < 4; ++ks) {
                    const int ro = (32 * ks + 8 * g + (i >> 2)) * CP + (i & 3) * 8;
#pragma unroll
                    for (int et = 0; et < 8; ++et) { const bf16x8 cf = tr2(CIM + ro + 32 * et, CIM + ro + 4 * CP + 32 * et); acc[et] = MFMA16(cf, qf[ks], acc[et]); }
                    const bf16x8 cf = tr2(CIM + ro + 256, CIM + ro + 4 * CP + 256);
                    a8 = MFMA16(cf, qf[ks], a8);
                }
                const float eb = __expf(bt);
#pragma unroll
                for (int et = 0; et < 8; ++et) acc[et] = acc[et] * eb;
                den = (g == 0) ? a8[0] * eb : 0.f;
            }
            const int kbhi = qt >> 1;
#pragma unroll 1
            for (int kb = 0; kb <= kbhi; ++kb) {
                float p[8];
#pragma unroll
                for (int sb = 0; sb < 2; ++sb) {
                    const bf16_t* kp = QK + (size_t)(t0 + 32 * kb + 16 * sb + i) * 1024 + 512 + h * 128 + 8 * g;
                    f32x4 sacc = (f32x4){0.f, 0.f, 0.f, 0.f};
#pragma unroll
                    for (int ks = 0; ks < 4; ++ks) { const bf16x8 kf = *(const bf16x8*)(kp + 32 * ks); sacc = MFMA16(kf, qf[ks], sacc); }
                    const f32x4 cv = *(const LAS f32x4*)(cs + 32 * kb + 16 * sb + 4 * g);
#pragma unroll
                    for (int j = 0; j < 4; ++j) { const int srow = 32 * kb + 16 * sb + 4 * g + j, tcol = 16 * qt + i;
                        const float pv = (srow <= tcol) ? sacc[j] * __expf(bt + cv[j]) : 0.f;
                        p[4 * sb + j] = pv; den += pv; } }
                u32x4 pw; pw.x = pk2(p[0], p[1]); pw.y = pk2(p[2], p[3]); pw.z = pk2(p[4], p[5]); pw.w = pk2(p[6], p[7]);
                const bf16x8 pf = __builtin_bit_cast(bf16x8, pw);
                const int ro = (32 * kb + 4 * g + (i >> 2)) * VP + (i & 3) * 8;
#pragma unroll
                for (int et = 0; et < 8; ++et) { const bf16x8 vf = tr2(VIM + ro + 32 * et, VIM + ro + 16 * VP + 32 * et); acc[et] = MFMA16(vf, pf, acc[et]); }
            }
            float dn = den; dn += __shfl_xor(dn, 16); dn += __shfl_xor(dn, 32);
            const float dd = 1.0f / fmaxf(fabsf(dn), 1.0f);
            float ss = 0.f;
#pragma unroll
            for (int et = 0; et < 8; ++et) { acc[et] = acc[et] * dd; ss += acc[et][0] * acc[et][0] + acc[et][1] * acc[et][1] + acc[et][2] * acc[et][2] + acc[et][3] * acc[et][3]; }
            ss += __shfl_xor(ss, 16); ss += __shfl_xor(ss, 32);
            const float rstd = 1.0f / sqrtf(ss * (1.0f / HDM) + EPS);
            const int tok = t0 + 16 * qt + i;
#pragma unroll
            for (int et = 0; et < 8; ++et) { const int e0 = 16 * et + 4 * g;
                const u32x2 ow = *(const u32x2*)(Z + (size_t)tok * NZ + ZOM + h * 128 + e0);
                const f32x4 gv = *(const f32x4*)(gn + h * 128 + e0);
                const float r0 = sigmoidf_(bflo(ow.x)) * acc[et][0] * rstd * gv[0], r1 = sigmoidf_(bfhi(ow.x)) * acc[et][1] * rstd * gv[1];
                const float r2 = sigmoidf_(bflo(ow.y)) * acc[et][2] * rstd * gv[2], r3 = sigmoidf_(bfhi(ow.y)) * acc[et][3] * rstd * gv[3];
                u32x2 o; o.x = pk2(r0, r1); o.y = pk2(r2, r3);
                *(u32x2*)(MIX + (size_t)tok * DM + 512 + h * 128 + e0) = o; }
        }
    }
}

__device__ __forceinline__ void router_phase(const Params& P, Frame& F, const bool commit) {
    const float* X1 = P.in[0]; const _Float16* DL = (const _Float16*)(P.ws + WS_XN); const float* g2 = P.in[13]; const float* wrt = (const float*)(P.ws + WS_WRT); const float* br = P.in[15];
    unsigned char* H8 = P.ws + WS_H8; int* cnt = (int*)(P.ws + WS_CTL); int* ltok = (int*)(P.ws + WS_LTOK); float* lgate = (float*)(P.ws + WS_LGATE); int* tke = (int*)(P.ws + WS_TKE);
    constexpr int HP = 4112;
    LAS int* lcnt = (LAS int*)(F.lds);
    LAS int* pe = lcnt + 64;
    LAS float* pg = (LAS float*)(pe + 256);
    LAS float* lp = pg + 256;
    LAS unsigned char* him = F.lds + 12288;
    const int lane = F.lane, tid = F.tid, w = F.wave, i = lane & 15, g = lane >> 4;
    for (int chunk = F.vcu; chunk < T / 64; chunk += F.G) {
        __syncthreads();
        if (tid < 64) lcnt[tid] = 0;
        for (int hp = 0; hp < 2; ++hp) {
            __syncthreads();
#pragma unroll
            for (int tt = 0; tt < 4; ++tt) {
                const int tl = w * 4 + tt, tok = chunk * 64 + hp * 32 + tl;
                const f32x4* xr = (const f32x4*)(X1 + (size_t)tok * DM);
                typedef _Float16 h4 __attribute__((ext_vector_type(4)));
                const h4* dr = (const h4*)(DL + (size_t)tok * DM);
                f32x4 v[4]; float s = 0.f;
#pragma unroll
                for (int j = 0; j < 4; ++j) { const f32x4 xv = xr[lane + 64 * j]; const h4 dv = dr[lane + 64 * j];
                    v[j] = xv + (f32x4){(float)dv[0], (float)dv[1], (float)dv[2], (float)dv[3]};
                    s += v[j][0] * v[j][0] + v[j][1] * v[j][1] + v[j][2] * v[j][2] + v[j][3] * v[j][3]; }
                s = wave_sum(s);
                const float r = 1.0f / sqrtf(s * (1.0f / DM) + EPS);
#pragma unroll
                for (int j = 0; j < 4; ++j) { const f32x4 gg = ((const f32x4*)g2)[lane + 64 * j]; v[j] = v[j] * r * gg;
                    *(LAS f32x4*)(him + tl * HP + 16 * (lane + 64 * j)) = v[j];
                    *(unsigned*)(H8 + (size_t)tok * DM + 4 * (lane + 64 * j)) = pk4_fp8(v[j][0] * SC_H, v[j][1] * SC_H, v[j][2] * SC_H, v[j][3] * SC_H); }
            }
            __syncthreads();
            {   const int tt2 = w & 1, et = (w >> 1) & 1, kh = w >> 2;
                const float* ap = wrt + (size_t)(16 * et + i) * DM + 512 * kh + 4 * g;
                const LAS unsigned char* bp = him + (16 * tt2 + i) * HP + (512 * kh + 4 * g) * 4;
                f32x4 acc = (f32x4){0.f, 0.f, 0.f, 0.f}, acc1 = (f32x4){0.f, 0.f, 0.f, 0.f};
#pragma unroll 8
                for (int c = 0; c < 32; ++c) {
                    const f32x4 av = *(const f32x4*)(ap + 16 * c); const f32x4 bv = *(const LAS f32x4*)(bp + 64 * c);
                    acc = __builtin_amdgcn_mfma_f32_16x16x4f32(av[0], bv[0], acc, 0, 0, 0); acc1 = __builtin_amdgcn_mfma_f32_16x16x4f32(av[1], bv[1], acc1, 0, 0, 0);
                    acc = __builtin_amdgcn_mfma_f32_16x16x4f32(av[2], bv[2], acc, 0, 0, 0); acc1 = __builtin_amdgcn_mfma_f32_16x16x4f32(av[3], bv[3], acc1, 0, 0, 0);
                }
                acc = acc + acc1;
                *(LAS f32x4*)(lp + (kh * 32 + 16 * tt2 + i) * 32 + 16 * et + 4 * g) = acc;
            }
            __syncthreads();
            if (tid < 32) {
                const LAS float* l0 = lp + tid * 32; const LAS float* l1 = lp + (32 + tid) * 32;
                float tv0 = -INFINITY, tv1 = -INFINITY, tv2 = -INFINITY, tv3 = -INFINITY; int te0 = 0, te1 = 0, te2 = 0, te3 = 0;
#pragma unroll
                for (int e = 0; e < NE; ++e) {
                    const float x = (l0[e] + l1[e]) + br[e];
                    const bool g0 = x > tv0, g1 = x > tv1, g2_ = x > tv2, g3 = x > tv3;
                    tv3 = g2_ ? tv2 : (g3 ? x : tv3); te3 = g2_ ? te2 : (g3 ? e : te3);
                    tv2 = g1 ? tv1 : (g2_ ? x : tv2); te2 = g1 ? te1 : (g2_ ? e : te2);
                    tv1 = g0 ? tv0 : (g1 ? x : tv1); te1 = g0 ? te0 : (g1 ? e : te1);
                    tv0 = g0 ? x : tv0; te0 = g0 ? e : te0;
                }
                const float e1 = __expf(tv1 - tv0), e2 = __expf(tv2 - tv0), e3 = __expf(tv3 - tv0);
                const float inv = 1.0f / (1.0f + e1 + e2 + e3);
                const int tl = hp * 32 + tid;
                const int rk0 = __hip_atomic_fetch_add((int*)(lcnt + te0), 1, __ATOMIC_RELAXED, __HIP_MEMORY_SCOPE_WORKGROUP);
                const int rk1 = __hip_atomic_fetch_add((int*)(lcnt + te1), 1, __ATOMIC_RELAXED, __HIP_MEMORY_SCOPE_WORKGROUP);
                const int rk2 = __hip_atomic_fetch_add((int*)(lcnt + te2), 1, __ATOMIC_RELAXED, __HIP_MEMORY_SCOPE_WORKGROUP);
                const int rk3 = __hip_atomic_fetch_add((int*)(lcnt + te3), 1, __ATOMIC_RELAXED, __HIP_MEMORY_SCOPE_WORKGROUP);
                pe[tl * 4 + 0] = te0 | (rk0 << 8); pe[tl * 4 + 1] = te1 | (rk1 << 8); pe[tl * 4 + 2] = te2 | (rk2 << 8); pe[tl * 4 + 3] = te3 | (rk3 << 8);
                pg[tl * 4 + 0] = inv; pg[tl * 4 + 1] = e1 * inv; pg[tl * 4 + 2] = e2 * inv; pg[tl * 4 + 3] = e3 * inv;
            }
        }
        __syncthreads();
        if (tid < NE && commit) { const int n = lcnt[tid]; lcnt[32 + tid] = n ? atomicAdd(&cnt[64 * tid], n) : 0; }
        __syncthreads();
        if (tid < 256 && commit) { const int wq = pe[tid], ee = wq & 255, p = lcnt[32 + ee] + (wq >> 8), tok = chunk * 64 + (tid >> 2);
            ltok[ee * T + p] = tok; lgate[ee * T + p] = pg[tid]; tke[tok * 4 + (tid & 3)] = ee | (p << 8); }
    }
}

__device__ __forceinline__ void build_tables(const Params& P, Frame& F) {
    LAS int* trs = (LAS int*)(F.lds + LDS_TAB); LAS int* cnts = trs + 64;
    const int* cnt = (const int*)(P.ws + WS_CTL);
    if (F.tid == 0) { int a = 0; for (int e = 0; e < NE; ++e) { const int n = cnt[64 * e]; trs[e] = a; cnts[e] = n; a += (n + 255) >> 8; } trs[NE] = a; }
    __syncthreads();
}

__device__ __forceinline__ void combine_phase(const Params& P, Frame& F, const bool commit) {
    const LAS int* trs = (const LAS int*)(F.lds + LDS_TAB);
    const bf16_t* Y = (const bf16_t*)(P.ws + WS_Y); const int* tke = (const int*)(P.ws + WS_TKE);
    float* out = P.out; const int lane = F.lane;
    for (int tok = F.gw; tok < T; tok += F.ngw) {
        f32x4 a[4];
        typedef _Float16 h4 __attribute__((ext_vector_type(4)));
#pragma unroll
        for (int j = 0; j < 4; ++j) { const f32x4 xv = *(const f32x4*)(P.in[0] + (size_t)tok * DM + 4 * (lane + 64 * j)); const h4 dv = *(const h4*)((const _Float16*)(P.ws + WS_XN) + (size_t)tok * DM + 4 * (lane + 64 * j));
            a[j] = xv + (f32x4){(float)dv[0], (float)dv[1], (float)dv[2], (float)dv[3]}; }
#pragma unroll
        for (int k = 0; k < 4; ++k) { const int w = tke[tok * 4 + k], e = w & 255, p = w >> 8; const size_t slot = (size_t)trs[e] * 256 + p;
#pragma unroll
            for (int j = 0; j < 4; ++j) { const u32x2 y = *(const u32x2*)(Y + slot * DM + 4 * (lane + 64 * j)); a[j][0] += bflo(y.x); a[j][1] += bfhi(y.x); a[j][2] += bflo(y.y); a[j][3] += bfhi(y.y); } }
#pragma unroll
        for (int j = 0; j < 4; ++j) if (commit || a[j][0] == 123456.789f) *(f32x4*)(out + (size_t)tok * DM + 4 * (lane + 64 * j)) = a[j];
    }
}


#define XB_TMO      128
#define XB_XCNT(j)  (256  + 64 * (j))
#define XB_XSUB(j)  (1280 + 64 * (j))
#define XB_XGEN(j)  (2304 + 64 * (j))
#define XB_TOP      3328
#define XB_TOPGEN   3392
#define XCD_BAR_WORDS 3456
#define XB_SPIN_CAP (1u << 18)
__device__ __forceinline__ unsigned xb_ld(unsigned* p)              { return __hip_atomic_load(p, __ATOMIC_RELAXED, __HIP_MEMORY_SCOPE_AGENT); }
__device__ __forceinline__ unsigned xb_add(unsigned* p, unsigned v) { return __hip_atomic_fetch_add(p, v, __ATOMIC_RELAXED, __HIP_MEMORY_SCOPE_AGENT); }
__device__ __forceinline__ unsigned xb_xcc_id() { return (unsigned)__builtin_amdgcn_s_getreg((3 << 11) | 20) & 0xFu; }
#define XB_SPIN(cond, bar) do { unsigned _sp = 0; while (cond) { __builtin_amdgcn_s_sleep(1); \
    if ((++_sp & 255u) == 0u) { if (xb_ld(&(bar)[XB_TMO])) break; if (_sp > XB_SPIN_CAP) { atomicAdd(&(bar)[XB_TMO], 1u); break; } } } } while (0)
struct XcdBarrier { unsigned* bar; unsigned x; volatile LAS unsigned* st; };
__device__ __forceinline__ XcdBarrier xcd_barrier_post(unsigned* bar, volatile LAS unsigned* st) {
    XcdBarrier b; b.bar = bar; b.x = xb_xcc_id(); b.st = st;
    if (threadIdx.x == 0) (void)xb_add(&bar[XB_XCNT(b.x)], 1u);
    return b;
}
__device__ __forceinline__ void xcd_barrier_complete(unsigned* bar, unsigned x, unsigned& nloc, unsigned& nx) {
    const unsigned G = gridDim.x * gridDim.y * gridDim.z;
    unsigned sum, cnt, mine, sp = 0u;
    for (;;) {
        sum = 0u; cnt = 0u; mine = 0u;
#pragma unroll
        for (unsigned j = 0; j < 16; ++j) { const unsigned c = xb_ld(&bar[XB_XCNT(j)]); sum += c; cnt += (c > 0u) ? 1u : 0u; mine = (j == x) ? c : mine; }
        if (sum == G) break;
        __builtin_amdgcn_s_sleep(1);
        if ((++sp & 255u) == 0u) { if (xb_ld(&bar[XB_TMO])) break; if (sp > XB_SPIN_CAP) { atomicAdd(&bar[XB_TMO], 1u); break; } }
    }
    nloc = mine > 0u ? mine : 1u; nx = cnt > 0u ? cnt : 1u;
}
__device__ __forceinline__ void xcd_barrier2(const XcdBarrier& b, unsigned& epoch) {
    asm volatile("s_waitcnt vmcnt(0)" ::: "memory");
    __syncthreads();
    const unsigned ep = ++epoch;
    if (threadIdx.x < 64) {
        unsigned* bar = b.bar; const unsigned lane = threadIdx.x;
        unsigned mask = 0u;
        if (lane == 0) {
            __builtin_amdgcn_s_waitcnt(0);
            unsigned nloc = b.st[0], nx = b.st[1];
            if (nloc == 0u) { xcd_barrier_complete(bar, b.x, nloc, nx); unsigned m = 0u;
#pragma unroll
                for (unsigned j = 0; j < 16; ++j) m |= (xb_ld(&bar[XB_XCNT(j)]) > 0u) ? (1u << j) : 0u;
                b.st[0] = nloc; b.st[1] = nx; b.st[2] = m; }
            mask = b.st[2];
            const unsigned old = xb_add(&bar[XB_XSUB(b.x)], 1u);
            if (old + 1u == ep * nloc) {
                __builtin_amdgcn_fence(__ATOMIC_RELEASE, "agent");
                asm volatile("s_waitcnt vmcnt(0)" ::: "memory");
                __hip_atomic_store(&bar[XB_XGEN(b.x)], ep, __ATOMIC_RELAXED, __HIP_MEMORY_SCOPE_AGENT);
            }
        }
        mask = __builtin_amdgcn_readfirstlane(mask);
        unsigned sp = 0;
        for (;;) {
            const bool need = lane < 16u && ((mask >> lane) & 1u);
            const unsigned v = need ? xb_ld(&bar[XB_XGEN(lane)]) : ep;
            if (__all(v >= ep)) break;
            __builtin_amdgcn_s_sleep(1);
            if ((++sp & 255u) == 0u) { if (xb_ld(&bar[XB_TMO])) break; if (sp > XB_SPIN_CAP) { atomicAdd(&bar[XB_TMO], 1u); break; } }
        }
        __builtin_amdgcn_fence(__ATOMIC_ACQUIRE, "agent");
        asm volatile("s_waitcnt vmcnt(0)" ::: "memory");
    }
    __syncthreads();
}

__global__ void __launch_bounds__(NTHR) fwd_megakernel(Params P) {
    extern __shared__ __attribute__((aligned(16))) unsigned char lds_raw[];
    Frame F;
    F.lds = (LAS unsigned char*)lds_raw;
    F.tid = threadIdx.x; F.lane = F.tid & 63; F.wave = __builtin_amdgcn_readfirstlane(F.tid >> 6);
    F.G = gridDim.x; { const int bx = blockIdx.x; F.vcu = (F.G % 8 == 0) ? (bx % 8) * (F.G / 8) + bx / 8 : bx; }
    F.gw = F.vcu * NWAVES + F.wave; F.ngw = F.G * NWAVES;
    unsigned char* ws = P.ws;
    LAS unsigned char* stage = F.lds + LDS_STAGE;
    volatile LAS unsigned* bst = (volatile LAS unsigned*)(F.lds + LDS_TAB + 512);
    if (F.tid < 4) bst[F.tid] = 0u;
    __syncthreads();
    const XcdBarrier bar = xcd_barrier_post((unsigned*)(ws + WS_CTL) + 4096, bst);
    LAS unsigned long long* tstamp = (LAS unsigned long long*)(F.lds + LDS_TAB + 640); int nstamp = 0;
    if (TPROBE >= 0 && blockIdx.x == 0 && F.tid == 0) tstamp[nstamp] = __builtin_amdgcn_s_memrealtime();
    ++nstamp;
    unsigned bar_epoch = 0u;
#define GRID_SYNC() do { xcd_barrier2(bar, bar_epoch); if (TPROBE >= 0 && blockIdx.x == 0 && F.tid == 0) tstamp[nstamp] = __builtin_amdgcn_s_memrealtime(); ++nstamp; } while (0)

    p0_prologue(P, F);
    if (DUP & 1) p0_prologue(P, F);
    GRID_SYNC();
    {
        pg8::DenseSched S{T / 256, NZ / 256, F.G, (int)blockIdx.x, DM, (const char*)(ws + WS_WIN), (DUP & 2) ? 2 : 1};
        pg8::EpiQKNorm E{(bf16_t*)(ws + WS_Z), P.in[3], P.in[4]};
        pg8::gemm_phase<false>(stage, (const char*)(ws + WS_XN), DM, S, E);
    }
    GRID_SYNC();
    if (DUP & 4096) { for (int q = 0; q < 10; ++q) GRID_SYNC(); }
    attn_phase(P, F);
    if (DUP & 8) attn_phase(P, F);
    ml1_phase(P, F);
    if (DUP & 16) ml1_phase(P, F);
    GRID_SYNC();
    ml2_phase(P, F);
    GRID_SYNC();
    ml3_phase(P, F);
    if (DUP & 32) ml3_phase(P, F);
    GRID_SYNC();
    {
        pg8::DenseSched S{T / 256, DM / 256, F.G, (int)blockIdx.x, DM, (const char*)(ws + WS_WOUT), (DUP & 64) ? 2 : 1};
        pg8::EpiF16 E{(_Float16*)(ws + WS_XN), DM};
        pg8::gemm_phase<false>(stage, (const char*)(ws + WS_MIX), DM, S, E);
    }
    GRID_SYNC();
    if (DUP & 512) router_phase(P, F, false);
    router_phase(P, F, true);
    GRID_SYNC();
    build_tables(P, F);
    const LAS int* trs = (const LAS int*)(F.lds + LDS_TAB); const LAS int* cnts = trs + 64;
    {
        pg8::MoeSched<true> S{trs, cnts, 8, F.G, (int)blockIdx.x, DM / 2, (const char*)(ws + WS_WGU), (size_t)2 * DFF * DM, (const int*)(ws + WS_LTOK)};
        pg8::EpiSwiglu E{(unsigned char*)(ws + WS_ACT), P.in[17]};
        pg8::gemm_phase<true>(stage, (const char*)(ws + WS_H8), DM / 2, S, E);
    }
    GRID_SYNC();
    {
        pg8::MoeSched<false> S{trs, cnts, 4, F.G, (int)blockIdx.x, DFF / 2, (const char*)(ws + WS_WD), (size_t)DM * DFF, nullptr};
        pg8::EpiDown E{(bf16_t*)(ws + WS_Y), P.in[19], (const float*)(ws + WS_LGATE), cnts};
        pg8::gemm_phase<true>(stage, (const char*)(ws + WS_ACT), DFF / 2, S, E);
    }
    GRID_SYNC();
    if (DUP & 1024) combine_phase(P, F, false);
    combine_phase(P, F, true);
    if (TPROBE >= 0 && blockIdx.x == 0 && F.tid == 0) {
        tstamp[nstamp] = __builtin_amdgcn_s_memrealtime();
        const unsigned long long span = tstamp[TPROBE + 1] - tstamp[TPROBE], t0_ = __builtin_amdgcn_s_memrealtime();
        while (__builtin_amdgcn_s_memrealtime() - t0_ < 4ull * span) __builtin_amdgcn_s_sleep(8);
    }
}
}

extern "C" void kernel_launch(void* const* d_in, const int* in_sizes, int n_in, void* d_out, int out_size, void* d_ws, size_t ws_size, hipStream_t stream) {
    static int grid = 0;
    if (grid == 0) {
        if (n_in != 20 || out_size != T * DM || ws_size < WS_END) { fprintf(stderr, "kernel_launch: unexpected problem (n_in %d out %d ws %zu)\n", n_in, out_size, ws_size); grid = -1; return; }
        int dev = 0, cus = 0, per_cu = 0;
        (void)hipGetDevice(&dev);
        (void)hipDeviceGetAttribute(&cus, hipDeviceAttributeMultiprocessorCount, dev);
        (void)hipFuncSetAttribute((const void*)fwd_megakernel, hipFuncAttributeMaxDynamicSharedMemorySize, LDS_BYTES);
        (void)hipOccupancyMaxActiveBlocksPerMultiprocessor(&per_cu, (const void*)fwd_megakernel, NTHR, LDS_BYTES);
        if (per_cu < 1) { fprintf(stderr, "kernel_launch: occupancy query says %d blocks per CU\n", per_cu); per_cu = 1; }
        grid = cus;
    }
    if (grid < 0) return;
    (void)hipMemsetAsync((char*)d_ws + WS_CTL, 0, 65536, stream);
    Params p{};
    for (int i = 0; i < 20; ++i) p.in[i] = (const float*)d_in[i];
    p.out = (float*)d_out; p.ws = (unsigned char*)d_ws;
    hipLaunchKernelGGL(fwd_megakernel, dim3(grid), dim3(NTHR), LDS_BYTES, stream, p);
    const hipError_t e = hipPeekAtLastError();
    if (e != hipSuccess) fprintf(stderr, "launch failed: %s (grid %d)\n", hipGetErrorString(e), grid);
}
```

```cpp
#include <hip/hip_runtime.h>
#include <cstdio>
#include <cstdint>

#define LAS __attribute__((address_space(3)))
typedef unsigned short bf16_t;
typedef short bf16x8 __attribute__((ext_vector_type(8)));
typedef short s16x4 __attribute__((ext_vector_type(4)));
typedef float f32x4 __attribute__((ext_vector_type(4)));
typedef unsigned u32x4 __attribute__((ext_vector_type(4)));
typedef unsigned u32x2 __attribute__((ext_vector_type(2)));
typedef int i32x4 __attribute__((ext_vector_type(4)));
typedef int i32x8 __attribute__((ext_vector_type(8)));

namespace {
constexpr int BATCH = 2, SEQ = 8192, T = BATCH * SEQ, DM = 1024, DIN = 3080, NZ = 3072;
constexpr int NHA = 8, NHM = 4, HDM = 128;
constexpr int NE = 32, DFF = 1024;
constexpr int CH = 256, NCH = SEQ / CH;
constexpr float EPS = 1e-6f;
constexpr float LOG2E = 1.4426950408889634f;
constexpr float SC_W = 32.f, SC_H = 8.f, SC_A = 4.f;
constexpr int ZQ = 0, ZK = 512, ZV = 1024, ZXM = 1536, ZVM = 2048, ZOM = 2560;
constexpr int NWAVES = 8, NTHR = 512;
constexpr int TPROBE = -1;
constexpr int DUP = 0;
constexpr size_t MiB = 1u << 20;
constexpr size_t WS_CTL = 0;
constexpr size_t WS_WIN = 1 * MiB;
constexpr size_t WS_WOUT = 7 * MiB;
constexpr size_t WS_WQK = 9 * MiB;
constexpr size_t WS_WGU = 16 * MiB;
constexpr size_t WS_WD = 144 * MiB;
constexpr size_t WS_XN = 208 * MiB;
constexpr size_t WS_Z = 240 * MiB;
constexpr size_t WS_GATE = 336 * MiB;
constexpr size_t WS_QK = 353 * MiB;
constexpr size_t WS_BC = 385 * MiB;
constexpr size_t WS_IG = 385 * MiB + 512 * 1024;
constexpr size_t WS_BT = 386 * MiB;
constexpr size_t WS_NV = 386 * MiB + 4096;
constexpr size_t WS_U = 387 * MiB;
constexpr size_t WS_MIX = 403 * MiB;
constexpr size_t WS_LTOK = 435 * MiB;
constexpr size_t WS_LGATE = 437 * MiB;
constexpr size_t WS_TKE = 439 * MiB;
constexpr size_t WS_WRT = 439 * MiB + 512 * 1024;
constexpr size_t WS_H8 = 728 * MiB;
constexpr size_t WS_CS = 337 * MiB;
constexpr size_t WS_ACT = 440 * MiB;
constexpr size_t WS_Y = 584 * MiB;
constexpr size_t WS_END = 744 * MiB;
constexpr int LDS_STAGE = 0;
constexpr int LDS_TAB = 144384;
constexpr int LDS_BYTES = 144384 + 1024;

__device__ __forceinline__ unsigned f2bf(float f) { unsigned u = __builtin_bit_cast(unsigned, f); return (u + 0x7fffu + ((u >> 16) & 1u)) >> 16; }
__device__ __forceinline__ unsigned pk2(float lo, float hi) { return f2bf(lo) | (f2bf(hi) << 16); }
__device__ __forceinline__ unsigned pk4_fp8(float a, float b, float c, float d) { int w = 0; w = __builtin_amdgcn_cvt_pk_fp8_f32(a, b, w, false); w = __builtin_amdgcn_cvt_pk_fp8_f32(c, d, w, true); return (unsigned)w; }
__device__ __forceinline__ float bf2f(unsigned b) { return __builtin_bit_cast(float, b << 16); }
__device__ __forceinline__ float bflo(unsigned w) { return __builtin_bit_cast(float, w << 16); }
__device__ __forceinline__ float bfhi(unsigned w) { return __builtin_bit_cast(float, w & 0xffff0000u); }
__device__ __forceinline__ float wave_sum(float v) {
#pragma unroll
    for (int o = 1; o < 64; o <<= 1) v += __shfl_xor(v, o);
    return v;
}
__device__ __forceinline__ float sigmoidf_(float x) { return 1.0f / (1.0f + __expf(-x)); }
}

namespace pg8 {
constexpr int BM = 256, BK = 64, HALF = 128, HTB = HALF * BK * 2, STAGE_BYTES = 8 * HTB, NXCD = 8, WGM = 8;
__host__ __device__ __forceinline__ int lds_byte(int r, int c) { const int st = (r >> 4) * 2 + (c >> 5), rr = r & 15, cc = c & 31, ob = rr * 64 + cc * 2; return st * 1024 + (ob ^ (((ob >> 9) & 1) << 5)); }
__host__ __device__ __forceinline__ void stage_rc(int b, int& R, int& C) { const int st = b / 1024, sb = b % 1024, swz = sb ^ (((sb >> 9) & 1) << 5); R = (st >> 1) * 16 + swz / 64; C = (st & 1) * 32 + (swz % 64) / 2; }
__host__ __device__ __forceinline__ int perm32(int rho) { const int n = rho >> 4, i = rho & 15; return 8 * (i >> 2) + 4 * n + (i & 3); }

__device__ __forceinline__ bool tile_order(int i, int G, int c, int nM, int nN, int& pm, int& pn) {
    const int nwg = nM * nN; const long L = (long)i * G + c; if (L >= nwg) return false;
    int wgid = (int)L; { const int q = nwg / NXCD, r = nwg % NXCD, xcd = wgid % NXCD, off = wgid / NXCD; wgid = (xcd < r ? xcd * (q + 1) : r * (q + 1) + (xcd - r) * q) + off; }
    const int nig = WGM * nN, gid = wgid / nig, fm = gid * WGM, gsz = (nM - fm) < WGM ? (nM - fm) : WGM;
    pm = fm + ((wgid % nig) % gsz); pn = (wgid % nig) / gsz; return true;
}

struct Unit { int pm, pn, e, mt; };

struct DenseSched {
    int nM, nN, G, c, K; const char* Bt; int reps;
    static constexpr bool DRAIN = false, AFFINE = true;
    __device__ __forceinline__ bool next(int i, Unit& u) const { u.e = 0; u.mt = 0; const int per = (nM * nN + G - 1) / G; if (i >= per * reps) return false; if (!tile_order(i % per, G, c, nM, nN, u.pm, u.pn)) return tile_order(0, G, c, nM, nN, u.pm, u.pn); return true; }
    __device__ __forceinline__ void a_off(const Unit& u, const int (&R)[2], const int (&C)[2], unsigned (&off)[2][2]) const {
#pragma unroll
        for (int h = 0; h < 2; ++h)
#pragma unroll
            for (int i = 0; i < 2; ++i) off[h][i] = (unsigned)(((u.pm * BM + h * HALF + R[i]) * K + C[i]) * 2);
    }
    __device__ __forceinline__ const char* b_ptr(const Unit& u) const { return Bt + (size_t)u.pn * BM * K * 2; }
};
template <bool GATHER> struct MoeSched {
    const LAS int* trs; const LAS int* cnts; int nN, G, c, K; const char* Bt; size_t bstride; const int* ltok;
    static constexpr bool DRAIN = GATHER, AFFINE = !GATHER;
    __device__ __forceinline__ bool next(int i, Unit& u) const {
        const int nM = __builtin_amdgcn_readfirstlane(trs[NE]);
        if (!tile_order(i, G, c, nM, nN, u.pm, u.pn)) return false;
        const int ln = (int)(threadIdx.x & 63u); const int tv = trs[ln < NE ? ln : NE - 1];
        const int e = __popcll(__ballot(ln >= 1 && ln < NE && tv <= u.pm));
        u.e = e; u.mt = u.pm - __builtin_amdgcn_readfirstlane(trs[e]); return true;
    }
    __device__ __forceinline__ void a_rows(const Unit& u, const int (&R)[2], int (&row)[2][2]) const {
        const int n = __builtin_amdgcn_readfirstlane(cnts[u.e]);
#pragma unroll
        for (int h = 0; h < 2; ++h)
#pragma unroll
            for (int i = 0; i < 2; ++i) {
                if (GATHER) { const int p = u.mt * BM + h * HALF + R[i]; row[h][i] = (p < n) ? ltok[u.e * T + p] : 0; }
                else row[h][i] = u.pm * BM + h * HALF + R[i];
            }
    }
    __device__ __forceinline__ void a_off(const Unit& u, const int (&R)[2], const int (&C)[2], unsigned (&off)[2][2]) const {
        int row[2][2]; a_rows(u, R, row);
#pragma unroll
        for (int h = 0; h < 2; ++h)
#pragma unroll
            for (int i = 0; i < 2; ++i) off[h][i] = (unsigned)((row[h][i] * K + C[i]) * 2);
    }
    __device__ __forceinline__ const char* b_ptr(const Unit& u) const { return Bt + (size_t)u.e * bstride + (size_t)u.pn * BM * K * 2; }
};

struct EpiQKNorm {
    static constexpr bool PERM = true; static constexpr int BMAP = 1;
    bf16_t* O; const float* gq; const float* gk;
    __device__ __forceinline__ void operator()(const f32x4 (&acc)[2][2][4][2], const Unit& u, int wr, int wc, int fr, int fq) const {
        const int row0 = u.pm * BM + wr * 64 + fr, col0 = u.pn * BM + wc * 64 + 8 * fq;
        const bool nrm = u.pn < 4; const float* g = (u.pn < 2) ? gq : gk; const float qs = (u.pn < 2) ? 0.125f * LOG2E : 1.0f;
        f32x4 gv[2][2];
#pragma unroll
        for (int bj = 0; bj < 2; ++bj)
#pragma unroll
            for (int n = 0; n < 2; ++n) gv[bj][n] = nrm ? *(const f32x4*)(g + 32 * bj + 8 * fq + 4 * n) : (f32x4){1.f, 1.f, 1.f, 1.f};
#pragma unroll
        for (int ai = 0; ai < 2; ++ai)
#pragma unroll
            for (int m = 0; m < 4; ++m) { bf16_t* rowp = O + (size_t)(row0 + ai * HALF + m * 16) * NZ + col0;
                float sc = 1.0f;
                if (nrm) { float ss = 0.f;
#pragma unroll
                    for (int bj = 0; bj < 2; ++bj)
#pragma unroll
                        for (int n = 0; n < 2; ++n) { const f32x4 v = acc[ai][bj][m][n]; ss += v[0] * v[0] + v[1] * v[1] + v[2] * v[2] + v[3] * v[3]; }
                    ss += __shfl_xor(ss, 16); ss += __shfl_xor(ss, 32);
                    sc = qs / sqrtf(ss * (1.0f / 64.f) + EPS); }
#pragma unroll
                for (int bj = 0; bj < 2; ++bj) { const f32x4 v0 = acc[ai][bj][m][0] * gv[bj][0] * sc, v1 = acc[ai][bj][m][1] * gv[bj][1] * sc;
                    u32x4 w; w.x = pk2(v0[0], v0[1]); w.y = pk2(v0[2], v0[3]); w.z = pk2(v1[0], v1[1]); w.w = pk2(v1[2], v1[3]);
                    *(u32x4*)(rowp + bj * 32) = w; } }
    }
};
struct EpiResF32 {
    static constexpr bool PERM = false; static constexpr int BMAP = 0;
    float* C; const float* Rs; int ldc;
    __device__ __forceinline__ void operator()(const f32x4 (&acc)[2][2][4][2], const Unit& u, int wr, int wc, int fr, int fq) const {
        const int row0 = u.pm * BM + wr * 64 + fr, col0 = u.pn * BM + wc * 32 + 4 * fq;
#pragma unroll
        for (int ai = 0; ai < 2; ++ai)
#pragma unroll
            for (int mp = 0; mp < 2; ++mp) {
                f32x4 r[2][2][2];
#pragma unroll
                for (int mm = 0; mm < 2; ++mm) { const size_t ro = (size_t)(row0 + ai * HALF + (2 * mp + mm) * 16) * ldc + col0;
#pragma unroll
                    for (int bj = 0; bj < 2; ++bj)
#pragma unroll
                        for (int n = 0; n < 2; ++n) r[mm][bj][n] = __builtin_nontemporal_load((const f32x4*)(Rs + ro + bj * HALF + n * 16)); }
#pragma unroll
                for (int mm = 0; mm < 2; ++mm) { const size_t ro = (size_t)(row0 + ai * HALF + (2 * mp + mm) * 16) * ldc + col0;
#pragma unroll
                    for (int bj = 0; bj < 2; ++bj)
#pragma unroll
                        for (int n = 0; n < 2; ++n) *(f32x4*)(C + ro + bj * HALF + n * 16) = acc[ai][bj][2 * mp + mm][n] + r[mm][bj][n]; }
            }
    }
};
struct EpiSwiglu {
    static constexpr bool PERM = true; static constexpr int BMAP = 0;
    unsigned char* O; const float* bgu;
    __device__ __forceinline__ void operator()(const f32x4 (&acc)[2][2][4][2], const Unit& u, int wr, int wc, int fr, int fq) const {
        const int row0 = u.pm * BM + wr * 64 + fr, f0 = u.pn * HALF + wc * 32 + 8 * fq;
        const float* bg = bgu + (size_t)u.e * 2 * DFF + f0;
        constexpr float inv = 1.0f / (SC_H * SC_W);
        f32x4 bgv[2], buv[2];
#pragma unroll
        for (int n = 0; n < 2; ++n) { bgv[n] = *(const f32x4*)(bg + 4 * n); buv[n] = *(const f32x4*)(bg + DFF + 4 * n); }
#pragma unroll
        for (int ai = 0; ai < 2; ++ai)
#pragma unroll
            for (int m = 0; m < 4; ++m) { unsigned char* rowp = O + (size_t)(row0 + ai * HALF + m * 16) * DFF + f0;
                float r[8];
#pragma unroll
                for (int n = 0; n < 2; ++n) { const f32x4 gv = acc[ai][0][m][n] * inv + bgv[n], uv = acc[ai][1][m][n] * inv + buv[n];
#pragma unroll
                    for (int j = 0; j < 4; ++j) { const float gg = fminf(gv[j], 7.0f), uu = fminf(fmaxf(uv[j], -7.0f), 7.0f);
                        r[4 * n + j] = SC_A * gg * (uu + 1.0f) * __builtin_amdgcn_rcpf(1.0f + __builtin_amdgcn_exp2f(-1.702f * LOG2E * gg)); } }
                u32x2 w; w.x = pk4_fp8(r[0], r[1], r[2], r[3]); w.y = pk4_fp8(r[4], r[5], r[6], r[7]);
                *(u32x2*)rowp = w; }
    }
};
struct EpiDown {
    static constexpr bool PERM = true; static constexpr int BMAP = 0;
    bf16_t* O; const float* bd; const float* lgate; const LAS int* cnts;
    __device__ __forceinline__ void operator()(const f32x4 (&acc)[2][2][4][2], const Unit& u, int wr, int wc, int fr, int fq) const {
        const int row0 = u.pm * BM + wr * 64 + fr, col0 = u.pn * BM + wc * 32 + 8 * fq;
        const int n_e = cnts[u.e];
        f32x4 bv[2][2];
#pragma unroll
        for (int bj = 0; bj < 2; ++bj)
#pragma unroll
            for (int n = 0; n < 2; ++n) bv[bj][n] = *(const f32x4*)(bd + (size_t)u.e * DM + col0 + bj * HALF + 4 * n);
        float gts[2][4];
#pragma unroll
        for (int ai = 0; ai < 2; ++ai)
#pragma unroll
            for (int m = 0; m < 4; ++m) { const int p = u.mt * BM + wr * 64 + fr + ai * HALF + m * 16; gts[ai][m] = lgate[(size_t)u.e * T + (p < T ? p : T - 1)]; }
#pragma unroll
        for (int ai = 0; ai < 2; ++ai)
#pragma unroll
            for (int m = 0; m < 4; ++m) { const int rt = wr * 64 + fr + ai * HALF + m * 16, p = u.mt * BM + rt;
                const float gt = (p < n_e) ? gts[ai][m] : 0.f;
                bf16_t* rowp = O + (size_t)(row0 + ai * HALF + m * 16) * DM + col0;
#pragma unroll
                for (int bj = 0; bj < 2; ++bj) { const f32x4 v0 = (acc[ai][bj][m][0] * (1.0f / (SC_A * SC_W)) + bv[bj][0]) * gt, v1 = (acc[ai][bj][m][1] * (1.0f / (SC_A * SC_W)) + bv[bj][1]) * gt;
                    u32x4 w; w.x = pk2(v0[0], v0[1]); w.y = pk2(v0[2], v0[3]); w.z = pk2(v1[0], v1[1]); w.w = pk2(v1[2], v1[3]);
                    *(u32x4*)(rowp + bj * HALF) = w; } }
    }
};

template <bool FP8, class Epi, class Sched>
__device__ __forceinline__ void gemm_phase(LAS unsigned char* lds, const char* A0, const int K, const Sched& S, const Epi& E) {
    int tid = threadIdx.x; asm volatile("" : "+v"(tid));
    const int wid = __builtin_amdgcn_readfirstlane(tid >> 6), lane = tid & 63, wr = wid >> 2, wc = wid & 3, fr = lane & 15, fq = lane >> 4;
    const int nt = K / BK;
    int Rr[2], Cc[2]; unsigned voffB[2];
#pragma unroll
    for (int i = 0; i < 2; ++i) { stage_rc(tid * 16 + i * 8192, Rr[i], Cc[i]); const int r5 = Epi::PERM ? perm32(Rr[i] & 31) : (Rr[i] & 31); const int Rb = Epi::BMAP ? (64 * (Rr[i] >> 5) + r5) : ((Rr[i] & ~31) + r5); voffB[i] = (unsigned)(Rb * K + Cc[i]) * 2u; }
    const size_t kstep = (size_t)(BK * 2);
    const size_t hstep = (size_t)(Epi::BMAP ? 32 : HALF) * K * 2;
    const unsigned ldsw = (unsigned)wid * 1024u;
    const int aoff = lds_byte(wr * 64 + fr, fq * 8), boff = lds_byte(wc * 32 + fr, fq * 8);
#define PG8_SA(b, h) (((b) * 2 + (h)) * HTB)
#define PG8_SB(b, h) ((4 + (b) * 2 + (h)) * HTB)
#define PG8_STAGE_B(bufoff, gbase) do { _Pragma("unroll") for (int _i = 0; _i < 2; ++_i) \
        __builtin_amdgcn_global_load_lds((const unsigned*)((const char*)(gbase) + voffB[_i]), (LAS unsigned*)(lds + (bufoff) + ldsw + _i * 8192), 16, 0, 0); } while (0)
#define PG8_STAGE_A(bufoff, gbase, o0, o1) do { \
        __builtin_amdgcn_global_load_lds((const unsigned*)((const char*)(gbase) + (o0)), (LAS unsigned*)(lds + (bufoff) + ldsw), 16, 0, 0); \
        __builtin_amdgcn_global_load_lds((const unsigned*)((const char*)(gbase) + (o1)), (LAS unsigned*)(lds + (bufoff) + ldsw + 8192), 16, 0, 0); } while (0)
#define PG8_LDA(dst, b, h) do { if constexpr (FP8) { _Pragma("unroll") for (int m = 0; m < 4; ++m) { const i32x4 lo_ = *(const LAS i32x4*)(lds + PG8_SA(b, h) + aoff + m * 2048), hi_ = *(const LAS i32x4*)(lds + PG8_SA(b, h) + aoff + m * 2048 + 1024); \
            dst##8[m] = __builtin_shufflevector(lo_, hi_, 0, 1, 2, 3, 4, 5, 6, 7); } } \
        else { _Pragma("unroll") for (int m = 0; m < 4; ++m) _Pragma("unroll") for (int k = 0; k < 2; ++k) dst[m][k] = *(const LAS bf16x8*)(lds + PG8_SA(b, h) + aoff + m * 2048 + k * 1024); } } while (0)
#define PG8_LDB(dst, b, h) do { if constexpr (FP8) { _Pragma("unroll") for (int n = 0; n < 2; ++n) { const i32x4 lo_ = *(const LAS i32x4*)(lds + PG8_SB(b, h) + boff + n * 2048), hi_ = *(const LAS i32x4*)(lds + PG8_SB(b, h) + boff + n * 2048 + 1024); \
            dst##8[n] = __builtin_shufflevector(lo_, hi_, 0, 1, 2, 3, 4, 5, 6, 7); } } \
        else { _Pragma("unroll") for (int n = 0; n < 2; ++n) _Pragma("unroll") for (int k = 0; k < 2; ++k) dst[n][k] = *(const LAS bf16x8*)(lds + PG8_SB(b, h) + boff + n * 2048 + k * 1024); } } while (0)
#define PG8_MMA(ai, bj, At, Bt) do { __builtin_amdgcn_s_setprio(1); \
        if constexpr (FP8) { _Pragma("unroll") for (int m = 0; m < 4; ++m) _Pragma("unroll") for (int n = 0; n < 2; ++n) \
            asm volatile("s_nop 1\n\tv_mfma_f32_16x16x128_f8f6f4 %0, %1, %2, %0" : "+v"(acc[ai][bj][m][n]) : "v"(Bt##8[n]), "v"(At##8[m])); } \
        else { _Pragma("unroll") for (int m = 0; m < 4; ++m) _Pragma("unroll") for (int n = 0; n < 2; ++n) _Pragma("unroll") for (int k = 0; k < 2; ++k) \
            acc[ai][bj][m][n] = __builtin_amdgcn_mfma_f32_16x16x32_bf16(Bt[n][k], At[m][k], acc[ai][bj][m][n], 0, 0, 0); } \
        __builtin_amdgcn_s_setprio(0); } while (0)
#define PG8_WAIT_V(n) asm volatile("s_waitcnt vmcnt(" #n ")" ::: "memory")
#define PG8_WAIT_L(n) asm volatile("s_waitcnt lgkmcnt(" #n ")" ::: "memory")
#define PG8_BAR __builtin_amdgcn_s_barrier()
#define PG8_SCHED __builtin_amdgcn_sched_barrier(0)
    Unit cur, nxt; int ui = 0;
    if (!S.next(0, cur)) return;
    f32x4 acc[2][2][4][2];
#pragma unroll
    for (int a = 0; a < 2; ++a)
#pragma unroll
        for (int b = 0; b < 2; ++b)
#pragma unroll
            for (int m = 0; m < 4; ++m)
#pragma unroll
                for (int n = 0; n < 2; ++n) acc[a][b][m][n] = (f32x4){0.f, 0.f, 0.f, 0.f};
    bf16x8 At[4][2], B0[2][2], B1[2][2]; i32x8 At8[4], B08[2], B18[2];
    unsigned offC[2][2], offN[2][2];
    const char* uA = A0; const char* nA = A0;
    if constexpr (Sched::AFFINE) {
#pragma unroll
        for (int h = 0; h < 2; ++h)
#pragma unroll
            for (int i = 0; i < 2; ++i) offC[h][i] = (unsigned)(((h * HALF + Rr[i]) * K + Cc[i]) * 2);
        uA = A0 + (size_t)cur.pm * BM * K * 2;
    } else S.a_off(cur, Rr, Cc, offC);
    const char* cB = S.b_ptr(cur);
    int rowP[2][2] = {{0, 0}, {0, 0}}; Unit nx2;
    if constexpr (!Sched::AFFINE) { if (S.next(1, nx2)) S.a_rows(nx2, Rr, rowP); }
    if (Sched::DRAIN) PG8_WAIT_V(0);
    PG8_STAGE_B(PG8_SB(0, 0), cB); PG8_STAGE_B(PG8_SB(0, 1), cB + hstep); PG8_STAGE_A(PG8_SA(0, 0), uA, offC[0][0], offC[0][1]); PG8_STAGE_A(PG8_SA(0, 1), uA, offC[1][0], offC[1][1]);
    if (wr == 1) PG8_BAR;
    PG8_WAIT_V(2); PG8_BAR;
    PG8_STAGE_B(PG8_SB(1, 0), cB + kstep); PG8_STAGE_A(PG8_SA(1, 0), uA + kstep, offC[0][0], offC[0][1]); PG8_STAGE_B(PG8_SB(1, 1), cB + hstep + kstep);
    PG8_WAIT_V(6); PG8_BAR;
    for (;;) {
        const bool has_next = S.next(ui + 1, nxt);
        const char* nB = cB;
        if constexpr (Sched::AFFINE) { nA = uA; if (has_next) { nA = A0 + (size_t)nxt.pm * BM * K * 2; nB = S.b_ptr(nxt); } }
        else {
            if (has_next) { nB = S.b_ptr(nxt);
#pragma unroll
                for (int h = 0; h < 2; ++h)
#pragma unroll
                    for (int i = 0; i < 2; ++i) offN[h][i] = (unsigned)((rowP[h][i] * K + Cc[i]) * 2);
                if (S.next(ui + 2, nx2)) S.a_rows(nx2, Rr, rowP);
            } else {
#pragma unroll
                for (int h = 0; h < 2; ++h)
#pragma unroll
                    for (int i = 0; i < 2; ++i) offN[h][i] = offC[h][i];
            }
        }
        for (int t = 0; t < nt; t += 2) {
            const bool last = (t == nt - 2);
            const char* a1 = uA + (size_t)(t + 1) * kstep;
            const char* a2 = last ? nA : uA + (size_t)(t + 2) * kstep; const char* b2 = last ? nB : cB + (size_t)(t + 2) * kstep;
            const char* a3 = a2 + kstep; const char* b3 = b2 + kstep;
            unsigned o00 = offC[0][0], o01 = offC[0][1], o10 = offC[1][0], o11 = offC[1][1];
            if constexpr (!Sched::AFFINE) { if (last) { o00 = offN[0][0]; o01 = offN[0][1]; o10 = offN[1][0]; o11 = offN[1][1]; } }
            PG8_LDB(B0, 0, 0); PG8_LDB(B1, 0, 1); PG8_SCHED; PG8_LDA(At, 0, 0); PG8_STAGE_A(PG8_SA(1, 1), a1, offC[1][0], offC[1][1]);
            PG8_WAIT_V(8); PG8_WAIT_L(0); PG8_BAR; PG8_MMA(0, 0, At, B0); PG8_MMA(0, 1, At, B1); PG8_BAR; PG8_SCHED;
            PG8_LDA(At, 0, 1); PG8_STAGE_B(PG8_SB(0, 0), b2); PG8_STAGE_B(PG8_SB(0, 1), b2 + hstep); PG8_STAGE_A(PG8_SA(0, 0), a2, o00, o01);
            PG8_WAIT_V(8); PG8_WAIT_L(0); PG8_BAR; PG8_MMA(1, 0, At, B0); PG8_MMA(1, 1, At, B1); PG8_BAR; PG8_SCHED;
            PG8_LDB(B0, 1, 0); PG8_LDB(B1, 1, 1); PG8_SCHED; PG8_LDA(At, 1, 0); PG8_STAGE_A(PG8_SA(0, 1), a2, o10, o11);
            PG8_WAIT_V(8); PG8_WAIT_L(0); PG8_BAR; PG8_MMA(0, 0, At, B0); PG8_MMA(0, 1, At, B1); PG8_BAR; PG8_SCHED;
            PG8_LDA(At, 1, 1); PG8_STAGE_B(PG8_SB(1, 0), b3); PG8_STAGE_B(PG8_SB(1, 1), b3 + hstep); PG8_STAGE_A(PG8_SA(1, 0), a3, o00, o01);
            PG8_WAIT_V(8); PG8_WAIT_L(0); PG8_BAR; PG8_MMA(1, 0, At, B0); PG8_MMA(1, 1, At, B1); PG8_BAR; PG8_SCHED;
        }
        if (wr == 0) PG8_BAR;
        if constexpr (FP8) {
            asm volatile("s_nop 15\n\ts_nop 15" : "+v"(acc[0][0][0][0]), "+v"(acc[0][0][0][1]), "+v"(acc[0][0][1][0]), "+v"(acc[0][0][1][1]), "+v"(acc[0][0][2][0]), "+v"(acc[0][0][2][1]), "+v"(acc[0][0][3][0]), "+v"(acc[0][0][3][1]),
                                                    "+v"(acc[0][1][0][0]), "+v"(acc[0][1][0][1]), "+v"(acc[0][1][1][0]), "+v"(acc[0][1][1][1]), "+v"(acc[0][1][2][0]), "+v"(acc[0][1][2][1]), "+v"(acc[0][1][3][0]), "+v"(acc[0][1][3][1]));
            asm volatile("s_nop 0" : "+v"(acc[1][0][0][0]), "+v"(acc[1][0][0][1]), "+v"(acc[1][0][1][0]), "+v"(acc[1][0][1][1]), "+v"(acc[1][0][2][0]), "+v"(acc[1][0][2][1]), "+v"(acc[1][0][3][0]), "+v"(acc[1][0][3][1]),
                                   "+v"(acc[1][1][0][0]), "+v"(acc[1][1][0][1]), "+v"(acc[1][1][1][0]), "+v"(acc[1][1][1][1]), "+v"(acc[1][1][2][0]), "+v"(acc[1][1][2][1]), "+v"(acc[1][1][3][0]), "+v"(acc[1][1][3][1]));
        }
        E(acc, cur, wr, wc, fr, fq);
        if (!has_next) break;
#pragma unroll
        for (int a = 0; a < 2; ++a)
#pragma unroll
            for (int b = 0; b < 2; ++b)
#pragma unroll
                for (int m = 0; m < 4; ++m)
#pragma unroll
                    for (int n = 0; n < 2; ++n) acc[a][b][m][n] = (f32x4){0.f, 0.f, 0.f, 0.f};
        cur = nxt; cB = nB; ++ui;
        if constexpr (Sched::AFFINE) uA = nA;
        else {
#pragma unroll
            for (int h = 0; h < 2; ++h)
#pragma unroll
                for (int i = 0; i < 2; ++i) offC[h][i] = offN[h][i];
        }
        if (wr == 1) PG8_BAR;
    }
    PG8_WAIT_V(0);
    PG8_BAR;
#undef PG8_SA
#undef PG8_SB
#undef PG8_STAGE_A
#undef PG8_STAGE_B
#undef PG8_LDA
#undef PG8_LDB
#undef PG8_MMA
#undef PG8_WAIT_V
#undef PG8_WAIT_L
#undef PG8_BAR
#undef PG8_SCHED
}
}

namespace {
struct Params { const float* in[20]; float* out; unsigned char* ws; };

struct Frame {
    LAS unsigned char* lds;
    int tid, lane, wave, G, vcu, gw, ngw;
};

struct ConvItem { const float* src; unsigned char* dst; int ldw, ldt, kind; float scale; };
__device__ __forceinline__ void conv_load(const ConvItem& I, f32x4 (&v)[8], int lane) {
    const int r8 = lane >> 3, c4 = (lane & 7) * 4;
#pragma unroll
    for (int i = 0; i < 8; ++i) v[i] = __builtin_nontemporal_load((const f32x4*)(I.src + (size_t)(8 * i + r8) * I.ldw + c4));
}
__device__ __forceinline__ void conv_store(const ConvItem& I, const f32x4 (&v)[8], LAS float* scr, int lane) {
    const int r8 = lane >> 3, c4 = (lane & 7) * 4;
#pragma unroll
    for (int i = 0; i < 8; ++i) { LAS float* d = scr + (8 * i + r8) * 33 + c4; d[0] = v[i][0]; d[1] = v[i][1]; d[2] = v[i][2]; d[3] = v[i][3]; }
    asm volatile("s_waitcnt lgkmcnt(0)" ::: "memory");
    const float scale = I.scale;
    if (I.kind == 0) {
        const int c = lane & 7;
#pragma unroll
        for (int j = 0; j < 4; ++j) { const int n = (lane >> 3) + 8 * j; const LAS float* s = scr + (8 * c) * 33 + n;
            u32x4 o; o.x = pk2(s[0 * 33] * scale, s[1 * 33] * scale); o.y = pk2(s[2 * 33] * scale, s[3 * 33] * scale); o.z = pk2(s[4 * 33] * scale, s[5 * 33] * scale); o.w = pk2(s[6 * 33] * scale, s[7 * 33] * scale);
            *(u32x4*)(I.dst + ((size_t)n * I.ldt + 8 * c) * 2) = o; }
    } else {
        const int n = lane >> 1, kh = lane & 1; const LAS float* s = scr + (32 * kh) * 33 + n;
        unsigned w[8];
#pragma unroll
        for (int q = 0; q < 8; ++q) w[q] = pk4_fp8(s[(4 * q) * 33] * scale, s[(4 * q + 1) * 33] * scale, s[(4 * q + 2) * 33] * scale, s[(4 * q + 3) * 33] * scale);
        unsigned char* d = I.dst + (size_t)n * I.ldt + 32 * kh;
        *(u32x4*)d = (u32x4){w[0], w[1], w[2], w[3]}; *(u32x4*)(d + 16) = (u32x4){w[4], w[5], w[6], w[7]};
    }
    asm volatile("s_waitcnt lgkmcnt(0)" ::: "memory");
}
template <class GetItem>
__device__ __forceinline__ void conv_run(GetItem get, int first, int n, int stride, LAS float* scr, int lane) {
    if (first >= n) return;
    ConvItem A, B, C; f32x4 va[8], vb[8], vc[8];
    get(first, A); conv_load(A, va, lane);
    const bool hb = first + stride < n, hc = first + 2 * stride < n;
    B = A; C = A;
    if (hb) { get(first + stride, B); conv_load(B, vb, lane); }
    if (hc) { get(first + 2 * stride, C); conv_load(C, vc, lane); }
    for (int it = first; it < n; it += stride) {
        conv_store(A, va, scr, lane);
        A = B; B = C;
#pragma unroll
        for (int i = 0; i < 8; ++i) { va[i] = vb[i]; vb[i] = vc[i]; }
        const int nx = it + 3 * stride;
        if (nx < n) { get(nx, C); conv_load(C, vc, lane); }
    }
}
constexpr int I_GU = NE * 16 * 64, I_D = NE * 16 * 32;
__device__ __forceinline__ void moe_item(const Params& P, int r, ConvItem& I) {
    I.kind = 1; I.scale = SC_W; I.ldt = DM;
    if (r < I_GU) { const int e = r >> 10, kb = (r >> 6) & 15, nb = r & 63, n0 = 32 * nb, f = n0 & 1023, up = n0 >> 10;
        const int drow = (f >> 7) * 256 + up * 128 + (f & 127);
        I.src = P.in[16] + (size_t)e * DM * 2 * DFF + (size_t)(64 * kb) * 2 * DFF + n0; I.ldw = 2 * DFF;
        I.dst = P.ws + WS_WGU + (size_t)e * 2 * DFF * DM + (size_t)drow * DM + 64 * kb;
    } else { r -= I_GU; const int e = r >> 9, kb = (r >> 5) & 15, nb = r & 31;
        I.src = P.in[18] + (size_t)e * DFF * DM + (size_t)(64 * kb) * DM + 32 * nb; I.ldw = DM;
        I.dst = P.ws + WS_WD + (size_t)e * DM * DFF + (size_t)(32 * nb) * DFF + 64 * kb; }
}
__device__ __forceinline__ void moe_convert(const Params& P, Frame& F, int cw, int ncw) {
    LAS float* scr = (LAS float*)(F.lds + F.wave * 8448);
    conv_run([&](int r, ConvItem& I) { moe_item(P, r, I); }, cw, I_GU + I_D, ncw, scr, F.lane);
}

__device__ __forceinline__ void p0_prologue(const Params& P, Frame& F) {
    unsigned char* ws = P.ws;
    const float* w_in = P.in[2];
    LAS float* scr = (LAS float*)(F.lds + F.wave * 8448);
    LAS float* gwl = (LAS float*)(F.lds + 73728);
    for (int i = F.tid; i < 1024 * 8; i += NTHR) gwl[(i & 7) * 1024 + (i >> 3)] = w_in[(size_t)(i >> 3) * DIN + NZ + (i & 7)];
    __syncthreads();
    constexpr int I_IN = 16 * 96, I_OUT = 16 * 32, I_QK = 8 * 2 * 4, I_ZERO = 8 * 3;
    bf16_t* WqkT = (bf16_t*)(ws + WS_WQK);
    conv_run([&](int r, ConvItem& I) {
        I.kind = 0; I.scale = 1.f;
        if (r < I_IN) { const int kb = r / 96, nb = r % 96; I.src = w_in + (size_t)(64 * kb) * DIN + 32 * nb; I.ldw = DIN; I.dst = ws + WS_WIN + ((size_t)(32 * nb) * DM + 64 * kb) * 2; I.ldt = DM; return; }
        r -= I_IN;
        if (r < I_OUT) { const int kb = r / 32, nb = r % 32; I.src = P.in[12] + (size_t)(64 * kb) * DM + 32 * nb; I.ldw = DM; I.dst = ws + WS_WOUT + ((size_t)(32 * nb) * DM + 64 * kb) * 2; I.ldt = DM; return; }
        r -= I_OUT;
        { const int isk = r >> 5, h = (r >> 3) & 3, kb = (r >> 2) & 1, nb = r & 3;
            I.src = P.in[isk ? 8 : 7] + (size_t)h * 16384 + (size_t)(64 * kb) * 128 + 32 * nb; I.ldw = 128;
            I.dst = ws + WS_WQK + ((size_t)(isk * 512 + h * 128 + 32 * nb) * 512 + h * 128 + 64 * kb) * 2; I.ldt = 512; I.scale = isk ? 0.08838834764831845f : 1.f; }
    }, F.gw, I_IN + I_OUT + I_QK, F.ngw, scr, F.lane);
    moe_convert(P, F, F.gw, F.ngw);
    for (int r = F.gw; r < I_ZERO; r += F.ngw) {
        const int rb = r / 3, j = r % 3, cb = j + (j >= (rb & 3) ? 1 : 0);
        for (int q = F.lane; q < 128 * 16; q += 64) { const int rr = q >> 4, cc = q & 15; *(u32x4*)(WqkT + (size_t)(rb * 128 + rr) * 512 + cb * 128 + cc * 8) = (u32x4){0u, 0u, 0u, 0u}; }
    }
    {
        const float* wr = P.in[14]; float* wrt = (float*)(ws + WS_WRT);
        for (int idx = F.vcu * NTHR + F.tid; idx < DM * NE; idx += F.G * NTHR) wrt[(idx & 31) * DM + (idx >> 5)] = wr[idx];
    }
    const float* x = P.in[0]; const float* g1 = P.in[1];
    bf16_t* XN = (bf16_t*)(ws + WS_XN); float* GATE = (float*)(ws + WS_GATE);
    for (int row0 = F.gw; row0 < T; row0 += 2 * F.ngw) {
        f32x4 vv[2][4];
#pragma unroll
        for (int q = 0; q < 2; ++q) { const int row = row0 + q * F.ngw; const f32x4* xr = (const f32x4*)(x + (size_t)(row < T ? row : row0) * DM);
#pragma unroll
            for (int j = 0; j < 4; ++j) vv[q][j] = __builtin_nontemporal_load(xr + F.lane + 64 * j); }
#pragma unroll
        for (int q = 0; q < 2; ++q) {
            const int row = row0 + q * F.ngw; if (row >= T) break;
            float s = 0.f;
#pragma unroll
            for (int j = 0; j < 4; ++j) s += vv[q][j][0] * vv[q][j][0] + vv[q][j][1] * vv[q][j][1] + vv[q][j][2] * vv[q][j][2] + vv[q][j][3] * vv[q][j][3];
            s = wave_sum(s);
            const float rs = 1.0f / sqrtf(s * (1.0f / DM) + EPS);
            float ga[8];
#pragma unroll
            for (int c = 0; c < 8; ++c) ga[c] = 0.f;
#pragma unroll
            for (int j = 0; j < 4; ++j) { const f32x4 gg = ((const f32x4*)g1)[F.lane + 64 * j]; const f32x4 v = vv[q][j] * rs * gg;
                u32x2 w; w.x = pk2(v[0], v[1]); w.y = pk2(v[2], v[3]);
                *(u32x2*)(XN + (size_t)row * DM + 4 * (F.lane + 64 * j)) = w;
#pragma unroll
                for (int c = 0; c < 8; ++c) { const f32x4 wc = *(const LAS f32x4*)(gwl + c * 1024 + 4 * (F.lane + 64 * j)); ga[c] += v[0] * wc[0] + v[1] * wc[1] + v[2] * wc[2] + v[3] * wc[3]; } }
#pragma unroll
            for (int c = 0; c < 8; ++c) ga[c] = wave_sum(ga[c]);
            if (F.lane == 0) { *(f32x4*)(GATE + (size_t)row * 8) = (f32x4){ga[0], ga[1], ga[2], ga[3]}; *(f32x4*)(GATE + (size_t)row * 8 + 4) = (f32x4){ga[4], ga[5], ga[6], ga[7]}; }
        }
    }
}

#define MFMA16(a, b, c) __builtin_amdgcn_mfma_f32_16x16x32_bf16((a), (b), (c), 0, 0, 0)
struct AttBlk { int tlb, off, d, qb, m, b, h, pass, tt, edge; };
__device__ __forceinline__ void att_decode(int fb, int w, int vcu, int G, AttBlk& k) {
    const int ul = fb / 30, r = fb - 30 * ul, t6 = r / 5; k.m = r - 5 * t6; k.pass = t6 >> 1; k.tt = t6 & 1;
    const int unit = vcu + ul * G; k.tlb = (unit & 31) * 256; k.h = (unit >> 5) & 7; k.b = unit >> 8;
    const int tau = 2 * w + k.tt; k.d = 1 << (2 * k.pass);
    k.off = k.pass == 0 ? 0 : (k.pass == 1 ? (tau & 3) : tau); k.qb = k.pass == 0 ? 16 * tau : (k.pass == 1 ? 16 * (tau >> 2) : 0);
    const int p0 = k.tlb + k.off; k.edge = (p0 + (k.qb - 144) * k.d < 0) || (p0 + (k.qb + 15) * k.d > SEQ - 1);
}
__device__ __forceinline__ void attn_phase(const Params& P, Frame& F) {
    const bf16_t* Z = (const bf16_t*)(P.ws + WS_Z); bf16_t* MIX = (bf16_t*)(P.ws + WS_MIX);
    const int tid = F.tid;
    const int lane = tid & 63, i = lane & 15, g = lane >> 4, w = F.wave;
    float gm = fabsf(P.in[4][lane]);
#pragma unroll
    for (int o = 1; o < 64; o <<= 1) gm = fmaxf(gm, __shfl_xor(gm, o));
    const float kmax = 8.0f * gm * 1.01f;
    constexpr int OP = 272;
    LAS unsigned char* OL = F.lds;
    LAS float* LL = (LAS float*)(F.lds + 256 * OP);
    LAS unsigned char* vb = F.lds + 256 * OP + 1024 + w * 4608;
    const int vwr = (lane >> 3) * 144 + (lane & 7) * 16;
    const int vrd = (4 * g + (i >> 2)) * 144 + (i & 3) * 8;
    const int nunits = (512 - F.vcu + F.G - 1) / F.G, NFB = 30 * nunits;
    if (NFB <= 0) return;
#define ATT_WGBAR() do { asm volatile("s_waitcnt lgkmcnt(0)" ::: "memory"); __builtin_amdgcn_s_barrier(); asm volatile("" ::: "memory"); } while (0)
#define ATT_LOAD(kd, kfn, vrn) do { const bf16_t* Kh_ = Z + (size_t)(kd).b * SEQ * NZ + ZK + (kd).h * 64 + 8 * g; const bf16_t* Vh_ = Z + (size_t)(kd).b * SEQ * NZ + ZV + (kd).h * 64 + 8 * (lane & 7); \
        const int nb_ = (kd).qb - 144 + 32 * (kd).m, p0_ = (kd).tlb + (kd).off; \
        if ((kd).edge) { \
        _Pragma("unroll") for (int sb = 0; sb < 2; ++sb) { int kp = p0_ + (nb_ + 16 * sb + i) * (kd).d; kp = kp < 0 ? 0 : (kp > SEQ - 1 ? SEQ - 1 : kp); const bf16_t* kr = Kh_ + (size_t)kp * NZ; kfn[sb][0] = *(const bf16x8*)kr; kfn[sb][1] = *(const bf16x8*)(kr + 32); } \
        _Pragma("unroll") for (int c = 0; c < 4; ++c) { int kp = p0_ + (nb_ + 8 * c + (lane >> 3)) * (kd).d; kp = kp < 0 ? 0 : (kp > SEQ - 1 ? SEQ - 1 : kp); vrn[c] = *(const u32x4*)(Vh_ + (size_t)kp * NZ); } \
        } else { const size_t dz_ = (size_t)(kd).d * NZ; const bf16_t* kr0 = Kh_ + (size_t)(p0_ + (nb_ + i) * (kd).d) * NZ; const bf16_t* vr0 = Vh_ + (size_t)(p0_ + (nb_ + (lane >> 3)) * (kd).d) * NZ; \
        _Pragma("unroll") for (int sb = 0; sb < 2; ++sb) { const bf16_t* kr = kr0 + 16 * sb * dz_; kfn[sb][0] = *(const bf16x8*)kr; kfn[sb][1] = *(const bf16x8*)(kr + 32); } \
        _Pragma("unroll") for (int c = 0; c < 4; ++c) vrn[c] = *(const u32x4*)(vr0 + 8 * c * dz_); } } while (0)
#define ATT_LOADQ(kd, q0_, q1_) do { const bf16_t* qr_ = Z + (size_t)((kd).b * SEQ + (kd).tlb + (kd).off + (kd).d * ((kd).qb + i)) * NZ + ZQ + (kd).h * 64 + 8 * g; q0_ = *(const bf16x8*)qr_; q1_ = *(const bf16x8*)(qr_ + 32); } while (0)
    bf16x8 kx0[2][2], kx1[2][2], kx2[2][2]; u32x4 vx0[4], vx1[4], vx2[4]; bf16x8 qn0, qn1, qf0, qf1;
    AttBlk cur, nx;
    att_decode(0, w, F.vcu, F.G, cur);
    ATT_LOADQ(cur, qn0, qn1);
    ATT_LOAD(cur, kx0, vx0);
    att_decode(1, w, F.vcu, F.G, nx); ATT_LOAD(nx, kx1, vx1);
    f32x4 o[4]; float lsum = 0.f, ref = 0.f, slope2 = 0.f;
    __syncthreads();
#define ATT_STEP(FB_, KA_, VA_, KL_, VL_) do { \
        att_decode(FB_, w, F.vcu, F.G, cur); \
        if (cur.m == 0) { \
            qf0 = qn0; qf1 = qn1; \
            if (FB_ + 5 < NFB) { att_decode(FB_ + 5, w, F.vcu, F.G, nx); ATT_LOADQ(nx, qn0, qn1); } \
            float ss = 0.f; \
_Pragma("unroll") \
            for (int j = 0; j < 8; ++j) { const float a = bf2f((unsigned short)qf0[j]), c = bf2f((unsigned short)qf1[j]); ss += a * a + c * c; } \
            ss += __shfl_xor(ss, 16); ss += __shfl_xor(ss, 32); \
            ref = sqrtf(ss) * kmax; slope2 = exp2f(-(float)(cur.h + 1)) * LOG2E; \
_Pragma("unroll") \
            for (int dt = 0; dt < 4; ++dt) o[dt] = (f32x4){0.f, 0.f, 0.f, 0.f}; \
            lsum = 0.f; \
        } \
        if (FB_ + 2 < NFB) { att_decode(FB_ + 2, w, F.vcu, F.G, nx); ATT_LOAD(nx, KL_, VL_); } \
        const int d = cur.d, qb = cur.qb, nb = qb - 144 + 32 * cur.m, p0 = cur.tlb + cur.off; \
_Pragma("unroll") \
        for (int c = 0; c < 4; ++c) *(LAS u32x4*)(vb + vwr + c * 8 * 144) = VA_[c]; \
        f32x4 s[2]; \
_Pragma("unroll") \
        for (int sb = 0; sb < 2; ++sb) { s[sb] = MFMA16(KA_[sb][0], qf0, ((f32x4){0.f, 0.f, 0.f, 0.f})); s[sb] = MFMA16(KA_[sb][1], qf1, s[sb]); } \
        float p[8]; \
        if (!cur.edge && cur.m >= 1 && cur.m <= 3) { \
            const float a0 = (float)((qb + i - nb - 4 * g) * d); \
            const float base = -slope2 * a0 - ref, st = slope2 * (float)d; \
_Pragma("unroll") \
            for (int sb = 0; sb < 2; ++sb) \
_Pragma("unroll") \
                for (int j = 0; j < 4; ++j) { const float pv = __builtin_amdgcn_exp2f(s[sb][j] + (base + st * (float)(16 * sb + j))); p[4 * sb + j] = pv; lsum += pv; } \
        } else { \
_Pragma("unroll") \
        for (int sb = 0; sb < 2; ++sb) \
_Pragma("unroll") \
            for (int j = 0; j < 4; ++j) { const int n = nb + 16 * sb + 4 * g + j, a = qb + i - n; \
                const bool valid = (a >= 0) && (a <= 128) && (p0 + n * d >= 0); \
                const float e = s[sb][j] - slope2 * (float)(a * d) - ref; \
                const float pv = valid ? __builtin_amdgcn_exp2f(e) : 0.f; \
                p[4 * sb + j] = pv; lsum += pv; } \
        } \
        u32x4 pw; pw.x = pk2(p[0], p[1]); pw.y = pk2(p[2], p[3]); pw.z = pk2(p[4], p[5]); pw.w = pk2(p[6], p[7]); \
        const bf16x8 pf = __builtin_bit_cast(bf16x8, pw); \
_Pragma("unroll") \
        for (int dt = 0; dt < 4; ++dt) { \
            const s16x4 v0 = __builtin_amdgcn_ds_read_tr16_b64_v4i16((LAS s16x4*)(vb + vrd + dt * 32)); \
            const s16x4 v1 = __builtin_amdgcn_ds_read_tr16_b64_v4i16((LAS s16x4*)(vb + vrd + 16 * 144 + dt * 32)); \
            const bf16x8 vf = (bf16x8){v0[0], v0[1], v0[2], v0[3], v1[0], v1[1], v1[2], v1[3]}; \
            o[dt] = MFMA16(vf, pf, o[dt]); \
        } \
        if (cur.m == 4) { \
            float ls = lsum; ls += __shfl_xor(ls, 16); ls += __shfl_xor(ls, 32); \
            const int row = cur.off + d * (qb + i); \
            LAS f32x4* orow = (LAS f32x4*)(OL + row * OP + 16 * g); \
            if (cur.pass == 0) { \
_Pragma("unroll") \
                for (int dt = 0; dt < 4; ++dt) orow[4 * dt] = o[dt]; \
                if (g == 0) LL[row] = ls; \
            } else { \
_Pragma("unroll") \
                for (int dt = 0; dt < 4; ++dt) orow[4 * dt] = orow[4 * dt] + o[dt]; \
                if (g == 0) LL[row] += ls; \
            } \
            if (cur.tt == 1) { \
                ATT_WGBAR(); \
                if (cur.pass == 2) { \
                    const int rw = tid >> 1, hf = tid & 1; \
                    const float inv = 1.0f / LL[rw]; \
                    const LAS f32x4* orw = (const LAS f32x4*)(OL + rw * OP + hf * 128); \
                    bf16_t* mrow = MIX + (size_t)(cur.b * SEQ + cur.tlb + rw) * DM + cur.h * 64 + hf * 32; \
_Pragma("unroll") \
                    for (int q = 0; q < 4; ++q) { const f32x4 a0 = orw[2 * q] * inv, a1 = orw[2 * q + 1] * inv; \
                        u32x4 wv_; wv_.x = pk2(a0[0], a0[1]); wv_.y = pk2(a0[2], a0[3]); wv_.z = pk2(a1[0], a1[1]); wv_.w = pk2(a1[2], a1[3]); \
                        *(u32x4*)(mrow + 8 * q) = wv_; } \
                    ATT_WGBAR(); \
                } \
            } \
        } \
    } while (0)
#pragma unroll 1
    for (int fb = 0; fb < NFB; fb += 3) {
        ATT_STEP(fb, kx0, vx0, kx2, vx2);
        ATT_STEP(fb + 1, kx1, vx1, kx0, vx0);
        ATT_STEP(fb + 2, kx2, vx2, kx1, vx1);
    }
#undef ATT_STEP
#undef ATT_LOAD
#undef ATT_LOADQ
#undef ATT_WGBAR
    __syncthreads();
}

__device__ __forceinline__ bf16x8 tr2(LAS unsigned char* p0, LAS unsigned char* p1) {
    const s16x4 a = __builtin_amdgcn_ds_read_tr16_b64_v4i16((LAS s16x4*)p0);
    const s16x4 b = __builtin_amdgcn_ds_read_tr16_b64_v4i16((LAS s16x4*)p1);
    return (bf16x8){a[0], a[1], a[2], a[3], b[0], b[1], b[2], b[3]};
}

__device__ __forceinline__ void ml1_phase(const Params& P, Frame& F) {
    const bf16_t* Z = (const bf16_t*)(P.ws + WS_Z); bf16_t* QK = (bf16_t*)(P.ws + WS_QK); const float* GATE = (const float*)(P.ws + WS_GATE);
    const bf16_t* WqkT = (const bf16_t*)(P.ws + WS_WQK);
    float* BC = (float*)(P.ws + WS_BC); float* IG = (float*)(P.ws + WS_IG); float* BT = (float*)(P.ws + WS_BT); float* U = (float*)(P.ws + WS_U); float* NV = (float*)(P.ws + WS_NV);
    const float* bi = P.in[9]; const float* bf = P.in[10]; const float* cw = P.in[5]; const float* cb = P.in[6];
    constexpr int PIT = 272;
    LAS unsigned char* KIM = F.lds; LAS unsigned char* VIM = F.lds + 128 * PIT; LAS unsigned char* XIM = F.lds + 2 * 128 * PIT;
    LAS float* bc = (LAS float*)(F.lds + 3 * 128 * PIT); LAS float* wv = bc + 256;
    const int tid = F.tid;
    const int lane = tid & 63, i = lane & 15, g = lane >> 4, w = F.wave;
    bf16x8 ones;
#pragma unroll
    for (int j = 0; j < 8; ++j) ones[j] = (i == 0) ? (short)0x3F80 : (short)0;
    for (int unit = F.vcu; unit < 256; unit += F.G) {
        const int bh = unit / NCH, c = unit % NCH, b = bh / NHM, h = bh % NHM, t0 = b * SEQ + c * CH;
        float ig = 0.f;
        __syncthreads();
        if (tid < 256) { const float f = GATE[(size_t)(t0 + tid) * 8 + 4 + h] + bf[h];
            bc[tid] = fminf(f, 0.f) - log1pf(__expf(-fabsf(f)));
            ig = GATE[(size_t)(t0 + tid) * 8 + h] + bi[h]; }
        __syncthreads();
        if (w == 0) {
            const f32x4 a = *(const LAS f32x4*)(bc + 4 * lane);
            const float s1 = a[0], s2 = s1 + a[1], s3 = s2 + a[2], s4 = s3 + a[3];
            float x = s4;
#pragma unroll
            for (int off = 1; off < 64; off <<= 1) { const float v = __shfl_up(x, off); if (lane >= off) x += v; }
            const float ex = x - s4;
            *(LAS f32x4*)(bc + 4 * lane) = (f32x4){ex + s1, ex + s2, ex + s3, ex + s4};
        }
        __syncthreads();
        if (tid < 256) { BC[(size_t)(t0 + tid) * 4 + h] = bc[tid]; IG[(size_t)(t0 + tid) * 4 + h] = ig; wv[tid] = __expf(bc[255] - bc[tid] + ig); }
        if (tid == 0) BT[unit] = bc[255];
        bf16x8 wf[2][4];
#pragma unroll
        for (int e2 = 0; e2 < 2; ++e2) { const bf16_t* wp = WqkT + (size_t)((w >> 2) * 512 + h * 128 + 32 * (w & 3) + 16 * e2 + i) * 512 + h * 128 + 8 * g;
#pragma unroll
            for (int ks = 0; ks < 4; ++ks) wf[e2][ks] = *(const bf16x8*)(wp + 32 * ks); }
        f32x4 acc[9];
#pragma unroll
        for (int q = 0; q < 9; ++q) acc[q] = (f32x4){0.f, 0.f, 0.f, 0.f};
        for (int half = 0; half < 2; ++half) {
            __syncthreads();
#pragma unroll
            for (int q = 0; q < 4; ++q) { const int id = tid + 512 * q, row = id >> 4, c8 = (id & 15) * 8, sidx = half * 128 + row, tok = t0 + sidx, tl = c * CH + sidx;
                const int ch = h * 128 + c8;
                float a[8];
                { const f32x4 b0 = *(const f32x4*)(cb + ch), b1 = *(const f32x4*)(cb + ch + 4); a[0] = b0[0]; a[1] = b0[1]; a[2] = b0[2]; a[3] = b0[3]; a[4] = b1[0]; a[5] = b1[1]; a[6] = b1[2]; a[7] = b1[3]; }
#pragma unroll
                for (int j = 0; j < 4; ++j) { const int dt = 3 - j; if (tl - dt >= 0) {
                        const u32x4 xw = *(const u32x4*)(Z + (size_t)(tok - dt) * NZ + ZXM + ch);
                        const f32x4 w0 = *(const f32x4*)(cw + j * 512 + ch), w1 = *(const f32x4*)(cw + j * 512 + ch + 4);
                        a[0] += w0[0] * bflo(xw.x); a[1] += w0[1] * bfhi(xw.x); a[2] += w0[2] * bflo(xw.y); a[3] += w0[3] * bfhi(xw.y);
                        a[4] += w1[0] * bflo(xw.z); a[5] += w1[1] * bfhi(xw.z); a[6] += w1[2] * bflo(xw.w); a[7] += w1[3] * bfhi(xw.w); } }
#pragma unroll
                for (int j = 0; j < 8; ++j) a[j] = a[j] * sigmoidf_(a[j]);
                u32x4 o; o.x = pk2(a[0], a[1]); o.y = pk2(a[2], a[3]); o.z = pk2(a[4], a[5]); o.w = pk2(a[6], a[7]);
                *(LAS u32x4*)(XIM + row * PIT + c8 * 2) = o;
                *(LAS u32x4*)(VIM + row * PIT + c8 * 2) = *(const u32x4*)(Z + (size_t)tok * NZ + ZVM + ch); }
            __syncthreads();
#pragma unroll 2
            for (int tt = 0; tt < 8; ++tt) {
                bf16x8 xf[4];
#pragma unroll
                for (int ks = 0; ks < 4; ++ks) xf[ks] = *(const LAS bf16x8*)(XIM + (16 * tt + i) * PIT + (32 * ks + 8 * g) * 2);
                const int trow = 16 * tt + i, sidx = half * 128 + trow; const float ws_ = wv[sidx];
                bf16_t* qkrow = QK + (size_t)(t0 + sidx) * 1024 + (w >> 2) * 512 + h * 128 + 32 * (w & 3) + 4 * g;
#pragma unroll
                for (int e2 = 0; e2 < 2; ++e2) {
                    f32x4 d = (f32x4){0.f, 0.f, 0.f, 0.f};
#pragma unroll
                    for (int ks = 0; ks < 4; ++ks) d = MFMA16(wf[e2][ks], xf[ks], d);
                    u32x2 o; o.x = pk2(d[0], d[1]); o.y = pk2(d[2], d[3]);
                    *(u32x2*)(qkrow + 16 * e2) = o;
                    if (w >= 4) { u32x2 ok; ok.x = pk2(d[0] * ws_, d[1] * ws_); ok.y = pk2(d[2] * ws_, d[3] * ws_); *(LAS u32x2*)(KIM + trow * PIT + (32 * (w & 3) + 16 * e2 + 4 * g) * 2) = ok; }
                }
            }
            __syncthreads();
#pragma unroll
            for (int kk = 0; kk < 4; ++kk) {
                const int ro = (32 * kk + 8 * g + (i >> 2)) * PIT + (i & 3) * 8;
                const bf16x8 af = tr2(KIM + ro + 32 * w, KIM + ro + 4 * PIT + 32 * w);
#pragma unroll
                for (int et = 0; et < 8; ++et) { const bf16x8 bfr = tr2(VIM + ro + 32 * et, VIM + ro + 4 * PIT + 32 * et); acc[et] = MFMA16(af, bfr, acc[et]); }
                acc[8] = MFMA16(af, ones, acc[8]);
            }
        }
        float* up = U + (size_t)unit * 16384 + (size_t)(16 * w + 4 * g) * 128 + i;
#pragma unroll
        for (int et = 0; et < 8; ++et)
#pragma unroll
            for (int j = 0; j < 4; ++j) up[j * 128 + 16 * et] = acc[et][j];
        if (i == 0) {
#pragma unroll
            for (int j = 0; j < 4; ++j) NV[unit * 128 + 16 * w + 4 * g + j] = acc[8][j];
        }
    }
}

__device__ __forceinline__ void ml2_phase(const Params& P, Frame& F) {
    const float* BT = (const float*)(P.ws + WS_BT); const float* U = (const float*)(P.ws + WS_U); const float* NV = (const float*)(P.ws + WS_NV);
    bf16_t* CS = (bf16_t*)(P.ws + WS_CS); float* NS = (float*)(P.ws + WS_CS + 8 * MiB);
    for (int item = F.vcu; item < 256; item += F.G) {
        const int bh = item >> 5, sl = item & 31, el = sl * 512 + F.tid;
        float u[NCH];
#pragma unroll
        for (int c = 0; c < NCH; ++c) u[c] = U[(size_t)(bh * NCH + c) * 16384 + el];
        float st = 0.f;
#pragma unroll
        for (int c = 0; c < NCH; ++c) { CS[(size_t)(bh * NCH + c) * 16384 + el] = (bf16_t)f2bf(st); st = __expf(BT[bh * NCH + c]) * st + u[c]; }
        if (sl == 0 && F.tid < 128) { float n = 0.f;
            for (int c = 0; c < NCH; ++c) { NS[(bh * NCH + c) * 128 + F.tid] = n; n = __expf(BT[bh * NCH + c]) * n + NV[(bh * NCH + c) * 128 + F.tid]; } }
    }
}

__device__ __forceinline__ void ml3_phase(const Params& P, Frame& F) {
    const bf16_t* Z = (const bf16_t*)(P.ws + WS_Z); const bf16_t* QK = (const bf16_t*)(P.ws + WS_QK);
    const float* BC = (const float*)(P.ws + WS_BC); const float* IG = (const float*)(P.ws + WS_IG); const float* BT = (const float*)(P.ws + WS_BT);
    const float* U = (const float*)(P.ws + WS_U); const float* NV = (const float*)(P.ws + WS_NV); const float* gn = P.in[11];
    bf16_t* MIX = (bf16_t*)(P.ws + WS_MIX);
    constexpr int CP = 288, VP = 272;
    LAS unsigned char* CIM = F.lds;
    LAS unsigned char* VIM = F.lds + 128 * CP;
    LAS float* cs = (LAS float*)(F.lds + 128 * CP + 256 * VP);
    LAS float* bq = cs + 256;
    const int tid = F.tid;
    const int lane = tid & 63, i = lane & 15, g = lane >> 4, w = F.wave;
    for (int unit = F.vcu; unit < 256; unit += F.G) {
        const int bh = unit / NCH, c = unit % NCH, b = bh / NHM, h = bh % NHM, t0 = b * SEQ + c * CH;
        __syncthreads();
#pragma unroll
        for (int q = 0; q < 8; ++q) { const int id = tid + 512 * q, row = id >> 4, c8 = (id & 15) * 8;
            *(LAS u32x4*)(VIM + row * VP + c8 * 2) = *(const u32x4*)(Z + (size_t)(t0 + row) * NZ + ZVM + h * 128 + c8); }
        if (tid < 256) { const float bb = BC[(size_t)(t0 + tid) * 4 + h]; bq[tid] = bb; cs[tid] = IG[(size_t)(t0 + tid) * 4 + h] - bb; }
        {   const bf16_t* cs = (const bf16_t*)(P.ws + WS_CS) + (size_t)unit * 16384; const float* ns = (const float*)(P.ws + WS_CS + 8 * MiB) + unit * 128;
#pragma unroll
            for (int q = 0; q < 4; ++q) { const int id = tid + 512 * q, d = id >> 4, e8 = (id & 15) * 8; *(LAS u32x4*)(CIM + d * CP + e8 * 2) = *(const u32x4*)(cs + d * 128 + e8); }
            if (tid < 128) { *(LAS u32x4*)(CIM + tid * CP + 256) = (u32x4){f2bf(ns[tid]), 0u, 0u, 0u}; *(LAS u32x4*)(CIM + tid * CP + 272) = (u32x4){0u, 0u, 0u, 0u}; }
        }
        __syncthreads();
#pragma unroll 1
        for (int a = 0; a < 2; ++a) {
            const int qt = a ? 15 - w : w;
            bf16x8 qf[4];
            { const bf16_t* qp = QK + (size_t)(t0 + 16 * qt + i) * 1024 + h * 128 + 8 * g;
#pragma unroll
                for (int ks = 0; ks < 4; ++ks) qf[ks] = *(const bf16x8*)(qp + 32 * ks); }
            const float bt = bq[16 * qt + i];
            f32x4 acc[8]; float den;
            {
                f32x4 a8 = (f32x4){0.f, 0.f, 0.f, 0.f};
#pragma unroll
                for (int et = 0; et < 8; ++et) acc[et] = (f32x4){0.f, 0.f, 0.f, 0.f};
#pragma unroll
                for (int ks = 0; ks < 4; ++ks) {
                    const int ro = (32 * ks + 8 * g + (i >> 2)) * CP + (i & 3) * 8;
#pragma unroll
                    for (int et = 0; et < 8; ++et) { const bf16x8 cf = tr2(CIM + ro + 32 * et, CIM + ro + 4 * CP + 32 * et); acc[et] = MFMA16(cf, qf[ks], acc[et]); }
                    const bf16x8 cf = tr2(CIM + ro + 256, CIM + ro + 4 * CP + 256);
                    a8 = MFMA16(cf, qf[ks], a8);
                }
                const float eb = __expf(bt);
#pragma unroll
                for (int et = 0; et < 8; ++et) acc[et] = acc[et] * eb;
                den = (g == 0) ? a8[0] * eb : 0.f;
            }
            const int kbhi = qt >> 1;
#pragma unroll 1
            for (int kb = 0; kb <= kbhi; ++kb) {
                float p[8];
#pragma unroll
                for (int sb = 0; sb < 2; ++sb) {
                    const bf16_t* kp = QK + (size_t)(t0 + 32 * kb + 16 * sb + i) * 1024 + 512 + h * 128 + 8 * g;
                    f32x4 sacc = (f32x4){0.f, 0.f, 0.f, 0.f};
#pragma unroll
                    for (int ks = 0; ks < 4; ++ks) { const bf16x8 kf = *(const bf16x8*)(kp + 32 * ks); sacc = MFMA16(kf, qf[ks], sacc); }
                    const f32x4 cv = *(const LAS f32x4*)(cs + 32 * kb + 16 * sb + 4 * g);
#pragma unroll
                    for (int j = 0; j < 4; ++j) { const int srow = 32 * kb + 16 * sb + 4 * g + j, tcol = 16 * qt + i;
                        const float pv = (srow <= tcol) ? sacc[j] * __expf(bt + cv[j]) : 0.f;
                        p[4 * sb + j] = pv; den += pv; } }
                u32x4 pw; pw.x = pk2(p[0], p[1]); pw.y = pk2(p[2], p[3]); pw.z = pk2(p[4], p[5]); pw.w = pk2(p[6], p[7]);
                const bf16x8 pf = __builtin_bit_cast(bf16x8, pw);
                const int ro = (32 * kb + 4 * g + (i >> 2)) * VP + (i & 3) * 8;
#pragma unroll
                for (int et = 0; et < 8; ++et) { const bf16x8 vf = tr2(VIM + ro + 32 * et, VIM + ro + 16 * VP + 32 * et); acc[et] = MFMA16(vf, pf, acc[et]); }
            }
            float dn = den; dn += __shfl_xor(dn, 16); dn += __shfl_xor(dn, 32);
            const float dd = 1.0f / fmaxf(fabsf(dn), 1.0f);
            float ss = 0.f;
#pragma unroll
            for (int et = 0; et < 8; ++et) { acc[et] = acc[et] * dd; ss += acc[et][0] * acc[et][0] + acc[et][1] * acc[et][1] + acc[et][2] * acc[et][2] + acc[et][3] * acc[et][3]; }
            ss += __shfl_xor(ss, 16); ss += __shfl_xor(ss, 32);
            const float rstd = 1.0f / sqrtf(ss * (1.0f / HDM) + EPS);
            const int tok = t0 + 16 * qt + i;
#pragma unroll
            for (int et = 0; et < 8; ++et) { const int e0 = 16 * et + 4 * g;
                const u32x2 ow = *(const u32x2*)(Z + (size_t)tok * NZ + ZOM + h * 128 + e0);
                const f32x4 gv = *(const f32x4*)(gn + h * 128 + e0);
                const float r0 = sigmoidf_(bflo(ow.x)) * acc[et][0] * rstd * gv[0], r1 = sigmoidf_(bfhi(ow.x)) * acc[et][1] * rstd * gv[1];
                const float r2 = sigmoidf_(bflo(ow.y)) * acc[et][2] * rstd * gv[2], r3 = sigmoidf_(bfhi(ow.y)) * acc[et][3] * rstd * gv[3];
                u32x2 o; o.x = pk2(r0, r1); o.y = pk2(r2, r3);
                *(u32x2*)(MIX + (size_t)tok * DM + 512 + h * 128 + e0) = o; }
        }
    }
}

__device__ __forceinline__ void router_phase(const Params& P, Frame& F, const bool commit) {
    const float* X1 = P.out; const float* g2 = P.in[13]; const float* wrt = (const float*)(P.ws + WS_WRT); const float* br = P.in[15];
    unsigned char* H8 = P.ws + WS_H8; int* cnt = (int*)(P.ws + WS_CTL); int* ltok = (int*)(P.ws + WS_LTOK); float* lgate = (float*)(P.ws + WS_LGATE); int* tke = (int*)(P.ws + WS_TKE);
    constexpr int HP = 4112;
    LAS int* lcnt = (LAS int*)(F.lds);
    LAS int* pe = lcnt + 64;
    LAS float* pg = (LAS float*)(pe + 256);
    LAS float* lp = pg + 256;
    LAS unsigned char* him = F.lds + 12288;
    const int lane = F.lane, tid = F.tid, w = F.wave, i = lane & 15, g = lane >> 4;
    for (int chunk = F.vcu; chunk < T / 64; chunk += F.G) {
        __syncthreads();
        if (tid < 64) lcnt[tid] = 0;
        for (int hp = 0; hp < 2; ++hp) {
            __syncthreads();
#pragma unroll
            for (int tt = 0; tt < 4; ++tt) {
                const int tl = w * 4 + tt, tok = chunk * 64 + hp * 32 + tl;
                const f32x4* xr = (const f32x4*)(X1 + (size_t)tok * DM);
                f32x4 v[4]; float s = 0.f;
#pragma unroll
                for (int j = 0; j < 4; ++j) { v[j] = xr[lane + 64 * j]; s += v[j][0] * v[j][0] + v[j][1] * v[j][1] + v[j][2] * v[j][2] + v[j][3] * v[j][3]; }
                s = wave_sum(s);
                const float r = 1.0f / sqrtf(s * (1.0f / DM) + EPS);
#pragma unroll
                for (int j = 0; j < 4; ++j) { const f32x4 gg = ((const f32x4*)g2)[lane + 64 * j]; v[j] = v[j] * r * gg;
                    *(LAS f32x4*)(him + tl * HP + 16 * (lane + 64 * j)) = v[j];
                    *(unsigned*)(H8 + (size_t)tok * DM + 4 * (lane + 64 * j)) = pk4_fp8(v[j][0] * SC_H, v[j][1] * SC_H, v[j][2] * SC_H, v[j][3] * SC_H); }
            }
            __syncthreads();
            {   const int tt2 = w & 1, et = (w >> 1) & 1, kh = w >> 2;
                const float* ap = wrt + (size_t)(16 * et + i) * DM + 512 * kh + 4 * g;
                const LAS unsigned char* bp = him + (16 * tt2 + i) * HP + (512 * kh + 4 * g) * 4;
                f32x4 acc = (f32x4){0.f, 0.f, 0.f, 0.f}, acc1 = (f32x4){0.f, 0.f, 0.f, 0.f};
#pragma unroll 8
                for (int c = 0; c < 32; ++c) {
                    const f32x4 av = *(const f32x4*)(ap + 16 * c); const f32x4 bv = *(const LAS f32x4*)(bp + 64 * c);
                    acc = __builtin_amdgcn_mfma_f32_16x16x4f32(av[0], bv[0], acc, 0, 0, 0); acc1 = __builtin_amdgcn_mfma_f32_16x16x4f32(av[1], bv[1], acc1, 0, 0, 0);
                    acc = __builtin_amdgcn_mfma_f32_16x16x4f32(av[2], bv[2], acc, 0, 0, 0); acc1 = __builtin_amdgcn_mfma_f32_16x16x4f32(av[3], bv[3], acc1, 0, 0, 0);
                }
                acc = acc + acc1;
                *(LAS f32x4*)(lp + (kh * 32 + 16 * tt2 + i) * 32 + 16 * et + 4 * g) = acc;
            }
            __syncthreads();
            if (tid < 32) {
                const LAS float* l0 = lp + tid * 32; const LAS float* l1 = lp + (32 + tid) * 32;
                float tv0 = -INFINITY, tv1 = -INFINITY, tv2 = -INFINITY, tv3 = -INFINITY; int te0 = 0, te1 = 0, te2 = 0, te3 = 0;
#pragma unroll
                for (int e = 0; e < NE; ++e) {
                    const float x = (l0[e] + l1[e]) + br[e];
                    const bool g0 = x > tv0, g1 = x > tv1, g2_ = x > tv2, g3 = x > tv3;
                    tv3 = g2_ ? tv2 : (g3 ? x : tv3); te3 = g2_ ? te2 : (g3 ? e : te3);
                    tv2 = g1 ? tv1 : (g2_ ? x : tv2); te2 = g1 ? te1 : (g2_ ? e : te2);
                    tv1 = g0 ? tv0 : (g1 ? x : tv1); te1 = g0 ? te0 : (g1 ? e : te1);
                    tv0 = g0 ? x : tv0; te0 = g0 ? e : te0;
                }
                const float e1 = __expf(tv1 - tv0), e2 = __expf(tv2 - tv0), e3 = __expf(tv3 - tv0);
                const float inv = 1.0f / (1.0f + e1 + e2 + e3);
                const int tl = hp * 32 + tid;
                const int rk0 = __hip_atomic_fetch_add((int*)(lcnt + te0), 1, __ATOMIC_RELAXED, __HIP_MEMORY_SCOPE_WORKGROUP);
                const int rk1 = __hip_atomic_fetch_add((int*)(lcnt + te1), 1, __ATOMIC_RELAXED, __HIP_MEMORY_SCOPE_WORKGROUP);
                const int rk2 = __hip_atomic_fetch_add((int*)(lcnt + te2), 1, __ATOMIC_RELAXED, __HIP_MEMORY_SCOPE_WORKGROUP);
                const int rk3 = __hip_atomic_fetch_add((int*)(lcnt + te3), 1, __ATOMIC_RELAXED, __HIP_MEMORY_SCOPE_WORKGROUP);
                pe[tl * 4 + 0] = te0 | (rk0 << 8); pe[tl * 4 + 1] = te1 | (rk1 << 8); pe[tl * 4 + 2] = te2 | (rk2 << 8); pe[tl * 4 + 3] = te3 | (rk3 << 8);
                pg[tl * 4 + 0] = inv; pg[tl * 4 + 1] = e1 * inv; pg[tl * 4 + 2] = e2 * inv; pg[tl * 4 + 3] = e3 * inv;
            }
        }
        __syncthreads();
        if (tid < NE && commit) { const int n = lcnt[tid]; lcnt[32 + tid] = n ? atomicAdd(&cnt[64 * tid], n) : 0; }
        __syncthreads();
        if (tid < 256 && commit) { const int wq = pe[tid], ee = wq & 255, p = lcnt[32 + ee] + (wq >> 8), tok = chunk * 64 + (tid >> 2);
            ltok[ee * T + p] = tok; lgate[ee * T + p] = pg[tid]; tke[tok * 4 + (tid & 3)] = ee | (p << 8); }
    }
}

__device__ __forceinline__ void build_tables(const Params& P, Frame& F) {
    LAS int* trs = (LAS int*)(F.lds + LDS_TAB); LAS int* cnts = trs + 64;
    const int* cnt = (const int*)(P.ws + WS_CTL);
    if (F.tid == 0) { int a = 0; for (int e = 0; e < NE; ++e) { const int n = cnt[64 * e]; trs[e] = a; cnts[e] = n; a += (n + 255) >> 8; } trs[NE] = a; }
    __syncthreads();
}

__device__ __forceinline__ void combine_phase(const Params& P, Frame& F, const bool commit) {
    const LAS int* trs = (const LAS int*)(F.lds + LDS_TAB);
    const bf16_t* Y = (const bf16_t*)(P.ws + WS_Y); const int* tke = (const int*)(P.ws + WS_TKE);
    float* out = P.out; const int lane = F.lane;
    for (int tok = F.gw; tok < T; tok += F.ngw) {
        f32x4 a[4];
#pragma unroll
        for (int j = 0; j < 4; ++j) a[j] = *(const f32x4*)(out + (size_t)tok * DM + 4 * (lane + 64 * j));
#pragma unroll
        for (int k = 0; k < 4; ++k) { const int w = tke[tok * 4 + k], e = w & 255, p = w >> 8; const size_t slot = (size_t)trs[e] * 256 + p;
#pragma unroll
            for (int j = 0; j < 4; ++j) { const u32x2 y = *(const u32x2*)(Y + slot * DM + 4 * (lane + 64 * j)); a[j][0] += bflo(y.x); a[j][1] += bfhi(y.x); a[j][2] += bflo(y.y); a[j][3] += bfhi(y.y); } }
#pragma unroll
        for (int j = 0; j < 4; ++j) if (commit || a[j][0] == 123456.789f) *(f32x4*)(out + (size_t)tok * DM + 4 * (lane + 64 * j)) = a[j];
    }
}


#define XB_TMO      128
#define XB_XCNT(j)  (256  + 64 * (j))
#define XB_XSUB(j)  (1280 + 64 * (j))
#define XB_XGEN(j)  (2304 + 64 * (j))
#define XB_TOP      3328
#define XB_TOPGEN   3392
#define XCD_BAR_WORDS 3456
#define XB_SPIN_CAP (1u << 18)
__device__ __forceinline__ unsigned xb_ld(unsigned* p)              { return __hip_atomic_load(p, __ATOMIC_RELAXED, __HIP_MEMORY_SCOPE_AGENT); }
__device__ __forceinline__ unsigned xb_add(unsigned* p, unsigned v) { return __hip_atomic_fetch_add(p, v, __ATOMIC_RELAXED, __HIP_MEMORY_SCOPE_AGENT); }
__device__ __forceinline__ unsigned xb_xcc_id() { return (unsigned)__builtin_amdgcn_s_getreg((3 << 11) | 20) & 0xFu; }
#define XB_SPIN(cond, bar) do { unsigned _sp = 0; while (cond) { __builtin_amdgcn_s_sleep(1); \
    if ((++_sp & 255u) == 0u) { if (xb_ld(&(bar)[XB_TMO])) break; if (_sp > XB_SPIN_CAP) { atomicAdd(&(bar)[XB_TMO], 1u); break; } } } } while (0)
struct XcdBarrier { unsigned* bar; unsigned x; volatile LAS unsigned* st; };
__device__ __forceinline__ XcdBarrier xcd_barrier_post(unsigned* bar, volatile LAS unsigned* st) {
    XcdBarrier b; b.bar = bar; b.x = xb_xcc_id(); b.st = st;
    if (threadIdx.x == 0) (void)xb_add(&bar[XB_XCNT(b.x)], 1u);
    return b;
}
__device__ __forceinline__ void xcd_barrier_complete(unsigned* bar, unsigned x, unsigned& nloc, unsigned& nx) {
    const unsigned G = gridDim.x * gridDim.y * gridDim.z;
    unsigned sum, cnt, mine, sp = 0u;
    for (;;) {
        sum = 0u; cnt = 0u; mine = 0u;
#pragma unroll
        for (unsigned j = 0; j < 16; ++j) { const unsigned c = xb_ld(&bar[XB_XCNT(j)]); sum += c; cnt += (c > 0u) ? 1u : 0u; mine = (j == x) ? c : mine; }
        if (sum == G) break;
        __builtin_amdgcn_s_sleep(1);
        if ((++sp & 255u) == 0u) { if (xb_ld(&bar[XB_TMO])) break; if (sp > XB_SPIN_CAP) { atomicAdd(&bar[XB_TMO], 1u); break; } }
    }
    nloc = mine > 0u ? mine : 1u; nx = cnt > 0u ? cnt : 1u;
}
__device__ __forceinline__ void xcd_barrier2(const XcdBarrier& b, unsigned& epoch) {
    asm volatile("s_waitcnt vmcnt(0)" ::: "memory");
    __syncthreads();
    const unsigned ep = ++epoch;
    if (threadIdx.x < 64) {
        unsigned* bar = b.bar; const unsigned lane = threadIdx.x;
        unsigned mask = 0u;
        if (lane == 0) {
            __builtin_amdgcn_s_waitcnt(0);
            unsigned nloc = b.st[0], nx = b.st[1];
            if (nloc == 0u) { xcd_barrier_complete(bar, b.x, nloc, nx); unsigned m = 0u;
#pragma unroll
                for (unsigned j = 0; j < 16; ++j) m |= (xb_ld(&bar[XB_XCNT(j)]) > 0u) ? (1u << j) : 0u;
                b.st[0] = nloc; b.st[1] = nx; b.st[2] = m; }
            mask = b.st[2];
            const unsigned old = xb_add(&bar[XB_XSUB(b.x)], 1u);
            if (old + 1u == ep * nloc) {
                __builtin_amdgcn_fence(__ATOMIC_RELEASE, "agent");
                asm volatile("s_waitcnt vmcnt(0)" ::: "memory");
                __hip_atomic_store(&bar[XB_XGEN(b.x)], ep, __ATOMIC_RELAXED, __HIP_MEMORY_SCOPE_AGENT);
            }
        }
        mask = __builtin_amdgcn_readfirstlane(mask);
        unsigned sp = 0;
        for (;;) {
            const bool need = lane < 16u && ((mask >> lane) & 1u);
            const unsigned v = need ? xb_ld(&bar[XB_XGEN(lane)]) : ep;
            if (__all(v >= ep)) break;
            __builtin_amdgcn_s_sleep(1);
            if ((++sp & 255u) == 0u) { if (xb_ld(&bar[XB_TMO])) break; if (sp > XB_SPIN_CAP) { atomicAdd(&bar[XB_TMO], 1u); break; } }
        }
        __builtin_amdgcn_fence(__ATOMIC_ACQUIRE, "agent");
        asm volatile("s_waitcnt vmcnt(0)" ::: "memory");
    }
    __syncthreads();
}

__global__ void __launch_bounds__(NTHR) fwd_megakernel(Params P) {
    extern __shared__ __attribute__((aligned(16))) unsigned char lds_raw[];
    Frame F;
    F.lds = (LAS unsigned char*)lds_raw;
    F.tid = threadIdx.x; F.lane = F.tid & 63; F.wave = __builtin_amdgcn_readfirstlane(F.tid >> 6);
    F.G = gridDim.x; { const int bx = blockIdx.x; F.vcu = (F.G % 8 == 0) ? (bx % 8) * (F.G / 8) + bx / 8 : bx; }
    F.gw = F.vcu * NWAVES + F.wave; F.ngw = F.G * NWAVES;
    unsigned char* ws = P.ws;
    LAS unsigned char* stage = F.lds + LDS_STAGE;
    volatile LAS unsigned* bst = (volatile LAS unsigned*)(F.lds + LDS_TAB + 512);
    if (F.tid < 4) bst[F.tid] = 0u;
    __syncthreads();
    const XcdBarrier bar = xcd_barrier_post((unsigned*)(ws + WS_CTL) + 4096, bst);
    LAS unsigned long long* tstamp = (LAS unsigned long long*)(F.lds + LDS_TAB + 640); int nstamp = 0;
    if (TPROBE >= 0 && blockIdx.x == 0 && F.tid == 0) tstamp[nstamp] = __builtin_amdgcn_s_memrealtime();
    ++nstamp;
    unsigned bar_epoch = 0u;
#define GRID_SYNC() do { xcd_barrier2(bar, bar_epoch); if (TPROBE >= 0 && blockIdx.x == 0 && F.tid == 0) tstamp[nstamp] = __builtin_amdgcn_s_memrealtime(); ++nstamp; } while (0)

    p0_prologue(P, F);
    if (DUP & 1) p0_prologue(P, F);
    GRID_SYNC();
    {
        pg8::DenseSched S{T / 256, NZ / 256, F.G, (int)blockIdx.x, DM, (const char*)(ws + WS_WIN), (DUP & 2) ? 2 : 1};
        pg8::EpiQKNorm E{(bf16_t*)(ws + WS_Z), P.in[3], P.in[4]};
        pg8::gemm_phase<false>(stage, (const char*)(ws + WS_XN), DM, S, E);
    }
    GRID_SYNC();
    if (DUP & 4096) { for (int q = 0; q < 10; ++q) GRID_SYNC(); }
    attn_phase(P, F);
    if (DUP & 8) attn_phase(P, F);
    ml1_phase(P, F);
    if (DUP & 16) ml1_phase(P, F);
    GRID_SYNC();
    ml2_phase(P, F);
    GRID_SYNC();
    ml3_phase(P, F);
    if (DUP & 32) ml3_phase(P, F);
    GRID_SYNC();
    {
        pg8::DenseSched S{T / 256, DM / 256, F.G, (int)blockIdx.x, DM, (const char*)(ws + WS_WOUT), (DUP & 64) ? 2 : 1};
        pg8::EpiResF32 E{P.out, P.in[0], DM};
        pg8::gemm_phase<false>(stage, (const char*)(ws + WS_MIX), DM, S, E);
    }
    GRID_SYNC();
    if (DUP & 512) router_phase(P, F, false);
    router_phase(P, F, true);
    GRID_SYNC();
    build_tables(P, F);
    const LAS int* trs = (const LAS int*)(F.lds + LDS_TAB); const LAS int* cnts = trs + 64;
    {
        pg8::MoeSched<true> S{trs, cnts, 8, F.G, (int)blockIdx.x, DM / 2, (const char*)(ws + WS_WGU), (size_t)2 * DFF * DM, (const int*)(ws + WS_LTOK)};
        pg8::EpiSwiglu E{(unsigned char*)(ws + WS_ACT), P.in[17]};
        pg8::gemm_phase<true>(stage, (const char*)(ws + WS_H8), DM / 2, S, E);
    }
    GRID_SYNC();
    {
        pg8::MoeSched<false> S{trs, cnts, 4, F.G, (int)blockIdx.x, DFF / 2, (const char*)(ws + WS_WD), (size_t)DM * DFF, nullptr};
        pg8::EpiDown E{(bf16_t*)(ws + WS_Y), P.in[19], (const float*)(ws + WS_LGATE), cnts};
        pg8::gemm_phase<true>(stage, (const char*)(ws + WS_ACT), DFF / 2, S, E);
    }
    GRID_SYNC();
    if (DUP & 1024) combine_phase(P, F, false);
    combine_phase(P, F, true);
    if (TPROBE >= 0 && blockIdx.x == 0 && F.tid == 0) {
        tstamp[nstamp] = __builtin_amdgcn_s_memrealtime();
        const unsigned long long span = tstamp[TPROBE + 1] - tstamp[TPROBE], t0_ = __builtin_amdgcn_s_memrealtime();
        while (__builtin_amdgcn_s_memrealtime() - t0_ < 4ull * span) __builtin_amdgcn_s_sleep(8);
    }
}
}

extern "C" void kernel_launch(void* const* d_in, const int* in_sizes, int n_in, void* d_out, int out_size, void* d_ws, size_t ws_size, hipStream_t stream) {
    static int grid = 0;
    if (grid == 0) {
        if (n_in != 20 || out_size != T * DM || ws_size < WS_END) { fprintf(stderr, "kernel_launch: unexpected problem (n_in %d out %d ws %zu)\n", n_in, out_size, ws_size); grid = -1; return; }
        int dev = 0, cus = 0, per_cu = 0;
        (void)hipGetDevice(&dev);
        (void)hipDeviceGetAttribute(&cus, hipDeviceAttributeMultiprocessorCount, dev);
        (void)hipFuncSetAttribute((const void*)fwd_megakernel, hipFuncAttributeMaxDynamicSharedMemorySize, LDS_BYTES);
        (void)hipOccupancyMaxActiveBlocksPerMultiprocessor(&per_cu, (const void*)fwd_megakernel, NTHR, LDS_BYTES);
        if (per_cu < 1) { fprintf(stderr, "kernel_launch: occupancy query says %d blocks per CU\n", per_cu); per_cu = 1; }
        grid = cus;
    }
    if (grid < 0) return;
    (void)hipMemsetAsync((char*)d_ws + WS_CTL, 0, 65536, stream);
    Params p{};
    for (int i = 0; i < 20; ++i) p.in[i] = (const float*)d_in[i];
    p.out = (float*)d_out; p.ws = (unsigned char*)d_ws;
    hipLaunchKernelGGL(fwd_megakernel, dim3(grid), dim3(NTHR), LDS_BYTES, stream, p);
    const hipError_t e = hipPeekAtLastError();
    if (e != hipSuccess) fprintf(stderr, "launch failed: %s (grid %d)\n", hipGetErrorString(e), grid);
}
```

```cpp
#include <hip/hip_runtime.h>
#include <cstdio>
#include <cstdint>

#define LAS __attribute__((address_space(3)))
typedef unsigned short bf16_t;
typedef short bf16x8 __attribute__((ext_vector_type(8)));
typedef short s16x4 __attribute__((ext_vector_type(4)));
typedef float f32x4 __attribute__((ext_vector_type(4)));
typedef unsigned u32x4 __attribute__((ext_vector_type(4)));
typedef unsigned u32x2 __attribute__((ext_vector_type(2)));
typedef int i32x4 __attribute__((ext_vector_type(4)));
typedef int i32x8 __attribute__((ext_vector_type(8)));

namespace {
constexpr int BATCH = 2, SEQ = 8192, T = BATCH * SEQ, DM = 1024, DIN = 3080, NZ = 3072;
constexpr int NHA = 8, NHM = 4, HDM = 128;
constexpr int NE = 32, DFF = 1024;
constexpr int CH = 256, NCH = SEQ / CH;
constexpr float EPS = 1e-6f;
constexpr float LOG2E = 1.4426950408889634f;
constexpr float SC_W = 32.f, SC_H = 8.f, SC_A = 4.f;
constexpr int ZQ = 0, ZK = 512, ZV = 1024, ZXM = 1536, ZVM = 2048, ZOM = 2560;
constexpr int NWAVES = 8, NTHR = 512;
constexpr int TPROBE = -1;
constexpr int DUP = 0;
constexpr size_t MiB = 1u << 20;
constexpr size_t WS_CTL = 0;
constexpr size_t WS_WIN = 1 * MiB;
constexpr size_t WS_WOUT = 7 * MiB;
constexpr size_t WS_WQK = 9 * MiB;
constexpr size_t WS_WGU = 16 * MiB;
constexpr size_t WS_WD = 144 * MiB;
constexpr size_t WS_XN = 208 * MiB;
constexpr size_t WS_Z = 240 * MiB;
constexpr size_t WS_GATE = 336 * MiB;
constexpr size_t WS_QK = 353 * MiB;
constexpr size_t WS_BC = 385 * MiB;
constexpr size_t WS_IG = 385 * MiB + 512 * 1024;
constexpr size_t WS_BT = 386 * MiB;
constexpr size_t WS_NV = 386 * MiB + 4096;
constexpr size_t WS_U = 387 * MiB;
constexpr size_t WS_MIX = 403 * MiB;
constexpr size_t WS_LTOK = 435 * MiB;
constexpr size_t WS_LGATE = 437 * MiB;
constexpr size_t WS_TKE = 439 * MiB;
constexpr size_t WS_WRT = 439 * MiB + 512 * 1024;
constexpr size_t WS_H8 = 728 * MiB;
constexpr size_t WS_CS = 337 * MiB;
constexpr size_t WS_ACT = 440 * MiB;
constexpr size_t WS_Y = 584 * MiB;
constexpr size_t WS_END = 744 * MiB;
constexpr int LDS_STAGE = 0;
constexpr int LDS_TAB = 144384;
constexpr int LDS_BYTES = 144384 + 1024;

__device__ __forceinline__ unsigned f2bf(float f) { unsigned u = __builtin_bit_cast(unsigned, f); return (u + 0x7fffu + ((u >> 16) & 1u)) >> 16; }
__device__ __forceinline__ unsigned pk2(float lo, float hi) { return f2bf(lo) | (f2bf(hi) << 16); }
__device__ __forceinline__ unsigned pk4_fp8(float a, float b, float c, float d) { int w = 0; w = __builtin_amdgcn_cvt_pk_fp8_f32(a, b, w, false); w = __builtin_amdgcn_cvt_pk_fp8_f32(c, d, w, true); return (unsigned)w; }
__device__ __forceinline__ float bf2f(unsigned b) { return __builtin_bit_cast(float, b << 16); }
__device__ __forceinline__ float bflo(unsigned w) { return __builtin_bit_cast(float, w << 16); }
__device__ __forceinline__ float bfhi(unsigned w) { return __builtin_bit_cast(float, w & 0xffff0000u); }
__device__ __forceinline__ float wave_sum(float v) {
#pragma unroll
    for (int o = 1; o < 64; o <<= 1) v += __shfl_xor(v, o);
    return v;
}
__device__ __forceinline__ float sigmoidf_(float x) { return 1.0f / (1.0f + __expf(-x)); }
}

namespace pg8 {
constexpr int BM = 256, BK = 64, HALF = 128, HTB = HALF * BK * 2, STAGE_BYTES = 8 * HTB, NXCD = 8, WGM = 8;
__host__ __device__ __forceinline__ int lds_byte(int r, int c) { const int st = (r >> 4) * 2 + (c >> 5), rr = r & 15, cc = c & 31, ob = rr * 64 + cc * 2; return st * 1024 + (ob ^ (((ob >> 9) & 1) << 5)); }
__host__ __device__ __forceinline__ void stage_rc(int b, int& R, int& C) { const int st = b / 1024, sb = b % 1024, swz = sb ^ (((sb >> 9) & 1) << 5); R = (st >> 1) * 16 + swz / 64; C = (st & 1) * 32 + (swz % 64) / 2; }
__host__ __device__ __forceinline__ int perm32(int rho) { const int n = rho >> 4, i = rho & 15; return 8 * (i >> 2) + 4 * n + (i & 3); }

__device__ __forceinline__ bool tile_order(int i, int G, int c, int nM, int nN, int& pm, int& pn) {
    const int nwg = nM * nN; const long L = (long)i * G + c; if (L >= nwg) return false;
    int wgid = (int)L; { const int q = nwg / NXCD, r = nwg % NXCD, xcd = wgid % NXCD, off = wgid / NXCD; wgid = (xcd < r ? xcd * (q + 1) : r * (q + 1) + (xcd - r) * q) + off; }
    const int nig = WGM * nN, gid = wgid / nig, fm = gid * WGM, gsz = (nM - fm) < WGM ? (nM - fm) : WGM;
    pm = fm + ((wgid % nig) % gsz); pn = (wgid % nig) / gsz; return true;
}

struct Unit { int pm, pn, e, mt; };

struct DenseSched {
    int nM, nN, G, c, K; const char* Bt; int reps;
    static constexpr bool DRAIN = false, AFFINE = true;
    __device__ __forceinline__ bool next(int i, Unit& u) const { u.e = 0; u.mt = 0; const int per = (nM * nN + G - 1) / G; if (i >= per * reps) return false; if (!tile_order(i % per, G, c, nM, nN, u.pm, u.pn)) return tile_order(0, G, c, nM, nN, u.pm, u.pn); return true; }
    __device__ __forceinline__ void a_off(const Unit& u, const int (&R)[2], const int (&C)[2], unsigned (&off)[2][2]) const {
#pragma unroll
        for (int h = 0; h < 2; ++h)
#pragma unroll
            for (int i = 0; i < 2; ++i) off[h][i] = (unsigned)(((u.pm * BM + h * HALF + R[i]) * K + C[i]) * 2);
    }
    __device__ __forceinline__ const char* b_ptr(const Unit& u) const { return Bt + (size_t)u.pn * BM * K * 2; }
};
template <bool GATHER> struct MoeSched {
    const LAS int* trs; const LAS int* cnts; int nN, G, c, K; const char* Bt; size_t bstride; const int* ltok;
    static constexpr bool DRAIN = GATHER, AFFINE = !GATHER;
    __device__ __forceinline__ bool next(int i, Unit& u) const {
        const int nM = __builtin_amdgcn_readfirstlane(trs[NE]);
        if (!tile_order(i, G, c, nM, nN, u.pm, u.pn)) return false;
        const int ln = (int)(threadIdx.x & 63u); const int tv = trs[ln < NE ? ln : NE - 1];
        const int e = __popcll(__ballot(ln >= 1 && ln < NE && tv <= u.pm));
        u.e = e; u.mt = u.pm - __builtin_amdgcn_readfirstlane(trs[e]); return true;
    }
    __device__ __forceinline__ void a_rows(const Unit& u, const int (&R)[2], int (&row)[2][2]) const {
        const int n = __builtin_amdgcn_readfirstlane(cnts[u.e]);
#pragma unroll
        for (int h = 0; h < 2; ++h)
#pragma unroll
            for (int i = 0; i < 2; ++i) {
                if (GATHER) { const int p = u.mt * BM + h * HALF + R[i]; row[h][i] = (p < n) ? ltok[u.e * T + p] : 0; }
                else row[h][i] = u.pm * BM + h * HALF + R[i];
            }
    }
    __device__ __forceinline__ void a_off(const Unit& u, const int (&R)[2], const int (&C)[2], unsigned (&off)[2][2]) const {
        int row[2][2]; a_rows(u, R, row);
#pragma unroll
        for (int h = 0; h < 2; ++h)
#pragma unroll
            for (int i = 0; i < 2; ++i) off[h][i] = (unsigned)((row[h][i] * K + C[i]) * 2);
    }
    __device__ __forceinline__ const char* b_ptr(const Unit& u) const { return Bt + (size_t)u.e * bstride + (size_t)u.pn * BM * K * 2; }
};

struct EpiQKNorm {
    static constexpr bool PERM = true; static constexpr int BMAP = 1;
    bf16_t* O; const float* gq; const float* gk;
    __device__ __forceinline__ void operator()(const f32x4 (&acc)[2][2][4][2], const Unit& u, int wr, int wc, int fr, int fq) const {
        const int row0 = u.pm * BM + wr * 64 + fr, col0 = u.pn * BM + wc * 64 + 8 * fq;
        const bool nrm = u.pn < 4; const float* g = (u.pn < 2) ? gq : gk; const float qs = (u.pn < 2) ? 0.125f * LOG2E : 1.0f;
        f32x4 gv[2][2];
#pragma unroll
        for (int bj = 0; bj < 2; ++bj)
#pragma unroll
            for (int n = 0; n < 2; ++n) gv[bj][n] = nrm ? *(const f32x4*)(g + 32 * bj + 8 * fq + 4 * n) : (f32x4){1.f, 1.f, 1.f, 1.f};
#pragma unroll
        for (int ai = 0; ai < 2; ++ai)
#pragma unroll
            for (int m = 0; m < 4; ++m) { bf16_t* rowp = O + (size_t)(row0 + ai * HALF + m * 16) * NZ + col0;
                float sc = 1.0f;
                if (nrm) { float ss = 0.f;
#pragma unroll
                    for (int bj = 0; bj < 2; ++bj)
#pragma unroll
                        for (int n = 0; n < 2; ++n) { const f32x4 v = acc[ai][bj][m][n]; ss += v[0] * v[0] + v[1] * v[1] + v[2] * v[2] + v[3] * v[3]; }
                    ss += __shfl_xor(ss, 16); ss += __shfl_xor(ss, 32);
                    sc = qs / sqrtf(ss * (1.0f / 64.f) + EPS); }
#pragma unroll
                for (int bj = 0; bj < 2; ++bj) { const f32x4 v0 = acc[ai][bj][m][0] * gv[bj][0] * sc, v1 = acc[ai][bj][m][1] * gv[bj][1] * sc;
                    u32x4 w; w.x = pk2(v0[0], v0[1]); w.y = pk2(v0[2], v0[3]); w.z = pk2(v1[0], v1[1]); w.w = pk2(v1[2], v1[3]);
                    *(u32x4*)(rowp + bj * 32) = w; } }
    }
};
struct EpiResF32 {
    static constexpr bool PERM = false; static constexpr int BMAP = 0;
    float* C; const float* Rs; int ldc;
    __device__ __forceinline__ void operator()(const f32x4 (&acc)[2][2][4][2], const Unit& u, int wr, int wc, int fr, int fq) const {
        const int row0 = u.pm * BM + wr * 64 + fr, col0 = u.pn * BM + wc * 32 + 4 * fq;
#pragma unroll
        for (int ai = 0; ai < 2; ++ai)
#pragma unroll
            for (int mp = 0; mp < 2; ++mp) {
                f32x4 r[2][2][2];
#pragma unroll
                for (int mm = 0; mm < 2; ++mm) { const size_t ro = (size_t)(row0 + ai * HALF + (2 * mp + mm) * 16) * ldc + col0;
#pragma unroll
                    for (int bj = 0; bj < 2; ++bj)
#pragma unroll
                        for (int n = 0; n < 2; ++n) r[mm][bj][n] = __builtin_nontemporal_load((const f32x4*)(Rs + ro + bj * HALF + n * 16)); }
#pragma unroll
                for (int mm = 0; mm < 2; ++mm) { const size_t ro = (size_t)(row0 + ai * HALF + (2 * mp + mm) * 16) * ldc + col0;
#pragma unroll
                    for (int bj = 0; bj < 2; ++bj)
#pragma unroll
                        for (int n = 0; n < 2; ++n) *(f32x4*)(C + ro + bj * HALF + n * 16) = acc[ai][bj][2 * mp + mm][n] + r[mm][bj][n]; }
            }
    }
};
struct EpiSwiglu {
    static constexpr bool PERM = true; static constexpr int BMAP = 0;
    unsigned char* O; const float* bgu;
    __device__ __forceinline__ void operator()(const f32x4 (&acc)[2][2][4][2], const Unit& u, int wr, int wc, int fr, int fq) const {
        const int row0 = u.pm * BM + wr * 64 + fr, f0 = u.pn * HALF + wc * 32 + 8 * fq;
        const float* bg = bgu + (size_t)u.e * 2 * DFF + f0;
        constexpr float inv = 1.0f / (SC_H * SC_W);
        f32x4 bgv[2], buv[2];
#pragma unroll
        for (int n = 0; n < 2; ++n) { bgv[n] = *(const f32x4*)(bg + 4 * n); buv[n] = *(const f32x4*)(bg + DFF + 4 * n); }
#pragma unroll
        for (int ai = 0; ai < 2; ++ai)
#pragma unroll
            for (int m = 0; m < 4; ++m) { unsigned char* rowp = O + (size_t)(row0 + ai * HALF + m * 16) * DFF + f0;
                float r[8];
#pragma unroll
                for (int n = 0; n < 2; ++n) { const f32x4 gv = acc[ai][0][m][n] * inv + bgv[n], uv = acc[ai][1][m][n] * inv + buv[n];
#pragma unroll
                    for (int j = 0; j < 4; ++j) { const float gg = fminf(gv[j], 7.0f), uu = fminf(fmaxf(uv[j], -7.0f), 7.0f);
                        r[4 * n + j] = SC_A * gg * (uu + 1.0f) * __builtin_amdgcn_rcpf(1.0f + __builtin_amdgcn_exp2f(-1.702f * LOG2E * gg)); } }
                u32x2 w; w.x = pk4_fp8(r[0], r[1], r[2], r[3]); w.y = pk4_fp8(r[4], r[5], r[6], r[7]);
                *(u32x2*)rowp = w; }
    }
};
struct EpiDown {
    static constexpr bool PERM = true; static constexpr int BMAP = 0;
    bf16_t* O; const float* bd; const float* lgate; const LAS int* cnts;
    __device__ __forceinline__ void operator()(const f32x4 (&acc)[2][2][4][2], const Unit& u, int wr, int wc, int fr, int fq) const {
        const int row0 = u.pm * BM + wr * 64 + fr, col0 = u.pn * BM + wc * 32 + 8 * fq;
        const int n_e = cnts[u.e];
        f32x4 bv[2][2];
#pragma unroll
        for (int bj = 0; bj < 2; ++bj)
#pragma unroll
            for (int n = 0; n < 2; ++n) bv[bj][n] = *(const f32x4*)(bd + (size_t)u.e * DM + col0 + bj * HALF + 4 * n);
        float gts[2][4];
#pragma unroll
        for (int ai = 0; ai < 2; ++ai)
#pragma unroll
            for (int m = 0; m < 4; ++m) { const int p = u.mt * BM + wr * 64 + fr + ai * HALF + m * 16; gts[ai][m] = lgate[(size_t)u.e * T + (p < T ? p : T - 1)]; }
#pragma unroll
        for (int ai = 0; ai < 2; ++ai)
#pragma unroll
            for (int m = 0; m < 4; ++m) { const int rt = wr * 64 + fr + ai * HALF + m * 16, p = u.mt * BM + rt;
                const float gt = (p < n_e) ? gts[ai][m] : 0.f;
                bf16_t* rowp = O + (size_t)(row0 + ai * HALF + m * 16) * DM + col0;
#pragma unroll
                for (int bj = 0; bj < 2; ++bj) { const f32x4 v0 = (acc[ai][bj][m][0] * (1.0f / (SC_A * SC_W)) + bv[bj][0]) * gt, v1 = (acc[ai][bj][m][1] * (1.0f / (SC_A * SC_W)) + bv[bj][1]) * gt;
                    u32x4 w; w.x = pk2(v0[0], v0[1]); w.y = pk2(v0[2], v0[3]); w.z = pk2(v1[0], v1[1]); w.w = pk2(v1[2], v1[3]);
                    *(u32x4*)(rowp + bj * HALF) = w; } }
    }
};

template <bool FP8, class Epi, class Sched>
__device__ __forceinline__ void gemm_phase(LAS unsigned char* lds, const char* A0, const int K, const Sched& S, const Epi& E) {
    int tid = threadIdx.x; asm volatile("" : "+v"(tid));
    const int wid = __builtin_amdgcn_readfirstlane(tid >> 6), lane = tid & 63, wr = wid >> 2, wc = wid & 3, fr = lane & 15, fq = lane >> 4;
    const int nt = K / BK;
    int Rr[2], Cc[2]; unsigned voffB[2];
#pragma unroll
    for (int i = 0; i < 2; ++i) { stage_rc(tid * 16 + i * 8192, Rr[i], Cc[i]); const int r5 = Epi::PERM ? perm32(Rr[i] & 31) : (Rr[i] & 31); const int Rb = Epi::BMAP ? (64 * (Rr[i] >> 5) + r5) : ((Rr[i] & ~31) + r5); voffB[i] = (unsigned)(Rb * K + Cc[i]) * 2u; }
    const size_t kstep = (size_t)(BK * 2);
    const size_t hstep = (size_t)(Epi::BMAP ? 32 : HALF) * K * 2;
    const unsigned ldsw = (unsigned)wid * 1024u;
    const int aoff = lds_byte(wr * 64 + fr, fq * 8), boff = lds_byte(wc * 32 + fr, fq * 8);
#define PG8_SA(b, h) (((b) * 2 + (h)) * HTB)
#define PG8_SB(b, h) ((4 + (b) * 2 + (h)) * HTB)
#define PG8_STAGE_B(bufoff, gbase) do { _Pragma("unroll") for (int _i = 0; _i < 2; ++_i) \
        __builtin_amdgcn_global_load_lds((const unsigned*)((const char*)(gbase) + voffB[_i]), (LAS unsigned*)(lds + (bufoff) + ldsw + _i * 8192), 16, 0, 0); } while (0)
#define PG8_STAGE_A(bufoff, gbase, o0, o1) do { \
        __builtin_amdgcn_global_load_lds((const unsigned*)((const char*)(gbase) + (o0)), (LAS unsigned*)(lds + (bufoff) + ldsw), 16, 0, 0); \
        __builtin_amdgcn_global_load_lds((const unsigned*)((const char*)(gbase) + (o1)), (LAS unsigned*)(lds + (bufoff) + ldsw + 8192), 16, 0, 0); } while (0)
#define PG8_LDA(dst, b, h) do { if constexpr (FP8) { _Pragma("unroll") for (int m = 0; m < 4; ++m) { const i32x4 lo_ = *(const LAS i32x4*)(lds + PG8_SA(b, h) + aoff + m * 2048), hi_ = *(const LAS i32x4*)(lds + PG8_SA(b, h) + aoff + m * 2048 + 1024); \
            dst##8[m] = __builtin_shufflevector(lo_, hi_, 0, 1, 2, 3, 4, 5, 6, 7); } } \
        else { _Pragma("unroll") for (int m = 0; m < 4; ++m) _Pragma("unroll") for (int k = 0; k < 2; ++k) dst[m][k] = *(const LAS bf16x8*)(lds + PG8_SA(b, h) + aoff + m * 2048 + k * 1024); } } while (0)
#define PG8_LDB(dst, b, h) do { if constexpr (FP8) { _Pragma("unroll") for (int n = 0; n < 2; ++n) { const i32x4 lo_ = *(const LAS i32x4*)(lds + PG8_SB(b, h) + boff + n * 2048), hi_ = *(const LAS i32x4*)(lds + PG8_SB(b, h) + boff + n * 2048 + 1024); \
            dst##8[n] = __builtin_shufflevector(lo_, hi_, 0, 1, 2, 3, 4, 5, 6, 7); } } \
        else { _Pragma("unroll") for (int n = 0; n < 2; ++n) _Pragma("unroll") for (int k = 0; k < 2; ++k) dst[n][k] = *(const LAS bf16x8*)(lds + PG8_SB(b, h) + boff + n * 2048 + k * 1024); } } while (0)
#define PG8_MMA(ai, bj, At, Bt) do { __builtin_amdgcn_s_setprio(1); \
        if constexpr (FP8) { _Pragma("unroll") for (int m = 0; m < 4; ++m) _Pragma("unroll") for (int n = 0; n < 2; ++n) \
            asm volatile("s_nop 1\n\tv_mfma_f32_16x16x128_f8f6f4 %0, %1, %2, %0" : "+v"(acc[ai][bj][m][n]) : "v"(Bt##8[n]), "v"(At##8[m])); } \
        else { _Pragma("unroll") for (int m = 0; m < 4; ++m) _Pragma("unroll") for (int n = 0; n < 2; ++n) _Pragma("unroll") for (int k = 0; k < 2; ++k) \
            acc[ai][bj][m][n] = __builtin_amdgcn_mfma_f32_16x16x32_bf16(Bt[n][k], At[m][k], acc[ai][bj][m][n], 0, 0, 0); } \
        __builtin_amdgcn_s_setprio(0); } while (0)
#define PG8_WAIT_V(n) asm volatile("s_waitcnt vmcnt(" #n ")" ::: "memory")
#define PG8_WAIT_L(n) asm volatile("s_waitcnt lgkmcnt(" #n ")" ::: "memory")
#define PG8_BAR __builtin_amdgcn_s_barrier()
#define PG8_SCHED __builtin_amdgcn_sched_barrier(0)
    Unit cur, nxt; int ui = 0;
    if (!S.next(0, cur)) return;
    f32x4 acc[2][2][4][2];
#pragma unroll
    for (int a = 0; a < 2; ++a)
#pragma unroll
        for (int b = 0; b < 2; ++b)
#pragma unroll
            for (int m = 0; m < 4; ++m)
#pragma unroll
                for (int n = 0; n < 2; ++n) acc[a][b][m][n] = (f32x4){0.f, 0.f, 0.f, 0.f};
    bf16x8 At[4][2], B0[2][2], B1[2][2]; i32x8 At8[4], B08[2], B18[2];
    unsigned offC[2][2], offN[2][2];
    const char* uA = A0; const char* nA = A0;
    if constexpr (Sched::AFFINE) {
#pragma unroll
        for (int h = 0; h < 2; ++h)
#pragma unroll
            for (int i = 0; i < 2; ++i) offC[h][i] = (unsigned)(((h * HALF + Rr[i]) * K + Cc[i]) * 2);
        uA = A0 + (size_t)cur.pm * BM * K * 2;
    } else S.a_off(cur, Rr, Cc, offC);
    const char* cB = S.b_ptr(cur);
    int rowP[2][2] = {{0, 0}, {0, 0}}; Unit nx2;
    if constexpr (!Sched::AFFINE) { if (S.next(1, nx2)) S.a_rows(nx2, Rr, rowP); }
    if (Sched::DRAIN) PG8_WAIT_V(0);
    PG8_STAGE_B(PG8_SB(0, 0), cB); PG8_STAGE_B(PG8_SB(0, 1), cB + hstep); PG8_STAGE_A(PG8_SA(0, 0), uA, offC[0][0], offC[0][1]); PG8_STAGE_A(PG8_SA(0, 1), uA, offC[1][0], offC[1][1]);
    if (wr == 1) PG8_BAR;
    PG8_WAIT_V(2); PG8_BAR;
    PG8_STAGE_B(PG8_SB(1, 0), cB + kstep); PG8_STAGE_A(PG8_SA(1, 0), uA + kstep, offC[0][0], offC[0][1]); PG8_STAGE_B(PG8_SB(1, 1), cB + hstep + kstep);
    PG8_WAIT_V(6); PG8_BAR;
    for (;;) {
        const bool has_next = S.next(ui + 1, nxt);
        const char* nB = cB;
        if constexpr (Sched::AFFINE) { nA = uA; if (has_next) { nA = A0 + (size_t)nxt.pm * BM * K * 2; nB = S.b_ptr(nxt); } }
        else {
            if (has_next) { nB = S.b_ptr(nxt);
#pragma unroll
                for (int h = 0; h < 2; ++h)
#pragma unroll
                    for (int i = 0; i < 2; ++i) offN[h][i] = (unsigned)((rowP[h][i] * K + Cc[i]) * 2);
                if (S.next(ui + 2, nx2)) S.a_rows(nx2, Rr, rowP);
            } else {
#pragma unroll
                for (int h = 0; h < 2; ++h)
#pragma unroll
                    for (int i = 0; i < 2; ++i) offN[h][i] = offC[h][i];
            }
        }
        for (int t = 0; t < nt; t += 2) {
            const bool last = (t == nt - 2);
            const char* a1 = uA + (size_t)(t + 1) * kstep;
            const char* a2 = last ? nA : uA + (size_t)(t + 2) * kstep; const char* b2 = last ? nB : cB + (size_t)(t + 2) * kstep;
            const char* a3 = a2 + kstep; const char* b3 = b2 + kstep;
            unsigned o00 = offC[0][0], o01 = offC[0][1], o10 = offC[1][0], o11 = offC[1][1];
            if constexpr (!Sched::AFFINE) { if (last) { o00 = offN[0][0]; o01 = offN[0][1]; o10 = offN[1][0]; o11 = offN[1][1]; } }
            PG8_LDB(B0, 0, 0); PG8_LDB(B1, 0, 1); PG8_SCHED; PG8_LDA(At, 0, 0); PG8_STAGE_A(PG8_SA(1, 1), a1, offC[1][0], offC[1][1]);
            PG8_WAIT_V(8); PG8_WAIT_L(0); PG8_BAR; PG8_MMA(0, 0, At, B0); PG8_MMA(0, 1, At, B1); PG8_BAR; PG8_SCHED;
            PG8_LDA(At, 0, 1); PG8_STAGE_B(PG8_SB(0, 0), b2); PG8_STAGE_B(PG8_SB(0, 1), b2 + hstep); PG8_STAGE_A(PG8_SA(0, 0), a2, o00, o01);
            PG8_WAIT_V(8); PG8_WAIT_L(0); PG8_BAR; PG8_MMA(1, 0, At, B0); PG8_MMA(1, 1, At, B1); PG8_BAR; PG8_SCHED;
            PG8_LDB(B0, 1, 0); PG8_LDB(B1, 1, 1); PG8_SCHED; PG8_LDA(At, 1, 0); PG8_STAGE_A(PG8_SA(0, 1), a2, o10, o11);
            PG8_WAIT_V(8); PG8_WAIT_L(0); PG8_BAR; PG8_MMA(0, 0, At, B0); PG8_MMA(0, 1, At, B1); PG8_BAR; PG8_SCHED;
            PG8_LDA(At, 1, 1); PG8_STAGE_B(PG8_SB(1, 0), b3); PG8_STAGE_B(PG8_SB(1, 1), b3 + hstep); PG8_STAGE_A(PG8_SA(1, 0), a3, o00, o01);
            PG8_WAIT_V(8); PG8_WAIT_L(0); PG8_BAR; PG8_MMA(1, 0, At, B0); PG8_MMA(1, 1, At, B1); PG8_BAR; PG8_SCHED;
        }
        if (wr == 0) PG8_BAR;
        if constexpr (FP8) {
            asm volatile("s_nop 15\n\ts_nop 15" : "+v"(acc[0][0][0][0]), "+v"(acc[0][0][0][1]), "+v"(acc[0][0][1][0]), "+v"(acc[0][0][1][1]), "+v"(acc[0][0][2][0]), "+v"(acc[0][0][2][1]), "+v"(acc[0][0][3][0]), "+v"(acc[0][0][3][1]),
                                                    "+v"(acc[0][1][0][0]), "+v"(acc[0][1][0][1]), "+v"(acc[0][1][1][0]), "+v"(acc[0][1][1][1]), "+v"(acc[0][1][2][0]), "+v"(acc[0][1][2][1]), "+v"(acc[0][1][3][0]), "+v"(acc[0][1][3][1]));
            asm volatile("s_nop 0" : "+v"(acc[1][0][0][0]), "+v"(acc[1][0][0][1]), "+v"(acc[1][0][1][0]), "+v"(acc[1][0][1][1]), "+v"(acc[1][0][2][0]), "+v"(acc[1][0][2][1]), "+v"(acc[1][0][3][0]), "+v"(acc[1][0][3][1]),
                                   "+v"(acc[1][1][0][0]), "+v"(acc[1][1][0][1]), "+v"(acc[1][1][1][0]), "+v"(acc[1][1][1][1]), "+v"(acc[1][1][2][0]), "+v"(acc[1][1][2][1]), "+v"(acc[1][1][3][0]), "+v"(acc[1][1][3][1]));
        }
        E(acc, cur, wr, wc, fr, fq);
        if (!has_next) break;
#pragma unroll
        for (int a = 0; a < 2; ++a)
#pragma unroll
            for (int b = 0; b < 2; ++b)
#pragma unroll
                for (int m = 0; m < 4; ++m)
#pragma unroll
                    for (int n = 0; n < 2; ++n) acc[a][b][m][n] = (f32x4){0.f, 0.f, 0.f, 0.f};
        cur = nxt; cB = nB; ++ui;
        if constexpr (Sched::AFFINE) uA = nA;
        else {
#pragma unroll
            for (int h = 0; h < 2; ++h)
#pragma unroll
                for (int i = 0; i < 2; ++i) offC[h][i] = offN[h][i];
        }
        if (wr == 1) PG8_BAR;
    }
    PG8_WAIT_V(0);
    PG8_BAR;
#undef PG8_SA
#undef PG8_SB
#undef PG8_STAGE_A
#undef PG8_STAGE_B
#undef PG8_LDA
#undef PG8_LDB
#undef PG8_MMA
#undef PG8_WAIT_V
#undef PG8_WAIT_L
#undef PG8_BAR
#undef PG8_SCHED
}
}

namespace {
struct Params { const float* in[20]; float* out; unsigned char* ws; };

struct Frame {
    LAS unsigned char* lds;
    int tid, lane, wave, G, vcu, gw, ngw;
};

struct ConvItem { const float* src; unsigned char* dst; int ldw, ldt, kind; float scale; };
__device__ __forceinline__ void conv_load(const ConvItem& I, f32x4 (&v)[8], int lane) {
    const int r8 = lane >> 3, c4 = (lane & 7) * 4;
#pragma unroll
    for (int i = 0; i < 8; ++i) v[i] = __builtin_nontemporal_load((const f32x4*)(I.src + (size_t)(8 * i + r8) * I.ldw + c4));
}
__device__ __forceinline__ void conv_store(const ConvItem& I, const f32x4 (&v)[8], LAS float* scr, int lane) {
    const int r8 = lane >> 3, c4 = (lane & 7) * 4;
#pragma unroll
    for (int i = 0; i < 8; ++i) { LAS float* d = scr + (8 * i + r8) * 33 + c4; d[0] = v[i][0]; d[1] = v[i][1]; d[2] = v[i][2]; d[3] = v[i][3]; }
    asm volatile("s_waitcnt lgkmcnt(0)" ::: "memory");
    const float scale = I.scale;
    if (I.kind == 0) {
        const int c = lane & 7;
#pragma unroll
        for (int j = 0; j < 4; ++j) { const int n = (lane >> 3) + 8 * j; const LAS float* s = scr + (8 * c) * 33 + n;
            u32x4 o; o.x = pk2(s[0 * 33] * scale, s[1 * 33] * scale); o.y = pk2(s[2 * 33] * scale, s[3 * 33] * scale); o.z = pk2(s[4 * 33] * scale, s[5 * 33] * scale); o.w = pk2(s[6 * 33] * scale, s[7 * 33] * scale);
            *(u32x4*)(I.dst + ((size_t)n * I.ldt + 8 * c) * 2) = o; }
    } else {
        const int n = lane >> 1, kh = lane & 1; const LAS float* s = scr + (32 * kh) * 33 + n;
        unsigned w[8];
#pragma unroll
        for (int q = 0; q < 8; ++q) w[q] = pk4_fp8(s[(4 * q) * 33] * scale, s[(4 * q + 1) * 33] * scale, s[(4 * q + 2) * 33] * scale, s[(4 * q + 3) * 33] * scale);
        unsigned char* d = I.dst + (size_t)n * I.ldt + 32 * kh;
        *(u32x4*)d = (u32x4){w[0], w[1], w[2], w[3]}; *(u32x4*)(d + 16) = (u32x4){w[4], w[5], w[6], w[7]};
    }
    asm volatile("s_waitcnt lgkmcnt(0)" ::: "memory");
}
template <class GetItem>
__device__ __forceinline__ void conv_run(GetItem get, int first, int n, int stride, LAS float* scr, int lane) {
    if (first >= n) return;
    ConvItem A, B, C; f32x4 va[8], vb[8], vc[8];
    get(first, A); conv_load(A, va, lane);
    const bool hb = first + stride < n, hc = first + 2 * stride < n;
    B = A; C = A;
    if (hb) { get(first + stride, B); conv_load(B, vb, lane); }
    if (hc) { get(first + 2 * stride, C); conv_load(C, vc, lane); }
    for (int it = first; it < n; it += stride) {
        conv_store(A, va, scr, lane);
        A = B; B = C;
#pragma unroll
        for (int i = 0; i < 8; ++i) { va[i] = vb[i]; vb[i] = vc[i]; }
        const int nx = it + 3 * stride;
        if (nx < n) { get(nx, C); conv_load(C, vc, lane); }
    }
}
constexpr int I_GU = NE * 16 * 64, I_D = NE * 16 * 32;
__device__ __forceinline__ void moe_item(const Params& P, int r, ConvItem& I) {
    I.kind = 1; I.scale = SC_W; I.ldt = DM;
    if (r < I_GU) { const int e = r >> 10, kb = (r >> 6) & 15, nb = r & 63, n0 = 32 * nb, f = n0 & 1023, up = n0 >> 10;
        const int drow = (f >> 7) * 256 + up * 128 + (f & 127);
        I.src = P.in[16] + (size_t)e * DM * 2 * DFF + (size_t)(64 * kb) * 2 * DFF + n0; I.ldw = 2 * DFF;
        I.dst = P.ws + WS_WGU + (size_t)e * 2 * DFF * DM + (size_t)drow * DM + 64 * kb;
    } else { r -= I_GU; const int e = r >> 9, kb = (r >> 5) & 15, nb = r & 31;
        I.src = P.in[18] + (size_t)e * DFF * DM + (size_t)(64 * kb) * DM + 32 * nb; I.ldw = DM;
        I.dst = P.ws + WS_WD + (size_t)e * DM * DFF + (size_t)(32 * nb) * DFF + 64 * kb; }
}
__device__ __forceinline__ void moe_convert(const Params& P, Frame& F, int cw, int ncw) {
    LAS float* scr = (LAS float*)(F.lds + F.wave * 8448);
    conv_run([&](int r, ConvItem& I) { moe_item(P, r, I); }, cw, I_GU + I_D, ncw, scr, F.lane);
}

__device__ __forceinline__ void p0_prologue(const Params& P, Frame& F) {
    unsigned char* ws = P.ws;
    const float* w_in = P.in[2];
    LAS float* scr = (LAS float*)(F.lds + F.wave * 8448);
    LAS float* gwl = (LAS float*)(F.lds + 73728);
    for (int i = F.tid; i < 1024 * 8; i += NTHR) gwl[(i & 7) * 1024 + (i >> 3)] = w_in[(size_t)(i >> 3) * DIN + NZ + (i & 7)];
    __syncthreads();
    constexpr int I_IN = 16 * 96, I_OUT = 16 * 32, I_QK = 8 * 2 * 4, I_ZERO = 8 * 3;
    bf16_t* WqkT = (bf16_t*)(ws + WS_WQK);
    conv_run([&](int r, ConvItem& I) {
        I.kind = 0; I.scale = 1.f;
        if (r < I_IN) { const int kb = r / 96, nb = r % 96; I.src = w_in + (size_t)(64 * kb) * DIN + 32 * nb; I.ldw = DIN; I.dst = ws + WS_WIN + ((size_t)(32 * nb) * DM + 64 * kb) * 2; I.ldt = DM; return; }
        r -= I_IN;
        if (r < I_OUT) { const int kb = r / 32, nb = r % 32; I.src = P.in[12] + (size_t)(64 * kb) * DM + 32 * nb; I.ldw = DM; I.dst = ws + WS_WOUT + ((size_t)(32 * nb) * DM + 64 * kb) * 2; I.ldt = DM; return; }
        r -= I_OUT;
        { const int isk = r >> 5, h = (r >> 3) & 3, kb = (r >> 2) & 1, nb = r & 3;
            I.src = P.in[isk ? 8 : 7] + (size_t)h * 16384 + (size_t)(64 * kb) * 128 + 32 * nb; I.ldw = 128;
            I.dst = ws + WS_WQK + ((size_t)(isk * 512 + h * 128 + 32 * nb) * 512 + h * 128 + 64 * kb) * 2; I.ldt = 512; I.scale = isk ? 0.08838834764831845f : 1.f; }
    }, F.gw, I_IN + I_OUT + I_QK, F.ngw, scr, F.lane);
    moe_convert(P, F, F.gw, F.ngw);
    for (int r = F.gw; r < I_ZERO; r += F.ngw) {
        const int rb = r / 3, j = r % 3, cb = j + (j >= (rb & 3) ? 1 : 0);
        for (int q = F.lane; q < 128 * 16; q += 64) { const int rr = q >> 4, cc = q & 15; *(u32x4*)(WqkT + (size_t)(rb * 128 + rr) * 512 + cb * 128 + cc * 8) = (u32x4){0u, 0u, 0u, 0u}; }
    }
    {
        const float* wr = P.in[14]; float* wrt = (float*)(ws + WS_WRT);
        for (int idx = F.vcu * NTHR + F.tid; idx < DM * NE; idx += F.G * NTHR) wrt[(idx & 31) * DM + (idx >> 5)] = wr[idx];
    }
    const float* x = P.in[0]; const float* g1 = P.in[1];
    bf16_t* XN = (bf16_t*)(ws + WS_XN); float* GATE = (float*)(ws + WS_GATE);
    for (int row0 = F.gw; row0 < T; row0 += 2 * F.ngw) {
        f32x4 vv[2][4];
#pragma unroll
        for (int q = 0; q < 2; ++q) { const int row = row0 + q * F.ngw; const f32x4* xr = (const f32x4*)(x + (size_t)(row < T ? row : row0) * DM);
#pragma unroll
            for (int j = 0; j < 4; ++j) vv[q][j] = __builtin_nontemporal_load(xr + F.lane + 64 * j); }
#pragma unroll
        for (int q = 0; q < 2; ++q) {
            const int row = row0 + q * F.ngw; if (row >= T) break;
            float s = 0.f;
#pragma unroll
            for (int j = 0; j < 4; ++j) s += vv[q][j][0] * vv[q][j][0] + vv[q][j][1] * vv[q][j][1] + vv[q][j][2] * vv[q][j][2] + vv[q][j][3] * vv[q][j][3];
            s = wave_sum(s);
            const float rs = 1.0f / sqrtf(s * (1.0f / DM) + EPS);
            float ga[8];
#pragma unroll
            for (int c = 0; c < 8; ++c) ga[c] = 0.f;
#pragma unroll
            for (int j = 0; j < 4; ++j) { const f32x4 gg = ((const f32x4*)g1)[F.lane + 64 * j]; const f32x4 v = vv[q][j] * rs * gg;
                u32x2 w; w.x = pk2(v[0], v[1]); w.y = pk2(v[2], v[3]);
                *(u32x2*)(XN + (size_t)row * DM + 4 * (F.lane + 64 * j)) = w;
#pragma unroll
                for (int c = 0; c < 8; ++c) { const f32x4 wc = *(const LAS f32x4*)(gwl + c * 1024 + 4 * (F.lane + 64 * j)); ga[c] += v[0] * wc[0] + v[1] * wc[1] + v[2] * wc[2] + v[3] * wc[3]; } }
#pragma unroll
            for (int c = 0; c < 8; ++c) ga[c] = wave_sum(ga[c]);
            if (F.lane == 0) { *(f32x4*)(GATE + (size_t)row * 8) = (f32x4){ga[0], ga[1], ga[2], ga[3]}; *(f32x4*)(GATE + (size_t)row * 8 + 4) = (f32x4){ga[4], ga[5], ga[6], ga[7]}; }
        }
    }
}

#define MFMA16(a, b, c) __builtin_amdgcn_mfma_f32_16x16x32_bf16((a), (b), (c), 0, 0, 0)
struct AttBlk { int tlb, off, d, qb, m, b, h, pass, dual, endpass, nb0, edge; };
__device__ __forceinline__ void att_decode(int fb, int w, int vcu, int G, AttBlk& k) {
    const int ul = fb / 20, r = fb - 20 * ul;
    const int unit = vcu + ul * G; k.tlb = (unit & 31) * 256; k.h = (unit >> 5) & 7; k.b = unit >> 8;
    if (r < 5) { k.pass = 0; k.m = r; k.d = 1; k.off = 0; k.qb = 32 * w; k.dual = 1; k.endpass = (r == 4); }
    else if (r < 10) { k.pass = 1; k.m = r - 5; k.d = 4; k.off = w & 3; k.qb = 32 * (w >> 2); k.dual = 1; k.endpass = (r == 9); }
    else { const int t2 = (r - 10) / 5; k.pass = 2; k.m = (r - 10) - 5 * t2; k.d = 16; k.off = 2 * w + t2; k.qb = 0; k.dual = 0; k.endpass = (r == 19); }
    k.nb0 = k.dual ? k.qb - 128 : k.qb - 144;
    const int p0 = k.tlb + k.off; k.edge = (p0 + k.nb0 * k.d < 0) || (p0 + (k.qb + (k.dual ? 31 : 15)) * k.d > SEQ - 1);
}
__device__ __forceinline__ void attn_phase(const Params& P, Frame& F) {
    const bf16_t* Z = (const bf16_t*)(P.ws + WS_Z); bf16_t* MIX = (bf16_t*)(P.ws + WS_MIX);
    const int tid = F.tid;
    const int lane = tid & 63, i = lane & 15, g = lane >> 4, w = F.wave;
    float gm = fabsf(P.in[4][lane]);
#pragma unroll
    for (int o = 1; o < 64; o <<= 1) gm = fmaxf(gm, __shfl_xor(gm, o));
    const float kmax = 8.0f * gm * 1.01f;
    constexpr int OP = 272;
    LAS unsigned char* OL = F.lds;
    LAS float* LL = (LAS float*)(F.lds + 256 * OP);
    LAS unsigned char* vb = F.lds + 256 * OP + 1024 + w * 4608;
    const int vwr = (lane >> 3) * 144 + (lane & 7) * 16;
    const int vrd = (4 * g + (i >> 2)) * 144 + (i & 3) * 8;
    const int nunits = (512 - F.vcu + F.G - 1) / F.G, NFB = 20 * nunits;
    if (NFB <= 0) return;
#define ATT_WGBAR() do { asm volatile("s_waitcnt lgkmcnt(0)" ::: "memory"); __builtin_amdgcn_s_barrier(); asm volatile("" ::: "memory"); } while (0)
#define ATT_LOAD(kd, kfn, vrn) do { const bf16_t* Kh_ = Z + (size_t)(kd).b * SEQ * NZ + ZK + (kd).h * 64 + 8 * g; const bf16_t* Vh_ = Z + (size_t)(kd).b * SEQ * NZ + ZV + (kd).h * 64 + 8 * (lane & 7); \
        const int nb_ = (kd).nb0 + 32 * (kd).m, p0_ = (kd).tlb + (kd).off; \
        if ((kd).edge) { \
        _Pragma("unroll") for (int sb = 0; sb < 2; ++sb) { int kp = p0_ + (nb_ + 16 * sb + i) * (kd).d; kp = kp < 0 ? 0 : (kp > SEQ - 1 ? SEQ - 1 : kp); const bf16_t* kr = Kh_ + (size_t)kp * NZ; kfn[sb][0] = *(const bf16x8*)kr; kfn[sb][1] = *(const bf16x8*)(kr + 32); } \
        _Pragma("unroll") for (int c = 0; c < 4; ++c) { int kp = p0_ + (nb_ + 8 * c + (lane >> 3)) * (kd).d; kp = kp < 0 ? 0 : (kp > SEQ - 1 ? SEQ - 1 : kp); vrn[c] = *(const u32x4*)(Vh_ + (size_t)kp * NZ); } \
        } else { const size_t dz_ = (size_t)(kd).d * NZ; const bf16_t* kr0 = Kh_ + (size_t)(p0_ + (nb_ + i) * (kd).d) * NZ; const bf16_t* vr0 = Vh_ + (size_t)(p0_ + (nb_ + (lane >> 3)) * (kd).d) * NZ; \
        _Pragma("unroll") for (int sb = 0; sb < 2; ++sb) { const bf16_t* kr = kr0 + 16 * sb * dz_; kfn[sb][0] = *(const bf16x8*)kr; kfn[sb][1] = *(const bf16x8*)(kr + 32); } \
        _Pragma("unroll") for (int c = 0; c < 4; ++c) vrn[c] = *(const u32x4*)(vr0 + 8 * c * dz_); } } while (0)
#define ATT_LOADQ(kd, sub_, q0_, q1_) do { const bf16_t* qr_ = Z + (size_t)((kd).b * SEQ + (kd).tlb + (kd).off + (kd).d * ((kd).qb + i + 16 * (sub_))) * NZ + ZQ + (kd).h * 64 + 8 * g; q0_ = *(const bf16x8*)qr_; q1_ = *(const bf16x8*)(qr_ + 32); } while (0)
#define ATT_QREF(q0_, q1_, ref_) do { float ss_ = 0.f; _Pragma("unroll") for (int j = 0; j < 8; ++j) { const float a_ = bf2f((unsigned short)q0_[j]), c_ = bf2f((unsigned short)q1_[j]); ss_ += a_ * a_ + c_ * c_; } \
        ss_ += __shfl_xor(ss_, 16); ss_ += __shfl_xor(ss_, 32); ref_ = sqrtf(ss_) * kmax; } while (0)
#define ATT_SUB(q0_, q1_, ref_, ls_, i2_, pf_) do { f32x4 s_[2]; \
        _Pragma("unroll") for (int sb = 0; sb < 2; ++sb) { s_[sb] = MFMA16(kf[sb][0], q0_, ((f32x4){0.f, 0.f, 0.f, 0.f})); s_[sb] = MFMA16(kf[sb][1], q1_, s_[sb]); } \
        float p_[8]; \
        if (!cur.edge && cur.m >= 1 && cur.m <= 3) { \
            const float a0_ = (float)((qb + (i2_) - nb - 4 * g) * d); const float base_ = -slope2 * a0_ - (ref_), st_ = slope2 * (float)d; \
            _Pragma("unroll") for (int sb = 0; sb < 2; ++sb) _Pragma("unroll") for (int j = 0; j < 4; ++j) { const float pv_ = __builtin_amdgcn_exp2f(s_[sb][j] + (base_ + st_ * (float)(16 * sb + j))); p_[4 * sb + j] = pv_; ls_ += pv_; } \
        } else { \
            _Pragma("unroll") for (int sb = 0; sb < 2; ++sb) _Pragma("unroll") for (int j = 0; j < 4; ++j) { const int n_ = nb + 16 * sb + 4 * g + j, a_ = qb + (i2_) - n_; \
                const bool valid_ = (a_ >= 0) && (a_ <= 128) && (p0 + n_ * d >= 0); \
                const float pv_ = valid_ ? __builtin_amdgcn_exp2f(s_[sb][j] - slope2 * (float)(a_ * d) - (ref_)) : 0.f; p_[4 * sb + j] = pv_; ls_ += pv_; } \
        } \
        u32x4 pw_; pw_.x = pk2(p_[0], p_[1]); pw_.y = pk2(p_[2], p_[3]); pw_.z = pk2(p_[4], p_[5]); pw_.w = pk2(p_[6], p_[7]); pf_ = __builtin_bit_cast(bf16x8, pw_); } while (0)
#define ATT_MERGE(o_, ls_, row_) do { float l2_ = ls_; l2_ += __shfl_xor(l2_, 16); l2_ += __shfl_xor(l2_, 32); LAS f32x4* orow_ = (LAS f32x4*)(OL + (row_) * OP + 16 * g); \
        if (cur.pass == 0) { _Pragma("unroll") for (int dt = 0; dt < 4; ++dt) orow_[4 * dt] = o_[dt]; if (g == 0) LL[row_] = l2_; } \
        else { _Pragma("unroll") for (int dt = 0; dt < 4; ++dt) orow_[4 * dt] = orow_[4 * dt] + o_[dt]; if (g == 0) LL[row_] += l2_; } } while (0)
    bf16x8 kfa[2][2], kfb[2][2]; u32x4 vra[4], vrb[4]; bf16x8 qnA0, qnA1, qnB0, qnB1, qA0, qA1, qB0, qB1;
    AttBlk cur, nx;
    att_decode(0, w, F.vcu, F.G, cur);
    ATT_LOADQ(cur, 0, qnA0, qnA1); ATT_LOADQ(cur, 1, qnB0, qnB1);
    ATT_LOAD(cur, kfa, vra);
    att_decode(1, w, F.vcu, F.G, nx); ATT_LOAD(nx, kfb, vrb);
    f32x4 oA[4], oB[4]; float lsA = 0.f, lsB = 0.f, refA = 0.f, refB = 0.f, slope2 = 0.f;
    qB0 = qnB0; qB1 = qnB1;
#pragma unroll
    for (int dt = 0; dt < 4; ++dt) oB[dt] = (f32x4){0.f, 0.f, 0.f, 0.f};
    __syncthreads();
#pragma unroll 1
    for (int fb = 0; fb < NFB; ++fb) {
        att_decode(fb, w, F.vcu, F.G, cur);
        if (cur.m == 0) {
            qA0 = qnA0; qA1 = qnA1; ATT_QREF(qA0, qA1, refA);
            if (cur.dual) { qB0 = qnB0; qB1 = qnB1; ATT_QREF(qB0, qB1, refB); }
            if (fb + 5 < NFB) { att_decode(fb + 5, w, F.vcu, F.G, nx); ATT_LOADQ(nx, 0, qnA0, qnA1); if (nx.dual) ATT_LOADQ(nx, 1, qnB0, qnB1); }
            slope2 = exp2f(-(float)(cur.h + 1)) * LOG2E;
#pragma unroll
            for (int dt = 0; dt < 4; ++dt) { oA[dt] = (f32x4){0.f, 0.f, 0.f, 0.f}; oB[dt] = (f32x4){0.f, 0.f, 0.f, 0.f}; }
            lsA = 0.f; lsB = 0.f;
        }
        bf16x8 kf[2][2]; u32x4 vr[4];
#pragma unroll
        for (int sb = 0; sb < 2; ++sb) { kf[sb][0] = kfa[sb][0]; kf[sb][1] = kfa[sb][1]; kfa[sb][0] = kfb[sb][0]; kfa[sb][1] = kfb[sb][1]; }
#pragma unroll
        for (int c = 0; c < 4; ++c) { vr[c] = vra[c]; vra[c] = vrb[c]; }
        if (fb + 2 < NFB) { att_decode(fb + 2, w, F.vcu, F.G, nx); ATT_LOAD(nx, kfb, vrb); }
        const int d = cur.d, qb = cur.qb, nb = cur.nb0 + 32 * cur.m, p0 = cur.tlb + cur.off;
#pragma unroll
        for (int c = 0; c < 4; ++c) *(LAS u32x4*)(vb + vwr + c * 8 * 144) = vr[c];
        bf16x8 pfA, pfB = (bf16x8){0, 0, 0, 0, 0, 0, 0, 0};
        ATT_SUB(qA0, qA1, refA, lsA, i, pfA);
        if (cur.dual) ATT_SUB(qB0, qB1, refB, lsB, i + 16, pfB);
        if (cur.dual) {
#pragma unroll
            for (int dt = 0; dt < 4; ++dt) {
                const s16x4 v0 = __builtin_amdgcn_ds_read_tr16_b64_v4i16((LAS s16x4*)(vb + vrd + dt * 32));
                const s16x4 v1 = __builtin_amdgcn_ds_read_tr16_b64_v4i16((LAS s16x4*)(vb + vrd + 16 * 144 + dt * 32));
                const bf16x8 vf = (bf16x8){v0[0], v0[1], v0[2], v0[3], v1[0], v1[1], v1[2], v1[3]};
                oA[dt] = MFMA16(vf, pfA, oA[dt]); oB[dt] = MFMA16(vf, pfB, oB[dt]);
            }
        } else {
#pragma unroll
            for (int dt = 0; dt < 4; ++dt) {
                const s16x4 v0 = __builtin_amdgcn_ds_read_tr16_b64_v4i16((LAS s16x4*)(vb + vrd + dt * 32));
                const s16x4 v1 = __builtin_amdgcn_ds_read_tr16_b64_v4i16((LAS s16x4*)(vb + vrd + 16 * 144 + dt * 32));
                const bf16x8 vf = (bf16x8){v0[0], v0[1], v0[2], v0[3], v1[0], v1[1], v1[2], v1[3]};
                oA[dt] = MFMA16(vf, pfA, oA[dt]);
            }
        }
        if (cur.m == 4) {
            const int rowA = cur.off + d * (qb + i);
            ATT_MERGE(oA, lsA, rowA);
            if (cur.dual) { const int rowB = rowA + 16 * d; ATT_MERGE(oB, lsB, rowB); }
            if (cur.endpass) {
                ATT_WGBAR();
                if (cur.pass == 2) {
                    const int rw = tid >> 1, hf = tid & 1;
                    const float inv = 1.0f / LL[rw];
                    const LAS f32x4* orw = (const LAS f32x4*)(OL + rw * OP + hf * 128);
                    bf16_t* mrow = MIX + (size_t)(cur.b * SEQ + cur.tlb + rw) * DM + cur.h * 64 + hf * 32;
#pragma unroll
                    for (int q = 0; q < 4; ++q) { const f32x4 a0 = orw[2 * q] * inv, a1 = orw[2 * q + 1] * inv;
                        u32x4 wv_; wv_.x = pk2(a0[0], a0[1]); wv_.y = pk2(a0[2], a0[3]); wv_.z = pk2(a1[0], a1[1]); wv_.w = pk2(a1[2], a1[3]);
                        *(u32x4*)(mrow + 8 * q) = wv_; }
                    ATT_WGBAR();
                }
            }
        }
    }
#undef ATT_LOAD
#undef ATT_LOADQ
#undef ATT_QREF
#undef ATT_SUB
#undef ATT_MERGE
#undef ATT_WGBAR
    __syncthreads();
}

__device__ __forceinline__ bf16x8 tr2(LAS unsigned char* p0, LAS unsigned char* p1) {
    const s16x4 a = __builtin_amdgcn_ds_read_tr16_b64_v4i16((LAS s16x4*)p0);
    const s16x4 b = __builtin_amdgcn_ds_read_tr16_b64_v4i16((LAS s16x4*)p1);
    return (bf16x8){a[0], a[1], a[2], a[3], b[0], b[1], b[2], b[3]};
}

__device__ __forceinline__ void ml1_phase(const Params& P, Frame& F) {
    const bf16_t* Z = (const bf16_t*)(P.ws + WS_Z); bf16_t* QK = (bf16_t*)(P.ws + WS_QK); const float* GATE = (const float*)(P.ws + WS_GATE);
    const bf16_t* WqkT = (const bf16_t*)(P.ws + WS_WQK);
    float* BC = (float*)(P.ws + WS_BC); float* IG = (float*)(P.ws + WS_IG); float* BT = (float*)(P.ws + WS_BT); float* U = (float*)(P.ws + WS_U); float* NV = (float*)(P.ws + WS_NV);
    const float* bi = P.in[9]; const float* bf = P.in[10]; const float* cw = P.in[5]; const float* cb = P.in[6];
    constexpr int PIT = 272;
    LAS unsigned char* KIM = F.lds; LAS unsigned char* VIM = F.lds + 128 * PIT; LAS unsigned char* XIM = F.lds + 2 * 128 * PIT;
    LAS float* bc = (LAS float*)(F.lds + 3 * 128 * PIT); LAS float* wv = bc + 256;
    const int tid = F.tid;
    const int lane = tid & 63, i = lane & 15, g = lane >> 4, w = F.wave;
    bf16x8 ones;
#pragma unroll
    for (int j = 0; j < 8; ++j) ones[j] = (i == 0) ? (short)0x3F80 : (short)0;
    for (int unit = F.vcu; unit < 256; unit += F.G) {
        const int bh = unit / NCH, c = unit % NCH, b = bh / NHM, h = bh % NHM, t0 = b * SEQ + c * CH;
        float ig = 0.f;
        __syncthreads();
        if (tid < 256) { const float f = GATE[(size_t)(t0 + tid) * 8 + 4 + h] + bf[h];
            bc[tid] = fminf(f, 0.f) - log1pf(__expf(-fabsf(f)));
            ig = GATE[(size_t)(t0 + tid) * 8 + h] + bi[h]; }
        __syncthreads();
        if (w == 0) {
            const f32x4 a = *(const LAS f32x4*)(bc + 4 * lane);
            const float s1 = a[0], s2 = s1 + a[1], s3 = s2 + a[2], s4 = s3 + a[3];
            float x = s4;
#pragma unroll
            for (int off = 1; off < 64; off <<= 1) { const float v = __shfl_up(x, off); if (lane >= off) x += v; }
            const float ex = x - s4;
            *(LAS f32x4*)(bc + 4 * lane) = (f32x4){ex + s1, ex + s2, ex + s3, ex + s4};
        }
        __syncthreads();
        if (tid < 256) { BC[(size_t)(t0 + tid) * 4 + h] = bc[tid]; IG[(size_t)(t0 + tid) * 4 + h] = ig; wv[tid] = __expf(bc[255] - bc[tid] + ig); }
        if (tid == 0) BT[unit] = bc[255];
        bf16x8 wf[2][4];
#pragma unroll
        for (int e2 = 0; e2 < 2; ++e2) { const bf16_t* wp = WqkT + (size_t)((w >> 2) * 512 + h * 128 + 32 * (w & 3) + 16 * e2 + i) * 512 + h * 128 + 8 * g;
#pragma unroll
            for (int ks = 0; ks < 4; ++ks) wf[e2][ks] = *(const bf16x8*)(wp + 32 * ks); }
        f32x4 acc[9];
#pragma unroll
        for (int q = 0; q < 9; ++q) acc[q] = (f32x4){0.f, 0.f, 0.f, 0.f};
        for (int half = 0; half < 2; ++half) {
            __syncthreads();
#pragma unroll
            for (int q = 0; q < 4; ++q) { const int id = tid + 512 * q, row = id >> 4, c8 = (id & 15) * 8, sidx = half * 128 + row, tok = t0 + sidx, tl = c * CH + sidx;
                const int ch = h * 128 + c8;
                float a[8];
                { const f32x4 b0 = *(const f32x4*)(cb + ch), b1 = *(const f32x4*)(cb + ch + 4); a[0] = b0[0]; a[1] = b0[1]; a[2] = b0[2]; a[3] = b0[3]; a[4] = b1[0]; a[5] = b1[1]; a[6] = b1[2]; a[7] = b1[3]; }
#pragma unroll
                for (int j = 0; j < 4; ++j) { const int dt = 3 - j; if (tl - dt >= 0) {
                        const u32x4 xw = *(const u32x4*)(Z + (size_t)(tok - dt) * NZ + ZXM + ch);
                        const f32x4 w0 = *(const f32x4*)(cw + j * 512 + ch), w1 = *(const f32x4*)(cw + j * 512 + ch + 4);
                        a[0] += w0[0] * bflo(xw.x); a[1] += w0[1] * bfhi(xw.x); a[2] += w0[2] * bflo(xw.y); a[3] += w0[3] * bfhi(xw.y);
                        a[4] += w1[0] * bflo(xw.z); a[5] += w1[1] * bfhi(xw.z); a[6] += w1[2] * bflo(xw.w); a[7] += w1[3] * bfhi(xw.w); } }
#pragma unroll
                for (int j = 0; j < 8; ++j) a[j] = a[j] * sigmoidf_(a[j]);
                u32x4 o; o.x = pk2(a[0], a[1]); o.y = pk2(a[2], a[3]); o.z = pk2(a[4], a[5]); o.w = pk2(a[6], a[7]);
                *(LAS u32x4*)(XIM + row * PIT + c8 * 2) = o;
                *(LAS u32x4*)(VIM + row * PIT + c8 * 2) = *(const u32x4*)(Z + (size_t)tok * NZ + ZVM + ch); }
            __syncthreads();
#pragma unroll 2
            for (int tt = 0; tt < 8; ++tt) {
                bf16x8 xf[4];
#pragma unroll
                for (int ks = 0; ks < 4; ++ks) xf[ks] = *(const LAS bf16x8*)(XIM + (16 * tt + i) * PIT + (32 * ks + 8 * g) * 2);
                const int trow = 16 * tt + i, sidx = half * 128 + trow; const float ws_ = wv[sidx];
                bf16_t* qkrow = QK + (size_t)(t0 + sidx) * 1024 + (w >> 2) * 512 + h * 128 + 32 * (w & 3) + 4 * g;
#pragma unroll
                for (int e2 = 0; e2 < 2; ++e2) {
                    f32x4 d = (f32x4){0.f, 0.f, 0.f, 0.f};
#pragma unroll
                    for (int ks = 0; ks < 4; ++ks) d = MFMA16(wf[e2][ks], xf[ks], d);
                    u32x2 o; o.x = pk2(d[0], d[1]); o.y = pk2(d[2], d[3]);
                    *(u32x2*)(qkrow + 16 * e2) = o;
                    if (w >= 4) { u32x2 ok; ok.x = pk2(d[0] * ws_, d[1] * ws_); ok.y = pk2(d[2] * ws_, d[3] * ws_); *(LAS u32x2*)(KIM + trow * PIT + (32 * (w & 3) + 16 * e2 + 4 * g) * 2) = ok; }
                }
            }
            __syncthreads();
#pragma unroll
            for (int kk = 0; kk < 4; ++kk) {
                const int ro = (32 * kk + 8 * g + (i >> 2)) * PIT + (i & 3) * 8;
                const bf16x8 af = tr2(KIM + ro + 32 * w, KIM + ro + 4 * PIT + 32 * w);
#pragma unroll
                for (int et = 0; et < 8; ++et) { const bf16x8 bfr = tr2(VIM + ro + 32 * et, VIM + ro + 4 * PIT + 32 * et); acc[et] = MFMA16(af, bfr, acc[et]); }
                acc[8] = MFMA16(af, ones, acc[8]);
            }
        }
        float* up = U + (size_t)unit * 16384 + (size_t)(16 * w + 4 * g) * 128 + i;
#pragma unroll
        for (int et = 0; et < 8; ++et)
#pragma unroll
            for (int j = 0; j < 4; ++j) up[j * 128 + 16 * et] = acc[et][j];
        if (i == 0) {
#pragma unroll
            for (int j = 0; j < 4; ++j) NV[unit * 128 + 16 * w + 4 * g + j] = acc[8][j];
        }
    }
}

__device__ __forceinline__ void ml2_phase(const Params& P, Frame& F) {
    const float* BT = (const float*)(P.ws + WS_BT); const float* U = (const float*)(P.ws + WS_U); const float* NV = (const float*)(P.ws + WS_NV);
    bf16_t* CS = (bf16_t*)(P.ws + WS_CS); float* NS = (float*)(P.ws + WS_CS + 8 * MiB);
    for (int item = F.vcu; item < 256; item += F.G) {
        const int bh = item >> 5, sl = item & 31, el = sl * 512 + F.tid;
        float u[NCH];
#pragma unroll
        for (int c = 0; c < NCH; ++c) u[c] = U[(size_t)(bh * NCH + c) * 16384 + el];
        float st = 0.f;
#pragma unroll
        for (int c = 0; c < NCH; ++c) { CS[(size_t)(bh * NCH + c) * 16384 + el] = (bf16_t)f2bf(st); st = __expf(BT[bh * NCH + c]) * st + u[c]; }
        if (sl == 0 && F.tid < 128) { float n = 0.f;
            for (int c = 0; c < NCH; ++c) { NS[(bh * NCH + c) * 128 + F.tid] = n; n = __expf(BT[bh * NCH + c]) * n + NV[(bh * NCH + c) * 128 + F.tid]; } }
    }
}

__device__ __forceinline__ void ml3_phase(const Params& P, Frame& F) {
    const bf16_t* Z = (const bf16_t*)(P.ws + WS_Z); const bf16_t* QK = (const bf16_t*)(P.ws + WS_QK);
    const float* BC = (const float*)(P.ws + WS_BC); const float* IG = (const float*)(P.ws + WS_IG); const float* BT = (const float*)(P.ws + WS_BT);
    const float* U = (const float*)(P.ws + WS_U); const float* NV = (const float*)(P.ws + WS_NV); const float* gn = P.in[11];
    bf16_t* MIX = (bf16_t*)(P.ws + WS_MIX);
    constexpr int CP = 288, VP = 272;
    LAS unsigned char* CIM = F.lds;
    LAS unsigned char* VIM = F.lds + 128 * CP;
    LAS float* cs = (LAS float*)(F.lds + 128 * CP + 256 * VP);
    LAS float* bq = cs + 256;
    const int tid = F.tid;
    const int lane = tid & 63, i = lane & 15, g = lane >> 4, w = F.wave;
    for (int unit = F.vcu; unit < 256; unit += F.G) {
        const int bh = unit / NCH, c = unit % NCH, b = bh / NHM, h = bh % NHM, t0 = b * SEQ + c * CH;
        __syncthreads();
#pragma unroll
        for (int q = 0; q < 8; ++q) { const int id = tid + 512 * q, row = id >> 4, c8 = (id & 15) * 8;
            *(LAS u32x4*)(VIM + row * VP + c8 * 2) = *(const u32x4*)(Z + (size_t)(t0 + row) * NZ + ZVM + h * 128 + c8); }
        if (tid < 256) { const float bb = BC[(size_t)(t0 + tid) * 4 + h]; bq[tid] = bb; cs[tid] = IG[(size_t)(t0 + tid) * 4 + h] - bb; }
        {   const bf16_t* cs = (const bf16_t*)(P.ws + WS_CS) + (size_t)unit * 16384; const float* ns = (const float*)(P.ws + WS_CS + 8 * MiB) + unit * 128;
#pragma unroll
            for (int q = 0; q < 4; ++q) { const int id = tid + 512 * q, d = id >> 4, e8 = (id & 15) * 8; *(LAS u32x4*)(CIM + d * CP + e8 * 2) = *(const u32x4*)(cs + d * 128 + e8); }
            if (tid < 128) { *(LAS u32x4*)(CIM + tid * CP + 256) = (u32x4){f2bf(ns[tid]), 0u, 0u, 0u}; *(LAS u32x4*)(CIM + tid * CP + 272) = (u32x4){0u, 0u, 0u, 0u}; }
        }
        __syncthreads();
#pragma unroll 1
        for (int a = 0; a < 2; ++a) {
            const int qt = a ? 15 - w : w;
            bf16x8 qf[4];
            { const bf16_t* qp = QK + (size_t)(t0 + 16 * qt + i) * 1024 + h * 128 + 8 * g;
#pragma unroll
                for (int ks = 0; ks < 4; ++ks) qf[ks] = *(const bf16x8*)(qp + 32 * ks); }
            const float bt = bq[16 * qt + i];
            f32x4 acc[8]; float den;
            {
                f32x4 a8 = (f32x4){0.f, 0.f, 0.f, 0.f};
#pragma unroll
                for (int et = 0; et < 8; ++et) acc[et] = (f32x4){0.f, 0.f, 0.f, 0.f};
#pragma unroll
                for (int ks = 0; ks < 4; ++ks) {
                    const int ro = (32 * ks + 8 * g + (i >> 2)) * CP + (i & 3) * 8;
#pragma unroll
                    for (int et = 0; et < 8; ++et) { const bf16x8 cf = tr2(CIM + ro + 32 * et, CIM + ro + 4 * CP + 32 * et); acc[et] = MFMA16(cf, qf[ks], acc[et]); }
                    const bf16x8 cf = tr2(CIM + ro + 256, CIM + ro + 4 * CP + 256);
                    a8 = MFMA16(cf, qf[ks], a8);
                }
                const float eb = __expf(bt);
#pragma unroll
                for (int et = 0; et < 8; ++et) acc[et] = acc[et] * eb;
                den = (g == 0) ? a8[0] * eb : 0.f;
            }
            const int kbhi = qt >> 1;
#pragma unroll 1
            for (int kb = 0; kb <= kbhi; ++kb) {
                float p[8];
#pragma unroll
                for (int sb = 0; sb < 2; ++sb) {
                    const bf16_t* kp = QK + (size_t)(t0 + 32 * kb + 16 * sb + i) * 1024 + 512 + h * 128 + 8 * g;
                    f32x4 sacc = (f32x4){0.f, 0.f, 0.f, 0.f};
#pragma unroll
                    for (int ks = 0; ks < 4; ++ks) { const bf16x8 kf = *(const bf16x8*)(kp + 32 * ks); sacc = MFMA16(kf, qf[ks], sacc); }
                    const f32x4 cv = *(const LAS f32x4*)(cs + 32 * kb + 16 * sb + 4 * g);
#pragma unroll
                    for (int j = 0; j < 4; ++j) { const int srow = 32 * kb + 16 * sb + 4 * g + j, tcol = 16 * qt + i;
                        const float pv = (srow <= tcol) ? sacc[j] * __expf(bt + cv[j]) : 0.f;
                        p[4 * sb + j] = pv; den += pv; } }
                u32x4 pw; pw.x = pk2(p[0], p[1]); pw.y = pk2(p[2], p[3]); pw.z = pk2(p[4], p[5]); pw.w = pk2(p[6], p[7]);
                const bf16x8 pf = __builtin_bit_cast(bf16x8, pw);
                const int ro = (32 * kb + 4 * g + (i >> 2)) * VP + (i & 3) * 8;
#pragma unroll
                for (int et = 0; et < 8; ++et) { const bf16x8 vf = tr2(VIM + ro + 32 * et, VIM + ro + 16 * VP + 32 * et); acc[et] = MFMA16(vf, pf, acc[et]); }
            }
            float dn = den; dn += __shfl_xor(dn, 16); dn += __shfl_xor(dn, 32);
            const float dd = 1.0f / fmaxf(fabsf(dn), 1.0f);
            float ss = 0.f;
#pragma unroll
            for (int et = 0; et < 8; ++et) { acc[et] = acc[et] * dd; ss += acc[et][0] * acc[et][0] + acc[et][1] * acc[et][1] + acc[et][2] * acc[et][2] + acc[et][3] * acc[et][3]; }
            ss += __shfl_xor(ss, 16); ss += __shfl_xor(ss, 32);
            const float rstd = 1.0f / sqrtf(ss * (1.0f / HDM) + EPS);
            const int tok = t0 + 16 * qt + i;
#pragma unroll
            for (int et = 0; et < 8; ++et) { const int e0 = 16 * et + 4 * g;
                const u32x2 ow = *(const u32x2*)(Z + (size_t)tok * NZ + ZOM + h * 128 + e0);
                const f32x4 gv = *(const f32x4*)(gn + h * 128 + e0);
                const float r0 = sigmoidf_(bflo(ow.x)) * acc[et][0] * rstd * gv[0], r1 = sigmoidf_(bfhi(ow.x)) * acc[et][1] * rstd * gv[1];
                const float r2 = sigmoidf_(bflo(ow.y)) * acc[et][2] * rstd * gv[2], r3 = sigmoidf_(bfhi(ow.y)) * acc[et][3] * rstd * gv[3];
                u32x2 o; o.x = pk2(r0, r1); o.y = pk2(r2, r3);
                *(u32x2*)(MIX + (size_t)tok * DM + 512 + h * 128 + e0) = o; }
        }
    }
}

__device__ __forceinline__ void router_phase(const Params& P, Frame& F, const bool commit) {
    const float* X1 = P.out; const float* g2 = P.in[13]; const float* wrt = (const float*)(P.ws + WS_WRT); const float* br = P.in[15];
    unsigned char* H8 = P.ws + WS_H8; int* cnt = (int*)(P.ws + WS_CTL); int* ltok = (int*)(P.ws + WS_LTOK); float* lgate = (float*)(P.ws + WS_LGATE); int* tke = (int*)(P.ws + WS_TKE);
    constexpr int HP = 4112;
    LAS int* lcnt = (LAS int*)(F.lds);
    LAS int* pe = lcnt + 64;
    LAS float* pg = (LAS float*)(pe + 256);
    LAS float* lp = pg + 256;
    LAS unsigned char* him = F.lds + 12288;
    const int lane = F.lane, tid = F.tid, w = F.wave, i = lane & 15, g = lane >> 4;
    for (int chunk = F.vcu; chunk < T / 64; chunk += F.G) {
        __syncthreads();
        if (tid < 64) lcnt[tid] = 0;
        for (int hp = 0; hp < 2; ++hp) {
            __syncthreads();
#pragma unroll
            for (int tt = 0; tt < 4; ++tt) {
                const int tl = w * 4 + tt, tok = chunk * 64 + hp * 32 + tl;
                const f32x4* xr = (const f32x4*)(X1 + (size_t)tok * DM);
                f32x4 v[4]; float s = 0.f;
#pragma unroll
                for (int j = 0; j < 4; ++j) { v[j] = xr[lane + 64 * j]; s += v[j][0] * v[j][0] + v[j][1] * v[j][1] + v[j][2] * v[j][2] + v[j][3] * v[j][3]; }
                s = wave_sum(s);
                const float r = 1.0f / sqrtf(s * (1.0f / DM) + EPS);
#pragma unroll
                for (int j = 0; j < 4; ++j) { const f32x4 gg = ((const f32x4*)g2)[lane + 64 * j]; v[j] = v[j] * r * gg;
                    *(LAS f32x4*)(him + tl * HP + 16 * (lane + 64 * j)) = v[j];
                    *(unsigned*)(H8 + (size_t)tok * DM + 4 * (lane + 64 * j)) = pk4_fp8(v[j][0] * SC_H, v[j][1] * SC_H, v[j][2] * SC_H, v[j][3] * SC_H); }
            }
            __syncthreads();
            {   const int tt2 = w & 1, et = (w >> 1) & 1, kh = w >> 2;
                const float* ap = wrt + (size_t)(16 * et + i) * DM + 512 * kh + 4 * g;
                const LAS unsigned char* bp = him + (16 * tt2 + i) * HP + (512 * kh + 4 * g) * 4;
                f32x4 acc = (f32x4){0.f, 0.f, 0.f, 0.f}, acc1 = (f32x4){0.f, 0.f, 0.f, 0.f};
#pragma unroll 8
                for (int c = 0; c < 32; ++c) {
                    const f32x4 av = *(const f32x4*)(ap + 16 * c); const f32x4 bv = *(const LAS f32x4*)(bp + 64 * c);
                    acc = __builtin_amdgcn_mfma_f32_16x16x4f32(av[0], bv[0], acc, 0, 0, 0); acc1 = __builtin_amdgcn_mfma_f32_16x16x4f32(av[1], bv[1], acc1, 0, 0, 0);
                    acc = __builtin_amdgcn_mfma_f32_16x16x4f32(av[2], bv[2], acc, 0, 0, 0); acc1 = __builtin_amdgcn_mfma_f32_16x16x4f32(av[3], bv[3], acc1, 0, 0, 0);
                }
                acc = acc + acc1;
                *(LAS f32x4*)(lp + (kh * 32 + 16 * tt2 + i) * 32 + 16 * et + 4 * g) = acc;
            }
            __syncthreads();
            if (tid < 32) {
                const LAS float* l0 = lp + tid * 32; const LAS float* l1 = lp + (32 + tid) * 32;
                float tv0 = -INFINITY, tv1 = -INFINITY, tv2 = -INFINITY, tv3 = -INFINITY; int te0 = 0, te1 = 0, te2 = 0, te3 = 0;
#pragma unroll
                for (int e = 0; e < NE; ++e) {
                    const float x = (l0[e] + l1[e]) + br[e];
                    const bool g0 = x > tv0, g1 = x > tv1, g2_ = x > tv2, g3 = x > tv3;
                    tv3 = g2_ ? tv2 : (g3 ? x : tv3); te3 = g2_ ? te2 : (g3 ? e : te3);
                    tv2 = g1 ? tv1 : (g2_ ? x : tv2); te2 = g1 ? te1 : (g2_ ? e : te2);
                    tv1 = g0 ? tv0 : (g1 ? x : tv1); te1 = g0 ? te0 : (g1 ? e : te1);
                    tv0 = g0 ? x : tv0; te0 = g0 ? e : te0;
                }
                const float e1 = __expf(tv1 - tv0), e2 = __expf(tv2 - tv0), e3 = __expf(tv3 - tv0);
                const float inv = 1.0f / (1.0f + e1 + e2 + e3);
                const int tl = hp * 32 + tid;
                const int rk0 = __hip_atomic_fetch_add((int*)(lcnt + te0), 1, __ATOMIC_RELAXED, __HIP_MEMORY_SCOPE_WORKGROUP);
                const int rk1 = __hip_atomic_fetch_add((int*)(lcnt + te1), 1, __ATOMIC_RELAXED, __HIP_MEMORY_SCOPE_WORKGROUP);
                const int rk2 = __hip_atomic_fetch_add((int*)(lcnt + te2), 1, __ATOMIC_RELAXED, __HIP_MEMORY_SCOPE_WORKGROUP);
                const int rk3 = __hip_atomic_fetch_add((int*)(lcnt + te3), 1, __ATOMIC_RELAXED, __HIP_MEMORY_SCOPE_WORKGROUP);
                pe[tl * 4 + 0] = te0 | (rk0 << 8); pe[tl * 4 + 1] = te1 | (rk1 << 8); pe[tl * 4 + 2] = te2 | (rk2 << 8); pe[tl * 4 + 3] = te3 | (rk3 << 8);
                pg[tl * 4 + 0] = inv; pg[tl * 4 + 1] = e1 * inv; pg[tl * 4 + 2] = e2 * inv; pg[tl * 4 + 3] = e3 * inv;
            }
        }
        __syncthreads();
        if (tid < NE && commit) { const int n = lcnt[tid]; lcnt[32 + tid] = n ? atomicAdd(&cnt[64 * tid], n) : 0; }
        __syncthreads();
        if (tid < 256 && commit) { const int wq = pe[tid], ee = wq & 255, p = lcnt[32 + ee] + (wq >> 8), tok = chunk * 64 + (tid >> 2);
            ltok[ee * T + p] = tok; lgate[ee * T + p] = pg[tid]; tke[tok * 4 + (tid & 3)] = ee | (p << 8); }
    }
}

__device__ __forceinline__ void build_tables(const Params& P, Frame& F) {
    LAS int* trs = (LAS int*)(F.lds + LDS_TAB); LAS int* cnts = trs + 64;
    const int* cnt = (const int*)(P.ws + WS_CTL);
    if (F.tid == 0) { int a = 0; for (int e = 0; e < NE; ++e) { const int n = cnt[64 * e]; trs[e] = a; cnts[e] = n; a += (n + 255) >> 8; } trs[NE] = a; }
    __syncthreads();
}

__device__ __forceinline__ void combine_phase(const Params& P, Frame& F, const bool commit) {
    const LAS int* trs = (const LAS int*)(F.lds + LDS_TAB);
    const bf16_t* Y = (const bf16_t*)(P.ws + WS_Y); const int* tke = (const int*)(P.ws + WS_TKE);
    float* out = P.out; const int lane = F.lane;
    for (int tok = F.gw; tok < T; tok += F.ngw) {
        f32x4 a[4];
#pragma unroll
        for (int j = 0; j < 4; ++j) a[j] = *(const f32x4*)(out + (size_t)tok * DM + 4 * (lane + 64 * j));
#pragma unroll
        for (int k = 0; k < 4; ++k) { const int w = tke[tok * 4 + k], e = w & 255, p = w >> 8; const size_t slot = (size_t)trs[e] * 256 + p;
#pragma unroll
            for (int j = 0; j < 4; ++j) { const u32x2 y = *(const u32x2*)(Y + slot * DM + 4 * (lane + 64 * j)); a[j][0] += bflo(y.x); a[j][1] += bfhi(y.x); a[j][2] += bflo(y.y); a[j][3] += bfhi(y.y); } }
#pragma unroll
        for (int j = 0; j < 4; ++j) if (commit || a[j][0] == 123456.789f) *(f32x4*)(out + (size_t)tok * DM + 4 * (lane + 64 * j)) = a[j];
    }
}


#define XB_TMO      128
#define XB_XCNT(j)  (256  + 64 * (j))
#define XB_XSUB(j)  (1280 + 64 * (j))
#define XB_XGEN(j)  (2304 + 64 * (j))
#define XB_TOP      3328
#define XB_TOPGEN   3392
#define XCD_BAR_WORDS 3456
#define XB_SPIN_CAP (1u << 18)
__device__ __forceinline__ unsigned xb_ld(unsigned* p)              { return __hip_atomic_load(p, __ATOMIC_RELAXED, __HIP_MEMORY_SCOPE_AGENT); }
__device__ __forceinline__ unsigned xb_add(unsigned* p, unsigned v) { return __hip_atomic_fetch_add(p, v, __ATOMIC_RELAXED, __HIP_MEMORY_SCOPE_AGENT); }
__device__ __forceinline__ unsigned xb_xcc_id() { return (unsigned)__builtin_amdgcn_s_getreg((3 << 11) | 20) & 0xFu; }
#define XB_SPIN(cond, bar) do { unsigned _sp = 0; while (cond) { __builtin_amdgcn_s_sleep(1); \
    if ((++_sp & 255u) == 0u) { if (xb_ld(&(bar)[XB_TMO])) break; if (_sp > XB_SPIN_CAP) { atomicAdd(&(bar)[XB_TMO], 1u); break; } } } } while (0)
struct XcdBarrier { unsigned* bar; unsigned x; volatile LAS unsigned* st; };
__device__ __forceinline__ XcdBarrier xcd_barrier_post(unsigned* bar, volatile LAS unsigned* st) {
    XcdBarrier b; b.bar = bar; b.x = xb_xcc_id(); b.st = st;
    if (threadIdx.x == 0) (void)xb_add(&bar[XB_XCNT(b.x)], 1u);
    return b;
}
__device__ __forceinline__ void xcd_barrier_complete(unsigned* bar, unsigned x, unsigned& nloc, unsigned& nx) {
    const unsigned G = gridDim.x * gridDim.y * gridDim.z;
    unsigned sum, cnt, mine, sp = 0u;
    for (;;) {
        sum = 0u; cnt = 0u; mine = 0u;
#pragma unroll
        for (unsigned j = 0; j < 16; ++j) { const unsigned c = xb_ld(&bar[XB_XCNT(j)]); sum += c; cnt += (c > 0u) ? 1u : 0u; mine = (j == x) ? c : mine; }
        if (sum == G) break;
        __builtin_amdgcn_s_sleep(1);
        if ((++sp & 255u) == 0u) { if (xb_ld(&bar[XB_TMO])) break; if (sp > XB_SPIN_CAP) { atomicAdd(&bar[XB_TMO], 1u); break; } }
    }
    nloc = mine > 0u ? mine : 1u; nx = cnt > 0u ? cnt : 1u;
}
__device__ __forceinline__ void xcd_barrier2(const XcdBarrier& b, unsigned& epoch) {
    asm volatile("s_waitcnt vmcnt(0)" ::: "memory");
    __syncthreads();
    const unsigned ep = ++epoch;
    if (threadIdx.x < 64) {
        unsigned* bar = b.bar; const unsigned lane = threadIdx.x;
        unsigned mask = 0u;
        if (lane == 0) {
            __builtin_amdgcn_s_waitcnt(0);
            unsigned nloc = b.st[0], nx = b.st[1];
            if (nloc == 0u) { xcd_barrier_complete(bar, b.x, nloc, nx); unsigned m = 0u;
#pragma unroll
                for (unsigned j = 0; j < 16; ++j) m |= (xb_ld(&bar[XB_XCNT(j)]) > 0u) ? (1u << j) : 0u;
                b.st[0] = nloc; b.st[1] = nx; b.st[2] = m; }
            mask = b.st[2];
            const unsigned old = xb_add(&bar[XB_XSUB(b.x)], 1u);
            if (old + 1u == ep * nloc) {
                __builtin_amdgcn_fence(__ATOMIC_RELEASE, "agent");
                asm volatile("s_waitcnt vmcnt(0)" ::: "memory");
                __hip_atomic_store(&bar[XB_XGEN(b.x)], ep, __ATOMIC_RELAXED, __HIP_MEMORY_SCOPE_AGENT);
            }
        }
        mask = __builtin_amdgcn_readfirstlane(mask);
        unsigned sp = 0;
        for (;;) {
            const bool need = lane < 16u && ((mask >> lane) & 1u);
            const unsigned v = need ? xb_ld(&bar[XB_XGEN(lane)]) : ep;
            if (__all(v >= ep)) break;
            __builtin_amdgcn_s_sleep(1);
            if ((++sp & 255u) == 0u) { if (xb_ld(&bar[XB_TMO])) break; if (sp > XB_SPIN_CAP) { atomicAdd(&bar[XB_TMO], 1u); break; } }
        }
        __builtin_amdgcn_fence(__ATOMIC_ACQUIRE, "agent");
        asm volatile("s_waitcnt vmcnt(0)" ::: "memory");
    }
    __syncthreads();
}

__global__ void __launch_bounds__(NTHR) fwd_megakernel(Params P) {
    extern __shared__ __attribute__((aligned(16))) unsigned char lds_raw[];
    Frame F;
    F.lds = (LAS unsigned char*)lds_raw;
    F.tid = threadIdx.x; F.lane = F.tid & 63; F.wave = __builtin_amdgcn_readfirstlane(F.tid >> 6);
    F.G = gridDim.x; { const int bx = blockIdx.x; F.vcu = (F.G % 8 == 0) ? (bx % 8) * (F.G / 8) + bx / 8 : bx; }
    F.gw = F.vcu * NWAVES + F.wave; F.ngw = F.G * NWAVES;
    unsigned char* ws = P.ws;
    LAS unsigned char* stage = F.lds + LDS_STAGE;
    volatile LAS unsigned* bst = (volatile LAS unsigned*)(F.lds + LDS_TAB + 512);
    if (F.tid < 4) bst[F.tid] = 0u;
    __syncthreads();
    const XcdBarrier bar = xcd_barrier_post((unsigned*)(ws + WS_CTL) + 4096, bst);
    LAS unsigned long long* tstamp = (LAS unsigned long long*)(F.lds + LDS_TAB + 640); int nstamp = 0;
    if (TPROBE >= 0 && blockIdx.x == 0 && F.tid == 0) tstamp[nstamp] = __builtin_amdgcn_s_memrealtime();
    ++nstamp;
    unsigned bar_epoch = 0u;
#define GRID_SYNC() do { xcd_barrier2(bar, bar_epoch); if (TPROBE >= 0 && blockIdx.x == 0 && F.tid == 0) tstamp[nstamp] = __builtin_amdgcn_s_memrealtime(); ++nstamp; } while (0)

    p0_prologue(P, F);
    if (DUP & 1) p0_prologue(P, F);
    GRID_SYNC();
    {
        pg8::DenseSched S{T / 256, NZ / 256, F.G, (int)blockIdx.x, DM, (const char*)(ws + WS_WIN), (DUP & 2) ? 2 : 1};
        pg8::EpiQKNorm E{(bf16_t*)(ws + WS_Z), P.in[3], P.in[4]};
        pg8::gemm_phase<false>(stage, (const char*)(ws + WS_XN), DM, S, E);
    }
    GRID_SYNC();
    if (DUP & 4096) { for (int q = 0; q < 10; ++q) GRID_SYNC(); }
    attn_phase(P, F);
    if (DUP & 8) attn_phase(P, F);
    ml1_phase(P, F);
    if (DUP & 16) ml1_phase(P, F);
    GRID_SYNC();
    ml2_phase(P, F);
    GRID_SYNC();
    ml3_phase(P, F);
    if (DUP & 32) ml3_phase(P, F);
    GRID_SYNC();
    {
        pg8::DenseSched S{T / 256, DM / 256, F.G, (int)blockIdx.x, DM, (const char*)(ws + WS_WOUT), (DUP & 64) ? 2 : 1};
        pg8::EpiResF32 E{P.out, P.in[0], DM};
        pg8::gemm_phase<false>(stage, (const char*)(ws + WS_MIX), DM, S, E);
    }
    GRID_SYNC();
    if (DUP & 512) router_phase(P, F, false);
    router_phase(P, F, true);
    GRID_SYNC();
    build_tables(P, F);
    const LAS int* trs = (const LAS int*)(F.lds + LDS_TAB); const LAS int* cnts = trs + 64;
    {
        pg8::MoeSched<true> S{trs, cnts, 8, F.G, (int)blockIdx.x, DM / 2, (const char*)(ws + WS_WGU), (size_t)2 * DFF * DM, (const int*)(ws + WS_LTOK)};
        pg8::EpiSwiglu E{(unsigned char*)(ws + WS_ACT), P.in[17]};
        pg8::gemm_phase<true>(stage, (const char*)(ws + WS_H8), DM / 2, S, E);
    }
    GRID_SYNC();
    {
        pg8::MoeSched<false> S{trs, cnts, 4, F.G, (int)blockIdx.x, DFF / 2, (const char*)(ws + WS_WD), (size_t)DM * DFF, nullptr};
        pg8::EpiDown E{(bf16_t*)(ws + WS_Y), P.in[19], (const float*)(ws + WS_LGATE), cnts};
        pg8::gemm_phase<true>(stage, (const char*)(ws + WS_ACT), DFF / 2, S, E);
    }
    GRID_SYNC();
    if (DUP & 1024) combine_phase(P, F, false);
    combine_phase(P, F, true);
    if (TPROBE >= 0 && blockIdx.x == 0 && F.tid == 0) {
        tstamp[nstamp] = __builtin_amdgcn_s_memrealtime();
        const unsigned long long span = tstamp[TPROBE + 1] - tstamp[TPROBE], t0_ = __builtin_amdgcn_s_memrealtime();
        while (__builtin_amdgcn_s_memrealtime() - t0_ < 4ull * span) __builtin_amdgcn_s_sleep(8);
    }
}
}

extern "C" void kernel_launch(void* const* d_in, const int* in_sizes, int n_in, void* d_out, int out_size, void* d_ws, size_t ws_size, hipStream_t stream) {
    static int grid = 0;
    if (grid == 0) {
        if (n_in != 20 || out_size != T * DM || ws_size < WS_END) { fprintf(stderr, "kernel_launch: unexpected problem (n_in %d out %d ws %zu)\n", n_in, out_size, ws_size); grid = -1; return; }
        int dev = 0, cus = 0, per_cu = 0;
        (void)hipGetDevice(&dev);
        (void)hipDeviceGetAttribute(&cus, hipDeviceAttributeMultiprocessorCount, dev);
        (void)hipFuncSetAttribute((const void*)fwd_megakernel, hipFuncAttributeMaxDynamicSharedMemorySize, LDS_BYTES);
        (void)hipOccupancyMaxActiveBlocksPerMultiprocessor(&per_cu, (const void*)fwd_megakernel, NTHR, LDS_BYTES);
        if (per_cu < 1) { fprintf(stderr, "kernel_launch: occupancy query says %d blocks per CU\n", per_cu); per_cu = 1; }
        grid = cus;
    }
    if (grid < 0) return;
    (void)hipMemsetAsync((char*)d_ws + WS_CTL, 0, 65536, stream);
    Params p{};
    for (int i = 0; i < 20; ++i) p.in[i] = (const float*)d_in[i];
    p.out = (float*)d_out; p.ws = (unsigned char*)d_ws;
    hipLaunchKernelGGL(fwd_megakernel, dim3(grid), dim3(NTHR), LDS_BYTES, stream, p);
    const hipError_t e = hipPeekAtLastError();
    if (e != hipSuccess) fprintf(stderr, "launch failed: %s (grid %d)\n", hipGetErrorString(e), grid);
}
```
